# Optimizing an MI355X kernel written in HIP

```python
import jax, jax.numpy as jnp
from jax import lax
import numpy as np

D_MODEL = 2048
BATCH = 2
SEQ = 16384
DEPTH = 4
DEC_BATCH = 8
DEC_SEQ = 32
PAST_LEN = 1024

CHUNK = 64
D_MIX = D_MODEL // 2
HEAD_DIM = 128
D_SB = D_MIX // 2
D_FOX = D_MIX - D_SB
H_SB = D_SB // HEAD_DIM
H_FOX = D_FOX // HEAD_DIM
PLE_DIM = 256
Q_BLOCK = 128
K_BLOCK = 128
SUPER_BLOCK = 1024
EPS = 1e-6
NEG_BIG = -1e30
FORGET_BIAS = 3.0
D_IN = 4 * D_SB + 4 * D_FOX + H_FOX

kernel_name = "hymba_stickbreak_fox_streaming_step"


def rms_norm(x, g):
    xf = x.astype(jnp.float32)
    var = jnp.mean(xf * xf, axis=-1, keepdims=True)
    return (xf * lax.rsqrt(var + EPS)).astype(x.dtype) * g


def head_rms_norm(o, g, n_heads):
    B, T, _ = o.shape
    of = o.reshape(B, T, n_heads, HEAD_DIM).astype(jnp.float32)
    of = of * lax.rsqrt(jnp.mean(of * of, axis=-1, keepdims=True) + EPS)
    return of.reshape(B, T, n_heads * HEAD_DIM).astype(o.dtype) * g


def map_query_blocks(fn, *qs):
    T = qs[0].shape[1]
    if T <= Q_BLOCK:
        return fn(*qs)
    nb = T // Q_BLOCK

    def to_blocks(a):
        a = a.reshape(a.shape[0], nb, Q_BLOCK, *a.shape[2:])
        return jnp.moveaxis(a, 1, 0)

    out = lax.map(lambda blk: fn(*blk), tuple(to_blocks(a) for a in qs))
    out = jnp.moveaxis(out, 0, 1)
    return out.reshape(out.shape[0], T, *out.shape[3:])


def causal_sweep(block_fn, q_arrays, P, T):
    outs = []
    for start in range(0, T, SUPER_BLOCK):
        end = min(start + SUPER_BLOCK, T)
        n_keys = -(-(P + end) // K_BLOCK) * K_BLOCK
        qs = [a[:, start:end] for a in q_arrays]
        outs.append(map_query_blocks(lambda *b, n=n_keys: block_fn(n, *b), *qs))
    return outs[0] if len(outs) == 1 else jnp.concatenate(outs, axis=1)


def stick_breaking_attention(q, k, v, q_pos, k_pos, P, T):
    scale = HEAD_DIM ** -0.5
    after_in_block = jnp.tril(jnp.ones((K_BLOCK, K_BLOCK), jnp.float32), -1)

    def block(n_keys, qb, pb):
        kb, vb, kp = k[:, :n_keys], v[:, :n_keys], k_pos[:n_keys]
        nk = n_keys // K_BLOCK
        z = jnp.einsum("bqhd,bkhd->bhqk", qb, kb).astype(jnp.float32) * scale
        allowed = kp[None, None, None, :] < pb[:, None, :, None]
        log_1m_beta = jnp.where(allowed, jax.nn.log_sigmoid(-z), 0.0)
        Bq, Hq, Qq, _ = z.shape
        lb = log_1m_beta.reshape(Bq, Hq, Qq, nk, K_BLOCK)
        inner = jnp.einsum("bhqnp,pj->bhqnj", lb, after_in_block, precision=lax.Precision.HIGHEST)
        after_blocks = jnp.tril(jnp.ones((nk, nk), jnp.float32), -1)
        cross = jnp.einsum("bhqm,mn->bhqn", lb.sum(-1), after_blocks, precision=lax.Precision.HIGHEST)
        suffix = (inner + cross[..., None]).reshape(Bq, Hq, Qq, n_keys)
        w = jnp.where(allowed, jnp.exp(jax.nn.log_sigmoid(z) + suffix), 0.0)
        return jnp.einsum("bhqk,bkhd->bqhd", w.astype(vb.dtype), vb)

    return causal_sweep(block, [q, q_pos], P, T)


def forgetting_attention(q, k, v, q_cum, k_cum, q_pos, k_pos, P, T):
    scale = HEAD_DIM ** -0.5
    k_cum_h = jnp.transpose(k_cum, (0, 2, 1))

    def block(n_keys, qb, cb, pb):
        kb, vb, kp = k[:, :n_keys], v[:, :n_keys], k_pos[:n_keys]
        s = jnp.einsum("bqhd,bkhd->bhqk", qb, kb).astype(jnp.float32) * scale
        bias = jnp.transpose(cb, (0, 2, 1))[..., None] - k_cum_h[:, :, None, :n_keys]
        allowed = kp[None, None, None, :] <= pb[:, None, :, None]
        w = jax.nn.softmax(jnp.where(allowed, s + bias, NEG_BIG), axis=-1)
        return jnp.einsum("bhqk,bkhd->bqhd", w.astype(vb.dtype), vb)

    return causal_sweep(block, [q, q_cum, q_pos], P, T)


def trunk_layer(x, p_i, w_in, b_f, g_attn, g_osb, g_ofox, w_out, w_ple, g_ple, w_ple_gate, past):
    B, T, _ = x.shape
    h = rms_norm(x, g_attn)
    proj = h @ w_in
    sizes = [D_SB] * 4 + [D_FOX] * 4
    idx, acc = [], 0
    for s_ in sizes:
        acc += s_
        idx.append(acc)
    q_sb, k_sb, v_sb, z_sb, q_fx, k_fx, v_fx, z_fx, f_fx = jnp.split(proj, idx, axis=-1)
    q_sb = q_sb.reshape(B, T, H_SB, HEAD_DIM)
    k_sb = k_sb.reshape(B, T, H_SB, HEAD_DIM)
    v_sb = v_sb.reshape(B, T, H_SB, HEAD_DIM)
    q_fx = q_fx.reshape(B, T, H_FOX, HEAD_DIM)
    k_fx = k_fx.reshape(B, T, H_FOX, HEAD_DIM)
    v_fx = v_fx.reshape(B, T, H_FOX, HEAD_DIM)
    logf = jax.nn.log_sigmoid((f_fx + b_f).astype(jnp.float32))

    if past is None:
        P = 0
        ks_all, vs_all, kf_all, vf_all, logf_all = k_sb, v_sb, k_fx, v_fx, logf
    else:
        c_ksb, c_vsb, c_kfx, c_vfx, c_logf = past
        P = c_ksb.shape[1]
        ks_all = jnp.concatenate([c_ksb, k_sb], axis=1)
        vs_all = jnp.concatenate([c_vsb, v_sb], axis=1)
        kf_all = jnp.concatenate([c_kfx, k_fx], axis=1)
        vf_all = jnp.concatenate([c_vfx, v_fx], axis=1)
        logf_all = jnp.concatenate([c_logf.astype(jnp.float32), logf], axis=1)
    cum_all = lax.cumsum(logf_all, axis=1)
    q_cum = cum_all[:, P:]
    L = P + T
    n_pad = -(-L // K_BLOCK) * K_BLOCK - L

    def pad_rows(a):
        if n_pad == 0:
            return a
        return jnp.pad(a, ((0, 0), (0, n_pad)) + ((0, 0),) * (a.ndim - 2))

    k_pos = jnp.arange(L + n_pad, dtype=jnp.int32)
    q_pos = (P + jnp.arange(T, dtype=jnp.int32))[None, :]

    o_sb = stick_breaking_attention(q_sb, pad_rows(ks_all), pad_rows(vs_all), q_pos, k_pos, P, T)
    o_fx = forgetting_attention(q_fx, pad_rows(kf_all), pad_rows(vf_all), q_cum, pad_rows(cum_all),
                                q_pos, k_pos, P, T)
    o_sb = head_rms_norm(o_sb.reshape(B, T, D_SB), g_osb, H_SB) * jax.nn.silu(z_sb)
    o_fx = head_rms_norm(o_fx.reshape(B, T, D_FOX), g_ofox, H_FOX) * jax.nn.silu(z_fx)
    x = x + jnp.concatenate([o_sb, o_fx], axis=-1) @ w_out
    x = x + (p_i @ w_ple) * jax.nn.sigmoid(rms_norm(x, g_ple) @ w_ple_gate)
    return x, (k_sb, v_sb, k_fx, v_fx, logf.astype(x.dtype))


def setup_inputs(seed: int = 0) -> dict:
    key = jax.random.key(seed)
    ks = jax.random.split(key, 20)
    f32 = jnp.float32
    nrm = lambda k, shp, s=1.0: jax.random.normal(k, shp, f32) * s
    return {
        "x_prompt": nrm(ks[0], (BATCH, SEQ, D_MODEL)),
        "x_sample": nrm(ks[1], (DEC_BATCH, DEC_SEQ, D_MODEL)),
        "p_prompt": nrm(ks[2], (DEPTH, BATCH, SEQ, PLE_DIM)),
        "p_sample": nrm(ks[3], (DEPTH, DEC_BATCH, DEC_SEQ, PLE_DIM)),
        "cache_sb_k": nrm(ks[4], (DEPTH, DEC_BATCH, PAST_LEN, H_SB, HEAD_DIM)),
        "cache_sb_v": nrm(ks[5], (DEPTH, DEC_BATCH, PAST_LEN, H_SB, HEAD_DIM)),
        "cache_fox_k": nrm(ks[6], (DEPTH, DEC_BATCH, PAST_LEN, H_FOX, HEAD_DIM)),
        "cache_fox_v": nrm(ks[7], (DEPTH, DEC_BATCH, PAST_LEN, H_FOX, HEAD_DIM)),
        "cache_fox_logf": jax.nn.log_sigmoid(FORGET_BIAS + nrm(ks[8], (DEPTH, DEC_BATCH, PAST_LEN, H_FOX))),
        "w_in": nrm(ks[9], (DEPTH, D_MODEL, D_IN), D_MODEL ** -0.5),
        "b_forget": FORGET_BIAS + nrm(ks[10], (DEPTH, H_FOX), 0.5),
        "g_attn_norm": 1.0 + nrm(ks[11], (DEPTH, D_MODEL), 0.02),
        "g_out_sb": 1.0 + nrm(ks[12], (DEPTH, D_SB), 0.02),
        "g_out_fox": 1.0 + nrm(ks[13], (DEPTH, D_FOX), 0.02),
        "w_out": nrm(ks[14], (DEPTH, D_MIX, D_MODEL), D_MIX ** -0.5),
        "w_ple": nrm(ks[15], (DEPTH, PLE_DIM, D_MODEL), PLE_DIM ** -0.5),
        "g_ple_norm": 1.0 + nrm(ks[16], (DEPTH, D_MODEL), 0.02),
        "w_ple_gate": nrm(ks[17], (DEPTH, D_MODEL, D_MODEL), D_MODEL ** -0.5),
        "g_final": 1.0 + nrm(ks[18], (D_MODEL,), 0.02),
    }


def reference(x_prompt, x_sample, p_prompt, p_sample, cache_sb_k, cache_sb_v, cache_fox_k,
              cache_fox_v, cache_fox_logf, w_in, b_forget, g_attn_norm, g_out_sb, g_out_fox,
              w_out, w_ple, g_ple_norm, w_ple_gate, g_final):
    xp, xs = x_prompt, x_sample
    new_p = [[] for _ in range(5)]
    new_s = [[] for _ in range(5)]
    for i in range(DEPTH):
        lw = (w_in[i], b_forget[i], g_attn_norm[i], g_out_sb[i], g_out_fox[i], w_out[i],
              w_ple[i], g_ple_norm[i], w_ple_gate[i])
        xp, st_p = trunk_layer(xp, p_prompt[i], *lw, None)
        past = (cache_sb_k[i], cache_sb_v[i], cache_fox_k[i], cache_fox_v[i], cache_fox_logf[i])
        xs, st_s = trunk_layer(xs, p_sample[i], *lw, past)
        for j in range(5):
            new_p[j].append(st_p[j])
            new_s[j].append(st_s[j])
    y_prompt = rms_norm(xp, g_final)
    y_sample = rms_norm(xs, g_final)
    sb_k_prompt, sb_v_prompt, fox_k_prompt, fox_v_prompt, fox_logf_prompt = [jnp.stack(a, axis=0) for a in new_p]
    sb_k_sample, sb_v_sample, fox_k_sample, fox_v_sample, fox_logf_sample = [jnp.stack(a, axis=0) for a in new_s]
    return (y_prompt, y_sample, sb_k_prompt, sb_v_prompt, fox_k_prompt, fox_v_prompt, fox_logf_prompt,
            sb_k_sample, sb_v_sample, fox_k_sample, fox_v_sample, fox_logf_sample)
```

```cpp
#include <hip/hip_runtime.h>
#include <hip/hip_cooperative_groups.h>
#include <cstdio>
namespace cg = cooperative_groups;

#define LAS __attribute__((address_space(3)))
typedef unsigned short u16;
typedef short bf16x8 __attribute__((ext_vector_type(8)));
typedef float f32x4 __attribute__((ext_vector_type(4)));
typedef float f32x16 __attribute__((ext_vector_type(16)));
typedef unsigned u32x2 __attribute__((ext_vector_type(2)));
typedef unsigned u32x4 __attribute__((ext_vector_type(4)));

constexpr int D_MODEL = 2048, SEQ = 16384, DEPTH = 4, DEC_BATCH = 8, DEC_SEQ = 32, PAST = 1024;
constexpr int NP = 2 * SEQ, NS = DEC_BATCH * DEC_SEQ, NR = NP + NS;
constexpr int DMIX = 1024, D_IN = 4100, PLE = 256;
constexpr int SL = 1088;
constexpr float EPS = 1e-6f;
constexpr float LOG2E = 1.4426950408889634f;
constexpr float QSCALE = 0.08838834764831845f * LOG2E;
constexpr int NITEMS = 1024 + 64;

constexpr size_t O_Y = 0;
constexpr size_t O_KV_P = (size_t)NR * D_MODEL;
constexpr size_t KVP = (size_t)DEPTH * NP * 512;
constexpr size_t O_LOGF_P = O_KV_P + 4 * KVP;
constexpr size_t O_KV_S = O_LOGF_P + (size_t)DEPTH * NP * 4;
constexpr size_t KVS = (size_t)DEPTH * NS * 512;
constexpr size_t O_LOGF_S = O_KV_S + 4 * KVS;
constexpr size_t OUT_TOTAL = O_LOGF_S + (size_t)DEPTH * NS * 4;

constexpr size_t al256(size_t x) { return (x + 255) & ~(size_t)255; }
constexpr size_t W_WTIN = 0;
constexpr size_t W_WTOUT = W_WTIN + (size_t)DEPTH * 4096 * 2048 * 2;
constexpr size_t W_WTPLE = W_WTOUT + (size_t)DEPTH * 2048 * 1024 * 2;
constexpr size_t W_WTGATE = W_WTPLE + (size_t)DEPTH * 2048 * 256 * 2;
constexpr size_t W_WF = W_WTGATE + (size_t)DEPTH * 2048 * 2048 * 2;
constexpr size_t W_XBA = W_WF + (size_t)DEPTH * 2048 * 4 * 4;
constexpr size_t W_PB = W_XBA + (size_t)NR * 2048 * 2;
constexpr size_t W_R = W_PB + (size_t)DEPTH * NR * 256 * 2;
constexpr size_t W_QB = W_R;
constexpr size_t W_KBP = W_QB + (size_t)NR * 1024 * 2;
constexpr size_t W_VTP = W_KBP + (size_t)NP * 1024 * 2;
constexpr size_t W_ZB = W_VTP + (size_t)NP * 1024 * 2;
constexpr size_t W_PLEB = W_R;
constexpr size_t W_XBB = W_R + al256((size_t)NR * 2048 * 2);
constexpr size_t R_SIZE = 2 * al256((size_t)NR * 2048 * 2) + 4096;
static_assert(W_ZB + (size_t)NR * 1024 * 2 <= W_R + R_SIZE, "region R too small");
constexpr size_t W_KBS = W_R + R_SIZE;
constexpr size_t W_VTS = W_KBS + (size_t)DEPTH * DEC_BATCH * SL * 1024 * 2;
constexpr size_t W_OB = W_VTS + (size_t)DEPTH * DEC_BATCH * 8 * 128 * SL * 2;
constexpr size_t W_SSQA = W_OB + (size_t)NR * 1024 * 2;
constexpr size_t W_SSQB = W_SSQA + (size_t)NR * 32 * 4;
constexpr size_t W_CIN = W_SSQB + (size_t)NR * 32 * 4;
constexpr size_t W_SEGTOT = W_CIN + (size_t)NR * 4 * 4;
constexpr size_t W_CCUM = W_SEGTOT + al256((size_t)(NR / 32) * 4 * 4);
constexpr size_t W_CTR = W_CCUM + (size_t)DEPTH * DEC_BATCH * PAST * 4 * 4;
constexpr size_t W_END = W_CTR + 4096;

struct P {
    const float *x_prompt, *x_sample, *p_prompt, *p_sample, *c_sbk, *c_sbv, *c_fxk, *c_fxv, *c_logf, *w_in, *b_f, *g_attn, *g_osb, *g_ofox, *w_out, *w_ple, *g_ple, *w_gate, *g_final;
    float* out;
    unsigned char* ws;
};

__device__ __forceinline__ unsigned cvt_pk_bf16(float lo, float hi) { unsigned r; asm volatile("v_cvt_pk_bf16_f32 %0, %1, %2" : "=v"(r) : "v"(lo), "v"(hi)); return r; }
__device__ __forceinline__ float bf_lo(unsigned w) { return __uint_as_float(w << 16); }
__device__ __forceinline__ float bf_hi(unsigned w) { return __uint_as_float(w & 0xffff0000u); }
__device__ __forceinline__ float fexp2(float x) { return __builtin_amdgcn_exp2f(x); }
__device__ __forceinline__ float flog2(float x) { return __builtin_amdgcn_logf(x); }
__device__ __forceinline__ int opaque_tid(int wv) { int l; asm volatile("v_mbcnt_lo_u32_b32 %0, -1, 0\n\tv_mbcnt_hi_u32_b32 %0, -1, %0" : "=v"(l)); return wv * 64 + l; }

namespace pg8 {
constexpr int BM = 256, BK = 64, HALF = 128, HTB = HALF * BK * 2, STAGE_BYTES = 8 * HTB, NXCD = 8, WGM = 8;
__host__ __device__ __forceinline__ int lds_byte(int r, int c) { const int st = (r >> 4) * 2 + (c >> 5), rr = r & 15, cc = c & 31, ob = rr * 64 + cc * 2; return st * 1024 + (ob ^ (((ob >> 9) & 1) << 5)); }
__host__ __device__ __forceinline__ void stage_rc(int b, int& R, int& C) { const int st = b / 1024, sb = b % 1024, swz = sb ^ (((sb >> 9) & 1) << 5); R = (st >> 1) * 16 + swz / 64; C = (st & 1) * 32 + (swz % 64) / 2; }
struct Unit { int pm, pn; };
struct Gemm { const u16* A; const u16* Bt; int M, N, K; };
struct StaticOrder {
    int nM, nN, nwg, G, c;
    __device__ void init(int M, int N, int G_, int c_) { nM = M / BM; nN = N / BM; nwg = nM * nN; G = G_; c = c_; }
    __device__ bool next(int i, Unit& u) const {
        const long L = (long)i * G + c; if (L >= nwg) return false;
        int wgid = (int)L; { const int q = nwg / NXCD, r = nwg % NXCD, xcd = wgid % NXCD, off = wgid / NXCD; wgid = (xcd < r ? xcd * (q + 1) : r * (q + 1) + (xcd - r) * q) + off; }
        const int nig = WGM * nN, gid = wgid / nig, fm = gid * WGM, gsz = (nM - fm) < WGM ? (nM - fm) : WGM;
        u.pm = fm + ((wgid % nig) % gsz); u.pn = (wgid % nig) / gsz; return true;
    }
};

template <class Epi>
__device__ __forceinline__ void gemm_phase(int wv, LAS unsigned char* lds, const Gemm g, const StaticOrder& S, const Epi& E) {
    const int tid = opaque_tid(wv), wid = __builtin_amdgcn_readfirstlane(tid >> 6), lane = tid & 63, wr = wid >> 2, wc = wid & 3, fr = lane & 15, fq = lane >> 4;
    const int K = g.K, nt = K / BK;
    unsigned voffA[2], voffB[2];
#pragma unroll
    for (int i = 0; i < 2; ++i) { int R, C; stage_rc(tid * 16 + i * 8192, R, C); voffA[i] = (unsigned)(R * K + C) * 2u; voffB[i] = voffA[i]; }
    const size_t kstep = (size_t)(BK * 2);
    const size_t hstep = (size_t)HALF * K * 2;
    const size_t tstep = 2 * hstep;
    const unsigned ldsw = (unsigned)wid * 1024u;
    const int aoff = lds_byte(wr * 64 + fr, fq * 8), boff = lds_byte(wc * 32 + fr, fq * 8);
#define PG8_SA(b, h) (((b) * 2 + (h)) * HTB)
#define PG8_SB(b, h) ((4 + (b) * 2 + (h)) * HTB)
#define PG8_STAGE(bufoff, gbase, voff) do { _Pragma("unroll") for (int _i = 0; _i < 2; ++_i) \
        __builtin_amdgcn_global_load_lds((const unsigned*)((const char*)(gbase) + (voff)[_i]), (LAS unsigned*)(lds + (bufoff) + ldsw + _i * 8192), 16, 0, 0); } while (0)
#define PG8_LDA(dst, b, h) do { _Pragma("unroll") for (int m = 0; m < 4; ++m) _Pragma("unroll") for (int k = 0; k < 2; ++k) dst[m][k] = *(const LAS bf16x8*)(lds + PG8_SA(b, h) + aoff + m * 2048 + k * 1024); } while (0)
#define PG8_LDB(dst, b, h) do { _Pragma("unroll") for (int n = 0; n < 2; ++n) _Pragma("unroll") for (int k = 0; k < 2; ++k) dst[n][k] = *(const LAS bf16x8*)(lds + PG8_SB(b, h) + boff + n * 2048 + k * 1024); } while (0)
#define PG8_MMA(ai, bj, At, Bt) do { __builtin_amdgcn_s_setprio(1); _Pragma("unroll") for (int m = 0; m < 4; ++m) _Pragma("unroll") for (int n = 0; n < 2; ++n) _Pragma("unroll") for (int k = 0; k < 2; ++k) \
        acc[ai][bj][m][n] = __builtin_amdgcn_mfma_f32_16x16x32_bf16(Bt[n][k], At[m][k], acc[ai][bj][m][n], 0, 0, 0); __builtin_amdgcn_s_setprio(0); } while (0)
#define PG8_WAIT_V(n) asm volatile("s_waitcnt vmcnt(" #n ")" ::: "memory")
#define PG8_WAIT_L(n) asm volatile("s_waitcnt lgkmcnt(" #n ")" ::: "memory")
#define PG8_BAR __builtin_amdgcn_s_barrier()
#define PG8_SCHED __builtin_amdgcn_sched_barrier(0)
    Unit cur, nxt; int ui = 0;
    if (!S.next(0, cur)) return;
    f32x4 acc[2][2][4][2];
#pragma unroll
    for (int a = 0; a < 2; ++a)
#pragma unroll
        for (int b = 0; b < 2; ++b)
#pragma unroll
            for (int m = 0; m < 4; ++m)
#pragma unroll
                for (int n = 0; n < 2; ++n) acc[a][b][m][n] = (f32x4){0.f, 0.f, 0.f, 0.f};
    bf16x8 At[4][2], B0[2][2], B1[2][2];
    const char* cA = (const char*)g.A + (size_t)cur.pm * tstep; const char* cB = (const char*)g.Bt + (size_t)cur.pn * tstep;
    PG8_STAGE(PG8_SB(0, 0), cB, voffB); PG8_STAGE(PG8_SA(0, 0), cA, voffA); PG8_STAGE(PG8_SB(0, 1), cB + hstep, voffB); PG8_STAGE(PG8_SA(0, 1), cA + hstep, voffA);
    if (wr == 1) PG8_BAR;
    PG8_WAIT_V(4); PG8_BAR;
    PG8_STAGE(PG8_SB(1, 0), cB + kstep, voffB); PG8_STAGE(PG8_SA(1, 0), cA + kstep, voffA); PG8_STAGE(PG8_SB(1, 1), cB + hstep + kstep, voffB);
    PG8_WAIT_V(6); PG8_BAR;
    for (;;) {
        const bool has_next = S.next(ui + 1, nxt);
        const char* nA = has_next ? (const char*)g.A + (size_t)nxt.pm * tstep : cA; const char* nB = has_next ? (const char*)g.Bt + (size_t)nxt.pn * tstep : cB;
        for (int t = 0; t < nt; t += 2) {
            const bool last = (t == nt - 2);
            const char* a1 = cA + (size_t)(t + 1) * kstep;
            const char* a2 = last ? nA : cA + (size_t)(t + 2) * kstep; const char* b2 = last ? nB : cB + (size_t)(t + 2) * kstep;
            const char* a3 = a2 + kstep; const char* b3 = b2 + kstep;
            PG8_LDB(B0, 0, 0); PG8_SCHED; PG8_LDA(At, 0, 0); PG8_STAGE(PG8_SA(1, 1), a1 + hstep, voffA);
            PG8_WAIT_L(8); PG8_BAR; PG8_WAIT_L(0); PG8_MMA(0, 0, At, B0); PG8_BAR; PG8_SCHED;
            PG8_LDB(B1, 0, 1); PG8_STAGE(PG8_SB(0, 0), b2, voffB);
            PG8_BAR; PG8_WAIT_L(0); PG8_MMA(0, 1, At, B1); PG8_BAR;
            PG8_LDA(At, 0, 1); PG8_STAGE(PG8_SA(0, 0), a2, voffA);
            PG8_BAR; PG8_WAIT_L(0); PG8_MMA(1, 0, At, B0); PG8_BAR; PG8_SCHED;
            PG8_STAGE(PG8_SB(0, 1), b2 + hstep, voffB);
            PG8_WAIT_V(6); PG8_BAR; PG8_MMA(1, 1, At, B1); PG8_BAR;
            PG8_LDB(B0, 1, 0); PG8_SCHED; PG8_LDA(At, 1, 0); PG8_STAGE(PG8_SA(0, 1), a2 + hstep, voffA);
            PG8_WAIT_L(8); PG8_BAR; PG8_WAIT_L(0); PG8_MMA(0, 0, At, B0); PG8_BAR; PG8_SCHED;
            PG8_LDB(B1, 1, 1); PG8_STAGE(PG8_SB(1, 0), b3, voffB);
            PG8_BAR; PG8_WAIT_L(0); PG8_MMA(0, 1, At, B1); PG8_BAR;
            PG8_LDA(At, 1, 1); PG8_STAGE(PG8_SA(1, 0), a3, voffA);
            PG8_BAR; PG8_WAIT_L(0); PG8_MMA(1, 0, At, B0); PG8_BAR; PG8_SCHED;
            PG8_STAGE(PG8_SB(1, 1), b3 + hstep, voffB);
            PG8_WAIT_V(6); PG8_BAR; PG8_MMA(1, 1, At, B1); PG8_BAR;
        }
        E(acc, cur, wr, wc, fr, fq);
        if (!has_next) break;
#pragma unroll
        for (int a = 0; a < 2; ++a)
#pragma unroll
            for (int b = 0; b < 2; ++b)
#pragma unroll
                for (int m = 0; m < 4; ++m)
#pragma unroll
                    for (int n = 0; n < 2; ++n) acc[a][b][m][n] = (f32x4){0.f, 0.f, 0.f, 0.f};
        cur = nxt; cA = nA; cB = nB; ++ui;
    }
    PG8_WAIT_V(0);
    if (wr == 0) PG8_BAR;
    PG8_BAR;
#undef PG8_SA
#undef PG8_SB
#undef PG8_STAGE
#undef PG8_LDA
#undef PG8_LDB
#undef PG8_MMA
#undef PG8_WAIT_V
#undef PG8_WAIT_L
#undef PG8_BAR
#undef PG8_SCHED
}
}


__device__ __forceinline__ float row_rstd(const float* ssq, int row, int fq) {
    const f32x4* q = (const f32x4*)(ssq + (size_t)row * 32 + fq * 8);
    const f32x4 a = q[0], b = q[1];
    float s = (a.x + a.y) + (a.z + a.w) + (b.x + b.y) + (b.z + b.w);
    s += __shfl_xor(s, 16); s += __shfl_xor(s, 32);
    return rsqrtf(s * (1.f / 2048.f) + EPS);
}

struct EpiProj {
    P p; int layer;
    __device__ __forceinline__ void operator()(const f32x4 (&acc)[2][2][4][2], const pg8::Unit& u, int wr, int wc, int fr, int fq) const {
        const int group = u.pn >> 1, type = group & 3, br = group >> 2;
        const int cgb = (u.pn & 1) * 256 + wc * 32 + 4 * fq;
        const float* ssqA = (const float*)(p.ws + W_SSQA);
        u16* Qb = (u16*)(p.ws + W_QB); u16* Zb = (u16*)(p.ws + W_ZB);
#pragma unroll
        for (int ai = 0; ai < 2; ++ai)
#pragma unroll
            for (int m = 0; m < 4; ++m) {
                __builtin_amdgcn_sched_barrier(0);
                const int row = u.pm * 256 + ai * 128 + wr * 64 + m * 16 + fr;
                const float rs = row_rstd(ssqA, row, fq);
                if (type == 0) {
                    u16* q = Qb + (size_t)row * 1024 + br * 512 + cgb; const float sc = rs * QSCALE;
#pragma unroll
                    for (int bj = 0; bj < 2; ++bj)
#pragma unroll
                        for (int n = 0; n < 2; ++n) { const f32x4 v = acc[ai][bj][m][n] * sc; u32x2 w; w.x = cvt_pk_bf16(v.x, v.y); w.y = cvt_pk_bf16(v.z, v.w); *(u32x2*)(q + bj * 128 + n * 16) = w; }
                } else if (type == 3) {
                    u16* z = Zb + (size_t)row * 1024 + br * 512 + cgb;
#pragma unroll
                    for (int bj = 0; bj < 2; ++bj)
#pragma unroll
                        for (int n = 0; n < 2; ++n) { f32x4 v = acc[ai][bj][m][n] * rs;
#pragma unroll
                            for (int j = 0; j < 4; ++j) v[j] = v[j] / (1.f + __expf(-v[j]));
                            u32x2 w; w.x = cvt_pk_bf16(v.x, v.y); w.y = cvt_pk_bf16(v.z, v.w); *(u32x2*)(z + bj * 128 + n * 16) = w; }
                } else {
                    float* o32; u16* kb; u16* vt; size_t vld;
                    if (row < NP) { const int b = row >> 14, t = row & (SEQ - 1);
                        o32 = p.out + O_KV_P + (size_t)(br * 2 + (type - 1)) * KVP + ((size_t)(layer * 2 + b) * SEQ + t) * 512;
                        kb = (u16*)(p.ws + W_KBP) + (size_t)row * 1024 + br * 512;
                        vt = (u16*)(p.ws + W_VTP) + (size_t)(b * 8 + br * 4) * 128 * SEQ + t; vld = SEQ;
                    } else { const int rr = row - NP, sb = rr >> 5, t = rr & 31;
                        o32 = p.out + O_KV_S + (size_t)(br * 2 + (type - 1)) * KVS + ((size_t)(layer * 8 + sb) * 32 + t) * 512;
                        kb = (u16*)(p.ws + W_KBS) + ((size_t)(layer * 8 + sb) * SL + PAST + t) * 1024 + br * 512;
                        vt = (u16*)(p.ws + W_VTS) + (size_t)((layer * 8 + sb) * 8 + br * 4) * 128 * SL + PAST + t; vld = SL;
                    }
#pragma unroll
                    for (int bj = 0; bj < 2; ++bj)
#pragma unroll
                        for (int n = 0; n < 2; ++n) { const f32x4 v = acc[ai][bj][m][n] * rs; const int cg = cgb + bj * 128 + n * 16;
                            *(f32x4*)(o32 + cg) = v;
                            if (type == 1) { u32x2 w; w.x = cvt_pk_bf16(v.x, v.y); w.y = cvt_pk_bf16(v.z, v.w); *(u32x2*)(kb + cg) = w; }
                            else { const unsigned w0 = cvt_pk_bf16(v.x, v.y), w1 = cvt_pk_bf16(v.z, v.w);
                                vt[(size_t)(cg + 0) * vld] = (u16)(w0 & 0xffffu); vt[(size_t)(cg + 1) * vld] = (u16)(w0 >> 16);
                                vt[(size_t)(cg + 2) * vld] = (u16)(w1 & 0xffffu); vt[(size_t)(cg + 3) * vld] = (u16)(w1 >> 16); } }
                }
            }
    }
};

struct EpiOut {
    P p;
    __device__ __forceinline__ void operator()(const f32x4 (&acc)[2][2][4][2], const pg8::Unit& u, int wr, int wc, int fr, int fq) const {
        float* ssqB = (float*)(p.ws + W_SSQB); u16* XbB = (u16*)(p.ws + W_XBB);
        const int c0 = u.pn * 256 + wc * 32 + 4 * fq;
#pragma unroll
        for (int ai = 0; ai < 2; ++ai)
#pragma unroll
            for (int m = 0; m < 4; ++m) {
                __builtin_amdgcn_sched_barrier(0);
                const int row = u.pm * 256 + ai * 128 + wr * 64 + m * 16 + fr;
                float* xr = p.out + (size_t)row * 2048 + c0; u16* xb = XbB + (size_t)row * 2048 + c0; float ss = 0.f;
#pragma unroll
                for (int bj = 0; bj < 2; ++bj)
#pragma unroll
                    for (int n = 0; n < 2; ++n) { f32x4 v = *(const f32x4*)(xr + bj * 128 + n * 16) + acc[ai][bj][m][n]; *(f32x4*)(xr + bj * 128 + n * 16) = v;
                        ss += v.x * v.x + v.y * v.y + v.z * v.z + v.w * v.w;
                        u32x2 w; w.x = cvt_pk_bf16(v.x, v.y); w.y = cvt_pk_bf16(v.z, v.w); *(u32x2*)(xb + bj * 128 + n * 16) = w; }
                ss += __shfl_xor(ss, 16); ss += __shfl_xor(ss, 32);
                if (fq == 0) ssqB[(size_t)row * 32 + u.pn * 4 + wc] = ss;
            }
    }
};

struct EpiPle {
    P p;
    __device__ __forceinline__ void operator()(const f32x4 (&acc)[2][2][4][2], const pg8::Unit& u, int wr, int wc, int fr, int fq) const {
        u16* O = (u16*)(p.ws + W_PLEB); const int c0 = u.pn * 256 + wc * 32 + 4 * fq;
#pragma unroll
        for (int ai = 0; ai < 2; ++ai)
#pragma unroll
            for (int m = 0; m < 4; ++m) { __builtin_amdgcn_sched_barrier(0); const int row = u.pm * 256 + ai * 128 + wr * 64 + m * 16 + fr; u16* o = O + (size_t)row * 2048 + c0;
#pragma unroll
                for (int bj = 0; bj < 2; ++bj)
#pragma unroll
                    for (int n = 0; n < 2; ++n) { const f32x4 v = acc[ai][bj][m][n]; u32x2 w; w.x = cvt_pk_bf16(v.x, v.y); w.y = cvt_pk_bf16(v.z, v.w); *(u32x2*)(o + bj * 128 + n * 16) = w; } }
    }
};

struct EpiGate {
    P p;
    __device__ __forceinline__ void operator()(const f32x4 (&acc)[2][2][4][2], const pg8::Unit& u, int wr, int wc, int fr, int fq) const {
        const float* ssqB = (const float*)(p.ws + W_SSQB); float* ssqA = (float*)(p.ws + W_SSQA); u16* XbA = (u16*)(p.ws + W_XBA); const u16* PL = (const u16*)(p.ws + W_PLEB);
        const int c0 = u.pn * 256 + wc * 32 + 4 * fq;
#pragma unroll
        for (int ai = 0; ai < 2; ++ai)
#pragma unroll
            for (int m = 0; m < 4; ++m) {
                __builtin_amdgcn_sched_barrier(0);
                const int row = u.pm * 256 + ai * 128 + wr * 64 + m * 16 + fr;
                const float rs = row_rstd(ssqB, row, fq);
                float* xr = p.out + (size_t)row * 2048 + c0; u16* xb = XbA + (size_t)row * 2048 + c0; const u16* pl = PL + (size_t)row * 2048 + c0; float ss = 0.f;
#pragma unroll
                for (int bj = 0; bj < 2; ++bj)
#pragma unroll
                    for (int n = 0; n < 2; ++n) { const f32x4 a = acc[ai][bj][m][n] * rs; const u32x2 pw = *(const u32x2*)(pl + bj * 128 + n * 16);
                        f32x4 v = *(const f32x4*)(xr + bj * 128 + n * 16);
                        v.x += bf_lo(pw.x) / (1.f + __expf(-a.x)); v.y += bf_hi(pw.x) / (1.f + __expf(-a.y)); v.z += bf_lo(pw.y) / (1.f + __expf(-a.z)); v.w += bf_hi(pw.y) / (1.f + __expf(-a.w));
                        *(f32x4*)(xr + bj * 128 + n * 16) = v;
                        ss += v.x * v.x + v.y * v.y + v.z * v.z + v.w * v.w;
                        u32x2 w; w.x = cvt_pk_bf16(v.x, v.y); w.y = cvt_pk_bf16(v.z, v.w); *(u32x2*)(xb + bj * 128 + n * 16) = w; }
                ss += __shfl_xor(ss, 16); ss += __shfl_xor(ss, 32);
                if (fq == 0) ssqA[(size_t)row * 32 + u.pn * 4 + wc] = ss;
            }
    }
};

__device__ __forceinline__ void transpose_tile(int wv, const float* src, size_t src_ld, u16* dst, size_t dst_ld, const float* gk, LAS float* T) {
    const int tid = opaque_tid(wv);
#pragma unroll
    for (int pz = 0; pz < 2; ++pz) { const int k = (tid >> 4) + 32 * pz, n4 = (tid & 15) * 4; const f32x4 v = *(const f32x4*)(src + (size_t)k * src_ld + n4); const float g = gk ? gk[k] : 1.f;
        T[k * 65 + n4 + 0] = v.x * g; T[k * 65 + n4 + 1] = v.y * g; T[k * 65 + n4 + 2] = v.z * g; T[k * 65 + n4 + 3] = v.w * g; }
    __syncthreads();
    { const int n = tid >> 3, kc = tid & 7; float f[8];
#pragma unroll
        for (int j = 0; j < 8; ++j) f[j] = T[(kc * 8 + j) * 65 + n];
        u32x4 w; w.x = cvt_pk_bf16(f[0], f[1]); w.y = cvt_pk_bf16(f[2], f[3]); w.z = cvt_pk_bf16(f[4], f[5]); w.w = cvt_pk_bf16(f[6], f[7]);
        *(u32x4*)(dst + (size_t)n * dst_ld + kc * 8) = w; }
    __syncthreads();
}

__device__ __forceinline__ void prep_phase(int wv, const P& p, LAS unsigned char* lds) {
    LAS float* T = (LAS float*)lds;
    const int tid = opaque_tid(wv), G = gridDim.x, B = blockIdx.x;
    const int wid = tid >> 6, lane = tid & 63;
    if (B == 0 && tid < 64) ((unsigned*)(p.ws + W_CTR))[tid] = 0u;
    for (int t = B; t < DEPTH * 2048; t += G) { const int L = t >> 11, r = t & 2047, kt = r >> 6, nt = r & 63;
        transpose_tile(wv, p.w_in + (size_t)L * 2048 * D_IN + (size_t)kt * 64 * D_IN + nt * 64, D_IN, (u16*)(p.ws + W_WTIN) + (size_t)L * 4096 * 2048 + (size_t)nt * 64 * 2048 + kt * 64, 2048, p.g_attn + L * 2048 + kt * 64, T); }
    for (int t = B; t < DEPTH * 512; t += G) { const int L = t >> 9, r = t & 511, kt = r >> 5, nt = r & 31;
        transpose_tile(wv, p.w_out + (size_t)L * 1024 * 2048 + (size_t)kt * 64 * 2048 + nt * 64, 2048, (u16*)(p.ws + W_WTOUT) + (size_t)L * 2048 * 1024 + (size_t)nt * 64 * 1024 + kt * 64, 1024, nullptr, T); }
    for (int t = B; t < DEPTH * 128; t += G) { const int L = t >> 7, r = t & 127, kt = r >> 5, nt = r & 31;
        transpose_tile(wv, p.w_ple + (size_t)L * 256 * 2048 + (size_t)kt * 64 * 2048 + nt * 64, 2048, (u16*)(p.ws + W_WTPLE) + (size_t)L * 2048 * 256 + (size_t)nt * 64 * 256 + kt * 64, 256, nullptr, T); }
    for (int t = B; t < DEPTH * 1024; t += G) { const int L = t >> 10, r = t & 1023, kt = r >> 5, nt = r & 31;
        transpose_tile(wv, p.w_gate + (size_t)L * 2048 * 2048 + (size_t)kt * 64 * 2048 + nt * 64, 2048, (u16*)(p.ws + W_WTGATE) + (size_t)L * 2048 * 2048 + (size_t)nt * 64 * 2048 + kt * 64, 2048, p.g_ple + L * 2048 + kt * 64, T); }
    for (int t = B; t < DEPTH * DEC_BATCH * 8 * 32; t += G) { const int mi = t >> 5, r = t & 31, kt = r >> 1, nt = r & 1; const int ls = mi >> 3, h8 = mi & 7, br = h8 >> 2, hh = h8 & 3;
        const float* src = (br ? p.c_fxv : p.c_sbv) + ((size_t)ls * PAST + kt * 64) * 512 + hh * 128 + nt * 64;
        transpose_tile(wv, src, 512, (u16*)(p.ws + W_VTS) + ((size_t)mi * 128 + nt * 64) * SL + kt * 64, SL, nullptr, T); }
    for (int i = B * 512 + tid; i < DEPTH * 2048 * 4; i += G * 512) { const int L = i >> 13, k = (i >> 2) & 2047, j = i & 3;
        ((float*)(p.ws + W_WF))[i] = p.g_attn[L * 2048 + k] * p.w_in[(size_t)L * 2048 * D_IN + (size_t)k * D_IN + 4096 + j]; }
    for (int row = B * 8 + wid; row < NR; row += G * 8) {
        const float* src = row < NP ? p.x_prompt + (size_t)row * 2048 : p.x_sample + (size_t)(row - NP) * 2048;
        float* xo = p.out + (size_t)row * 2048; u16* xb = (u16*)(p.ws + W_XBA) + (size_t)row * 2048; float ss = 0.f;
#pragma unroll
        for (int i = 0; i < 8; ++i) { const int c = (i * 64 + lane) * 4; const f32x4 v = *(const f32x4*)(src + c); *(f32x4*)(xo + c) = v; ss += v.x * v.x + v.y * v.y + v.z * v.z + v.w * v.w;
            u32x2 w; w.x = cvt_pk_bf16(v.x, v.y); w.y = cvt_pk_bf16(v.z, v.w); *(u32x2*)(xb + c) = w; }
#pragma unroll
        for (int d = 1; d < 64; d <<= 1) ss += __shfl_xor(ss, d);
        if (lane < 32) ((float*)(p.ws + W_SSQA))[(size_t)row * 32 + lane] = lane == 0 ? ss : 0.f;
    }
    for (size_t i = (size_t)B * 512 + tid; i < (size_t)DEPTH * NR * 64; i += (size_t)G * 512) { const int L = (int)(i / ((size_t)NR * 64)); const size_t r = i % ((size_t)NR * 64); const int row = (int)(r >> 6), c4 = (int)(r & 63) * 4;
        const float* src = row < NP ? p.p_prompt + ((size_t)L * NP + row) * 256 + c4 : p.p_sample + ((size_t)L * NS + (row - NP)) * 256 + c4;
        const f32x4 v = *(const f32x4*)src; u32x2 w; w.x = cvt_pk_bf16(v.x, v.y); w.y = cvt_pk_bf16(v.z, v.w); *(u32x2*)((u16*)(p.ws + W_PB) + ((size_t)L * NR + row) * 256 + c4) = w; }
    for (size_t i = (size_t)B * 512 + tid; i < (size_t)2 * DEPTH * DEC_BATCH * PAST * 128; i += (size_t)G * 512) { const int br = (int)(i / ((size_t)DEPTH * DEC_BATCH * PAST * 128)); const size_t r = i % ((size_t)DEPTH * DEC_BATCH * PAST * 128);
        const int ls = (int)(r / (PAST * 128)), pos = (int)((r / 128) % PAST), c4 = (int)(r & 127) * 4;
        const f32x4 v = *(const f32x4*)((br ? p.c_fxk : p.c_sbk) + ((size_t)ls * PAST + pos) * 512 + c4); u32x2 w; w.x = cvt_pk_bf16(v.x, v.y); w.y = cvt_pk_bf16(v.z, v.w);
        *(u32x2*)((u16*)(p.ws + W_KBS) + ((size_t)ls * SL + pos) * 1024 + br * 512 + c4) = w; }
    for (int s = B * 8 + wid; s < DEPTH * DEC_BATCH * 4; s += G * 8) { const int ls = s >> 2, hh = s & 3; const float* src = p.c_logf + (size_t)ls * PAST * 4 + hh; float v[16]; float run = 0.f;
#pragma unroll
        for (int i = 0; i < 16; ++i) { run += src[(size_t)(lane * 16 + i) * 4]; v[i] = run; }
        float x = run;
#pragma unroll
        for (int d = 1; d < 64; d <<= 1) { const float y = __shfl_up(x, d); if (lane >= d) x += y; }
        const float pre = x - run; float* dst = (float*)(p.ws + W_CCUM) + (size_t)ls * PAST * 4 + hh;
#pragma unroll
        for (int i = 0; i < 16; ++i) dst[(size_t)(lane * 16 + i) * 4] = pre + v[i];
    }
}

__device__ __forceinline__ void logf_items(int wv, const P& p, int layer, LAS unsigned char* lds) {
    LAS f32x4* WfL = (LAS f32x4*)lds;
    LAS float* lf = (LAS float*)(lds + 40960);
    const int tid = opaque_tid(wv);
    const f32x4* Wf = (const f32x4*)(p.ws + W_WF) + (size_t)layer * 2048;
    const float* ssqA = (const float*)(p.ws + W_SSQA);
    for (int blk = blockIdx.x; blk < NR / 128; blk += gridDim.x) {
        __syncthreads();
#pragma unroll
        for (int i = 0; i < 4; ++i) { const int k = tid + 512 * i; WfL[k + (k >> 9)] = Wf[k]; }
        __syncthreads();
        const int rl = tid >> 2, kq = tid & 3, row = blk * 128 + rl;
        const u16* xr = (const u16*)(p.ws + W_XBA) + (size_t)row * 2048 + kq * 512;
        f32x4 a = (f32x4){0.f, 0.f, 0.f, 0.f};
        for (int i = 0; i < 64; ++i) { const u32x4 xv = *(const u32x4*)(xr + i * 8); const LAS f32x4* w = WfL + kq * 513 + i * 8;
            a += w[0] * bf_lo(xv.x); a += w[1] * bf_hi(xv.x); a += w[2] * bf_lo(xv.y); a += w[3] * bf_hi(xv.y); a += w[4] * bf_lo(xv.z); a += w[5] * bf_hi(xv.z); a += w[6] * bf_lo(xv.w); a += w[7] * bf_hi(xv.w); }
#pragma unroll
        for (int j = 0; j < 4; ++j) { a[j] += __shfl_xor(a[j], 1); a[j] += __shfl_xor(a[j], 2); }
        if (kq == 0) { float s = 0.f; const f32x4* q = (const f32x4*)(ssqA + (size_t)row * 32);
#pragma unroll
            for (int i = 0; i < 8; ++i) { const f32x4 v = q[i]; s += (v.x + v.y) + (v.z + v.w); }
            const float rs = rsqrtf(s * (1.f / 2048.f) + EPS); f32x4 lg;
#pragma unroll
            for (int j = 0; j < 4; ++j) { const float f = a[j] * rs + p.b_f[layer * 4 + j]; lg[j] = fminf(f, 0.f) - log1pf(expf(-fabsf(f))); }
            float* o = row < NP ? p.out + O_LOGF_P + ((size_t)layer * NP + row) * 4 : p.out + O_LOGF_S + ((size_t)layer * NS + (row - NP)) * 4;
            *(f32x4*)o = lg; lf[rl * 4 + 0] = lg.x; lf[rl * 4 + 1] = lg.y; lf[rl * 4 + 2] = lg.z; lf[rl * 4 + 3] = lg.w; }
        __syncthreads();
        if (tid < 16) { const int seg = tid >> 2, hh = tid & 3; float run = 0.f; float* cin = (float*)(p.ws + W_CIN);
            for (int i = 0; i < 32; ++i) { run += lf[(seg * 32 + i) * 4 + hh]; cin[(size_t)(blk * 128 + seg * 32 + i) * 4 + hh] = run; }
            ((float*)(p.ws + W_SEGTOT))[(size_t)(blk * 4 + seg) * 4 + hh] = run; }
    }
    __syncthreads();
}

constexpr int A_KB = 0, A_VB = 34816, A_CK = 71680, A_SEG = 72192, A_MISC = 74240;
constexpr int KROW = 272, VROW = 144;

__device__ __forceinline__ void attn_phase(int wv, const P& p, int layer, LAS unsigned char* lds) {
    const int tid = opaque_tid(wv), wid = __builtin_amdgcn_readfirstlane(tid >> 6), lane = tid & 63, r = lane & 31, h = lane >> 5;
    LAS float* segpre = (LAS float*)(lds + A_SEG);
    LAS int* misc = (LAS int*)(lds + A_MISC);
    LAS float* wtot = (LAS float*)(lds + A_MISC + 128);
    unsigned* ctr = (unsigned*)(p.ws + W_CTR) + layer;
    const float* Cin = (const float*)(p.ws + W_CIN);
    const int prow = 16 * (r >> 4) + 8 * ((r >> 2) & 1) + 4 * ((r >> 3) & 1) + (r & 3);
    for (;;) {
        __syncthreads();
        if (tid == 0) misc[0] = (int)atomicAdd(ctr, 1u);
        __syncthreads();
        const int item = misc[0];
        if (item >= NITEMS) break;
        int head8, qpos0, nw, row0, ldv, sbi = 0, bi = 0; const u16 *Kb, *Vt; const bool prompt = item < 1024;
        if (prompt) { const int qt = 63 - (item >> 4), rem = item & 15; bi = rem >> 3; head8 = rem & 7; qpos0 = qt * 256; nw = 8; row0 = bi * SEQ + qpos0;
            Kb = (const u16*)(p.ws + W_KBP) + (size_t)bi * SEQ * 1024 + head8 * 128; Vt = (const u16*)(p.ws + W_VTP) + (size_t)(bi * 8 + head8) * 128 * SEQ; ldv = SEQ;
        } else { const int s = item - 1024; sbi = s >> 3; head8 = s & 7; qpos0 = PAST; nw = 1; row0 = NP + sbi * 32;
            Kb = (const u16*)(p.ws + W_KBS) + (size_t)(layer * 8 + sbi) * SL * 1024 + head8 * 128; Vt = (const u16*)(p.ws + W_VTS) + (size_t)((layer * 8 + sbi) * 8 + head8) * 128 * SL; ldv = SL; }
        const bool fox = head8 >= 4; const int hf = head8 & 3;
        const float* ccum = (const float*)(p.ws + W_CCUM) + (size_t)(layer * 8 + sbi) * PAST * 4 + hf;
        if (fox && prompt) {
            const int nseg = (qpos0 + 256) >> 5; const float v = tid < nseg ? ((const float*)(p.ws + W_SEGTOT))[(size_t)(bi * 512 + tid) * 4 + hf] : 0.f; float x = v;
#pragma unroll
            for (int d = 1; d < 64; d <<= 1) { const float y = __shfl_up(x, d); if (lane >= d) x += y; }
            if (lane == 63) wtot[wid] = x;
            __syncthreads();
            float pre = 0.f; for (int w = 0; w < wid; ++w) pre += wtot[w];
            segpre[tid] = pre + x - v;
            __syncthreads();
        }
        auto getC = [&](int pos) -> float {
            if (prompt) return segpre[pos >> 5] + Cin[(size_t)(bi * SEQ + pos) * 4 + hf];
            if (pos < PAST) return ccum[(size_t)pos * 4];
            if (pos < PAST + 32) return ccum[(size_t)(PAST - 1) * 4] + Cin[(size_t)(NP + sbi * 32 + pos - PAST) * 4 + hf];
            return 0.f; };
        const bool wact = wid < nw;
        bf16x8 qf[8];
        float cq2 = 0.f;
        const int qlo = qpos0 + 32 * wid, qhi = qlo + 31, qpos = qlo + r;
        if (wact) { const u16* qrow = (const u16*)(p.ws + W_QB) + (size_t)(row0 + 32 * wid + r) * 1024 + head8 * 128 + 8 * h;
#pragma unroll
            for (int kk = 0; kk < 8; ++kk) qf[kk] = *(const bf16x8*)(qrow + 16 * kk);
            if (fox) cq2 = getC(qpos) * LOG2E; }
        else {
#pragma unroll
            for (int kk = 0; kk < 8; ++kk) qf[kk] = (bf16x8){0, 0, 0, 0, 0, 0, 0, 0}; }
        u32x4 kreg[2], vreg[2]; float ckreg = 0.f;
        const int krow_ = tid >> 4, kch = tid & 15, vrow_ = tid >> 3, vch = tid & 7;
#define LOAD_TILE(jt_) do { const int k0_ = (jt_) * 64; _Pragma("unroll") for (int pz = 0; pz < 2; ++pz) { \
            kreg[pz] = *(const u32x4*)(Kb + (size_t)(k0_ + krow_ + 32 * pz) * 1024 + kch * 8); \
            vreg[pz] = *(const u32x4*)(Vt + (size_t)(vrow_ + 64 * pz) * ldv + k0_ + vch * 8); } \
            if (fox && tid < 64) ckreg = getC(k0_ + tid) * LOG2E; } while (0)
#define STORE_TILE(buf_) do { _Pragma("unroll") for (int pz = 0; pz < 2; ++pz) { \
            *(LAS u32x4*)(lds + A_KB + (buf_) * 17408 + (krow_ + 32 * pz) * KROW + kch * 16) = kreg[pz]; \
            *(LAS u32x4*)(lds + A_VB + (buf_) * 18432 + (vrow_ + 64 * pz) * VROW + vch * 16) = vreg[pz]; } \
            if (fox && tid < 64) *(LAS float*)(lds + A_CK + (buf_) * 256 + tid * 4) = ckreg; } while (0)
        const int jt_top = (qpos0 + 32 * nw - 1) >> 6;
        LOAD_TILE(jt_top); STORE_TILE(0);
        __syncthreads();
        f32x16 o[4];
#pragma unroll
        for (int dt = 0; dt < 4; ++dt)
#pragma unroll
            for (int i = 0; i < 16; ++i) o[dt][i] = 0.f;
        float carry = 0.f, mrun = -1e30f, lsum = 0.f; bool wave_done = !wact;
        for (int jt = jt_top, it = 0; jt >= 0; --jt, ++it) {
            const int cur = it & 1; const bool more = jt > 0;
            if (more) LOAD_TILE(jt - 1);
            const int key0 = jt * 64;
            if (!wave_done && key0 <= qhi) {
                const bool diag = key0 + 63 >= qlo;
                const LAS unsigned char* kb = lds + A_KB + cur * 17408 + prow * KROW + 16 * h;
                const LAS unsigned char* vb = lds + A_VB + cur * 18432 + r * VROW + 16 * h;
                f32x16 sv[2];
#pragma unroll
                for (int i = 0; i < 16; ++i) { sv[0][i] = 0.f; sv[1][i] = 0.f; }
#pragma unroll
                for (int kk = 0; kk < 8; ++kk) { const bf16x8 a0 = *(const LAS bf16x8*)(kb + kk * 32); const bf16x8 a1 = *(const LAS bf16x8*)(kb + 32 * KROW + kk * 32);
                    sv[0] = __builtin_amdgcn_mfma_f32_32x32x16_bf16(a0, qf[kk], sv[0], 0, 0, 0); sv[1] = __builtin_amdgcn_mfma_f32_32x32x16_bf16(a1, qf[kk], sv[1], 0, 0, 0); }
                if (!fox) {
#pragma unroll
                    for (int kt = 1; kt >= 0; --kt) {
                        float sp[16], ex[16], tot[2];
#pragma unroll
                        for (int rg = 0; rg < 16; ++rg) { const int kpos = key0 + 32 * kt + 16 * (rg >> 3) + 8 * h + (rg & 7); const float z = sv[kt][rg];
                            const float spv = fmaxf(z, 0.f) + flog2(1.f + fexp2(-fabsf(z))); sp[rg] = (!diag || kpos < qpos) ? spv : 0.f; }
#pragma unroll
                        for (int c = 0; c < 2; ++c) { float run = 0.f;
#pragma unroll
                            for (int idx = 7; idx >= 0; --idx) { ex[8 * c + idx] = run; run += sp[8 * c + idx]; }
                            tot[c] = run; }
                        const float pt0 = __shfl_xor(tot[0], 32), pt1 = __shfl_xor(tot[1], 32);
                        const float off1 = carry + (h ? 0.f : pt1), off0 = carry + (h ? (pt1 + tot[1]) : (pt0 + tot[1] + pt1));
#pragma unroll
                        for (int rg = 0; rg < 16; ++rg) { const int kpos = key0 + 32 * kt + 16 * (rg >> 3) + 8 * h + (rg & 7);
                            const float e2 = sv[kt][rg] - sp[rg] - ((rg >= 8 ? off1 : off0) + ex[rg]);
                            sv[kt][rg] = (!diag || kpos < qpos) ? fexp2(e2) : 0.f; }
                        carry += (tot[0] + tot[1]) + (pt0 + pt1);
                    }
                    if (__all(carry > 152.f)) wave_done = true;
                } else {
                    const LAS float* ckb = (const LAS float*)(lds + A_CK + cur * 256) + 8 * h;
                    float mx = -1e30f;
#pragma unroll
                    for (int kt = 0; kt < 2; ++kt)
#pragma unroll
                        for (int q4 = 0; q4 < 4; ++q4) { const f32x4 ck = *(const LAS f32x4*)(ckb + 32 * kt + 16 * (q4 >> 1) + 4 * (q4 & 1));
#pragma unroll
                            for (int j = 0; j < 4; ++j) { const int rg = 4 * q4 + j; const int kpos = key0 + 32 * kt + 16 * (rg >> 3) + 8 * h + (rg & 7);
                                float x = sv[kt][rg] + (cq2 - ck[j]); if (diag && kpos > qpos) x = -1e30f; sv[kt][rg] = x; mx = fmaxf(mx, x); } }
                    mx = fmaxf(mx, __shfl_xor(mx, 32));
                    const float mnew = fmaxf(mrun, mx), alpha = fexp2(mrun - mnew); mrun = mnew; float ps = 0.f;
#pragma unroll
                    for (int kt = 0; kt < 2; ++kt)
#pragma unroll
                        for (int rg = 0; rg < 16; ++rg) { const float pv = fexp2(sv[kt][rg] - mnew); sv[kt][rg] = pv; ps += pv; }
                    lsum = lsum * alpha + ps;
#pragma unroll
                    for (int dt = 0; dt < 4; ++dt) o[dt] *= alpha;
                }
#pragma unroll
                for (int kt = 0; kt < 2; ++kt)
#pragma unroll
                    for (int c = 0; c < 2; ++c) { union { u32x4 u; bf16x8 v; } pf;
                        pf.u.x = cvt_pk_bf16(sv[kt][8 * c + 0], sv[kt][8 * c + 1]); pf.u.y = cvt_pk_bf16(sv[kt][8 * c + 2], sv[kt][8 * c + 3]);
                        pf.u.z = cvt_pk_bf16(sv[kt][8 * c + 4], sv[kt][8 * c + 5]); pf.u.w = cvt_pk_bf16(sv[kt][8 * c + 6], sv[kt][8 * c + 7]);
#pragma unroll
                        for (int dt = 0; dt < 4; ++dt) { const bf16x8 vf = *(const LAS bf16x8*)(vb + dt * 32 * VROW + (32 * kt + 16 * c) * 2);
                            o[dt] = __builtin_amdgcn_mfma_f32_32x32x16_bf16(vf, pf.v, o[dt], 0, 0, 0); } }
            }
            if (more) STORE_TILE(cur ^ 1);
            if (lane == 0) misc[8 + cur * 8 + wid] = wave_done ? 1 : 0;
            __syncthreads();
            int alld = 1;
#pragma unroll
            for (int w = 0; w < 8; ++w) alld &= misc[8 + cur * 8 + w];
            if (alld) break;
        }
#undef LOAD_TILE
#undef STORE_TILE
        if (wact) {
            if (fox) { lsum += __shfl_xor(lsum, 32); const float inv = 1.f / lsum;
#pragma unroll
                for (int dt = 0; dt < 4; ++dt) o[dt] *= inv; }
            float ss = 0.f;
#pragma unroll
            for (int dt = 0; dt < 4; ++dt)
#pragma unroll
                for (int i = 0; i < 16; ++i) ss += o[dt][i] * o[dt][i];
            ss += __shfl_xor(ss, 32);
            const float rn = rsqrtf(ss * (1.f / 128.f) + EPS);
            const int row = row0 + 32 * wid + r;
            const float* gp = (fox ? p.g_ofox : p.g_osb) + layer * 512 + hf * 128 + 4 * h;
            const u16* zp = (const u16*)(p.ws + W_ZB) + (size_t)row * 1024 + head8 * 128 + 4 * h;
            u16* op = (u16*)(p.ws + W_OB) + (size_t)row * 1024 + head8 * 128 + 4 * h;
#pragma unroll
            for (int dt = 0; dt < 4; ++dt)
#pragma unroll
                for (int bb = 0; bb < 4; ++bb) { const int d = 32 * dt + 8 * bb; const f32x4 g = *(const f32x4*)(gp + d); const u32x2 zz = *(const u32x2*)(zp + d);
                    const float v0 = o[dt][4 * bb + 0] * rn * g.x * bf_lo(zz.x), v1 = o[dt][4 * bb + 1] * rn * g.y * bf_hi(zz.x), v2 = o[dt][4 * bb + 2] * rn * g.z * bf_lo(zz.y), v3 = o[dt][4 * bb + 3] * rn * g.w * bf_hi(zz.y);
                    u32x2 w; w.x = cvt_pk_bf16(v0, v1); w.y = cvt_pk_bf16(v2, v3); *(u32x2*)(op + d) = w; }
        }
    }
}

__device__ __forceinline__ void final_phase(int wv, const P& p) {
    const int tid = opaque_tid(wv), wid = tid >> 6, lane = tid & 63;
    const float* ssqA = (const float*)(p.ws + W_SSQA);
    for (int row = blockIdx.x * 8 + wid; row < NR; row += gridDim.x * 8) {
        float s = lane < 32 ? ssqA[(size_t)row * 32 + lane] : 0.f;
#pragma unroll
        for (int d = 1; d < 64; d <<= 1) s += __shfl_xor(s, d);
        const float rs = rsqrtf(s * (1.f / 2048.f) + EPS);
        float* xo = p.out + (size_t)row * 2048;
#pragma unroll
        for (int i = 0; i < 8; ++i) { const int c = (i * 64 + lane) * 4; f32x4 v = *(const f32x4*)(xo + c); const f32x4 g = *(const f32x4*)(p.g_final + c); v = v * rs * g; *(f32x4*)(xo + c) = v; }
    }
}

constexpr int LDS_BYTES = pg8::STAGE_BYTES;

__global__ __launch_bounds__(512, 2) void fwd_megakernel(P p) {
    extern __shared__ __attribute__((aligned(16))) unsigned char shm[];
    LAS unsigned char* lds = (LAS unsigned char*)shm;
    cg::grid_group grid = cg::this_grid();
    const int wv = __builtin_amdgcn_readfirstlane(threadIdx.x >> 6);
    prep_phase(wv, p, lds);
    grid.sync();
    pg8::StaticOrder S;
    for (int layer_ = 0; layer_ < DEPTH; ++layer_) {
        int layer = layer_; asm volatile("" : "+s"(layer));
        {
            pg8::Gemm g{(const u16*)(p.ws + W_XBA), (const u16*)(p.ws + W_WTIN) + (size_t)layer * 4096 * 2048, NR, 4096, 2048};
            S.init(g.M, g.N, (int)gridDim.x, (int)blockIdx.x); EpiProj E{p, layer};
            pg8::gemm_phase(wv, lds, g, S, E);
            logf_items(wv, p, layer, lds);
        }
        grid.sync();
        attn_phase(wv, p, layer, lds);
        grid.sync();
        {
            pg8::Gemm g{(const u16*)(p.ws + W_OB), (const u16*)(p.ws + W_WTOUT) + (size_t)layer * 2048 * 1024, NR, 2048, 1024};
            S.init(g.M, g.N, (int)gridDim.x, (int)blockIdx.x); EpiOut E{p};
            pg8::gemm_phase(wv, lds, g, S, E);
            pg8::Gemm g2{(const u16*)(p.ws + W_PB) + (size_t)layer * NR * 256, (const u16*)(p.ws + W_WTPLE) + (size_t)layer * 2048 * 256, NR, 2048, 256};
            S.init(g2.M, g2.N, (int)gridDim.x, (int)(gridDim.x - 1 - blockIdx.x)); EpiPle E2{p};
            pg8::gemm_phase(wv, lds, g2, S, E2);
        }
        grid.sync();
        {
            pg8::Gemm g{(const u16*)(p.ws + W_XBB), (const u16*)(p.ws + W_WTGATE) + (size_t)layer * 2048 * 2048, NR, 2048, 2048};
            S.init(g.M, g.N, (int)gridDim.x, (int)blockIdx.x); EpiGate E{p};
            pg8::gemm_phase(wv, lds, g, S, E);
        }
        grid.sync();
    }
    final_phase(wv, p);
}

extern "C" void kernel_launch(void* const* d_in, const int* in_sizes, int n_in, void* d_out, int out_size, void* d_ws, size_t ws_size, hipStream_t stream) {
    static int grid_blocks = 0;
    if (!grid_blocks) {
        if (n_in != 19 || (size_t)out_size != OUT_TOTAL || ws_size < W_END) { fprintf(stderr, "kernel_launch: unexpected shapes: n_in %d out %d (want %zu) ws %zu (want %zu)\n", n_in, out_size, OUT_TOTAL, ws_size, W_END); grid_blocks = -1; return; }
        int dev = 0, cus = 0, per_cu = 0;
        hipGetDevice(&dev);
        hipDeviceGetAttribute(&cus, hipDeviceAttributeMultiprocessorCount, dev);
        if (hipFuncSetAttribute((const void*)fwd_megakernel, hipFuncAttributeMaxDynamicSharedMemorySize, LDS_BYTES) != hipSuccess) fprintf(stderr, "kernel_launch: hipFuncSetAttribute failed\n");
        if (hipOccupancyMaxActiveBlocksPerMultiprocessor(&per_cu, (const void*)fwd_megakernel, 512, LDS_BYTES) != hipSuccess || per_cu < 1) { fprintf(stderr, "kernel_launch: occupancy query gave %d\n", per_cu); per_cu = 1; }
        (void)hipGetLastError();
        grid_blocks = cus * per_cu;
    }
    if (grid_blocks < 0) return;
    P p{};
    const float** f = (const float**)&p;
    for (int i = 0; i < 19; ++i) f[i] = (const float*)d_in[i];
    p.out = (float*)d_out; p.ws = (unsigned char*)d_ws;
    void* args[] = {&p};
    hipError_t e = hipLaunchCooperativeKernel((const void*)fwd_megakernel, dim3(grid_blocks), dim3(512), args, LDS_BYTES, stream);
    if (e != hipSuccess) fprintf(stderr, "cooperative launch failed: %s (grid %d)\n", hipGetErrorString(e), grid_blocks);
}
```

```cpp
#include <hip/hip_runtime.h>
#include <hip/hip_cooperative_groups.h>
#include <cstdio>
namespace cg = cooperative_groups;

#define LAS __attribute__((address_space(3)))
typedef unsigned short u16;
typedef short bf16x8 __attribute__((ext_vector_type(8)));
typedef float f32x4 __attribute__((ext_vector_type(4)));
typedef float f32x16 __attribute__((ext_vector_type(16)));
typedef unsigned u32x2 __attribute__((ext_vector_type(2)));
typedef unsigned u32x4 __attribute__((ext_vector_type(4)));

constexpr int D_MODEL = 2048, SEQ = 16384, DEPTH = 4, DEC_BATCH = 8, DEC_SEQ = 32, PAST = 1024;
constexpr int NP = 2 * SEQ, NS = DEC_BATCH * DEC_SEQ, NR = NP + NS;
constexpr int DMIX = 1024, D_IN = 4100, PLE = 256;
constexpr int SL = 1088;
constexpr float EPS = 1e-6f;
constexpr float LOG2E = 1.4426950408889634f;
constexpr float QSCALE = 0.08838834764831845f * LOG2E;
constexpr int NITEMS = 1024 + 64;

constexpr size_t O_Y = 0;
constexpr size_t O_KV_P = (size_t)NR * D_MODEL;
constexpr size_t KVP = (size_t)DEPTH * NP * 512;
constexpr size_t O_LOGF_P = O_KV_P + 4 * KVP;
constexpr size_t O_KV_S = O_LOGF_P + (size_t)DEPTH * NP * 4;
constexpr size_t KVS = (size_t)DEPTH * NS * 512;
constexpr size_t O_LOGF_S = O_KV_S + 4 * KVS;
constexpr size_t OUT_TOTAL = O_LOGF_S + (size_t)DEPTH * NS * 4;

constexpr size_t al256(size_t x) { return (x + 255) & ~(size_t)255; }
constexpr size_t W_WTIN = 0;
constexpr size_t W_WTOUT = W_WTIN + (size_t)DEPTH * 4096 * 2048 * 2;
constexpr size_t W_WTPLE = W_WTOUT + (size_t)DEPTH * 2048 * 1024 * 2;
constexpr size_t W_WTGATE = W_WTPLE + (size_t)DEPTH * 2048 * 256 * 2;
constexpr size_t W_WF = W_WTGATE + (size_t)DEPTH * 2048 * 2048 * 2;
constexpr size_t W_XBA = W_WF + (size_t)DEPTH * 2048 * 4 * 4;
constexpr size_t W_PB = W_XBA + (size_t)NR * 2048 * 2;
constexpr size_t W_R = W_PB + (size_t)DEPTH * NR * 256 * 2;
constexpr size_t W_QB = W_R;
constexpr size_t W_KBP = W_QB + (size_t)NR * 1024 * 2;
constexpr size_t W_VTP = W_KBP + (size_t)NP * 1024 * 2;
constexpr size_t W_ZB = W_VTP + (size_t)NP * 1024 * 2;
constexpr size_t W_PLEB = W_R;
constexpr size_t W_XBB = W_R + al256((size_t)NR * 2048 * 2);
constexpr size_t R_SIZE = 2 * al256((size_t)NR * 2048 * 2) + 4096;
static_assert(W_ZB + (size_t)NR * 1024 * 2 <= W_R + R_SIZE, "region R too small");
constexpr size_t W_KBS = W_R + R_SIZE;
constexpr size_t W_VTS = W_KBS + (size_t)DEPTH * DEC_BATCH * SL * 1024 * 2;
constexpr size_t W_OB = W_VTS + (size_t)DEPTH * DEC_BATCH * 8 * 128 * SL * 2;
constexpr size_t W_SSQA = W_OB + (size_t)NR * 1024 * 2;
constexpr size_t W_SSQB = W_SSQA + (size_t)NR * 32 * 4;
constexpr size_t W_CIN = W_SSQB + (size_t)NR * 32 * 4;
constexpr size_t W_SEGTOT = W_CIN + (size_t)NR * 4 * 4;
constexpr size_t W_CCUM = W_SEGTOT + al256((size_t)(NR / 32) * 4 * 4);
constexpr size_t W_CTR = W_CCUM + (size_t)DEPTH * DEC_BATCH * PAST * 4 * 4;
constexpr size_t W_END = W_CTR + 4096;

struct P {
    const float *x_prompt, *x_sample, *p_prompt, *p_sample, *c_sbk, *c_sbv, *c_fxk, *c_fxv, *c_logf, *w_in, *b_f, *g_attn, *g_osb, *g_ofox, *w_out, *w_ple, *g_ple, *w_gate, *g_final;
    float* out;
    unsigned char* ws;
};

__device__ __forceinline__ unsigned cvt_pk_bf16(float lo, float hi) { unsigned r; asm volatile("v_cvt_pk_bf16_f32 %0, %1, %2" : "=v"(r) : "v"(lo), "v"(hi)); return r; }
__device__ __forceinline__ float bf_lo(unsigned w) { return __uint_as_float(w << 16); }
__device__ __forceinline__ float bf_hi(unsigned w) { return __uint_as_float(w & 0xffff0000u); }
__device__ __forceinline__ float fexp2(float x) { return __builtin_amdgcn_exp2f(x); }
__device__ __forceinline__ float flog2(float x) { return __builtin_amdgcn_logf(x); }
__device__ __forceinline__ int opaque_tid(int wv) { int l; asm volatile("v_mbcnt_lo_u32_b32 %0, -1, 0\n\tv_mbcnt_hi_u32_b32 %0, -1, %0" : "=v"(l)); return wv * 64 + l; }

namespace pg8 {
constexpr int BM = 256, BK = 64, HALF = 128, HTB = HALF * BK * 2, STAGE_BYTES = 8 * HTB, NXCD = 8, WGM = 8;
__host__ __device__ __forceinline__ int lds_byte(int r, int c) { const int st = (r >> 4) * 2 + (c >> 5), rr = r & 15, cc = c & 31, ob = rr * 64 + cc * 2; return st * 1024 + (ob ^ (((ob >> 9) & 1) << 5)); }
__host__ __device__ __forceinline__ void stage_rc(int b, int& R, int& C) { const int st = b / 1024, sb = b % 1024, swz = sb ^ (((sb >> 9) & 1) << 5); R = (st >> 1) * 16 + swz / 64; C = (st & 1) * 32 + (swz % 64) / 2; }
struct Unit { int pm, pn; };
struct Gemm { const u16* A; const u16* Bt; int M, N, K; };
struct StaticOrder {
    int nM, nN, nwg, G, c;
    __device__ void init(int M, int N, int G_, int c_) { nM = M / BM; nN = N / BM; nwg = nM * nN; G = G_; c = c_; }
    __device__ bool next(int i, Unit& u) const {
        const long L = (long)i * G + c; if (L >= nwg) return false;
        int wgid = (int)L; { const int q = nwg / NXCD, r = nwg % NXCD, xcd = wgid % NXCD, off = wgid / NXCD; wgid = (xcd < r ? xcd * (q + 1) : r * (q + 1) + (xcd - r) * q) + off; }
        const int nig = WGM * nN, gid = wgid / nig, fm = gid * WGM, gsz = (nM - fm) < WGM ? (nM - fm) : WGM;
        u.pm = fm + ((wgid % nig) % gsz); u.pn = (wgid % nig) / gsz; return true;
    }
};

template <class Epi>
__device__ __forceinline__ void gemm_phase(int wv, LAS unsigned char* lds, const Gemm g, const StaticOrder& S, const Epi& E) {
    const int tid = opaque_tid(wv), wid = __builtin_amdgcn_readfirstlane(tid >> 6), lane = tid & 63, wr = wid >> 2, wc = wid & 3, fr = lane & 15, fq = lane >> 4;
    const int K = g.K, nt = K / BK;
    unsigned voffA[2], voffB[2];
#pragma unroll
    for (int i = 0; i < 2; ++i) { int R, C; stage_rc(tid * 16 + i * 8192, R, C); voffA[i] = (unsigned)(R * K + C) * 2u; voffB[i] = voffA[i]; }
    const size_t kstep = (size_t)(BK * 2);
    const size_t hstep = (size_t)HALF * K * 2;
    const size_t tstep = 2 * hstep;
    const unsigned ldsw = (unsigned)wid * 1024u;
    const int aoff = lds_byte(wr * 64 + fr, fq * 8), boff = lds_byte(wc * 32 + fr, fq * 8);
#define PG8_SA(b, h) (((b) * 2 + (h)) * HTB)
#define PG8_SB(b, h) ((4 + (b) * 2 + (h)) * HTB)
#define PG8_STAGE(bufoff, gbase, voff) do { _Pragma("unroll") for (int _i = 0; _i < 2; ++_i) \
        __builtin_amdgcn_global_load_lds((const unsigned*)((const char*)(gbase) + (voff)[_i]), (LAS unsigned*)(lds + (bufoff) + ldsw + _i * 8192), 16, 0, 0); } while (0)
#define PG8_LDA(dst, b, h) do { _Pragma("unroll") for (int m = 0; m < 4; ++m) _Pragma("unroll") for (int k = 0; k < 2; ++k) dst[m][k] = *(const LAS bf16x8*)(lds + PG8_SA(b, h) + aoff + m * 2048 + k * 1024); } while (0)
#define PG8_LDB(dst, b, h) do { _Pragma("unroll") for (int n = 0; n < 2; ++n) _Pragma("unroll") for (int k = 0; k < 2; ++k) dst[n][k] = *(const LAS bf16x8*)(lds + PG8_SB(b, h) + boff + n * 2048 + k * 1024); } while (0)
#define PG8_MMA(ai, bj, At, Bt) do { __builtin_amdgcn_s_setprio(1); _Pragma("unroll") for (int m = 0; m < 4; ++m) _Pragma("unroll") for (int n = 0; n < 2; ++n) _Pragma("unroll") for (int k = 0; k < 2; ++k) \
        acc[ai][bj][m][n] = __builtin_amdgcn_mfma_f32_16x16x32_bf16(Bt[n][k], At[m][k], acc[ai][bj][m][n], 0, 0, 0); __builtin_amdgcn_s_setprio(0); } while (0)
#define PG8_WAIT_V(n) asm volatile("s_waitcnt vmcnt(" #n ")" ::: "memory")
#define PG8_WAIT_L(n) asm volatile("s_waitcnt lgkmcnt(" #n ")" ::: "memory")
#define PG8_BAR __builtin_amdgcn_s_barrier()
#define PG8_SCHED __builtin_amdgcn_sched_barrier(0)
    Unit cur, nxt; int ui = 0;
    if (!S.next(0, cur)) return;
    f32x4 acc[2][2][4][2];
#pragma unroll
    for (int a = 0; a < 2; ++a)
#pragma unroll
        for (int b = 0; b < 2; ++b)
#pragma unroll
            for (int m = 0; m < 4; ++m)
#pragma unroll
                for (int n = 0; n < 2; ++n) acc[a][b][m][n] = (f32x4){0.f, 0.f, 0.f, 0.f};
    bf16x8 At[4][2], B0[2][2], B1[2][2];
    const char* cA = (const char*)g.A + (size_t)cur.pm * tstep; const char* cB = (const char*)g.Bt + (size_t)cur.pn * tstep;
    PG8_STAGE(PG8_SB(0, 0), cB, voffB); PG8_STAGE(PG8_SA(0, 0), cA, voffA); PG8_STAGE(PG8_SB(0, 1), cB + hstep, voffB); PG8_STAGE(PG8_SA(0, 1), cA + hstep, voffA);
    if (wr == 1) PG8_BAR;
    PG8_WAIT_V(4); PG8_BAR;
    PG8_STAGE(PG8_SB(1, 0), cB + kstep, voffB); PG8_STAGE(PG8_SA(1, 0), cA + kstep, voffA); PG8_STAGE(PG8_SB(1, 1), cB + hstep + kstep, voffB);
    PG8_WAIT_V(6); PG8_BAR;
    for (;;) {
        const bool has_next = S.next(ui + 1, nxt);
        const char* nA = has_next ? (const char*)g.A + (size_t)nxt.pm * tstep : cA; const char* nB = has_next ? (const char*)g.Bt + (size_t)nxt.pn * tstep : cB;
        for (int t = 0; t < nt; t += 2) {
            const bool last = (t == nt - 2);
            const char* a1 = cA + (size_t)(t + 1) * kstep;
            const char* a2 = last ? nA : cA + (size_t)(t + 2) * kstep; const char* b2 = last ? nB : cB + (size_t)(t + 2) * kstep;
            const char* a3 = a2 + kstep; const char* b3 = b2 + kstep;
            PG8_LDB(B0, 0, 0); PG8_SCHED; PG8_LDA(At, 0, 0); PG8_STAGE(PG8_SA(1, 1), a1 + hstep, voffA);
            PG8_WAIT_L(8); PG8_BAR; PG8_WAIT_L(0); PG8_MMA(0, 0, At, B0); PG8_BAR; PG8_SCHED;
            PG8_LDB(B1, 0, 1); PG8_STAGE(PG8_SB(0, 0), b2, voffB);
            PG8_BAR; PG8_WAIT_L(0); PG8_MMA(0, 1, At, B1); PG8_BAR;
            PG8_LDA(At, 0, 1); PG8_STAGE(PG8_SA(0, 0), a2, voffA);
            PG8_BAR; PG8_WAIT_L(0); PG8_MMA(1, 0, At, B0); PG8_BAR; PG8_SCHED;
            PG8_STAGE(PG8_SB(0, 1), b2 + hstep, voffB);
            PG8_WAIT_V(6); PG8_BAR; PG8_MMA(1, 1, At, B1); PG8_BAR;
            PG8_LDB(B0, 1, 0); PG8_SCHED; PG8_LDA(At, 1, 0); PG8_STAGE(PG8_SA(0, 1), a2 + hstep, voffA);
            PG8_WAIT_L(8); PG8_BAR; PG8_WAIT_L(0); PG8_MMA(0, 0, At, B0); PG8_BAR; PG8_SCHED;
            PG8_LDB(B1, 1, 1); PG8_STAGE(PG8_SB(1, 0), b3, voffB);
            PG8_BAR; PG8_WAIT_L(0); PG8_MMA(0, 1, At, B1); PG8_BAR;
            PG8_LDA(At, 1, 1); PG8_STAGE(PG8_SA(1, 0), a3, voffA);
            PG8_BAR; PG8_WAIT_L(0); PG8_MMA(1, 0, At, B0); PG8_BAR; PG8_SCHED;
            PG8_STAGE(PG8_SB(1, 1), b3 + hstep, voffB);
            PG8_WAIT_V(6); PG8_BAR; PG8_MMA(1, 1, At, B1); PG8_BAR;
        }
        E(acc, cur, wr, wc, fr, fq);
        if (!has_next) break;
#pragma unroll
        for (int a = 0; a < 2; ++a)
#pragma unroll
            for (int b = 0; b < 2; ++b)
#pragma unroll
                for (int m = 0; m < 4; ++m)
#pragma unroll
                    for (int n = 0; n < 2; ++n) acc[a][b][m][n] = (f32x4){0.f, 0.f, 0.f, 0.f};
        cur = nxt; cA = nA; cB = nB; ++ui;
    }
    PG8_WAIT_V(0);
    if (wr == 0) PG8_BAR;
    PG8_BAR;
#undef PG8_SA
#undef PG8_SB
#undef PG8_STAGE
#undef PG8_LDA
#undef PG8_LDB
#undef PG8_MMA
#undef PG8_WAIT_V
#undef PG8_WAIT_L
#undef PG8_BAR
#undef PG8_SCHED
}
}


__device__ __forceinline__ float row_rstd(const float* ssq, int row, int fq) {
    const f32x4* q = (const f32x4*)(ssq + (size_t)row * 32 + fq * 8);
    const f32x4 a = q[0], b = q[1];
    float s = (a.x + a.y) + (a.z + a.w) + (b.x + b.y) + (b.z + b.w);
    s += __shfl_xor(s, 16); s += __shfl_xor(s, 32);
    return rsqrtf(s * (1.f / 2048.f) + EPS);
}

struct EpiProj {
    P p; int layer;
    __device__ __forceinline__ void operator()(const f32x4 (&acc)[2][2][4][2], const pg8::Unit& u, int wr, int wc, int fr, int fq) const {
        const int group = u.pn >> 1, type = group & 3, br = group >> 2;
        const int cgb = (u.pn & 1) * 256 + wc * 32 + 4 * fq;
        const float* ssqA = (const float*)(p.ws + W_SSQA);
        u16* Qb = (u16*)(p.ws + W_QB); u16* Zb = (u16*)(p.ws + W_ZB);
        float kmx[2] = {0.f, 0.f};
#pragma unroll
        for (int ai = 0; ai < 2; ++ai)
#pragma unroll
            for (int m = 0; m < 4; ++m) {
                __builtin_amdgcn_sched_barrier(0);
                const int row = u.pm * 256 + ai * 128 + wr * 64 + m * 16 + fr;
                const float rs = row_rstd(ssqA, row, fq);
                if (type == 0) {
                    u16* q = Qb + (size_t)row * 1024 + br * 512 + cgb; const float sc = rs * QSCALE;
#pragma unroll
                    for (int bj = 0; bj < 2; ++bj)
#pragma unroll
                        for (int n = 0; n < 2; ++n) { const f32x4 v = acc[ai][bj][m][n] * sc; u32x2 w; w.x = cvt_pk_bf16(v.x, v.y); w.y = cvt_pk_bf16(v.z, v.w); *(u32x2*)(q + bj * 128 + n * 16) = w; }
                } else if (type == 3) {
                    u16* z = Zb + (size_t)row * 1024 + br * 512 + cgb;
#pragma unroll
                    for (int bj = 0; bj < 2; ++bj)
#pragma unroll
                        for (int n = 0; n < 2; ++n) { f32x4 v = acc[ai][bj][m][n] * rs;
#pragma unroll
                            for (int j = 0; j < 4; ++j) v[j] = v[j] / (1.f + __expf(-v[j]));
                            u32x2 w; w.x = cvt_pk_bf16(v.x, v.y); w.y = cvt_pk_bf16(v.z, v.w); *(u32x2*)(z + bj * 128 + n * 16) = w; }
                } else {
                    float* o32; u16* kb; u16* vt; size_t vld; float kss[2] = {0.f, 0.f};
                    if (row < NP) { const int b = row >> 14, t = row & (SEQ - 1);
                        o32 = p.out + O_KV_P + (size_t)(br * 2 + (type - 1)) * KVP + ((size_t)(layer * 2 + b) * SEQ + t) * 512;
                        kb = (u16*)(p.ws + W_KBP) + (size_t)row * 1024 + br * 512;
                        vt = (u16*)(p.ws + W_VTP) + (size_t)(b * 8 + br * 4) * 128 * SEQ + t; vld = SEQ;
                    } else { const int rr = row - NP, sb = rr >> 5, t = rr & 31;
                        o32 = p.out + O_KV_S + (size_t)(br * 2 + (type - 1)) * KVS + ((size_t)(layer * 8 + sb) * 32 + t) * 512;
                        kb = (u16*)(p.ws + W_KBS) + ((size_t)(layer * 8 + sb) * SL + PAST + t) * 1024 + br * 512;
                        vt = (u16*)(p.ws + W_VTS) + (size_t)((layer * 8 + sb) * 8 + br * 4) * 128 * SL + PAST + t; vld = SL;
                    }
#pragma unroll
                    for (int bj = 0; bj < 2; ++bj)
#pragma unroll
                        for (int n = 0; n < 2; ++n) { const f32x4 v = acc[ai][bj][m][n] * rs; const int cg = cgb + bj * 128 + n * 16;
                            kss[bj] += v.x * v.x + v.y * v.y + v.z * v.z + v.w * v.w;
                            *(f32x4*)(o32 + cg) = v;
                            if (type == 1) { u32x2 w; w.x = cvt_pk_bf16(v.x, v.y); w.y = cvt_pk_bf16(v.z, v.w); *(u32x2*)(kb + cg) = w; }
                            else { const unsigned w0 = cvt_pk_bf16(v.x, v.y), w1 = cvt_pk_bf16(v.z, v.w);
                                vt[(size_t)(cg + 0) * vld] = (u16)(w0 & 0xffffu); vt[(size_t)(cg + 1) * vld] = (u16)(w0 >> 16);
                                vt[(size_t)(cg + 2) * vld] = (u16)(w1 & 0xffffu); vt[(size_t)(cg + 3) * vld] = (u16)(w1 >> 16); } }
                    if (type == 1 && br == 1) {
#pragma unroll
                        for (int bj = 0; bj < 2; ++bj) { float t = kss[bj]; t += __shfl_xor(t, 16); t += __shfl_xor(t, 32); kmx[bj] = fmaxf(kmx[bj], t); } }
                }
            }
        if (type == 1 && br == 1 && u.pm < NP / 256) {
#pragma unroll
            for (int bj = 0; bj < 2; ++bj) { float t = kmx[bj]; t = fmaxf(t, __shfl_xor(t, 1)); t = fmaxf(t, __shfl_xor(t, 2)); t = fmaxf(t, __shfl_xor(t, 4)); t = fmaxf(t, __shfl_xor(t, 8));
                if (fr == 0 && fq == 0) atomicMax((unsigned*)(p.ws + W_CTR) + 64 + ((layer * 2 + (u.pm >> 6)) * 4 + (u.pn & 1) * 2 + bj) * 4 + wc, __float_as_uint(t)); }
        }
    }
};

struct EpiOut {
    P p;
    __device__ __forceinline__ void operator()(const f32x4 (&acc)[2][2][4][2], const pg8::Unit& u, int wr, int wc, int fr, int fq) const {
        float* ssqB = (float*)(p.ws + W_SSQB); u16* XbB = (u16*)(p.ws + W_XBB);
        const int c0 = u.pn * 256 + wc * 32 + 4 * fq;
#pragma unroll
        for (int ai = 0; ai < 2; ++ai)
#pragma unroll
            for (int m = 0; m < 4; ++m) {
                __builtin_amdgcn_sched_barrier(0);
                const int row = u.pm * 256 + ai * 128 + wr * 64 + m * 16 + fr;
                float* xr = p.out + (size_t)row * 2048 + c0; u16* xb = XbB + (size_t)row * 2048 + c0; float ss = 0.f;
#pragma unroll
                for (int bj = 0; bj < 2; ++bj)
#pragma unroll
                    for (int n = 0; n < 2; ++n) { f32x4 v = *(const f32x4*)(xr + bj * 128 + n * 16) + acc[ai][bj][m][n]; *(f32x4*)(xr + bj * 128 + n * 16) = v;
                        ss += v.x * v.x + v.y * v.y + v.z * v.z + v.w * v.w;
                        u32x2 w; w.x = cvt_pk_bf16(v.x, v.y); w.y = cvt_pk_bf16(v.z, v.w); *(u32x2*)(xb + bj * 128 + n * 16) = w; }
                ss += __shfl_xor(ss, 16); ss += __shfl_xor(ss, 32);
                if (fq == 0) ssqB[(size_t)row * 32 + u.pn * 4 + wc] = ss;
            }
    }
};

struct EpiPle {
    P p;
    __device__ __forceinline__ void operator()(const f32x4 (&acc)[2][2][4][2], const pg8::Unit& u, int wr, int wc, int fr, int fq) const {
        u16* O = (u16*)(p.ws + W_PLEB); const int c0 = u.pn * 256 + wc * 32 + 4 * fq;
#pragma unroll
        for (int ai = 0; ai < 2; ++ai)
#pragma unroll
            for (int m = 0; m < 4; ++m) { __builtin_amdgcn_sched_barrier(0); const int row = u.pm * 256 + ai * 128 + wr * 64 + m * 16 + fr; u16* o = O + (size_t)row * 2048 + c0;
#pragma unroll
                for (int bj = 0; bj < 2; ++bj)
#pragma unroll
                    for (int n = 0; n < 2; ++n) { const f32x4 v = acc[ai][bj][m][n]; u32x2 w; w.x = cvt_pk_bf16(v.x, v.y); w.y = cvt_pk_bf16(v.z, v.w); *(u32x2*)(o + bj * 128 + n * 16) = w; } }
    }
};

struct EpiGate {
    P p;
    __device__ __forceinline__ void operator()(const f32x4 (&acc)[2][2][4][2], const pg8::Unit& u, int wr, int wc, int fr, int fq) const {
        const float* ssqB = (const float*)(p.ws + W_SSQB); float* ssqA = (float*)(p.ws + W_SSQA); u16* XbA = (u16*)(p.ws + W_XBA); const u16* PL = (const u16*)(p.ws + W_PLEB);
        const int c0 = u.pn * 256 + wc * 32 + 4 * fq;
#pragma unroll
        for (int ai = 0; ai < 2; ++ai)
#pragma unroll
            for (int m = 0; m < 4; ++m) {
                __builtin_amdgcn_sched_barrier(0);
                const int row = u.pm * 256 + ai * 128 + wr * 64 + m * 16 + fr;
                const float rs = row_rstd(ssqB, row, fq);
                float* xr = p.out + (size_t)row * 2048 + c0; u16* xb = XbA + (size_t)row * 2048 + c0; const u16* pl = PL + (size_t)row * 2048 + c0; float ss = 0.f;
#pragma unroll
                for (int bj = 0; bj < 2; ++bj)
#pragma unroll
                    for (int n = 0; n < 2; ++n) { const f32x4 a = acc[ai][bj][m][n] * rs; const u32x2 pw = *(const u32x2*)(pl + bj * 128 + n * 16);
                        f32x4 v = *(const f32x4*)(xr + bj * 128 + n * 16);
                        v.x += bf_lo(pw.x) / (1.f + __expf(-a.x)); v.y += bf_hi(pw.x) / (1.f + __expf(-a.y)); v.z += bf_lo(pw.y) / (1.f + __expf(-a.z)); v.w += bf_hi(pw.y) / (1.f + __expf(-a.w));
                        *(f32x4*)(xr + bj * 128 + n * 16) = v;
                        ss += v.x * v.x + v.y * v.y + v.z * v.z + v.w * v.w;
                        u32x2 w; w.x = cvt_pk_bf16(v.x, v.y); w.y = cvt_pk_bf16(v.z, v.w); *(u32x2*)(xb + bj * 128 + n * 16) = w; }
                ss += __shfl_xor(ss, 16); ss += __shfl_xor(ss, 32);
                if (fq == 0) ssqA[(size_t)row * 32 + u.pn * 4 + wc] = ss;
            }
    }
};

__device__ __forceinline__ void transpose_tile(int wv, const float* src, size_t src_ld, u16* dst, size_t dst_ld, const float* gk, LAS float* T) {
    const int tid = opaque_tid(wv);
#pragma unroll
    for (int pz = 0; pz < 2; ++pz) { const int k = (tid >> 4) + 32 * pz, n4 = (tid & 15) * 4; const f32x4 v = *(const f32x4*)(src + (size_t)k * src_ld + n4); const float g = gk ? gk[k] : 1.f;
        T[k * 65 + n4 + 0] = v.x * g; T[k * 65 + n4 + 1] = v.y * g; T[k * 65 + n4 + 2] = v.z * g; T[k * 65 + n4 + 3] = v.w * g; }
    __syncthreads();
    { const int n = tid >> 3, kc = tid & 7; float f[8];
#pragma unroll
        for (int j = 0; j < 8; ++j) f[j] = T[(kc * 8 + j) * 65 + n];
        u32x4 w; w.x = cvt_pk_bf16(f[0], f[1]); w.y = cvt_pk_bf16(f[2], f[3]); w.z = cvt_pk_bf16(f[4], f[5]); w.w = cvt_pk_bf16(f[6], f[7]);
        *(u32x4*)(dst + (size_t)n * dst_ld + kc * 8) = w; }
    __syncthreads();
}

__device__ __forceinline__ void prep_phase(int wv, const P& p, LAS unsigned char* lds) {
    LAS float* T = (LAS float*)lds;
    const int tid = opaque_tid(wv), G = gridDim.x, B = blockIdx.x;
    const int wid = tid >> 6, lane = tid & 63;
    if (B == 0) { ((unsigned*)(p.ws + W_CTR))[tid] = 0u; ((unsigned*)(p.ws + W_CTR))[tid + 512] = 0u; }
    for (int t = B; t < DEPTH * 2048; t += G) { const int L = t >> 11, r = t & 2047, kt = r >> 6, nt = r & 63;
        transpose_tile(wv, p.w_in + (size_t)L * 2048 * D_IN + (size_t)kt * 64 * D_IN + nt * 64, D_IN, (u16*)(p.ws + W_WTIN) + (size_t)L * 4096 * 2048 + (size_t)nt * 64 * 2048 + kt * 64, 2048, p.g_attn + L * 2048 + kt * 64, T); }
    for (int t = B; t < DEPTH * 512; t += G) { const int L = t >> 9, r = t & 511, kt = r >> 5, nt = r & 31;
        transpose_tile(wv, p.w_out + (size_t)L * 1024 * 2048 + (size_t)kt * 64 * 2048 + nt * 64, 2048, (u16*)(p.ws + W_WTOUT) + (size_t)L * 2048 * 1024 + (size_t)nt * 64 * 1024 + kt * 64, 1024, nullptr, T); }
    for (int t = B; t < DEPTH * 128; t += G) { const int L = t >> 7, r = t & 127, kt = r >> 5, nt = r & 31;
        transpose_tile(wv, p.w_ple + (size_t)L * 256 * 2048 + (size_t)kt * 64 * 2048 + nt * 64, 2048, (u16*)(p.ws + W_WTPLE) + (size_t)L * 2048 * 256 + (size_t)nt * 64 * 256 + kt * 64, 256, nullptr, T); }
    for (int t = B; t < DEPTH * 1024; t += G) { const int L = t >> 10, r = t & 1023, kt = r >> 5, nt = r & 31;
        transpose_tile(wv, p.w_gate + (size_t)L * 2048 * 2048 + (size_t)kt * 64 * 2048 + nt * 64, 2048, (u16*)(p.ws + W_WTGATE) + (size_t)L * 2048 * 2048 + (size_t)nt * 64 * 2048 + kt * 64, 2048, p.g_ple + L * 2048 + kt * 64, T); }
    for (int t = B; t < DEPTH * DEC_BATCH * 8 * 32; t += G) { const int mi = t >> 5, r = t & 31, kt = r >> 1, nt = r & 1; const int ls = mi >> 3, h8 = mi & 7, br = h8 >> 2, hh = h8 & 3;
        const float* src = (br ? p.c_fxv : p.c_sbv) + ((size_t)ls * PAST + kt * 64) * 512 + hh * 128 + nt * 64;
        transpose_tile(wv, src, 512, (u16*)(p.ws + W_VTS) + ((size_t)mi * 128 + nt * 64) * SL + kt * 64, SL, nullptr, T); }
    for (int i = B * 512 + tid; i < DEPTH * 2048 * 4; i += G * 512) { const int L = i >> 13, k = (i >> 2) & 2047, j = i & 3;
        ((float*)(p.ws + W_WF))[i] = p.g_attn[L * 2048 + k] * p.w_in[(size_t)L * 2048 * D_IN + (size_t)k * D_IN + 4096 + j]; }
    for (int row = B * 8 + wid; row < NR; row += G * 8) {
        const float* src = row < NP ? p.x_prompt + (size_t)row * 2048 : p.x_sample + (size_t)(row - NP) * 2048;
        float* xo = p.out + (size_t)row * 2048; u16* xb = (u16*)(p.ws + W_XBA) + (size_t)row * 2048; float ss = 0.f;
#pragma unroll
        for (int i = 0; i < 8; ++i) { const int c = (i * 64 + lane) * 4; const f32x4 v = *(const f32x4*)(src + c); *(f32x4*)(xo + c) = v; ss += v.x * v.x + v.y * v.y + v.z * v.z + v.w * v.w;
            u32x2 w; w.x = cvt_pk_bf16(v.x, v.y); w.y = cvt_pk_bf16(v.z, v.w); *(u32x2*)(xb + c) = w; }
#pragma unroll
        for (int d = 1; d < 64; d <<= 1) ss += __shfl_xor(ss, d);
        if (lane < 32) ((float*)(p.ws + W_SSQA))[(size_t)row * 32 + lane] = lane == 0 ? ss : 0.f;
    }
    for (size_t i = (size_t)B * 512 + tid; i < (size_t)DEPTH * NR * 64; i += (size_t)G * 512) { const int L = (int)(i / ((size_t)NR * 64)); const size_t r = i % ((size_t)NR * 64); const int row = (int)(r >> 6), c4 = (int)(r & 63) * 4;
        const float* src = row < NP ? p.p_prompt + ((size_t)L * NP + row) * 256 + c4 : p.p_sample + ((size_t)L * NS + (row - NP)) * 256 + c4;
        const f32x4 v = *(const f32x4*)src; u32x2 w; w.x = cvt_pk_bf16(v.x, v.y); w.y = cvt_pk_bf16(v.z, v.w); *(u32x2*)((u16*)(p.ws + W_PB) + ((size_t)L * NR + row) * 256 + c4) = w; }
    for (size_t i = (size_t)B * 512 + tid; i < (size_t)2 * DEPTH * DEC_BATCH * PAST * 128; i += (size_t)G * 512) { const int br = (int)(i / ((size_t)DEPTH * DEC_BATCH * PAST * 128)); const size_t r = i % ((size_t)DEPTH * DEC_BATCH * PAST * 128);
        const int ls = (int)(r / (PAST * 128)), pos = (int)((r / 128) % PAST), c4 = (int)(r & 127) * 4;
        const f32x4 v = *(const f32x4*)((br ? p.c_fxk : p.c_sbk) + ((size_t)ls * PAST + pos) * 512 + c4); u32x2 w; w.x = cvt_pk_bf16(v.x, v.y); w.y = cvt_pk_bf16(v.z, v.w);
        *(u32x2*)((u16*)(p.ws + W_KBS) + ((size_t)ls * SL + pos) * 1024 + br * 512 + c4) = w; }
    for (int s = B * 8 + wid; s < DEPTH * DEC_BATCH * 4; s += G * 8) { const int ls = s >> 2, hh = s & 3; const float* src = p.c_logf + (size_t)ls * PAST * 4 + hh; float v[16]; float run = 0.f;
#pragma unroll
        for (int i = 0; i < 16; ++i) { run += src[(size_t)(lane * 16 + i) * 4]; v[i] = run; }
        float x = run;
#pragma unroll
        for (int d = 1; d < 64; d <<= 1) { const float y = __shfl_up(x, d); if (lane >= d) x += y; }
        const float pre = x - run; float* dst = (float*)(p.ws + W_CCUM) + (size_t)ls * PAST * 4 + hh;
#pragma unroll
        for (int i = 0; i < 16; ++i) dst[(size_t)(lane * 16 + i) * 4] = pre + v[i];
    }
}

__device__ __forceinline__ void logf_items(int wv, const P& p, int layer, LAS unsigned char* lds) {
    LAS f32x4* WfL = (LAS f32x4*)lds;
    LAS float* lf = (LAS float*)(lds + 40960);
    const int tid = opaque_tid(wv);
    const f32x4* Wf = (const f32x4*)(p.ws + W_WF) + (size_t)layer * 2048;
    const float* ssqA = (const float*)(p.ws + W_SSQA);
    if (blockIdx.x >= 16)
    for (int blk = (int)blockIdx.x - 16; blk < NR / 128; blk += (int)gridDim.x - 16) {
        __syncthreads();
#pragma unroll
        for (int i = 0; i < 4; ++i) { const int k = tid + 512 * i; WfL[k + (k >> 9)] = Wf[k]; }
        __syncthreads();
        const int rl = tid >> 2, kq = tid & 3, row = blk * 128 + rl;
        const u16* xr = (const u16*)(p.ws + W_XBA) + (size_t)row * 2048 + kq * 512;
        f32x4 a = (f32x4){0.f, 0.f, 0.f, 0.f};
        for (int i = 0; i < 64; ++i) { const u32x4 xv = *(const u32x4*)(xr + i * 8); const LAS f32x4* w = WfL + kq * 513 + i * 8;
            a += w[0] * bf_lo(xv.x); a += w[1] * bf_hi(xv.x); a += w[2] * bf_lo(xv.y); a += w[3] * bf_hi(xv.y); a += w[4] * bf_lo(xv.z); a += w[5] * bf_hi(xv.z); a += w[6] * bf_lo(xv.w); a += w[7] * bf_hi(xv.w); }
#pragma unroll
        for (int j = 0; j < 4; ++j) { a[j] += __shfl_xor(a[j], 1); a[j] += __shfl_xor(a[j], 2); }
        if (kq == 0) { float s = 0.f; const f32x4* q = (const f32x4*)(ssqA + (size_t)row * 32);
#pragma unroll
            for (int i = 0; i < 8; ++i) { const f32x4 v = q[i]; s += (v.x + v.y) + (v.z + v.w); }
            const float rs = rsqrtf(s * (1.f / 2048.f) + EPS); f32x4 lg;
#pragma unroll
            for (int j = 0; j < 4; ++j) { const float f = a[j] * rs + p.b_f[layer * 4 + j]; lg[j] = fminf(f, 0.f) - log1pf(expf(-fabsf(f))); }
            float* o = row < NP ? p.out + O_LOGF_P + ((size_t)layer * NP + row) * 4 : p.out + O_LOGF_S + ((size_t)layer * NS + (row - NP)) * 4;
            *(f32x4*)o = lg; lf[rl * 4 + 0] = lg.x; lf[rl * 4 + 1] = lg.y; lf[rl * 4 + 2] = lg.z; lf[rl * 4 + 3] = lg.w; }
        __syncthreads();
        if (tid < 16) { const int seg = tid >> 2, hh = tid & 3; float run = 0.f; float* cin = (float*)(p.ws + W_CIN);
            for (int i = 0; i < 32; ++i) { run += lf[(seg * 32 + i) * 4 + hh]; cin[(size_t)(blk * 128 + seg * 32 + i) * 4 + hh] = run; }
            ((float*)(p.ws + W_SEGTOT))[(size_t)(blk * 4 + seg) * 4 + hh] = run; }
    }
    __syncthreads();
}

constexpr int A_KB = 0, A_VB = 34816, A_CK = 71680, A_SEG = 72192, A_MISC = 74240;
constexpr int KROW = 272, VROW = 144;

__device__ __forceinline__ void attn_phase(int wv, const P& p, int layer, LAS unsigned char* lds) {
    const int tid = opaque_tid(wv), wid = __builtin_amdgcn_readfirstlane(tid >> 6), lane = tid & 63, r = lane & 31, h = lane >> 5;
    LAS float* segpre = (LAS float*)(lds + A_SEG);
    LAS int* misc = (LAS int*)(lds + A_MISC);
    LAS float* wtot = (LAS float*)(lds + A_MISC + 128);
    unsigned* ctr = (unsigned*)(p.ws + W_CTR) + layer;
    const float* Cin = (const float*)(p.ws + W_CIN);
    const int prow = 16 * (r >> 4) + 8 * ((r >> 2) & 1) + 4 * ((r >> 3) & 1) + (r & 3);
    for (;;) {
        __syncthreads();
        if (tid == 0) misc[0] = (int)atomicAdd(ctr, 1u);
        __syncthreads();
        const int item = misc[0];
        if (item >= NITEMS) break;
        int head8, qpos0, nw, row0, ldv, sbi = 0, bi = 0; const u16 *Kb, *Vt; const bool prompt = item < 1024;
        if (prompt) { const int qt = 63 - (item >> 4), rem = item & 15; bi = rem >> 3; head8 = rem & 7; qpos0 = qt * 256; nw = 8; row0 = bi * SEQ + qpos0;
            Kb = (const u16*)(p.ws + W_KBP) + (size_t)bi * SEQ * 1024 + head8 * 128; Vt = (const u16*)(p.ws + W_VTP) + (size_t)(bi * 8 + head8) * 128 * SEQ; ldv = SEQ;
        } else { const int s = item - 1024; sbi = s >> 3; head8 = s & 7; qpos0 = PAST; nw = 1; row0 = NP + sbi * 32;
            Kb = (const u16*)(p.ws + W_KBS) + (size_t)(layer * 8 + sbi) * SL * 1024 + head8 * 128; Vt = (const u16*)(p.ws + W_VTS) + (size_t)((layer * 8 + sbi) * 8 + head8) * 128 * SL; ldv = SL; }
        const bool fox = head8 >= 4; const int hf = head8 & 3;
        const float* ccum = (const float*)(p.ws + W_CCUM) + (size_t)(layer * 8 + sbi) * PAST * 4 + hf;
        if (fox && prompt) {
            const int nseg = (qpos0 + 256) >> 5; const float v = tid < nseg ? ((const float*)(p.ws + W_SEGTOT))[(size_t)(bi * 512 + tid) * 4 + hf] : 0.f; float x = v;
#pragma unroll
            for (int d = 1; d < 64; d <<= 1) { const float y = __shfl_up(x, d); if (lane >= d) x += y; }
            if (lane == 63) wtot[wid] = x;
            __syncthreads();
            float pre = 0.f; for (int w = 0; w < wid; ++w) pre += wtot[w];
            segpre[tid] = pre + x - v;
            __syncthreads();
        }
        auto getC = [&](int pos) -> float {
            if (prompt) return segpre[pos >> 5] + Cin[(size_t)(bi * SEQ + pos) * 4 + hf];
            if (pos < PAST) return ccum[(size_t)pos * 4];
            if (pos < PAST + 32) return ccum[(size_t)(PAST - 1) * 4] + Cin[(size_t)(NP + sbi * 32 + pos - PAST) * 4 + hf];
            return 0.f; };
        const bool wact = wid < nw;
        bf16x8 qf[8];
        float cq2 = 0.f;
        const int qlo = qpos0 + 32 * wid, qhi = qlo + 31, qpos = qlo + r;
        if (wact) { const u16* qrow = (const u16*)(p.ws + W_QB) + (size_t)(row0 + 32 * wid + r) * 1024 + head8 * 128 + 8 * h;
#pragma unroll
            for (int kk = 0; kk < 8; ++kk) qf[kk] = *(const bf16x8*)(qrow + 16 * kk);
            if (fox) cq2 = getC(qpos) * LOG2E; }
        else {
#pragma unroll
            for (int kk = 0; kk < 8; ++kk) qf[kk] = (bf16x8){0, 0, 0, 0, 0, 0, 0, 0}; }
        float qnK = 3.0e38f;
        if (fox && prompt) { const unsigned* ks = (const unsigned*)(p.ws + W_CTR) + 64 + ((layer * 2 + bi) * 4 + hf) * 4;
            const float kmax = sqrtf(__uint_as_float(ks[0]) + __uint_as_float(ks[1]) + __uint_as_float(ks[2]) + __uint_as_float(ks[3])) * 1.01f; float qn2 = 0.f;
#pragma unroll
            for (int kk = 0; kk < 8; ++kk)
#pragma unroll
                for (int i = 0; i < 8; ++i) { const float f = __uint_as_float(((unsigned)(unsigned short)qf[kk][i]) << 16); qn2 += f * f; }
            qn2 += __shfl_xor(qn2, 32); qnK = sqrtf(qn2) * 1.01f * kmax; }
        u32x4 kreg[2], vreg[2]; float ckreg = 0.f;
        const int krow_ = tid >> 4, kch = tid & 15, vrow_ = tid >> 3, vch = tid & 7;
#define LOAD_TILE(jt_) do { const int k0_ = (jt_) * 64; _Pragma("unroll") for (int pz = 0; pz < 2; ++pz) { \
            kreg[pz] = *(const u32x4*)(Kb + (size_t)(k0_ + krow_ + 32 * pz) * 1024 + kch * 8); \
            vreg[pz] = *(const u32x4*)(Vt + (size_t)(vrow_ + 64 * pz) * ldv + k0_ + vch * 8); } \
            if (fox && tid < 64) ckreg = getC(k0_ + tid) * LOG2E; } while (0)
#define STORE_TILE(buf_) do { _Pragma("unroll") for (int pz = 0; pz < 2; ++pz) { \
            *(LAS u32x4*)(lds + A_KB + (buf_) * 17408 + (krow_ + 32 * pz) * KROW + kch * 16) = kreg[pz]; \
            *(LAS u32x4*)(lds + A_VB + (buf_) * 18432 + (vrow_ + 64 * pz) * VROW + vch * 16) = vreg[pz]; } \
            if (fox && tid < 64) *(LAS float*)(lds + A_CK + (buf_) * 256 + tid * 4) = ckreg; } while (0)
        const int jt_top = (qpos0 + 32 * nw - 1) >> 6;
        LOAD_TILE(jt_top); STORE_TILE(0);
        __syncthreads();
        f32x16 o[4];
#pragma unroll
        for (int dt = 0; dt < 4; ++dt)
#pragma unroll
            for (int i = 0; i < 16; ++i) o[dt][i] = 0.f;
        float carry = 0.f, mrun = -1e30f, lsum = 0.f; bool wave_done = !wact;
        for (int jt = jt_top, it = 0; jt >= 0; --jt, ++it) {
            const int cur = it & 1; const bool more = jt > 0;
            if (more) LOAD_TILE(jt - 1);
            const int key0 = jt * 64;
            if (fox && prompt && !wave_done && key0 <= qhi) {
                const float ck63 = *(const LAS float*)(lds + A_CK + cur * 256 + 252);
                if (__all((qnK + cq2 - ck63) < (mrun - 155.f))) wave_done = true; }
            if (!wave_done && key0 <= qhi) {
                const bool diag = key0 + 63 >= qlo;
                const LAS unsigned char* kb = lds + A_KB + cur * 17408 + prow * KROW + 16 * h;
                const LAS unsigned char* vb = lds + A_VB + cur * 18432 + r * VROW + 16 * h;
                f32x16 sv[2];
#pragma unroll
                for (int i = 0; i < 16; ++i) { sv[0][i] = 0.f; sv[1][i] = 0.f; }
#pragma unroll
                for (int kk = 0; kk < 8; ++kk) { const bf16x8 a0 = *(const LAS bf16x8*)(kb + kk * 32); const bf16x8 a1 = *(const LAS bf16x8*)(kb + 32 * KROW + kk * 32);
                    sv[0] = __builtin_amdgcn_mfma_f32_32x32x16_bf16(a0, qf[kk], sv[0], 0, 0, 0); sv[1] = __builtin_amdgcn_mfma_f32_32x32x16_bf16(a1, qf[kk], sv[1], 0, 0, 0); }
                if (!fox) {
#pragma unroll
                    for (int kt = 1; kt >= 0; --kt) {
                        float sp[16], ex[16], tot[2];
#pragma unroll
                        for (int rg = 0; rg < 16; ++rg) { const int kpos = key0 + 32 * kt + 16 * (rg >> 3) + 8 * h + (rg & 7); const float z = sv[kt][rg];
                            const float spv = fmaxf(z, 0.f) + flog2(1.f + fexp2(-fabsf(z))); sp[rg] = (!diag || kpos < qpos) ? spv : 0.f; }
#pragma unroll
                        for (int c = 0; c < 2; ++c) { float run = 0.f;
#pragma unroll
                            for (int idx = 7; idx >= 0; --idx) { ex[8 * c + idx] = run; run += sp[8 * c + idx]; }
                            tot[c] = run; }
                        const float pt0 = __shfl_xor(tot[0], 32), pt1 = __shfl_xor(tot[1], 32);
                        const float off1 = carry + (h ? 0.f : pt1), off0 = carry + (h ? (pt1 + tot[1]) : (pt0 + tot[1] + pt1));
#pragma unroll
                        for (int rg = 0; rg < 16; ++rg) { const int kpos = key0 + 32 * kt + 16 * (rg >> 3) + 8 * h + (rg & 7);
                            const float e2 = sv[kt][rg] - sp[rg] - ((rg >= 8 ? off1 : off0) + ex[rg]);
                            sv[kt][rg] = (!diag || kpos < qpos) ? fexp2(e2) : 0.f; }
                        carry += (tot[0] + tot[1]) + (pt0 + pt1);
                    }
                    if (__all(carry > 152.f)) wave_done = true;
                } else {
                    const LAS float* ckb = (const LAS float*)(lds + A_CK + cur * 256) + 8 * h;
                    float mx = -1e30f;
#pragma unroll
                    for (int kt = 0; kt < 2; ++kt)
#pragma unroll
                        for (int q4 = 0; q4 < 4; ++q4) { const f32x4 ck = *(const LAS f32x4*)(ckb + 32 * kt + 16 * (q4 >> 1) + 4 * (q4 & 1));
#pragma unroll
                            for (int j = 0; j < 4; ++j) { const int rg = 4 * q4 + j; const int kpos = key0 + 32 * kt + 16 * (rg >> 3) + 8 * h + (rg & 7);
                                float x = sv[kt][rg] + (cq2 - ck[j]); if (diag && kpos > qpos) x = -1e30f; sv[kt][rg] = x; mx = fmaxf(mx, x); } }
                    mx = fmaxf(mx, __shfl_xor(mx, 32));
                    const float mnew = fmaxf(mrun, mx), alpha = fexp2(mrun - mnew); mrun = mnew; float ps = 0.f;
#pragma unroll
                    for (int kt = 0; kt < 2; ++kt)
#pragma unroll
                        for (int rg = 0; rg < 16; ++rg) { const float pv = fexp2(sv[kt][rg] - mnew); sv[kt][rg] = pv; ps += pv; }
                    lsum = lsum * alpha + ps;
                    if (!__all(alpha == 1.f)) {
#pragma unroll
                        for (int dt = 0; dt < 4; ++dt) o[dt] *= alpha; }
                }
#pragma unroll
                for (int kt = 0; kt < 2; ++kt)
#pragma unroll
                    for (int c = 0; c < 2; ++c) { union { u32x4 u; bf16x8 v; } pf;
                        pf.u.x = cvt_pk_bf16(sv[kt][8 * c + 0], sv[kt][8 * c + 1]); pf.u.y = cvt_pk_bf16(sv[kt][8 * c + 2], sv[kt][8 * c + 3]);
                        pf.u.z = cvt_pk_bf16(sv[kt][8 * c + 4], sv[kt][8 * c + 5]); pf.u.w = cvt_pk_bf16(sv[kt][8 * c + 6], sv[kt][8 * c + 7]);
#pragma unroll
                        for (int dt = 0; dt < 4; ++dt) { const bf16x8 vf = *(const LAS bf16x8*)(vb + dt * 32 * VROW + (32 * kt + 16 * c) * 2);
                            o[dt] = __builtin_amdgcn_mfma_f32_32x32x16_bf16(vf, pf.v, o[dt], 0, 0, 0); } }
            }
            if (more) STORE_TILE(cur ^ 1);
            if (lane == 0) misc[8 + cur * 8 + wid] = wave_done ? 1 : 0;
            __syncthreads();
            int alld = 1;
#pragma unroll
            for (int w = 0; w < 8; ++w) alld &= misc[8 + cur * 8 + w];
            if (alld) break;
        }
#undef LOAD_TILE
#undef STORE_TILE
        if (wact) {
            if (fox) { lsum += __shfl_xor(lsum, 32); const float inv = 1.f / lsum;
#pragma unroll
                for (int dt = 0; dt < 4; ++dt) o[dt] *= inv; }
            float ss = 0.f;
#pragma unroll
            for (int dt = 0; dt < 4; ++dt)
#pragma unroll
                for (int i = 0; i < 16; ++i) ss += o[dt][i] * o[dt][i];
            ss += __shfl_xor(ss, 32);
            const float rn = rsqrtf(ss * (1.f / 128.f) + EPS);
            const int row = row0 + 32 * wid + r;
            const float* gp = (fox ? p.g_ofox : p.g_osb) + layer * 512 + hf * 128 + 4 * h;
            const u16* zp = (const u16*)(p.ws + W_ZB) + (size_t)row * 1024 + head8 * 128 + 4 * h;
            u16* op = (u16*)(p.ws + W_OB) + (size_t)row * 1024 + head8 * 128 + 4 * h;
#pragma unroll
            for (int dt = 0; dt < 4; ++dt)
#pragma unroll
                for (int bb = 0; bb < 4; ++bb) { const int d = 32 * dt + 8 * bb; const f32x4 g = *(const f32x4*)(gp + d); const u32x2 zz = *(const u32x2*)(zp + d);
                    const float v0 = o[dt][4 * bb + 0] * rn * g.x * bf_lo(zz.x), v1 = o[dt][4 * bb + 1] * rn * g.y * bf_hi(zz.x), v2 = o[dt][4 * bb + 2] * rn * g.z * bf_lo(zz.y), v3 = o[dt][4 * bb + 3] * rn * g.w * bf_hi(zz.y);
                    u32x2 w; w.x = cvt_pk_bf16(v0, v1); w.y = cvt_pk_bf16(v2, v3); *(u32x2*)(op + d) = w; }
        }
    }
}

__device__ __forceinline__ void final_phase(int wv, const P& p) {
    const int tid = opaque_tid(wv), wid = tid >> 6, lane = tid & 63;
    const float* ssqA = (const float*)(p.ws + W_SSQA);
    for (int row = blockIdx.x * 8 + wid; row < NR; row += gridDim.x * 8) {
        float s = lane < 32 ? ssqA[(size_t)row * 32 + lane] : 0.f;
#pragma unroll
        for (int d = 1; d < 64; d <<= 1) s += __shfl_xor(s, d);
        const float rs = rsqrtf(s * (1.f / 2048.f) + EPS);
        float* xo = p.out + (size_t)row * 2048;
#pragma unroll
        for (int i = 0; i < 8; ++i) { const int c = (i * 64 + lane) * 4; f32x4 v = *(const f32x4*)(xo + c); const f32x4 g = *(const f32x4*)(p.g_final + c); v = v * rs * g; *(f32x4*)(xo + c) = v; }
    }
}

constexpr int LDS_BYTES = pg8::STAGE_BYTES;

__global__ __launch_bounds__(512, 2) void fwd_megakernel(P p) {
    extern __shared__ __attribute__((aligned(16))) unsigned char shm[];
    LAS unsigned char* lds = (LAS unsigned char*)shm;
    cg::grid_group grid = cg::this_grid();
    const int wv = __builtin_amdgcn_readfirstlane(threadIdx.x >> 6);
    prep_phase(wv, p, lds);
    grid.sync();
    pg8::StaticOrder S;
    for (int layer_ = 0; layer_ < DEPTH; ++layer_) {
        int layer = layer_, bid = (int)blockIdx.x, G = (int)gridDim.x; asm volatile("" : "+s"(layer), "+s"(bid), "+s"(G));
        {
            pg8::Gemm g{(const u16*)(p.ws + W_XBA), (const u16*)(p.ws + W_WTIN) + (size_t)layer * 4096 * 2048, NR, 4096, 2048};
            S.init(g.M, g.N, G, bid); EpiProj E{p, layer};
            pg8::gemm_phase(wv, lds, g, S, E);
            logf_items(wv, p, layer, lds);
        }
        grid.sync();
        attn_phase(wv, p, layer, lds);
        grid.sync();
        {
            pg8::Gemm g{(const u16*)(p.ws + W_OB), (const u16*)(p.ws + W_WTOUT) + (size_t)layer * 2048 * 1024, NR, 2048, 1024};
            S.init(g.M, g.N, G, bid); EpiOut E{p};
            pg8::gemm_phase(wv, lds, g, S, E);
            pg8::Gemm g2{(const u16*)(p.ws + W_PB) + (size_t)layer * NR * 256, (const u16*)(p.ws + W_WTPLE) + (size_t)layer * 2048 * 256, NR, 2048, 256};
            S.init(g2.M, g2.N, G - 8, bid - 8); EpiPle E2{p};
            if (bid >= 8) pg8::gemm_phase(wv, lds, g2, S, E2);
        }
        grid.sync();
        {
            pg8::Gemm g{(const u16*)(p.ws + W_XBB), (const u16*)(p.ws + W_WTGATE) + (size_t)layer * 2048 * 2048, NR, 2048, 2048};
            S.init(g.M, g.N, G, bid); EpiGate E{p};
            pg8::gemm_phase(wv, lds, g, S, E);
        }
        grid.sync();
    }
    final_phase(wv, p);
}

extern "C" void kernel_launch(void* const* d_in, const int* in_sizes, int n_in, void* d_out, int out_size, void* d_ws, size_t ws_size, hipStream_t stream) {
    static int grid_blocks = 0;
    if (!grid_blocks) {
        if (n_in != 19 || (size_t)out_size != OUT_TOTAL || ws_size < W_END) { fprintf(stderr, "kernel_launch: unexpected shapes: n_in %d out %d (want %zu) ws %zu (want %zu)\n", n_in, out_size, OUT_TOTAL, ws_size, W_END); grid_blocks = -1; return; }
        int dev = 0, cus = 0, per_cu = 0;
        hipGetDevice(&dev);
        hipDeviceGetAttribute(&cus, hipDeviceAttributeMultiprocessorCount, dev);
        if (hipFuncSetAttribute((const void*)fwd_megakernel, hipFuncAttributeMaxDynamicSharedMemorySize, LDS_BYTES) != hipSuccess) fprintf(stderr, "kernel_launch: hipFuncSetAttribute failed\n");
        if (hipOccupancyMaxActiveBlocksPerMultiprocessor(&per_cu, (const void*)fwd_megakernel, 512, LDS_BYTES) != hipSuccess || per_cu < 1) { fprintf(stderr, "kernel_launch: occupancy query gave %d\n", per_cu); per_cu = 1; }
        (void)hipGetLastError();
        grid_blocks = cus * per_cu;
    }
    if (grid_blocks < 0) return;
    P p{};
    const float** f = (const float**)&p;
    for (int i = 0; i < 19; ++i) f[i] = (const float*)d_in[i];
    p.out = (float*)d_out; p.ws = (unsigned char*)d_ws;
    void* args[] = {&p};
    hipError_t e = hipLaunchCooperativeKernel((const void*)fwd_megakernel, dim3(grid_blocks), dim3(512), args, LDS_BYTES, stream);
    if (e != hipSuccess) fprintf(stderr, "cooperative launch failed: %s (grid %d)\n", hipGetErrorString(e), grid_blocks);
}
```

```cpp
#include <hip/hip_runtime.h>
#include <hip/hip_cooperative_groups.h>
#include <cstdio>
namespace cg = cooperative_groups;

#define LAS __attribute__((address_space(3)))
typedef unsigned short u16;
typedef short bf16x8 __attribute__((ext_vector_type(8)));
typedef float f32x4 __attribute__((ext_vector_type(4)));
typedef float f32x16 __attribute__((ext_vector_type(16)));
typedef unsigned u32x2 __attribute__((ext_vector_type(2)));
typedef unsigned u32x4 __attribute__((ext_vector_type(4)));

constexpr int D_MODEL = 2048, SEQ = 16384, DEPTH = 4, DEC_BATCH = 8, DEC_SEQ = 32, PAST = 1024;
constexpr int NP = 2 * SEQ, NS = DEC_BATCH * DEC_SEQ, NR = NP + NS;
constexpr int DMIX = 1024, D_IN = 4100, PLE = 256;
constexpr int SL = 1088;
constexpr float EPS = 1e-6f;
constexpr float LOG2E = 1.4426950408889634f;
constexpr float QSCALE = 0.08838834764831845f * LOG2E;
constexpr int NITEMS = 1024 + 64;

constexpr size_t O_Y = 0;
constexpr size_t O_KV_P = (size_t)NR * D_MODEL;
constexpr size_t KVP = (size_t)DEPTH * NP * 512;
constexpr size_t O_LOGF_P = O_KV_P + 4 * KVP;
constexpr size_t O_KV_S = O_LOGF_P + (size_t)DEPTH * NP * 4;
constexpr size_t KVS = (size_t)DEPTH * NS * 512;
constexpr size_t O_LOGF_S = O_KV_S + 4 * KVS;
constexpr size_t OUT_TOTAL = O_LOGF_S + (size_t)DEPTH * NS * 4;

constexpr size_t al256(size_t x) { return (x + 255) & ~(size_t)255; }
constexpr size_t W_WTIN = 0;
constexpr size_t W_WTOUT = W_WTIN + (size_t)DEPTH * 4096 * 2048 * 2;
constexpr size_t W_WTPLE = W_WTOUT + (size_t)DEPTH * 2048 * 1024 * 2;
constexpr size_t W_WTGATE = W_WTPLE + (size_t)DEPTH * 2048 * 256 * 2;
constexpr size_t W_WF = W_WTGATE + (size_t)DEPTH * 2048 * 2048 * 2;
constexpr size_t W_XBA = W_WF + (size_t)DEPTH * 2048 * 4 * 4;
constexpr size_t W_PB = W_XBA + (size_t)NR * 2048 * 2;
constexpr size_t W_R = W_PB + (size_t)DEPTH * NR * 256 * 2;
constexpr size_t W_QB = W_R;
constexpr size_t W_KBP = W_QB + (size_t)NR * 1024 * 2;
constexpr size_t W_VTP = W_KBP + (size_t)NP * 1024 * 2;
constexpr size_t W_ZB = W_VTP + (size_t)NP * 1024 * 2;
constexpr size_t W_PLEB = W_R;
constexpr size_t W_XBB = W_R + al256((size_t)NR * 2048 * 2);
constexpr size_t R_SIZE = 2 * al256((size_t)NR * 2048 * 2) + 4096;
static_assert(W_ZB + (size_t)NR * 1024 * 2 <= W_R + R_SIZE, "region R too small");
constexpr size_t W_KBS = W_R + R_SIZE;
constexpr size_t W_VTS = W_KBS + (size_t)DEPTH * DEC_BATCH * SL * 1024 * 2;
constexpr size_t W_OB = W_VTS + (size_t)DEPTH * DEC_BATCH * 8 * 128 * SL * 2;
constexpr size_t W_SSQA = W_OB + (size_t)NR * 1024 * 2;
constexpr size_t W_SSQB = W_SSQA + (size_t)NR * 32 * 4;
constexpr size_t W_CIN = W_SSQB + (size_t)NR * 32 * 4;
constexpr size_t W_SEGTOT = W_CIN + (size_t)NR * 4 * 4;
constexpr size_t W_CCUM = W_SEGTOT + al256((size_t)(NR / 32) * 4 * 4);
constexpr size_t W_CTR = W_CCUM + (size_t)DEPTH * DEC_BATCH * PAST * 4 * 4;
constexpr size_t W_END = W_CTR + 4096;

struct P {
    const float *x_prompt, *x_sample, *p_prompt, *p_sample, *c_sbk, *c_sbv, *c_fxk, *c_fxv, *c_logf, *w_in, *b_f, *g_attn, *g_osb, *g_ofox, *w_out, *w_ple, *g_ple, *w_gate, *g_final;
    float* out;
    unsigned char* ws;
};

__device__ __forceinline__ unsigned cvt_pk_bf16(float lo, float hi) { unsigned r; asm volatile("v_cvt_pk_bf16_f32 %0, %1, %2" : "=v"(r) : "v"(lo), "v"(hi)); return r; }
__device__ __forceinline__ float bf_lo(unsigned w) { return __uint_as_float(w << 16); }
__device__ __forceinline__ float bf_hi(unsigned w) { return __uint_as_float(w & 0xffff0000u); }
__device__ __forceinline__ float fexp2(float x) { return __builtin_amdgcn_exp2f(x); }
__device__ __forceinline__ float flog2(float x) { return __builtin_amdgcn_logf(x); }
__device__ __forceinline__ int opaque_tid(int wv) { int l; asm volatile("v_mbcnt_lo_u32_b32 %0, -1, 0\n\tv_mbcnt_hi_u32_b32 %0, -1, %0" : "=v"(l)); return wv * 64 + l; }

namespace pg8 {
constexpr int BM = 256, BK = 64, HALF = 128, HTB = HALF * BK * 2, STAGE_BYTES = 8 * HTB, NXCD = 8, WGM = 8;
__host__ __device__ __forceinline__ int lds_byte(int r, int c) { const int st = (r >> 4) * 2 + (c >> 5), rr = r & 15, cc = c & 31, ob = rr * 64 + cc * 2; return st * 1024 + (ob ^ (((ob >> 9) & 1) << 5)); }
__host__ __device__ __forceinline__ void stage_rc(int b, int& R, int& C) { const int st = b / 1024, sb = b % 1024, swz = sb ^ (((sb >> 9) & 1) << 5); R = (st >> 1) * 16 + swz / 64; C = (st & 1) * 32 + (swz % 64) / 2; }
struct Unit { int pm, pn; };
struct Gemm { const u16* A; const u16* Bt; int M, N, K; };
struct StaticOrder {
    int nM, nN, nwg, G, c;
    __device__ void init(int M, int N, int G_, int c_) { nM = M / BM; nN = N / BM; nwg = nM * nN; G = G_; c = c_; }
    __device__ bool next(int i, Unit& u) const {
        const long L = (long)i * G + c; if (L >= nwg) return false;
        int wgid = (int)L; { const int q = nwg / NXCD, r = nwg % NXCD, xcd = wgid % NXCD, off = wgid / NXCD; wgid = (xcd < r ? xcd * (q + 1) : r * (q + 1) + (xcd - r) * q) + off; }
        const int nig = WGM * nN, gid = wgid / nig, fm = gid * WGM, gsz = (nM - fm) < WGM ? (nM - fm) : WGM;
        u.pm = fm + ((wgid % nig) % gsz); u.pn = (wgid % nig) / gsz; return true;
    }
};

template <class Epi>
__device__ __forceinline__ void gemm_phase(int wv, LAS unsigned char* lds, const Gemm g, const StaticOrder& S, const Epi& E) {
    const int tid = opaque_tid(wv), wid = __builtin_amdgcn_readfirstlane(tid >> 6), lane = tid & 63, wr = wid >> 2, wc = wid & 3, fr = lane & 15, fq = lane >> 4;
    const int K = g.K, nt = K / BK;
    unsigned voffA[2], voffB[2];
#pragma unroll
    for (int i = 0; i < 2; ++i) { int R, C; stage_rc(tid * 16 + i * 8192, R, C); voffA[i] = (unsigned)(R * K + C) * 2u; voffB[i] = voffA[i]; }
    const size_t kstep = (size_t)(BK * 2);
    const size_t hstep = (size_t)HALF * K * 2;
    const size_t tstep = 2 * hstep;
    const unsigned ldsw = (unsigned)wid * 1024u;
    const int aoff = lds_byte(wr * 64 + fr, fq * 8), boff = lds_byte(wc * 32 + fr, fq * 8);
#define PG8_SA(b, h) (((b) * 2 + (h)) * HTB)
#define PG8_SB(b, h) ((4 + (b) * 2 + (h)) * HTB)
#define PG8_STAGE(bufoff, gbase, voff) do { _Pragma("unroll") for (int _i = 0; _i < 2; ++_i) \
        __builtin_amdgcn_global_load_lds((const unsigned*)((const char*)(gbase) + (voff)[_i]), (LAS unsigned*)(lds + (bufoff) + ldsw + _i * 8192), 16, 0, 0); } while (0)
#define PG8_LDA(dst, b, h) do { _Pragma("unroll") for (int m = 0; m < 4; ++m) _Pragma("unroll") for (int k = 0; k < 2; ++k) dst[m][k] = *(const LAS bf16x8*)(lds + PG8_SA(b, h) + aoff + m * 2048 + k * 1024); } while (0)
#define PG8_LDB(dst, b, h) do { _Pragma("unroll") for (int n = 0; n < 2; ++n) _Pragma("unroll") for (int k = 0; k < 2; ++k) dst[n][k] = *(const LAS bf16x8*)(lds + PG8_SB(b, h) + boff + n * 2048 + k * 1024); } while (0)
#define PG8_MMA(ai, bj, At, Bt) do { __builtin_amdgcn_s_setprio(1); _Pragma("unroll") for (int m = 0; m < 4; ++m) _Pragma("unroll") for (int n = 0; n < 2; ++n) _Pragma("unroll") for (int k = 0; k < 2; ++k) \
        acc[ai][bj][m][n] = __builtin_amdgcn_mfma_f32_16x16x32_bf16(Bt[n][k], At[m][k], acc[ai][bj][m][n], 0, 0, 0); __builtin_amdgcn_s_setprio(0); } while (0)
#define PG8_WAIT_V(n) asm volatile("s_waitcnt vmcnt(" #n ")" ::: "memory")
#define PG8_WAIT_L(n) asm volatile("s_waitcnt lgkmcnt(" #n ")" ::: "memory")
#define PG8_BAR __builtin_amdgcn_s_barrier()
#define PG8_SCHED __builtin_amdgcn_sched_barrier(0)
    Unit cur, nxt; int ui = 0;
    if (!S.next(0, cur)) return;
    f32x4 acc[2][2][4][2];
#pragma unroll
    for (int a = 0; a < 2; ++a)
#pragma unroll
        for (int b = 0; b < 2; ++b)
#pragma unroll
            for (int m = 0; m < 4; ++m)
#pragma unroll
                for (int n = 0; n < 2; ++n) acc[a][b][m][n] = (f32x4){0.f, 0.f, 0.f, 0.f};
    bf16x8 At[4][2], B0[2][2], B1[2][2];
    const char* cA = (const char*)g.A + (size_t)cur.pm * tstep; const char* cB = (const char*)g.Bt + (size_t)cur.pn * tstep;
    PG8_STAGE(PG8_SB(0, 0), cB, voffB); PG8_STAGE(PG8_SA(0, 0), cA, voffA); PG8_STAGE(PG8_SB(0, 1), cB + hstep, voffB); PG8_STAGE(PG8_SA(0, 1), cA + hstep, voffA);
    if (wr == 1) PG8_BAR;
    PG8_WAIT_V(4); PG8_BAR;
    PG8_STAGE(PG8_SB(1, 0), cB + kstep, voffB); PG8_STAGE(PG8_SA(1, 0), cA + kstep, voffA); PG8_STAGE(PG8_SB(1, 1), cB + hstep + kstep, voffB);
    PG8_WAIT_V(6); PG8_BAR;
    for (;;) {
        const bool has_next = S.next(ui + 1, nxt);
        const char* nA = has_next ? (const char*)g.A + (size_t)nxt.pm * tstep : cA; const char* nB = has_next ? (const char*)g.Bt + (size_t)nxt.pn * tstep : cB;
        for (int t = 0; t < nt; t += 2) {
            const bool last = (t == nt - 2);
            const char* a1 = cA + (size_t)(t + 1) * kstep;
            const char* a2 = last ? nA : cA + (size_t)(t + 2) * kstep; const char* b2 = last ? nB : cB + (size_t)(t + 2) * kstep;
            const char* a3 = a2 + kstep; const char* b3 = b2 + kstep;
            PG8_LDB(B0, 0, 0); PG8_SCHED; PG8_LDA(At, 0, 0); PG8_STAGE(PG8_SA(1, 1), a1 + hstep, voffA);
            PG8_WAIT_L(8); PG8_BAR; PG8_WAIT_L(0); PG8_MMA(0, 0, At, B0); PG8_BAR; PG8_SCHED;
            PG8_LDB(B1, 0, 1); PG8_STAGE(PG8_SB(0, 0), b2, voffB);
            PG8_BAR; PG8_WAIT_L(0); PG8_MMA(0, 1, At, B1); PG8_BAR;
            PG8_LDA(At, 0, 1); PG8_STAGE(PG8_SA(0, 0), a2, voffA);
            PG8_BAR; PG8_WAIT_L(0); PG8_MMA(1, 0, At, B0); PG8_BAR; PG8_SCHED;
            PG8_STAGE(PG8_SB(0, 1), b2 + hstep, voffB);
            PG8_WAIT_V(6); PG8_BAR; PG8_MMA(1, 1, At, B1); PG8_BAR;
            PG8_LDB(B0, 1, 0); PG8_SCHED; PG8_LDA(At, 1, 0); PG8_STAGE(PG8_SA(0, 1), a2 + hstep, voffA);
            PG8_WAIT_L(8); PG8_BAR; PG8_WAIT_L(0); PG8_MMA(0, 0, At, B0); PG8_BAR; PG8_SCHED;
            PG8_LDB(B1, 1, 1); PG8_STAGE(PG8_SB(1, 0), b3, voffB);
            PG8_BAR; PG8_WAIT_L(0); PG8_MMA(0, 1, At, B1); PG8_BAR;
            PG8_LDA(At, 1, 1); PG8_STAGE(PG8_SA(1, 0), a3, voffA);
            PG8_BAR; PG8_WAIT_L(0); PG8_MMA(1, 0, At, B0); PG8_BAR; PG8_SCHED;
            PG8_STAGE(PG8_SB(1, 1), b3 + hstep, voffB);
            PG8_WAIT_V(6); PG8_BAR; PG8_MMA(1, 1, At, B1); PG8_BAR;
        }
        E(acc, cur, wr, wc, fr, fq);
        if (!has_next) break;
#pragma unroll
        for (int a = 0; a < 2; ++a)
#pragma unroll
            for (int b = 0; b < 2; ++b)
#pragma unroll
                for (int m = 0; m < 4; ++m)
#pragma unroll
                    for (int n = 0; n < 2; ++n) acc[a][b][m][n] = (f32x4){0.f, 0.f, 0.f, 0.f};
        cur = nxt; cA = nA; cB = nB; ++ui;
    }
    PG8_WAIT_V(0);
    if (wr == 0) PG8_BAR;
    PG8_BAR;
#undef PG8_SA
#undef PG8_SB
#undef PG8_STAGE
#undef PG8_LDA
#undef PG8_LDB
#undef PG8_MMA
#undef PG8_WAIT_V
#undef PG8_WAIT_L
#undef PG8_BAR
#undef PG8_SCHED
}
}


__device__ __forceinline__ float row_rstd(const float* ssq, int row, int fq) {
    const f32x4* q = (const f32x4*)(ssq + (size_t)row * 32 + fq * 8);
    const f32x4 a = q[0], b = q[1];
    float s = (a.x + a.y) + (a.z + a.w) + (b.x + b.y) + (b.z + b.w);
    s += __shfl_xor(s, 16); s += __shfl_xor(s, 32);
    return rsqrtf(s * (1.f / 2048.f) + EPS);
}

struct EpiProj {
    P p; int layer;
    __device__ __forceinline__ void operator()(const f32x4 (&acc)[2][2][4][2], const pg8::Unit& u, int wr, int wc, int fr, int fq) const {
        const int group = u.pn >> 1, type = group & 3, br = group >> 2;
        const int cgb = (u.pn & 1) * 256 + wc * 32 + 4 * fq;
        const float* ssqA = (const float*)(p.ws + W_SSQA);
        u16* Qb = (u16*)(p.ws + W_QB); u16* Zb = (u16*)(p.ws + W_ZB);
        float kmx[2] = {0.f, 0.f};
#pragma unroll
        for (int ai = 0; ai < 2; ++ai)
#pragma unroll
            for (int m = 0; m < 4; ++m) {
                __builtin_amdgcn_sched_barrier(0);
                const int row = u.pm * 256 + ai * 128 + wr * 64 + m * 16 + fr;
                const float rs = row_rstd(ssqA, row, fq);
                if (type == 0) {
                    u16* q = Qb + (size_t)row * 1024 + br * 512 + cgb; const float sc = rs * QSCALE;
#pragma unroll
                    for (int bj = 0; bj < 2; ++bj)
#pragma unroll
                        for (int n = 0; n < 2; ++n) { const f32x4 v = acc[ai][bj][m][n] * sc; u32x2 w; w.x = cvt_pk_bf16(v.x, v.y); w.y = cvt_pk_bf16(v.z, v.w); *(u32x2*)(q + bj * 128 + n * 16) = w; }
                } else if (type == 3) {
                    u16* z = Zb + (size_t)row * 1024 + br * 512 + cgb;
#pragma unroll
                    for (int bj = 0; bj < 2; ++bj)
#pragma unroll
                        for (int n = 0; n < 2; ++n) { f32x4 v = acc[ai][bj][m][n] * rs;
#pragma unroll
                            for (int j = 0; j < 4; ++j) v[j] = v[j] / (1.f + __expf(-v[j]));
                            u32x2 w; w.x = cvt_pk_bf16(v.x, v.y); w.y = cvt_pk_bf16(v.z, v.w); *(u32x2*)(z + bj * 128 + n * 16) = w; }
                } else {
                    float* o32; u16* kb; u16* vt; size_t vld; float kss[2] = {0.f, 0.f};
                    if (row < NP) { const int b = row >> 14, t = row & (SEQ - 1);
                        o32 = p.out + O_KV_P + (size_t)(br * 2 + (type - 1)) * KVP + ((size_t)(layer * 2 + b) * SEQ + t) * 512;
                        kb = (u16*)(p.ws + W_KBP) + (size_t)row * 1024 + br * 512;
                        vt = (u16*)(p.ws + W_VTP) + (size_t)(b * 8 + br * 4) * 128 * SEQ + t; vld = SEQ;
                    } else { const int rr = row - NP, sb = rr >> 5, t = rr & 31;
                        o32 = p.out + O_KV_S + (size_t)(br * 2 + (type - 1)) * KVS + ((size_t)(layer * 8 + sb) * 32 + t) * 512;
                        kb = (u16*)(p.ws + W_KBS) + ((size_t)(layer * 8 + sb) * SL + PAST + t) * 1024 + br * 512;
                        vt = (u16*)(p.ws + W_VTS) + (size_t)((layer * 8 + sb) * 8 + br * 4) * 128 * SL + PAST + t; vld = SL;
                    }
#pragma unroll
                    for (int bj = 0; bj < 2; ++bj)
#pragma unroll
                        for (int n = 0; n < 2; ++n) { const f32x4 v = acc[ai][bj][m][n] * rs; const int cg = cgb + bj * 128 + n * 16;
                            kss[bj] += v.x * v.x + v.y * v.y + v.z * v.z + v.w * v.w;
                            *(f32x4*)(o32 + cg) = v;
                            if (type == 1) { u32x2 w; w.x = cvt_pk_bf16(v.x, v.y); w.y = cvt_pk_bf16(v.z, v.w); *(u32x2*)(kb + cg) = w; }
                            else { const unsigned w0 = cvt_pk_bf16(v.x, v.y), w1 = cvt_pk_bf16(v.z, v.w);
                                vt[(size_t)(cg + 0) * vld] = (u16)(w0 & 0xffffu); vt[(size_t)(cg + 1) * vld] = (u16)(w0 >> 16);
                                vt[(size_t)(cg + 2) * vld] = (u16)(w1 & 0xffffu); vt[(size_t)(cg + 3) * vld] = (u16)(w1 >> 16); } }
                    if (type == 1 && br == 1) {
#pragma unroll
                        for (int bj = 0; bj < 2; ++bj) { float t = kss[bj]; t += __shfl_xor(t, 16); t += __shfl_xor(t, 32); kmx[bj] = fmaxf(kmx[bj], t); } }
                }
            }
        if (type == 1 && br == 1 && u.pm < NP / 256) {
#pragma unroll
            for (int bj = 0; bj < 2; ++bj) { float t = kmx[bj]; t = fmaxf(t, __shfl_xor(t, 1)); t = fmaxf(t, __shfl_xor(t, 2)); t = fmaxf(t, __shfl_xor(t, 4)); t = fmaxf(t, __shfl_xor(t, 8));
                if (fr == 0 && fq == 0) atomicMax((unsigned*)(p.ws + W_CTR) + 64 + ((layer * 2 + (u.pm >> 6)) * 4 + (u.pn & 1) * 2 + bj) * 4 + wc, __float_as_uint(t)); }
        }
    }
};

struct EpiOut {
    P p;
    __device__ __forceinline__ void operator()(const f32x4 (&acc)[2][2][4][2], const pg8::Unit& u, int wr, int wc, int fr, int fq) const {
        float* ssqB = (float*)(p.ws + W_SSQB); u16* XbB = (u16*)(p.ws + W_XBB); const u16* XbA = (const u16*)(p.ws + W_XBA);
        const int c0 = u.pn * 256 + wc * 32 + 4 * fq;
#pragma unroll
        for (int ai = 0; ai < 2; ++ai)
#pragma unroll
            for (int m = 0; m < 4; ++m) {
                __builtin_amdgcn_sched_barrier(0);
                const int row = u.pm * 256 + ai * 128 + wr * 64 + m * 16 + fr;
                const u16* xr = XbA + (size_t)row * 2048 + c0; u16* xb = XbB + (size_t)row * 2048 + c0; float ss = 0.f;
#pragma unroll
                for (int bj = 0; bj < 2; ++bj)
#pragma unroll
                    for (int n = 0; n < 2; ++n) { const u32x2 xw = *(const u32x2*)(xr + bj * 128 + n * 16); f32x4 v = acc[ai][bj][m][n];
                        v.x += bf_lo(xw.x); v.y += bf_hi(xw.x); v.z += bf_lo(xw.y); v.w += bf_hi(xw.y);
                        ss += v.x * v.x + v.y * v.y + v.z * v.z + v.w * v.w;
                        u32x2 w; w.x = cvt_pk_bf16(v.x, v.y); w.y = cvt_pk_bf16(v.z, v.w); *(u32x2*)(xb + bj * 128 + n * 16) = w; }
                ss += __shfl_xor(ss, 16); ss += __shfl_xor(ss, 32);
                if (fq == 0) ssqB[(size_t)row * 32 + u.pn * 4 + wc] = ss;
            }
    }
};

struct EpiPle {
    P p;
    __device__ __forceinline__ void operator()(const f32x4 (&acc)[2][2][4][2], const pg8::Unit& u, int wr, int wc, int fr, int fq) const {
        u16* O = (u16*)(p.ws + W_PLEB); const int c0 = u.pn * 256 + wc * 32 + 4 * fq;
#pragma unroll
        for (int ai = 0; ai < 2; ++ai)
#pragma unroll
            for (int m = 0; m < 4; ++m) { __builtin_amdgcn_sched_barrier(0); const int row = u.pm * 256 + ai * 128 + wr * 64 + m * 16 + fr; u16* o = O + (size_t)row * 2048 + c0;
#pragma unroll
                for (int bj = 0; bj < 2; ++bj)
#pragma unroll
                    for (int n = 0; n < 2; ++n) { const f32x4 v = acc[ai][bj][m][n]; u32x2 w; w.x = cvt_pk_bf16(v.x, v.y); w.y = cvt_pk_bf16(v.z, v.w); *(u32x2*)(o + bj * 128 + n * 16) = w; } }
    }
};

struct EpiGate {
    P p;
    __device__ __forceinline__ void operator()(const f32x4 (&acc)[2][2][4][2], const pg8::Unit& u, int wr, int wc, int fr, int fq) const {
        const float* ssqB = (const float*)(p.ws + W_SSQB); float* ssqA = (float*)(p.ws + W_SSQA); u16* XbA = (u16*)(p.ws + W_XBA); const u16* XbB = (const u16*)(p.ws + W_XBB); const u16* PL = (const u16*)(p.ws + W_PLEB);
        const int c0 = u.pn * 256 + wc * 32 + 4 * fq;
#pragma unroll
        for (int ai = 0; ai < 2; ++ai)
#pragma unroll
            for (int m = 0; m < 4; ++m) {
                __builtin_amdgcn_sched_barrier(0);
                const int row = u.pm * 256 + ai * 128 + wr * 64 + m * 16 + fr;
                const float rs = row_rstd(ssqB, row, fq);
                const u16* xr = XbB + (size_t)row * 2048 + c0; u16* xb = XbA + (size_t)row * 2048 + c0; const u16* pl = PL + (size_t)row * 2048 + c0; float ss = 0.f;
#pragma unroll
                for (int bj = 0; bj < 2; ++bj)
#pragma unroll
                    for (int n = 0; n < 2; ++n) { const f32x4 a = acc[ai][bj][m][n] * rs; const u32x2 pw = *(const u32x2*)(pl + bj * 128 + n * 16); const u32x2 xw = *(const u32x2*)(xr + bj * 128 + n * 16);
                        f32x4 v;
                        v.x = bf_lo(xw.x) + bf_lo(pw.x) / (1.f + __expf(-a.x)); v.y = bf_hi(xw.x) + bf_hi(pw.x) / (1.f + __expf(-a.y)); v.z = bf_lo(xw.y) + bf_lo(pw.y) / (1.f + __expf(-a.z)); v.w = bf_hi(xw.y) + bf_hi(pw.y) / (1.f + __expf(-a.w));
                        ss += v.x * v.x + v.y * v.y + v.z * v.z + v.w * v.w;
                        u32x2 w; w.x = cvt_pk_bf16(v.x, v.y); w.y = cvt_pk_bf16(v.z, v.w); *(u32x2*)(xb + bj * 128 + n * 16) = w; }
                ss += __shfl_xor(ss, 16); ss += __shfl_xor(ss, 32);
                if (fq == 0) ssqA[(size_t)row * 32 + u.pn * 4 + wc] = ss;
            }
    }
};

__device__ __forceinline__ void transpose_tile(int wv, const float* src, size_t src_ld, u16* dst, size_t dst_ld, const float* gk, LAS float* T) {
    const int tid = opaque_tid(wv);
#pragma unroll
    for (int pz = 0; pz < 2; ++pz) { const int k = (tid >> 4) + 32 * pz, n4 = (tid & 15) * 4; const f32x4 v = *(const f32x4*)(src + (size_t)k * src_ld + n4); const float g = gk ? gk[k] : 1.f;
        T[k * 65 + n4 + 0] = v.x * g; T[k * 65 + n4 + 1] = v.y * g; T[k * 65 + n4 + 2] = v.z * g; T[k * 65 + n4 + 3] = v.w * g; }
    __syncthreads();
    { const int n = tid >> 3, kc = tid & 7; float f[8];
#pragma unroll
        for (int j = 0; j < 8; ++j) f[j] = T[(kc * 8 + j) * 65 + n];
        u32x4 w; w.x = cvt_pk_bf16(f[0], f[1]); w.y = cvt_pk_bf16(f[2], f[3]); w.z = cvt_pk_bf16(f[4], f[5]); w.w = cvt_pk_bf16(f[6], f[7]);
        *(u32x4*)(dst + (size_t)n * dst_ld + kc * 8) = w; }
    __syncthreads();
}

__device__ __forceinline__ void prep_phase(int wv, const P& p, LAS unsigned char* lds) {
    LAS float* T = (LAS float*)lds;
    const int tid = opaque_tid(wv), G = gridDim.x, B = blockIdx.x;
    const int wid = tid >> 6, lane = tid & 63;
    if (B == 0) { ((unsigned*)(p.ws + W_CTR))[tid] = 0u; ((unsigned*)(p.ws + W_CTR))[tid + 512] = 0u; }
    for (int t = B; t < DEPTH * 2048; t += G) { const int L = t >> 11, r = t & 2047, kt = r >> 6, nt = r & 63;
        transpose_tile(wv, p.w_in + (size_t)L * 2048 * D_IN + (size_t)kt * 64 * D_IN + nt * 64, D_IN, (u16*)(p.ws + W_WTIN) + (size_t)L * 4096 * 2048 + (size_t)nt * 64 * 2048 + kt * 64, 2048, p.g_attn + L * 2048 + kt * 64, T); }
    for (int t = B; t < DEPTH * 512; t += G) { const int L = t >> 9, r = t & 511, kt = r >> 5, nt = r & 31;
        transpose_tile(wv, p.w_out + (size_t)L * 1024 * 2048 + (size_t)kt * 64 * 2048 + nt * 64, 2048, (u16*)(p.ws + W_WTOUT) + (size_t)L * 2048 * 1024 + (size_t)nt * 64 * 1024 + kt * 64, 1024, nullptr, T); }
    for (int t = B; t < DEPTH * 128; t += G) { const int L = t >> 7, r = t & 127, kt = r >> 5, nt = r & 31;
        transpose_tile(wv, p.w_ple + (size_t)L * 256 * 2048 + (size_t)kt * 64 * 2048 + nt * 64, 2048, (u16*)(p.ws + W_WTPLE) + (size_t)L * 2048 * 256 + (size_t)nt * 64 * 256 + kt * 64, 256, nullptr, T); }
    for (int t = B; t < DEPTH * 1024; t += G) { const int L = t >> 10, r = t & 1023, kt = r >> 5, nt = r & 31;
        transpose_tile(wv, p.w_gate + (size_t)L * 2048 * 2048 + (size_t)kt * 64 * 2048 + nt * 64, 2048, (u16*)(p.ws + W_WTGATE) + (size_t)L * 2048 * 2048 + (size_t)nt * 64 * 2048 + kt * 64, 2048, p.g_ple + L * 2048 + kt * 64, T); }
    for (int t = B; t < DEPTH * DEC_BATCH * 8 * 32; t += G) { const int mi = t >> 5, r = t & 31, kt = r >> 1, nt = r & 1; const int ls = mi >> 3, h8 = mi & 7, br = h8 >> 2, hh = h8 & 3;
        const float* src = (br ? p.c_fxv : p.c_sbv) + ((size_t)ls * PAST + kt * 64) * 512 + hh * 128 + nt * 64;
        transpose_tile(wv, src, 512, (u16*)(p.ws + W_VTS) + ((size_t)mi * 128 + nt * 64) * SL + kt * 64, SL, nullptr, T); }
    for (int i = B * 512 + tid; i < DEPTH * 2048 * 4; i += G * 512) { const int L = i >> 13, k = (i >> 2) & 2047, j = i & 3;
        ((float*)(p.ws + W_WF))[i] = p.g_attn[L * 2048 + k] * p.w_in[(size_t)L * 2048 * D_IN + (size_t)k * D_IN + 4096 + j]; }
    for (int row = B * 8 + wid; row < NR; row += G * 8) {
        const float* src = row < NP ? p.x_prompt + (size_t)row * 2048 : p.x_sample + (size_t)(row - NP) * 2048;
        u16* xb = (u16*)(p.ws + W_XBA) + (size_t)row * 2048; float ss = 0.f;
#pragma unroll
        for (int i = 0; i < 8; ++i) { const int c = (i * 64 + lane) * 4; const f32x4 v = *(const f32x4*)(src + c); ss += v.x * v.x + v.y * v.y + v.z * v.z + v.w * v.w;
            u32x2 w; w.x = cvt_pk_bf16(v.x, v.y); w.y = cvt_pk_bf16(v.z, v.w); *(u32x2*)(xb + c) = w; }
#pragma unroll
        for (int d = 1; d < 64; d <<= 1) ss += __shfl_xor(ss, d);
        if (lane < 32) ((float*)(p.ws + W_SSQA))[(size_t)row * 32 + lane] = lane == 0 ? ss : 0.f;
    }
    for (size_t i = (size_t)B * 512 + tid; i < (size_t)DEPTH * NR * 64; i += (size_t)G * 512) { const int L = (int)(i / ((size_t)NR * 64)); const size_t r = i % ((size_t)NR * 64); const int row = (int)(r >> 6), c4 = (int)(r & 63) * 4;
        const float* src = row < NP ? p.p_prompt + ((size_t)L * NP + row) * 256 + c4 : p.p_sample + ((size_t)L * NS + (row - NP)) * 256 + c4;
        const f32x4 v = *(const f32x4*)src; u32x2 w; w.x = cvt_pk_bf16(v.x, v.y); w.y = cvt_pk_bf16(v.z, v.w); *(u32x2*)((u16*)(p.ws + W_PB) + ((size_t)L * NR + row) * 256 + c4) = w; }
    for (size_t i = (size_t)B * 512 + tid; i < (size_t)2 * DEPTH * DEC_BATCH * PAST * 128; i += (size_t)G * 512) { const int br = (int)(i / ((size_t)DEPTH * DEC_BATCH * PAST * 128)); const size_t r = i % ((size_t)DEPTH * DEC_BATCH * PAST * 128);
        const int ls = (int)(r / (PAST * 128)), pos = (int)((r / 128) % PAST), c4 = (int)(r & 127) * 4;
        const f32x4 v = *(const f32x4*)((br ? p.c_fxk : p.c_sbk) + ((size_t)ls * PAST + pos) * 512 + c4); u32x2 w; w.x = cvt_pk_bf16(v.x, v.y); w.y = cvt_pk_bf16(v.z, v.w);
        *(u32x2*)((u16*)(p.ws + W_KBS) + ((size_t)ls * SL + pos) * 1024 + br * 512 + c4) = w; }
    for (int s = B * 8 + wid; s < DEPTH * DEC_BATCH * 4; s += G * 8) { const int ls = s >> 2, hh = s & 3; const float* src = p.c_logf + (size_t)ls * PAST * 4 + hh; float v[16]; float run = 0.f;
#pragma unroll
        for (int i = 0; i < 16; ++i) { run += src[(size_t)(lane * 16 + i) * 4]; v[i] = run; }
        float x = run;
#pragma unroll
        for (int d = 1; d < 64; d <<= 1) { const float y = __shfl_up(x, d); if (lane >= d) x += y; }
        const float pre = x - run; float* dst = (float*)(p.ws + W_CCUM) + (size_t)ls * PAST * 4 + hh;
#pragma unroll
        for (int i = 0; i < 16; ++i) dst[(size_t)(lane * 16 + i) * 4] = pre + v[i];
    }
}

__device__ __forceinline__ void logf_items(int wv, const P& p, int layer, LAS unsigned char* lds) {
    LAS f32x4* WfL = (LAS f32x4*)lds;
    LAS float* lf = (LAS float*)(lds + 40960);
    const int tid = opaque_tid(wv);
    const f32x4* Wf = (const f32x4*)(p.ws + W_WF) + (size_t)layer * 2048;
    const float* ssqA = (const float*)(p.ws + W_SSQA);
    if (blockIdx.x >= 16)
    for (int blk = (int)blockIdx.x - 16; blk < NR / 128; blk += (int)gridDim.x - 16) {
        __syncthreads();
#pragma unroll
        for (int i = 0; i < 4; ++i) { const int k = tid + 512 * i; WfL[k + (k >> 9)] = Wf[k]; }
        __syncthreads();
        const int rl = tid >> 2, kq = tid & 3, row = blk * 128 + rl;
        const u16* xr = (const u16*)(p.ws + W_XBA) + (size_t)row * 2048 + kq * 512;
        f32x4 a = (f32x4){0.f, 0.f, 0.f, 0.f};
        for (int i = 0; i < 64; ++i) { const u32x4 xv = *(const u32x4*)(xr + i * 8); const LAS f32x4* w = WfL + kq * 513 + i * 8;
            a += w[0] * bf_lo(xv.x); a += w[1] * bf_hi(xv.x); a += w[2] * bf_lo(xv.y); a += w[3] * bf_hi(xv.y); a += w[4] * bf_lo(xv.z); a += w[5] * bf_hi(xv.z); a += w[6] * bf_lo(xv.w); a += w[7] * bf_hi(xv.w); }
#pragma unroll
        for (int j = 0; j < 4; ++j) { a[j] += __shfl_xor(a[j], 1); a[j] += __shfl_xor(a[j], 2); }
        if (kq == 0) { float s = 0.f; const f32x4* q = (const f32x4*)(ssqA + (size_t)row * 32);
#pragma unroll
            for (int i = 0; i < 8; ++i) { const f32x4 v = q[i]; s += (v.x + v.y) + (v.z + v.w); }
            const float rs = rsqrtf(s * (1.f / 2048.f) + EPS); f32x4 lg;
#pragma unroll
            for (int j = 0; j < 4; ++j) { const float f = a[j] * rs + p.b_f[layer * 4 + j]; lg[j] = fminf(f, 0.f) - log1pf(expf(-fabsf(f))); }
            float* o = row < NP ? p.out + O_LOGF_P + ((size_t)layer * NP + row) * 4 : p.out + O_LOGF_S + ((size_t)layer * NS + (row - NP)) * 4;
            *(f32x4*)o = lg; lf[rl * 4 + 0] = lg.x; lf[rl * 4 + 1] = lg.y; lf[rl * 4 + 2] = lg.z; lf[rl * 4 + 3] = lg.w; }
        __syncthreads();
        if (tid < 16) { const int seg = tid >> 2, hh = tid & 3; float run = 0.f; float* cin = (float*)(p.ws + W_CIN);
            for (int i = 0; i < 32; ++i) { run += lf[(seg * 32 + i) * 4 + hh]; cin[(size_t)(blk * 128 + seg * 32 + i) * 4 + hh] = run; }
            ((float*)(p.ws + W_SEGTOT))[(size_t)(blk * 4 + seg) * 4 + hh] = run; }
    }
    __syncthreads();
}

constexpr int A_KB = 0, A_VB = 34816, A_CK = 71680, A_SEG = 72192, A_MISC = 74240;
constexpr int KROW = 272, VROW = 144;

__device__ __forceinline__ void attn_phase(int wv, const P& p, int layer, LAS unsigned char* lds) {
    const int tid = opaque_tid(wv), wid = __builtin_amdgcn_readfirstlane(tid >> 6), lane = tid & 63, r = lane & 31, h = lane >> 5;
    LAS float* segpre = (LAS float*)(lds + A_SEG);
    LAS int* misc = (LAS int*)(lds + A_MISC);
    LAS float* wtot = (LAS float*)(lds + A_MISC + 128);
    unsigned* ctr = (unsigned*)(p.ws + W_CTR) + layer;
    const float* Cin = (const float*)(p.ws + W_CIN);
    const int prow = 16 * (r >> 4) + 8 * ((r >> 2) & 1) + 4 * ((r >> 3) & 1) + (r & 3);
    for (;;) {
        __syncthreads();
        if (tid == 0) misc[0] = (int)atomicAdd(ctr, 1u);
        __syncthreads();
        const int item = misc[0];
        if (item >= NITEMS) break;
        int head8, qpos0, nw, row0, ldv, sbi = 0, bi = 0; const u16 *Kb, *Vt; const bool prompt = item < 1024;
        if (prompt) { const int qt = 63 - (item >> 4), rem = item & 15; bi = rem >> 3; head8 = rem & 7; qpos0 = qt * 256; nw = 8; row0 = bi * SEQ + qpos0;
            Kb = (const u16*)(p.ws + W_KBP) + (size_t)bi * SEQ * 1024 + head8 * 128; Vt = (const u16*)(p.ws + W_VTP) + (size_t)(bi * 8 + head8) * 128 * SEQ; ldv = SEQ;
        } else { const int s = item - 1024; sbi = s >> 3; head8 = s & 7; qpos0 = PAST; nw = 1; row0 = NP + sbi * 32;
            Kb = (const u16*)(p.ws + W_KBS) + (size_t)(layer * 8 + sbi) * SL * 1024 + head8 * 128; Vt = (const u16*)(p.ws + W_VTS) + (size_t)((layer * 8 + sbi) * 8 + head8) * 128 * SL; ldv = SL; }
        const bool fox = head8 >= 4; const int hf = head8 & 3;
        const float* ccum = (const float*)(p.ws + W_CCUM) + (size_t)(layer * 8 + sbi) * PAST * 4 + hf;
        if (fox && prompt) {
            const int nseg = (qpos0 + 256) >> 5; const float v = tid < nseg ? ((const float*)(p.ws + W_SEGTOT))[(size_t)(bi * 512 + tid) * 4 + hf] : 0.f; float x = v;
#pragma unroll
            for (int d = 1; d < 64; d <<= 1) { const float y = __shfl_up(x, d); if (lane >= d) x += y; }
            if (lane == 63) wtot[wid] = x;
            __syncthreads();
            float pre = 0.f; for (int w = 0; w < wid; ++w) pre += wtot[w];
            segpre[tid] = pre + x - v;
            __syncthreads();
        }
        auto getC = [&](int pos) -> float {
            if (prompt) return segpre[pos >> 5] + Cin[(size_t)(bi * SEQ + pos) * 4 + hf];
            if (pos < PAST) return ccum[(size_t)pos * 4];
            if (pos < PAST + 32) return ccum[(size_t)(PAST - 1) * 4] + Cin[(size_t)(NP + sbi * 32 + pos - PAST) * 4 + hf];
            return 0.f; };
        const bool wact = wid < nw;
        bf16x8 qf[8];
        float cq2 = 0.f;
        const int qlo = qpos0 + 32 * wid, qhi = qlo + 31, qpos = qlo + r;
        if (wact) { const u16* qrow = (const u16*)(p.ws + W_QB) + (size_t)(row0 + 32 * wid + r) * 1024 + head8 * 128 + 8 * h;
#pragma unroll
            for (int kk = 0; kk < 8; ++kk) qf[kk] = *(const bf16x8*)(qrow + 16 * kk);
            if (fox) cq2 = getC(qpos) * LOG2E; }
        else {
#pragma unroll
            for (int kk = 0; kk < 8; ++kk) qf[kk] = (bf16x8){0, 0, 0, 0, 0, 0, 0, 0}; }
        float qnK = 3.0e38f;
        if (fox && prompt) { const unsigned* ks = (const unsigned*)(p.ws + W_CTR) + 64 + ((layer * 2 + bi) * 4 + hf) * 4;
            const float kmax = sqrtf(__uint_as_float(ks[0]) + __uint_as_float(ks[1]) + __uint_as_float(ks[2]) + __uint_as_float(ks[3])) * 1.01f; float qn2 = 0.f;
#pragma unroll
            for (int kk = 0; kk < 8; ++kk)
#pragma unroll
                for (int i = 0; i < 8; ++i) { const float f = __uint_as_float(((unsigned)(unsigned short)qf[kk][i]) << 16); qn2 += f * f; }
            qn2 += __shfl_xor(qn2, 32); qnK = sqrtf(qn2) * 1.01f * kmax; }
        u32x4 kreg[2], vreg[2]; float ckreg = 0.f;
        const int krow_ = tid >> 4, kch = tid & 15, vrow_ = tid >> 3, vch = tid & 7;
#define LOAD_TILE(jt_) do { const int k0_ = (jt_) * 64; _Pragma("unroll") for (int pz = 0; pz < 2; ++pz) { \
            kreg[pz] = *(const u32x4*)(Kb + (size_t)(k0_ + krow_ + 32 * pz) * 1024 + kch * 8); \
            vreg[pz] = *(const u32x4*)(Vt + (size_t)(vrow_ + 64 * pz) * ldv + k0_ + vch * 8); } \
            if (fox && tid < 64) ckreg = getC(k0_ + tid) * LOG2E; } while (0)
#define STORE_TILE(buf_) do { _Pragma("unroll") for (int pz = 0; pz < 2; ++pz) { \
            *(LAS u32x4*)(lds + A_KB + (buf_) * 17408 + (krow_ + 32 * pz) * KROW + kch * 16) = kreg[pz]; \
            *(LAS u32x4*)(lds + A_VB + (buf_) * 18432 + (vrow_ + 64 * pz) * VROW + vch * 16) = vreg[pz]; } \
            if (fox && tid < 64) *(LAS float*)(lds + A_CK + (buf_) * 256 + tid * 4) = ckreg; } while (0)
        const int jt_top = (qpos0 + 32 * nw - 1) >> 6;
        LOAD_TILE(jt_top); STORE_TILE(0);
        __syncthreads();
        f32x16 o[4];
#pragma unroll
        for (int dt = 0; dt < 4; ++dt)
#pragma unroll
            for (int i = 0; i < 16; ++i) o[dt][i] = 0.f;
        float carry = 0.f, mrun = -1e30f, lsum = 0.f; bool wave_done = !wact;
        for (int jt = jt_top, it = 0; jt >= 0; --jt, ++it) {
            const int cur = it & 1; const bool more = jt > 0;
            if (more) LOAD_TILE(jt - 1);
            const int key0 = jt * 64;
            if (fox && prompt && !wave_done && key0 <= qhi) {
                const float ck63 = *(const LAS float*)(lds + A_CK + cur * 256 + 252);
                if (__all((qnK + cq2 - ck63) < (mrun - 155.f))) wave_done = true; }
            if (!wave_done && key0 <= qhi) {
                const bool diag = key0 + 63 >= qlo;
                const LAS unsigned char* kb = lds + A_KB + cur * 17408 + prow * KROW + 16 * h;
                const LAS unsigned char* vb = lds + A_VB + cur * 18432 + r * VROW + 16 * h;
                f32x16 sv[2];
#pragma unroll
                for (int i = 0; i < 16; ++i) { sv[0][i] = 0.f; sv[1][i] = 0.f; }
#pragma unroll
                for (int kk = 0; kk < 8; ++kk) { const bf16x8 a0 = *(const LAS bf16x8*)(kb + kk * 32); const bf16x8 a1 = *(const LAS bf16x8*)(kb + 32 * KROW + kk * 32);
                    sv[0] = __builtin_amdgcn_mfma_f32_32x32x16_bf16(a0, qf[kk], sv[0], 0, 0, 0); sv[1] = __builtin_amdgcn_mfma_f32_32x32x16_bf16(a1, qf[kk], sv[1], 0, 0, 0); }
                if (!fox) {
#pragma unroll
                    for (int kt = 1; kt >= 0; --kt) {
                        float sp[16], ex[16], tot[2];
#pragma unroll
                        for (int rg = 0; rg < 16; ++rg) { const int kpos = key0 + 32 * kt + 16 * (rg >> 3) + 8 * h + (rg & 7); const float z = sv[kt][rg];
                            const float spv = fmaxf(z, 0.f) + flog2(1.f + fexp2(-fabsf(z))); sp[rg] = (!diag || kpos < qpos) ? spv : 0.f; }
#pragma unroll
                        for (int c = 0; c < 2; ++c) { float run = 0.f;
#pragma unroll
                            for (int idx = 7; idx >= 0; --idx) { ex[8 * c + idx] = run; run += sp[8 * c + idx]; }
                            tot[c] = run; }
                        const float pt0 = __shfl_xor(tot[0], 32), pt1 = __shfl_xor(tot[1], 32);
                        const float off1 = carry + (h ? 0.f : pt1), off0 = carry + (h ? (pt1 + tot[1]) : (pt0 + tot[1] + pt1));
#pragma unroll
                        for (int rg = 0; rg < 16; ++rg) { const int kpos = key0 + 32 * kt + 16 * (rg >> 3) + 8 * h + (rg & 7);
                            const float e2 = sv[kt][rg] - sp[rg] - ((rg >= 8 ? off1 : off0) + ex[rg]);
                            sv[kt][rg] = (!diag || kpos < qpos) ? fexp2(e2) : 0.f; }
                        carry += (tot[0] + tot[1]) + (pt0 + pt1);
                    }
                    if (__all(carry > 152.f)) wave_done = true;
                } else {
                    const LAS float* ckb = (const LAS float*)(lds + A_CK + cur * 256) + 8 * h;
                    float mx = -1e30f;
#pragma unroll
                    for (int kt = 0; kt < 2; ++kt)
#pragma unroll
                        for (int q4 = 0; q4 < 4; ++q4) { const f32x4 ck = *(const LAS f32x4*)(ckb + 32 * kt + 16 * (q4 >> 1) + 4 * (q4 & 1));
#pragma unroll
                            for (int j = 0; j < 4; ++j) { const int rg = 4 * q4 + j; const int kpos = key0 + 32 * kt + 16 * (rg >> 3) + 8 * h + (rg & 7);
                                float x = sv[kt][rg] + (cq2 - ck[j]); if (diag && kpos > qpos) x = -1e30f; sv[kt][rg] = x; mx = fmaxf(mx, x); } }
                    mx = fmaxf(mx, __shfl_xor(mx, 32));
                    const float mnew = fmaxf(mrun, mx), alpha = fexp2(mrun - mnew); mrun = mnew; float ps = 0.f;
#pragma unroll
                    for (int kt = 0; kt < 2; ++kt)
#pragma unroll
                        for (int rg = 0; rg < 16; ++rg) { const float pv = fexp2(sv[kt][rg] - mnew); sv[kt][rg] = pv; ps += pv; }
                    lsum = lsum * alpha + ps;
                    if (!__all(alpha == 1.f)) {
#pragma unroll
                        for (int dt = 0; dt < 4; ++dt) o[dt] *= alpha; }
                }
#pragma unroll
                for (int kt = 0; kt < 2; ++kt)
#pragma unroll
                    for (int c = 0; c < 2; ++c) { union { u32x4 u; bf16x8 v; } pf;
                        pf.u.x = cvt_pk_bf16(sv[kt][8 * c + 0], sv[kt][8 * c + 1]); pf.u.y = cvt_pk_bf16(sv[kt][8 * c + 2], sv[kt][8 * c + 3]);
                        pf.u.z = cvt_pk_bf16(sv[kt][8 * c + 4], sv[kt][8 * c + 5]); pf.u.w = cvt_pk_bf16(sv[kt][8 * c + 6], sv[kt][8 * c + 7]);
#pragma unroll
                        for (int dt = 0; dt < 4; ++dt) { const bf16x8 vf = *(const LAS bf16x8*)(vb + dt * 32 * VROW + (32 * kt + 16 * c) * 2);
                            o[dt] = __builtin_amdgcn_mfma_f32_32x32x16_bf16(vf, pf.v, o[dt], 0, 0, 0); } }
            }
            if (more) STORE_TILE(cur ^ 1);
            if (lane == 0) misc[8 + cur * 8 + wid] = wave_done ? 1 : 0;
            __syncthreads();
            int alld = 1;
#pragma unroll
            for (int w = 0; w < 8; ++w) alld &= misc[8 + cur * 8 + w];
            if (alld) break;
        }
#undef LOAD_TILE
#undef STORE_TILE
        if (wact) {
            if (fox) { lsum += __shfl_xor(lsum, 32); const float inv = 1.f / lsum;
#pragma unroll
                for (int dt = 0; dt < 4; ++dt) o[dt] *= inv; }
            float ss = 0.f;
#pragma unroll
            for (int dt = 0; dt < 4; ++dt)
#pragma unroll
                for (int i = 0; i < 16; ++i) ss += o[dt][i] * o[dt][i];
            ss += __shfl_xor(ss, 32);
            const float rn = rsqrtf(ss * (1.f / 128.f) + EPS);
            const int row = row0 + 32 * wid + r;
            const float* gp = (fox ? p.g_ofox : p.g_osb) + layer * 512 + hf * 128 + 4 * h;
            const u16* zp = (const u16*)(p.ws + W_ZB) + (size_t)row * 1024 + head8 * 128 + 4 * h;
            u16* op = (u16*)(p.ws + W_OB) + (size_t)row * 1024 + head8 * 128 + 4 * h;
#pragma unroll
            for (int dt = 0; dt < 4; ++dt)
#pragma unroll
                for (int bb = 0; bb < 4; ++bb) { const int d = 32 * dt + 8 * bb; const f32x4 g = *(const f32x4*)(gp + d); const u32x2 zz = *(const u32x2*)(zp + d);
                    const float v0 = o[dt][4 * bb + 0] * rn * g.x * bf_lo(zz.x), v1 = o[dt][4 * bb + 1] * rn * g.y * bf_hi(zz.x), v2 = o[dt][4 * bb + 2] * rn * g.z * bf_lo(zz.y), v3 = o[dt][4 * bb + 3] * rn * g.w * bf_hi(zz.y);
                    u32x2 w; w.x = cvt_pk_bf16(v0, v1); w.y = cvt_pk_bf16(v2, v3); *(u32x2*)(op + d) = w; }
        }
    }
}

__device__ __forceinline__ void final_phase(int wv, const P& p) {
    const int tid = opaque_tid(wv), wid = tid >> 6, lane = tid & 63;
    const float* ssqA = (const float*)(p.ws + W_SSQA);
    for (int row = blockIdx.x * 8 + wid; row < NR; row += gridDim.x * 8) {
        float s = lane < 32 ? ssqA[(size_t)row * 32 + lane] : 0.f;
#pragma unroll
        for (int d = 1; d < 64; d <<= 1) s += __shfl_xor(s, d);
        const float rs = rsqrtf(s * (1.f / 2048.f) + EPS);
        float* xo = p.out + (size_t)row * 2048; const u16* xb = (const u16*)(p.ws + W_XBA) + (size_t)row * 2048;
#pragma unroll
        for (int i = 0; i < 8; ++i) { const int c = (i * 64 + lane) * 4; const u32x2 xw = *(const u32x2*)(xb + c); const f32x4 g = *(const f32x4*)(p.g_final + c);
            f32x4 v; v.x = bf_lo(xw.x) * rs * g.x; v.y = bf_hi(xw.x) * rs * g.y; v.z = bf_lo(xw.y) * rs * g.z; v.w = bf_hi(xw.y) * rs * g.w; *(f32x4*)(xo + c) = v; }
    }
}

constexpr int LDS_BYTES = pg8::STAGE_BYTES;

__global__ __launch_bounds__(512, 2) void fwd_megakernel(P p) {
    extern __shared__ __attribute__((aligned(16))) unsigned char shm[];
    LAS unsigned char* lds = (LAS unsigned char*)shm;
    cg::grid_group grid = cg::this_grid();
    const int wv = __builtin_amdgcn_readfirstlane(threadIdx.x >> 6);
    prep_phase(wv, p, lds);
    grid.sync();
    pg8::StaticOrder S;
    for (int layer_ = 0; layer_ < DEPTH; ++layer_) {
        int layer = layer_, bid = (int)blockIdx.x, G = (int)gridDim.x; asm volatile("" : "+s"(layer), "+s"(bid), "+s"(G));
        {
            pg8::Gemm g{(const u16*)(p.ws + W_XBA), (const u16*)(p.ws + W_WTIN) + (size_t)layer * 4096 * 2048, NR, 4096, 2048};
            S.init(g.M, g.N, G, bid); EpiProj E{p, layer};
            pg8::gemm_phase(wv, lds, g, S, E);
            logf_items(wv, p, layer, lds);
        }
        grid.sync();
        attn_phase(wv, p, layer, lds);
        grid.sync();
        {
            pg8::Gemm g{(const u16*)(p.ws + W_OB), (const u16*)(p.ws + W_WTOUT) + (size_t)layer * 2048 * 1024, NR, 2048, 1024};
            S.init(g.M, g.N, G, bid); EpiOut E{p};
            pg8::gemm_phase(wv, lds, g, S, E);
            pg8::Gemm g2{(const u16*)(p.ws + W_PB) + (size_t)layer * NR * 256, (const u16*)(p.ws + W_WTPLE) + (size_t)layer * 2048 * 256, NR, 2048, 256};
            S.init(g2.M, g2.N, G - 8, bid - 8); EpiPle E2{p};
            if (bid >= 8) pg8::gemm_phase(wv, lds, g2, S, E2);
        }
        grid.sync();
        {
            pg8::Gemm g{(const u16*)(p.ws + W_XBB), (const u16*)(p.ws + W_WTGATE) + (size_t)layer * 2048 * 2048, NR, 2048, 2048};
            S.init(g.M, g.N, G, bid); EpiGate E{p};
            pg8::gemm_phase(wv, lds, g, S, E);
        }
        grid.sync();
    }
    final_phase(wv, p);
}

extern "C" void kernel_launch(void* const* d_in, const int* in_sizes, int n_in, void* d_out, int out_size, void* d_ws, size_t ws_size, hipStream_t stream) {
    static int grid_blocks = 0;
    if (!grid_blocks) {
        if (n_in != 19 || (size_t)out_size != OUT_TOTAL || ws_size < W_END) { fprintf(stderr, "kernel_launch: unexpected shapes: n_in %d out %d (want %zu) ws %zu (want %zu)\n", n_in, out_size, OUT_TOTAL, ws_size, W_END); grid_blocks = -1; return; }
        int dev = 0, cus = 0, per_cu = 0;
        hipGetDevice(&dev);
        hipDeviceGetAttribute(&cus, hipDeviceAttributeMultiprocessorCount, dev);
        if (hipFuncSetAttribute((const void*)fwd_megakernel, hipFuncAttributeMaxDynamicSharedMemorySize, LDS_BYTES) != hipSuccess) fprintf(stderr, "kernel_launch: hipFuncSetAttribute failed\n");
        if (hipOccupancyMaxActiveBlocksPerMultiprocessor(&per_cu, (const void*)fwd_megakernel, 512, LDS_BYTES) != hipSuccess || per_cu < 1) { fprintf(stderr, "kernel_launch: occupancy query gave %d\n", per_cu); per_cu = 1; }
        (void)hipGetLastError();
        grid_blocks = cus * per_cu;
    }
    if (grid_blocks < 0) return;
    P p{};
    const float** f = (const float**)&p;
    for (int i = 0; i < 19; ++i) f[i] = (const float*)d_in[i];
    p.out = (float*)d_out; p.ws = (unsigned char*)d_ws;
    void* args[] = {&p};
    hipError_t e = hipLaunchCooperativeKernel((const void*)fwd_megakernel, dim3(grid_blocks), dim3(512), args, LDS_BYTES, stream);
    if (e != hipSuccess) fprintf(stderr, "cooperative launch failed: %s (grid %d)\n", hipGetErrorString(e), grid_blocks);
}
```

```cpp
#include <hip/hip_runtime.h>
#include <hip/hip_cooperative_groups.h>
#include <cstdio>
namespace cg = cooperative_groups;

#define LAS __attribute__((address_space(3)))
typedef unsigned short u16;
typedef short bf16x8 __attribute__((ext_vector_type(8)));
typedef float f32x4 __attribute__((ext_vector_type(4)));
typedef float f32x16 __attribute__((ext_vector_type(16)));
typedef unsigned u32x2 __attribute__((ext_vector_type(2)));
typedef unsigned u32x4 __attribute__((ext_vector_type(4)));

constexpr int D_MODEL = 2048, SEQ = 16384, DEPTH = 4, DEC_BATCH = 8, DEC_SEQ = 32, PAST = 1024;
constexpr int NP = 2 * SEQ, NS = DEC_BATCH * DEC_SEQ, NR = NP + NS;
constexpr int DMIX = 1024, D_IN = 4100, PLE = 256;
constexpr int SL = 1088;
constexpr float EPS = 1e-6f;
constexpr float LOG2E = 1.4426950408889634f;
constexpr float QSCALE = 0.08838834764831845f * LOG2E;
constexpr int NITEMS = 1024 + 64;

constexpr size_t O_Y = 0;
constexpr size_t O_KV_P = (size_t)NR * D_MODEL;
constexpr size_t KVP = (size_t)DEPTH * NP * 512;
constexpr size_t O_LOGF_P = O_KV_P + 4 * KVP;
constexpr size_t O_KV_S = O_LOGF_P + (size_t)DEPTH * NP * 4;
constexpr size_t KVS = (size_t)DEPTH * NS * 512;
constexpr size_t O_LOGF_S = O_KV_S + 4 * KVS;
constexpr size_t OUT_TOTAL = O_LOGF_S + (size_t)DEPTH * NS * 4;

constexpr size_t al256(size_t x) { return (x + 255) & ~(size_t)255; }
constexpr size_t W_WTIN = 0;
constexpr size_t W_WTOUT = W_WTIN + (size_t)DEPTH * 4096 * 2048 * 2;
constexpr size_t W_WTPLE = W_WTOUT + (size_t)DEPTH * 2048 * 1024 * 2;
constexpr size_t W_WTGATE = W_WTPLE + (size_t)DEPTH * 2048 * 256 * 2;
constexpr size_t W_WF = W_WTGATE + (size_t)DEPTH * 2048 * 2048 * 2;
constexpr size_t W_XBA = W_WF + (size_t)DEPTH * 2048 * 4 * 4;
constexpr size_t W_PB = W_XBA + (size_t)NR * 2048 * 2;
constexpr size_t W_R = W_PB + (size_t)DEPTH * NR * 256 * 2;
constexpr size_t W_QB = W_R;
constexpr size_t W_KBP = W_QB + (size_t)NR * 1024 * 2;
constexpr size_t W_VTP = W_KBP + (size_t)NP * 1024 * 2;
constexpr size_t W_ZB = W_VTP + (size_t)NP * 1024 * 2;
constexpr size_t W_PLEB = W_R;
constexpr size_t W_XBB = W_R + al256((size_t)NR * 2048 * 2);
constexpr size_t R_SIZE = 2 * al256((size_t)NR * 2048 * 2) + 4096;
static_assert(W_ZB + (size_t)NR * 1024 * 2 <= W_R + R_SIZE, "region R too small");
constexpr size_t W_KBS = W_R + R_SIZE;
constexpr size_t W_VTS = W_KBS + (size_t)DEPTH * DEC_BATCH * SL * 1024 * 2;
constexpr size_t W_OB = W_VTS + (size_t)DEPTH * DEC_BATCH * 8 * 128 * SL * 2;
constexpr size_t W_SSQA = W_OB + (size_t)NR * 1024 * 2;
constexpr size_t W_SSQB = W_SSQA + (size_t)NR * 32 * 4;
constexpr size_t W_CIN = W_SSQB + (size_t)NR * 32 * 4;
constexpr size_t W_SEGTOT = W_CIN + (size_t)NR * 4 * 4;
constexpr size_t W_CCUM = W_SEGTOT + al256((size_t)(NR / 32) * 4 * 4);
constexpr size_t W_CTR = W_CCUM + (size_t)DEPTH * DEC_BATCH * PAST * 4 * 4;
constexpr size_t W_PLES = W_CTR + 4096;
constexpr size_t W_END = W_PLES + (size_t)NS * 2048 * 2;

struct P {
    const float *x_prompt, *x_sample, *p_prompt, *p_sample, *c_sbk, *c_sbv, *c_fxk, *c_fxv, *c_logf, *w_in, *b_f, *g_attn, *g_osb, *g_ofox, *w_out, *w_ple, *g_ple, *w_gate, *g_final;
    float* out;
    unsigned char* ws;
};

__device__ __forceinline__ unsigned cvt_pk_bf16(float lo, float hi) { unsigned r; asm volatile("v_cvt_pk_bf16_f32 %0, %1, %2" : "=v"(r) : "v"(lo), "v"(hi)); return r; }
__device__ __forceinline__ float bf_lo(unsigned w) { return __uint_as_float(w << 16); }
__device__ __forceinline__ float bf_hi(unsigned w) { return __uint_as_float(w & 0xffff0000u); }
__device__ __forceinline__ float fexp2(float x) { return __builtin_amdgcn_exp2f(x); }
__device__ __forceinline__ float flog2(float x) { return __builtin_amdgcn_logf(x); }
__device__ __forceinline__ int opaque_tid(int wv) { int l; asm volatile("v_mbcnt_lo_u32_b32 %0, -1, 0\n\tv_mbcnt_hi_u32_b32 %0, -1, %0" : "=v"(l)); return wv * 64 + l; }

namespace pg8 {
constexpr int BM = 256, BK = 64, HALF = 128, HTB = HALF * BK * 2, STAGE_BYTES = 8 * HTB, NXCD = 8, WGM = 8;
__host__ __device__ __forceinline__ int lds_byte(int r, int c) { const int st = (r >> 4) * 2 + (c >> 5), rr = r & 15, cc = c & 31, ob = rr * 64 + cc * 2; return st * 1024 + (ob ^ (((ob >> 9) & 1) << 5)); }
__host__ __device__ __forceinline__ void stage_rc(int b, int& R, int& C) { const int st = b / 1024, sb = b % 1024, swz = sb ^ (((sb >> 9) & 1) << 5); R = (st >> 1) * 16 + swz / 64; C = (st & 1) * 32 + (swz % 64) / 2; }
struct Unit { int pm, pn; };
struct Gemm { const u16* A; const u16* Bt; int M, N, K; };
struct StaticOrder {
    int nM, nN, nwg, G, c;
    int one_pm, one_pn;
    __device__ void init(int M, int N, int G_, int c_) { nM = M / BM; nN = N / BM; nwg = nM * nN; G = G_; c = c_; one_pm = -1; one_pn = 0; }
    __device__ void init_one(int pm, int pn) { nM = 1; nN = 1; nwg = 1; G = 1; c = 0; one_pm = pm; one_pn = pn; }
    __device__ bool next(int i, Unit& u) const {
        if (one_pm >= 0) { if (i > 0) return false; u.pm = one_pm; u.pn = one_pn; return true; }
        const long L = (long)i * G + c; if (L >= nwg) return false;
        int wgid = (int)L; { const int q = nwg / NXCD, r = nwg % NXCD, xcd = wgid % NXCD, off = wgid / NXCD; wgid = (xcd < r ? xcd * (q + 1) : r * (q + 1) + (xcd - r) * q) + off; }
        const int nig = WGM * nN, gid = wgid / nig, fm = gid * WGM, gsz = (nM - fm) < WGM ? (nM - fm) : WGM;
        u.pm = fm + ((wgid % nig) % gsz); u.pn = (wgid % nig) / gsz; return true;
    }
};

template <class Epi>
__device__ __forceinline__ void gemm_phase(int wv, LAS unsigned char* lds, const Gemm g, const StaticOrder& S, const Epi& E, const int skew_ticks = 0) {
    const int tid = opaque_tid(wv), wid = __builtin_amdgcn_readfirstlane(tid >> 6), lane = tid & 63, wr = wid >> 2, wc = wid & 3, fr = lane & 15, fq = lane >> 4;
    const int K = g.K, nt = K / BK;
    unsigned voffA[2], voffB0[2], voffB1[2];
#pragma unroll
    for (int i = 0; i < 2; ++i) { int R, C; stage_rc(tid * 16 + i * 8192, R, C); voffA[i] = (unsigned)(R * K + C) * 2u;
        const int rho = R & 31, pr = 8 * ((rho & 15) >> 2) + 4 * (rho >> 4) + (rho & 3), Rb = 64 * (R >> 5) + pr;
        voffB0[i] = (unsigned)(Rb * K + C) * 2u; voffB1[i] = (unsigned)((Rb + 32) * K + C) * 2u; }
    const size_t kstep = (size_t)(BK * 2);
    const size_t hstep = (size_t)HALF * K * 2;
    const size_t tstep = 2 * hstep;
    const unsigned ldsw = (unsigned)wid * 1024u;
    const int aoff = lds_byte(wr * 64 + fr, fq * 8), boff = lds_byte(wc * 32 + fr, fq * 8);
#define PG8_SA(b, h) (((b) * 2 + (h)) * HTB)
#define PG8_SB(b, h) ((4 + (b) * 2 + (h)) * HTB)
#define PG8_STAGE(bufoff, gbase, voff) do { _Pragma("unroll") for (int _i = 0; _i < 2; ++_i) \
        __builtin_amdgcn_global_load_lds((const unsigned*)((const char*)(gbase) + (voff)[_i]), (LAS unsigned*)(lds + (bufoff) + ldsw + _i * 8192), 16, 0, 0); } while (0)
#define PG8_LDA(dst, b, h) do { _Pragma("unroll") for (int m = 0; m < 4; ++m) _Pragma("unroll") for (int k = 0; k < 2; ++k) dst[m][k] = *(const LAS bf16x8*)(lds + PG8_SA(b, h) + aoff + m * 2048 + k * 1024); } while (0)
#define PG8_LDB(dst, b, h) do { _Pragma("unroll") for (int n = 0; n < 2; ++n) _Pragma("unroll") for (int k = 0; k < 2; ++k) dst[n][k] = *(const LAS bf16x8*)(lds + PG8_SB(b, h) + boff + n * 2048 + k * 1024); } while (0)
#define PG8_MMA(ai, bj, At, Bt) do { __builtin_amdgcn_s_setprio(1); _Pragma("unroll") for (int m = 0; m < 4; ++m) _Pragma("unroll") for (int n = 0; n < 2; ++n) _Pragma("unroll") for (int k = 0; k < 2; ++k) \
        acc[ai][bj][m][n] = __builtin_amdgcn_mfma_f32_16x16x32_bf16(Bt[n][k], At[m][k], acc[ai][bj][m][n], 0, 0, 0); __builtin_amdgcn_s_setprio(0); } while (0)
#define PG8_WAIT_V(n) asm volatile("s_waitcnt vmcnt(" #n ")" ::: "memory")
#define PG8_WAIT_L(n) asm volatile("s_waitcnt lgkmcnt(" #n ")" ::: "memory")
#define PG8_BAR __builtin_amdgcn_s_barrier()
#define PG8_SCHED __builtin_amdgcn_sched_barrier(0)
    Unit cur, nxt; int ui = 0;
    if (!S.next(0, cur)) return;
    if (skew_ticks > 0) {
        const unsigned long long t0 = __builtin_amdgcn_s_memrealtime();
        while ((long long)(__builtin_amdgcn_s_memrealtime() - t0) < (long long)skew_ticks) __builtin_amdgcn_s_sleep(32);
    }
    f32x4 acc[2][2][4][2];
#pragma unroll
    for (int a = 0; a < 2; ++a)
#pragma unroll
        for (int b = 0; b < 2; ++b)
#pragma unroll
            for (int m = 0; m < 4; ++m)
#pragma unroll
                for (int n = 0; n < 2; ++n) acc[a][b][m][n] = (f32x4){0.f, 0.f, 0.f, 0.f};
    bf16x8 At[4][2], B0[2][2], B1[2][2];
    const char* cA = (const char*)g.A + (size_t)cur.pm * tstep; const char* cB = (const char*)g.Bt + (size_t)cur.pn * tstep;
    PG8_STAGE(PG8_SB(0, 0), cB, voffB0); PG8_STAGE(PG8_SA(0, 0), cA, voffA); PG8_STAGE(PG8_SB(0, 1), cB, voffB1); PG8_STAGE(PG8_SA(0, 1), cA + hstep, voffA);
    if (wr == 1) PG8_BAR;
    PG8_WAIT_V(4); PG8_BAR;
    PG8_STAGE(PG8_SB(1, 0), cB + kstep, voffB0); PG8_STAGE(PG8_SA(1, 0), cA + kstep, voffA); PG8_STAGE(PG8_SB(1, 1), cB + kstep, voffB1);
    PG8_WAIT_V(6); PG8_BAR;
    for (;;) {
        const bool has_next = S.next(ui + 1, nxt);
        const char* nA = has_next ? (const char*)g.A + (size_t)nxt.pm * tstep : cA; const char* nB = has_next ? (const char*)g.Bt + (size_t)nxt.pn * tstep : cB;
        for (int t = 0; t < nt; t += 2) {
            const bool last = (t == nt - 2);
            const char* a1 = cA + (size_t)(t + 1) * kstep;
            const char* a2 = last ? nA : cA + (size_t)(t + 2) * kstep; const char* b2 = last ? nB : cB + (size_t)(t + 2) * kstep;
            const char* a3 = a2 + kstep; const char* b3 = b2 + kstep;
            PG8_LDB(B0, 0, 0); PG8_SCHED; PG8_LDA(At, 0, 0); PG8_STAGE(PG8_SA(1, 1), a1 + hstep, voffA);
            PG8_WAIT_L(8); PG8_BAR; PG8_WAIT_L(0); PG8_MMA(0, 0, At, B0); PG8_BAR; PG8_SCHED;
            PG8_LDB(B1, 0, 1); PG8_STAGE(PG8_SB(0, 0), b2, voffB0);
            PG8_BAR; PG8_WAIT_L(0); PG8_MMA(0, 1, At, B1); PG8_BAR;
            PG8_LDA(At, 0, 1); PG8_STAGE(PG8_SA(0, 0), a2, voffA);
            PG8_BAR; PG8_WAIT_L(0); PG8_MMA(1, 0, At, B0); PG8_BAR; PG8_SCHED;
            PG8_STAGE(PG8_SB(0, 1), b2, voffB1);
            PG8_WAIT_V(6); PG8_BAR; PG8_MMA(1, 1, At, B1); PG8_BAR;
            PG8_LDB(B0, 1, 0); PG8_SCHED; PG8_LDA(At, 1, 0); PG8_STAGE(PG8_SA(0, 1), a2 + hstep, voffA);
            PG8_WAIT_L(8); PG8_BAR; PG8_WAIT_L(0); PG8_MMA(0, 0, At, B0); PG8_BAR; PG8_SCHED;
            PG8_LDB(B1, 1, 1); PG8_STAGE(PG8_SB(1, 0), b3, voffB0);
            PG8_BAR; PG8_WAIT_L(0); PG8_MMA(0, 1, At, B1); PG8_BAR;
            PG8_LDA(At, 1, 1); PG8_STAGE(PG8_SA(1, 0), a3, voffA);
            PG8_BAR; PG8_WAIT_L(0); PG8_MMA(1, 0, At, B0); PG8_BAR; PG8_SCHED;
            PG8_STAGE(PG8_SB(1, 1), b3, voffB1);
            PG8_WAIT_V(6); PG8_BAR; PG8_MMA(1, 1, At, B1); PG8_BAR;
        }
        E(acc, cur, wr, wc, fr, fq);
        if (!has_next) break;
#pragma unroll
        for (int a = 0; a < 2; ++a)
#pragma unroll
            for (int b = 0; b < 2; ++b)
#pragma unroll
                for (int m = 0; m < 4; ++m)
#pragma unroll
                    for (int n = 0; n < 2; ++n) acc[a][b][m][n] = (f32x4){0.f, 0.f, 0.f, 0.f};
        cur = nxt; cA = nA; cB = nB; ++ui;
    }
    PG8_WAIT_V(0);
    if (wr == 0) PG8_BAR;
    PG8_BAR;
#undef PG8_SA
#undef PG8_SB
#undef PG8_STAGE
#undef PG8_LDA
#undef PG8_LDB
#undef PG8_MMA
#undef PG8_WAIT_V
#undef PG8_WAIT_L
#undef PG8_BAR
#undef PG8_SCHED
}
}


__device__ __forceinline__ float row_rstd(const float* ssq, int row, int fq) {
    const f32x4* q = (const f32x4*)(ssq + (size_t)row * 32 + fq * 8);
    const f32x4 a = q[0], b = q[1];
    float s = (a.x + a.y) + (a.z + a.w) + (b.x + b.y) + (b.z + b.w);
    s += __shfl_xor(s, 16); s += __shfl_xor(s, 32);
    return rsqrtf(s * (1.f / 2048.f) + EPS);
}
__device__ __forceinline__ u32x4 pack8(const f32x4 a, const f32x4 b) { u32x4 w; w.x = cvt_pk_bf16(a.x, a.y); w.y = cvt_pk_bf16(a.z, a.w); w.z = cvt_pk_bf16(b.x, b.y); w.w = cvt_pk_bf16(b.z, b.w); return w; }

struct EpiProj {
    P p; int layer;
    __device__ __forceinline__ void operator()(const f32x4 (&acc)[2][2][4][2], const pg8::Unit& u, int wr, int wc, int fr, int fq) const {
        const int group = u.pn >> 1, type = group & 3, br = group >> 2;
        const int cgb = (u.pn & 1) * 256 + wc * 64 + 8 * fq;
        const float* ssqA = (const float*)(p.ws + W_SSQA);
        u16* Qb = (u16*)(p.ws + W_QB); u16* Zb = (u16*)(p.ws + W_ZB);
        float kmx = 0.f;
        float rsv[8];
#pragma unroll
        for (int i = 0; i < 8; ++i) rsv[i] = row_rstd(ssqA, u.pm * 256 + (i >> 2) * 128 + wr * 64 + (i & 3) * 16 + fr, fq);
#pragma unroll
        for (int ai = 0; ai < 2; ++ai)
#pragma unroll
            for (int m = 0; m < 4; ++m) {
                const int row = u.pm * 256 + ai * 128 + wr * 64 + m * 16 + fr;
                const float rs = rsv[ai * 4 + m];
                if (type == 0) {
                    u16* q = Qb + (size_t)row * 1024 + br * 512 + cgb; const float sc = rs * QSCALE;
#pragma unroll
                    for (int bj = 0; bj < 2; ++bj) *(u32x4*)(q + bj * 32) = pack8(acc[ai][bj][m][0] * sc, acc[ai][bj][m][1] * sc);
                } else if (type == 3) {
                    u16* z = Zb + (size_t)row * 1024 + br * 512 + cgb;
#pragma unroll
                    for (int bj = 0; bj < 2; ++bj) { f32x4 v0 = acc[ai][bj][m][0] * rs, v1 = acc[ai][bj][m][1] * rs;
#pragma unroll
                        for (int j = 0; j < 4; ++j) { v0[j] = v0[j] * __builtin_amdgcn_rcpf(1.f + __expf(-v0[j])); v1[j] = v1[j] * __builtin_amdgcn_rcpf(1.f + __expf(-v1[j])); }
                        *(u32x4*)(z + bj * 32) = pack8(v0, v1); }
                } else {
                    float* o32; u16* kb; u16* vt; size_t vld; float kss = 0.f;
                    if (row < NP) { const int b = row >> 14, t = row & (SEQ - 1);
                        o32 = p.out + O_KV_P + (size_t)(br * 2 + (type - 1)) * KVP + ((size_t)(layer * 2 + b) * SEQ + t) * 512;
                        kb = (u16*)(p.ws + W_KBP) + (size_t)row * 1024 + br * 512;
                        vt = (u16*)(p.ws + W_VTP) + (size_t)(b * 8 + br * 4) * 128 * SEQ + t; vld = SEQ;
                    } else { const int rr = row - NP, sb = rr >> 5, t = rr & 31;
                        o32 = p.out + O_KV_S + (size_t)(br * 2 + (type - 1)) * KVS + ((size_t)(layer * 8 + sb) * 32 + t) * 512;
                        kb = (u16*)(p.ws + W_KBS) + ((size_t)(layer * 8 + sb) * SL + PAST + t) * 1024 + br * 512;
                        vt = (u16*)(p.ws + W_VTS) + (size_t)((layer * 8 + sb) * 8 + br * 4) * 128 * SL + PAST + t; vld = SL;
                    }
#pragma unroll
                    for (int bj = 0; bj < 2; ++bj) { const f32x4 v0 = acc[ai][bj][m][0] * rs, v1 = acc[ai][bj][m][1] * rs; const int cg = cgb + bj * 32;
                        kss += (v0.x * v0.x + v0.y * v0.y + v0.z * v0.z + v0.w * v0.w) + (v1.x * v1.x + v1.y * v1.y + v1.z * v1.z + v1.w * v1.w);
                        *(f32x4*)(o32 + cg) = v0; *(f32x4*)(o32 + cg + 4) = v1;
                        const u32x4 w = pack8(v0, v1);
                        if (type == 1) *(u32x4*)(kb + cg) = w;
                        else { vt[(size_t)(cg + 0) * vld] = (u16)(w.x & 0xffffu); vt[(size_t)(cg + 1) * vld] = (u16)(w.x >> 16); vt[(size_t)(cg + 2) * vld] = (u16)(w.y & 0xffffu); vt[(size_t)(cg + 3) * vld] = (u16)(w.y >> 16);
                               vt[(size_t)(cg + 4) * vld] = (u16)(w.z & 0xffffu); vt[(size_t)(cg + 5) * vld] = (u16)(w.z >> 16); vt[(size_t)(cg + 6) * vld] = (u16)(w.w & 0xffffu); vt[(size_t)(cg + 7) * vld] = (u16)(w.w >> 16); } }
                    if (type == 1 && br == 1) { kss += __shfl_xor(kss, 16); kss += __shfl_xor(kss, 32); kmx = fmaxf(kmx, kss); }
                }
            }
        if (type == 1 && br == 1 && u.pm < NP / 256) {
            float t = kmx; t = fmaxf(t, __shfl_xor(t, 1)); t = fmaxf(t, __shfl_xor(t, 2)); t = fmaxf(t, __shfl_xor(t, 4)); t = fmaxf(t, __shfl_xor(t, 8));
            if (fr == 0 && fq == 0) atomicMax((unsigned*)(p.ws + W_CTR) + 64 + ((layer * 2 + (u.pm >> 6)) * 4 + (u.pn & 1) * 2 + (wc >> 1)) * 4 + (wc & 1), __float_as_uint(t));
        }
    }
};

struct EpiOut {
    P p;
    __device__ __forceinline__ void operator()(const f32x4 (&acc)[2][2][4][2], const pg8::Unit& u, int wr, int wc, int fr, int fq) const {
        float* ssqB = (float*)(p.ws + W_SSQB); u16* XbB = (u16*)(p.ws + W_XBB); const u16* XbA = (const u16*)(p.ws + W_XBA);
        const int c0 = u.pn * 256 + wc * 64 + 8 * fq;
#pragma unroll
        for (int ai = 0; ai < 2; ++ai) {
            u32x4 xw[4][2];
#pragma unroll
            for (int m = 0; m < 4; ++m) { const u16* xr = XbA + (size_t)(u.pm * 256 + ai * 128 + wr * 64 + m * 16 + fr) * 2048 + c0;
#pragma unroll
                for (int bj = 0; bj < 2; ++bj) xw[m][bj] = *(const u32x4*)(xr + bj * 32); }
#pragma unroll
            for (int m = 0; m < 4; ++m) {
                const int row = u.pm * 256 + ai * 128 + wr * 64 + m * 16 + fr;
                u16* xb = XbB + (size_t)row * 2048 + c0; float ss = 0.f;
#pragma unroll
                for (int bj = 0; bj < 2; ++bj) { const u32x4 w0 = xw[m][bj]; f32x4 v0 = acc[ai][bj][m][0], v1 = acc[ai][bj][m][1];
                    v0.x += bf_lo(w0.x); v0.y += bf_hi(w0.x); v0.z += bf_lo(w0.y); v0.w += bf_hi(w0.y); v1.x += bf_lo(w0.z); v1.y += bf_hi(w0.z); v1.z += bf_lo(w0.w); v1.w += bf_hi(w0.w);
                    ss += (v0.x * v0.x + v0.y * v0.y + v0.z * v0.z + v0.w * v0.w) + (v1.x * v1.x + v1.y * v1.y + v1.z * v1.z + v1.w * v1.w);
                    *(u32x4*)(xb + bj * 32) = pack8(v0, v1); }
                ss += __shfl_xor(ss, 16); ss += __shfl_xor(ss, 32);
                if (fq == 0) ssqB[(size_t)row * 32 + u.pn * 4 + wc] = ss;
            }
        }
    }
};

struct EpiPle {
    P p;
    __device__ __forceinline__ void operator()(const f32x4 (&acc)[2][2][4][2], const pg8::Unit& u, int wr, int wc, int fr, int fq) const {
        u16* O = u.pm == NP / 256 ? (u16*)(p.ws + W_PLES) - (size_t)NP * 2048 : (u16*)(p.ws + W_PLEB); const int c0 = u.pn * 256 + wc * 64 + 8 * fq;
#pragma unroll
        for (int ai = 0; ai < 2; ++ai)
#pragma unroll
            for (int m = 0; m < 4; ++m) { const int row = u.pm * 256 + ai * 128 + wr * 64 + m * 16 + fr; u16* o = O + (size_t)row * 2048 + c0;
#pragma unroll
                for (int bj = 0; bj < 2; ++bj) *(u32x4*)(o + bj * 32) = pack8(acc[ai][bj][m][0], acc[ai][bj][m][1]); }
    }
};

struct EpiGate {
    P p;
    __device__ __forceinline__ void operator()(const f32x4 (&acc)[2][2][4][2], const pg8::Unit& u, int wr, int wc, int fr, int fq) const {
        const float* ssqB = (const float*)(p.ws + W_SSQB); float* ssqA = (float*)(p.ws + W_SSQA); u16* XbA = (u16*)(p.ws + W_XBA); const u16* XbB = (const u16*)(p.ws + W_XBB); const u16* PL = u.pm == NP / 256 ? (const u16*)(p.ws + W_PLES) - (size_t)NP * 2048 : (const u16*)(p.ws + W_PLEB);
        const int c0 = u.pn * 256 + wc * 64 + 8 * fq;
        float rsv[8];
#pragma unroll
        for (int i = 0; i < 8; ++i) rsv[i] = row_rstd(ssqB, u.pm * 256 + (i >> 2) * 128 + wr * 64 + (i & 3) * 16 + fr, fq);
#pragma unroll
        for (int g4 = 0; g4 < 4; ++g4) { const int ai = g4 >> 1, m0 = (g4 & 1) * 2;
            u32x4 xw[2][2], pw[2][2];
#pragma unroll
            for (int mm = 0; mm < 2; ++mm) { const size_t ro = (size_t)(u.pm * 256 + ai * 128 + wr * 64 + (m0 + mm) * 16 + fr) * 2048 + c0;
#pragma unroll
                for (int bj = 0; bj < 2; ++bj) { xw[mm][bj] = *(const u32x4*)(XbB + ro + bj * 32); pw[mm][bj] = *(const u32x4*)(PL + ro + bj * 32); } }
#pragma unroll
            for (int mm = 0; mm < 2; ++mm) { const int m = m0 + mm;
                const int row = u.pm * 256 + ai * 128 + wr * 64 + m * 16 + fr;
                const float rs = rsv[ai * 4 + m];
                u16* xb = XbA + (size_t)row * 2048 + c0; float ss = 0.f;
#pragma unroll
                for (int bj = 0; bj < 2; ++bj) { const f32x4 a0 = acc[ai][bj][m][0] * rs, a1 = acc[ai][bj][m][1] * rs; const u32x4 pq = pw[mm][bj], xq = xw[mm][bj];
                    f32x4 v0, v1;
                    v0.x = bf_lo(xq.x) + bf_lo(pq.x) * __builtin_amdgcn_rcpf(1.f + __expf(-a0.x)); v0.y = bf_hi(xq.x) + bf_hi(pq.x) * __builtin_amdgcn_rcpf(1.f + __expf(-a0.y));
                    v0.z = bf_lo(xq.y) + bf_lo(pq.y) * __builtin_amdgcn_rcpf(1.f + __expf(-a0.z)); v0.w = bf_hi(xq.y) + bf_hi(pq.y) * __builtin_amdgcn_rcpf(1.f + __expf(-a0.w));
                    v1.x = bf_lo(xq.z) + bf_lo(pq.z) * __builtin_amdgcn_rcpf(1.f + __expf(-a1.x)); v1.y = bf_hi(xq.z) + bf_hi(pq.z) * __builtin_amdgcn_rcpf(1.f + __expf(-a1.y));
                    v1.z = bf_lo(xq.w) + bf_lo(pq.w) * __builtin_amdgcn_rcpf(1.f + __expf(-a1.z)); v1.w = bf_hi(xq.w) + bf_hi(pq.w) * __builtin_amdgcn_rcpf(1.f + __expf(-a1.w));
                    ss += (v0.x * v0.x + v0.y * v0.y + v0.z * v0.z + v0.w * v0.w) + (v1.x * v1.x + v1.y * v1.y + v1.z * v1.z + v1.w * v1.w);
                    *(u32x4*)(xb + bj * 32) = pack8(v0, v1); }
                ss += __shfl_xor(ss, 16); ss += __shfl_xor(ss, 32);
                if (fq == 0) ssqA[(size_t)row * 32 + u.pn * 4 + wc] = ss;
            }
        }
    }
};

struct TDesc { const float* src; size_t sld; u16* dst; size_t dld; const float* gk; };
constexpr int NT_WIN = DEPTH * 2048, NT_WOUT = DEPTH * 512, NT_WPLE = DEPTH * 128, NT_WGATE = DEPTH * 1024, NT_VC = DEPTH * DEC_BATCH * 8 * 32;
constexpr int NT_ALL = NT_WIN + NT_WOUT + NT_WPLE + NT_WGATE + NT_VC;
__device__ __forceinline__ TDesc tile_desc(const P& p, int t) {
    TDesc d;
    if (t < NT_WIN) { const int L = t >> 11, r = t & 2047, kt = r >> 6, nt = r & 63;
        d.src = p.w_in + (size_t)L * 2048 * D_IN + (size_t)kt * 64 * D_IN + nt * 64; d.sld = D_IN; d.dst = (u16*)(p.ws + W_WTIN) + (size_t)L * 4096 * 2048 + (size_t)nt * 64 * 2048 + kt * 64; d.dld = 2048; d.gk = p.g_attn + L * 2048 + kt * 64; return d; }
    t -= NT_WIN;
    if (t < NT_WOUT) { const int L = t >> 9, r = t & 511, kt = r >> 5, nt = r & 31;
        d.src = p.w_out + (size_t)L * 1024 * 2048 + (size_t)kt * 64 * 2048 + nt * 64; d.sld = 2048; d.dst = (u16*)(p.ws + W_WTOUT) + (size_t)L * 2048 * 1024 + (size_t)nt * 64 * 1024 + kt * 64; d.dld = 1024; d.gk = nullptr; return d; }
    t -= NT_WOUT;
    if (t < NT_WPLE) { const int L = t >> 7, r = t & 127, kt = r >> 5, nt = r & 31;
        d.src = p.w_ple + (size_t)L * 256 * 2048 + (size_t)kt * 64 * 2048 + nt * 64; d.sld = 2048; d.dst = (u16*)(p.ws + W_WTPLE) + (size_t)L * 2048 * 256 + (size_t)nt * 64 * 256 + kt * 64; d.dld = 256; d.gk = nullptr; return d; }
    t -= NT_WPLE;
    if (t < NT_WGATE) { const int L = t >> 10, r = t & 1023, kt = r >> 5, nt = r & 31;
        d.src = p.w_gate + (size_t)L * 2048 * 2048 + (size_t)kt * 64 * 2048 + nt * 64; d.sld = 2048; d.dst = (u16*)(p.ws + W_WTGATE) + (size_t)L * 2048 * 2048 + (size_t)nt * 64 * 2048 + kt * 64; d.dld = 2048; d.gk = p.g_ple + L * 2048 + kt * 64; return d; }
    t -= NT_WGATE;
    { const int mi = t >> 5, r = t & 31, kt = r >> 1, nt = r & 1; const int ls = mi >> 3, h8 = mi & 7, br = h8 >> 2, hh = h8 & 3;
        d.src = (br ? p.c_fxv : p.c_sbv) + ((size_t)ls * PAST + kt * 64) * 512 + hh * 128 + nt * 64; d.sld = 512; d.dst = (u16*)(p.ws + W_VTS) + ((size_t)mi * 128 + nt * 64) * SL + kt * 64; d.dld = SL; d.gk = nullptr; return d; }
}

__device__ __forceinline__ void prep_phase(int wv, const P& p, LAS unsigned char* lds) {
    LAS float* T = (LAS float*)lds;
    const int tid = opaque_tid(wv), G = gridDim.x, B = blockIdx.x;
    const int wid = tid >> 6, lane = tid & 63;
    if (B == 0) { ((unsigned*)(p.ws + W_CTR))[tid] = 0u; ((unsigned*)(p.ws + W_CTR))[tid + 512] = 0u; }
    {
        const int k0 = tid >> 4, n4 = (tid & 15) * 4, no = tid >> 3, kc = tid & 7;
        f32x4 v0, v1; float g0 = 1.f, g1 = 1.f; TDesc d;
        int t = B;
        if (t < NT_ALL) { d = tile_desc(p, t); v0 = *(const f32x4*)(d.src + (size_t)k0 * d.sld + n4); v1 = *(const f32x4*)(d.src + (size_t)(k0 + 32) * d.sld + n4); if (d.gk) { g0 = d.gk[k0]; g1 = d.gk[k0 + 32]; } }
        while (t < NT_ALL) {
            T[k0 * 65 + n4 + 0] = v0.x * g0; T[k0 * 65 + n4 + 1] = v0.y * g0; T[k0 * 65 + n4 + 2] = v0.z * g0; T[k0 * 65 + n4 + 3] = v0.w * g0;
            T[(k0 + 32) * 65 + n4 + 0] = v1.x * g1; T[(k0 + 32) * 65 + n4 + 1] = v1.y * g1; T[(k0 + 32) * 65 + n4 + 2] = v1.z * g1; T[(k0 + 32) * 65 + n4 + 3] = v1.w * g1;
            __syncthreads();
            const TDesc dc = d; const int tn = t + G;
            if (tn < NT_ALL) { d = tile_desc(p, tn); v0 = *(const f32x4*)(d.src + (size_t)k0 * d.sld + n4); v1 = *(const f32x4*)(d.src + (size_t)(k0 + 32) * d.sld + n4); g0 = 1.f; g1 = 1.f; if (d.gk) { g0 = d.gk[k0]; g1 = d.gk[k0 + 32]; } }
            float f[8];
#pragma unroll
            for (int j = 0; j < 8; ++j) f[j] = T[(kc * 8 + j) * 65 + no];
            u32x4 w; w.x = cvt_pk_bf16(f[0], f[1]); w.y = cvt_pk_bf16(f[2], f[3]); w.z = cvt_pk_bf16(f[4], f[5]); w.w = cvt_pk_bf16(f[6], f[7]);
            *(u32x4*)(dc.dst + (size_t)no * dc.dld + kc * 8) = w;
            __syncthreads();
            t = tn;
        }
    }
    for (int i = B * 512 + tid; i < DEPTH * 2048 * 4; i += G * 512) { const int L = i >> 13, k = (i >> 2) & 2047, j = i & 3;
        ((float*)(p.ws + W_WF))[i] = p.g_attn[L * 2048 + k] * p.w_in[(size_t)L * 2048 * D_IN + (size_t)k * D_IN + 4096 + j]; }
    for (int row = B * 8 + wid; row < NR; row += G * 8) {
        const float* src = row < NP ? p.x_prompt + (size_t)row * 2048 : p.x_sample + (size_t)(row - NP) * 2048;
        u16* xb = (u16*)(p.ws + W_XBA) + (size_t)row * 2048; float ss = 0.f;
#pragma unroll
        for (int i = 0; i < 8; ++i) { const int c = (i * 64 + lane) * 4; const f32x4 v = *(const f32x4*)(src + c); ss += v.x * v.x + v.y * v.y + v.z * v.z + v.w * v.w;
            u32x2 w; w.x = cvt_pk_bf16(v.x, v.y); w.y = cvt_pk_bf16(v.z, v.w); *(u32x2*)(xb + c) = w; }
#pragma unroll
        for (int d = 1; d < 64; d <<= 1) ss += __shfl_xor(ss, d);
        if (lane < 32) ((float*)(p.ws + W_SSQA))[(size_t)row * 32 + lane] = lane == 0 ? ss : 0.f;
    }
    for (size_t i0 = (size_t)B * 512 + tid; i0 < (size_t)DEPTH * NR * 64; i0 += (size_t)G * 512 * 4) { f32x4 v[4]; u16* dp[4];
#pragma unroll
        for (int q = 0; q < 4; ++q) { const size_t i = i0 + (size_t)q * G * 512; dp[q] = nullptr;
            if (i < (size_t)DEPTH * NR * 64) { const int L = (int)(i / ((size_t)NR * 64)); const size_t r = i % ((size_t)NR * 64); const int row = (int)(r >> 6), c4 = (int)(r & 63) * 4;
                const float* src = row < NP ? p.p_prompt + ((size_t)L * NP + row) * 256 + c4 : p.p_sample + ((size_t)L * NS + (row - NP)) * 256 + c4;
                v[q] = *(const f32x4*)src; dp[q] = (u16*)(p.ws + W_PB) + ((size_t)L * NR + row) * 256 + c4; } }
#pragma unroll
        for (int q = 0; q < 4; ++q) if (dp[q]) { u32x2 w; w.x = cvt_pk_bf16(v[q].x, v[q].y); w.y = cvt_pk_bf16(v[q].z, v[q].w); *(u32x2*)dp[q] = w; } }
    for (size_t i0 = (size_t)B * 512 + tid; i0 < (size_t)2 * DEPTH * DEC_BATCH * PAST * 128; i0 += (size_t)G * 512 * 4) { f32x4 v[4]; u16* dp[4];
#pragma unroll
        for (int q = 0; q < 4; ++q) { const size_t i = i0 + (size_t)q * G * 512; dp[q] = nullptr;
            if (i < (size_t)2 * DEPTH * DEC_BATCH * PAST * 128) { const int br = (int)(i / ((size_t)DEPTH * DEC_BATCH * PAST * 128)); const size_t r = i % ((size_t)DEPTH * DEC_BATCH * PAST * 128);
                const int ls = (int)(r / (PAST * 128)), pos = (int)((r / 128) % PAST), c4 = (int)(r & 127) * 4;
                v[q] = *(const f32x4*)((br ? p.c_fxk : p.c_sbk) + ((size_t)ls * PAST + pos) * 512 + c4); dp[q] = (u16*)(p.ws + W_KBS) + ((size_t)ls * SL + pos) * 1024 + br * 512 + c4; } }
#pragma unroll
        for (int q = 0; q < 4; ++q) if (dp[q]) { u32x2 w; w.x = cvt_pk_bf16(v[q].x, v[q].y); w.y = cvt_pk_bf16(v[q].z, v[q].w); *(u32x2*)dp[q] = w; } }
    for (int s = B * 8 + wid; s < DEPTH * DEC_BATCH * 4; s += G * 8) { const int ls = s >> 2, hh = s & 3; const float* src = p.c_logf + (size_t)ls * PAST * 4 + hh; float v[16]; float run = 0.f;
#pragma unroll
        for (int i = 0; i < 16; ++i) { run += src[(size_t)(lane * 16 + i) * 4]; v[i] = run; }
        float x = run;
#pragma unroll
        for (int d = 1; d < 64; d <<= 1) { const float y = __shfl_up(x, d); if (lane >= d) x += y; }
        const float pre = x - run; float* dst = (float*)(p.ws + W_CCUM) + (size_t)ls * PAST * 4 + hh;
#pragma unroll
        for (int i = 0; i < 16; ++i) dst[(size_t)(lane * 16 + i) * 4] = pre + v[i];
    }
}

__device__ __forceinline__ void logf_items(int wv, const P& p, int layer, LAS unsigned char* lds, int blk0, int blk_end, int blk_step) {
    LAS f32x4* WfL = (LAS f32x4*)lds;
    LAS float* lf = (LAS float*)(lds + 40960);
    const int tid = opaque_tid(wv);
    const f32x4* Wf = (const f32x4*)(p.ws + W_WF) + (size_t)layer * 2048;
    const float* ssqA = (const float*)(p.ws + W_SSQA);
    for (int blk = blk0; blk < blk_end; blk += blk_step) {
        __syncthreads();
#pragma unroll
        for (int i = 0; i < 4; ++i) { const int k = tid + 512 * i; WfL[k + (k >> 9)] = Wf[k]; }
        __syncthreads();
        const int rl = tid >> 2, kq = tid & 3, row = blk * 128 + rl;
        const u16* xr = (const u16*)(p.ws + W_XBA) + (size_t)row * 2048 + kq * 512;
        f32x4 a = (f32x4){0.f, 0.f, 0.f, 0.f};
        for (int i = 0; i < 64; ++i) { const u32x4 xv = *(const u32x4*)(xr + i * 8); const LAS f32x4* w = WfL + kq * 513 + i * 8;
            a += w[0] * bf_lo(xv.x); a += w[1] * bf_hi(xv.x); a += w[2] * bf_lo(xv.y); a += w[3] * bf_hi(xv.y); a += w[4] * bf_lo(xv.z); a += w[5] * bf_hi(xv.z); a += w[6] * bf_lo(xv.w); a += w[7] * bf_hi(xv.w); }
#pragma unroll
        for (int j = 0; j < 4; ++j) { a[j] += __shfl_xor(a[j], 1); a[j] += __shfl_xor(a[j], 2); }
        if (kq == 0) { float s = 0.f; const f32x4* q = (const f32x4*)(ssqA + (size_t)row * 32);
#pragma unroll
            for (int i = 0; i < 8; ++i) { const f32x4 v = q[i]; s += (v.x + v.y) + (v.z + v.w); }
            const float rs = rsqrtf(s * (1.f / 2048.f) + EPS); f32x4 lg;
#pragma unroll
            for (int j = 0; j < 4; ++j) { const float f = a[j] * rs + p.b_f[layer * 4 + j]; lg[j] = fminf(f, 0.f) - log1pf(expf(-fabsf(f))); }
            float* o = row < NP ? p.out + O_LOGF_P + ((size_t)layer * NP + row) * 4 : p.out + O_LOGF_S + ((size_t)layer * NS + (row - NP)) * 4;
            *(f32x4*)o = lg; lf[rl * 4 + 0] = lg.x; lf[rl * 4 + 1] = lg.y; lf[rl * 4 + 2] = lg.z; lf[rl * 4 + 3] = lg.w; }
        __syncthreads();
        if (tid < 16) { const int seg = tid >> 2, hh = tid & 3; float run = 0.f; float* cin = (float*)(p.ws + W_CIN);
            for (int i = 0; i < 32; ++i) { run += lf[(seg * 32 + i) * 4 + hh]; cin[(size_t)(blk * 128 + seg * 32 + i) * 4 + hh] = run; }
            ((float*)(p.ws + W_SEGTOT))[(size_t)(blk * 4 + seg) * 4 + hh] = run; }
    }
    __syncthreads();
}

constexpr int TEAM = 32;
__device__ __forceinline__ void team_barrier(unsigned* ctr) {
    __threadfence();
    __syncthreads();
    if (threadIdx.x == 0) {
        __hip_atomic_fetch_add(ctr, 1u, __ATOMIC_RELEASE, __HIP_MEMORY_SCOPE_AGENT);
        while (__hip_atomic_load(ctr, __ATOMIC_ACQUIRE, __HIP_MEMORY_SCOPE_AGENT) < (unsigned)TEAM) __builtin_amdgcn_s_sleep(8);
    }
    __syncthreads();
    __threadfence();
}

constexpr int A_KB = 0, A_VB = 34816, A_CK = 71680, A_SEG = 72192, A_MISC = 74240;
constexpr int KROW = 272, VROW = 144;

__device__ __forceinline__ void attn_phase(int wv, const P& p, int layer, LAS unsigned char* lds) {
    LAS float* segpre = (LAS float*)(lds + A_SEG);
    LAS int* misc = (LAS int*)(lds + A_MISC);
    LAS float* wtot = (LAS float*)(lds + A_MISC + 128);
    unsigned* ctr = (unsigned*)(p.ws + W_CTR) + layer;
    const float* Cin = (const float*)(p.ws + W_CIN);
    const int bid = blockIdx.x; const bool team = bid < TEAM;
    unsigned* tbar = (unsigned*)(p.ws + W_CTR) + 16 + layer * 8;
    int sd_left = 0, tstate = team ? 0 : 2;
    if (team) {
        pg8::StaticOrder S1;
        if (layer > 0) {
            if (bid < 8) { pg8::Gemm g{(const u16*)(p.ws + W_OB), (const u16*)(p.ws + W_WTOUT) + (size_t)(layer - 1) * 2048 * 1024, NR, 2048, 1024}; S1.init_one(NP / 256, bid); EpiOut E{p}; pg8::gemm_phase(wv, lds, g, S1, E); }
            else if (bid < 16) { pg8::Gemm g{(const u16*)(p.ws + W_PB) + (size_t)(layer - 1) * NR * 256, (const u16*)(p.ws + W_WTPLE) + (size_t)(layer - 1) * 2048 * 256, NR, 2048, 256}; S1.init_one(NP / 256, bid - 8); EpiPle E{p}; pg8::gemm_phase(wv, lds, g, S1, E); }
            team_barrier(tbar + 0);
            if (bid < 8) { pg8::Gemm g{(const u16*)(p.ws + W_XBB), (const u16*)(p.ws + W_WTGATE) + (size_t)(layer - 1) * 2048 * 2048, NR, 2048, 2048}; S1.init_one(NP / 256, bid); EpiGate E{p}; pg8::gemm_phase(wv, lds, g, S1, E); }
            team_barrier(tbar + 1);
        }
        if (bid < 16) { pg8::Gemm g{(const u16*)(p.ws + W_XBA), (const u16*)(p.ws + W_WTIN) + (size_t)layer * 4096 * 2048, NR, 4096, 2048}; S1.init_one(NP / 256, bid); EpiProj E{p, layer}; pg8::gemm_phase(wv, lds, g, S1, E); }
        else if (bid < 18) logf_items(wv, p, layer, lds, NP / 128 + (bid - 16), NP / 128 + (bid - 16) + 1, 1);
        team_barrier(tbar + 2);
        sd_left = 2;
    }
    for (;;) {
        if (tstate == 0 && sd_left == 0) {
            if (layer == DEPTH - 1) {
                pg8::StaticOrder S1;
                team_barrier(tbar + 3);
                if (bid < 8) { pg8::Gemm g{(const u16*)(p.ws + W_OB), (const u16*)(p.ws + W_WTOUT) + (size_t)layer * 2048 * 1024, NR, 2048, 1024}; S1.init_one(NP / 256, bid); EpiOut E{p}; pg8::gemm_phase(wv, lds, g, S1, E); }
                else if (bid < 16) { pg8::Gemm g{(const u16*)(p.ws + W_PB) + (size_t)layer * NR * 256, (const u16*)(p.ws + W_WTPLE) + (size_t)layer * 2048 * 256, NR, 2048, 256}; S1.init_one(NP / 256, bid - 8); EpiPle E{p}; pg8::gemm_phase(wv, lds, g, S1, E); }
                team_barrier(tbar + 4);
                if (bid < 8) { pg8::Gemm g{(const u16*)(p.ws + W_XBB), (const u16*)(p.ws + W_WTGATE) + (size_t)layer * 2048 * 2048, NR, 2048, 2048}; S1.init_one(NP / 256, bid); EpiGate E{p}; pg8::gemm_phase(wv, lds, g, S1, E); }
            }
            tstate = 2;
        }
        const int tid = opaque_tid(wv), wid = __builtin_amdgcn_readfirstlane(tid >> 6), lane = tid & 63, r = lane & 31, h = lane >> 5;
        const int prow = 16 * (r >> 4) + 8 * ((r >> 2) & 1) + 4 * ((r >> 3) & 1) + (r & 3);
        __syncthreads();
        if (tid == 0) misc[0] = sd_left > 0 ? 1024 + (2 - sd_left) * TEAM + bid : (int)atomicAdd(ctr, 1u);
        __syncthreads();
        int item = misc[0];
        if (sd_left > 0) --sd_left; else if (item >= 1024) break;
        int head8, qpos0, nw, row0, ldv, sbi = 0, bi = 0; const u16 *Kb, *Vt; const bool prompt = item < 1024;
        if (prompt) { const int qt = 63 - (item >> 4), rem = item & 15; bi = rem >> 3; head8 = rem & 7; qpos0 = qt * 256; nw = 8; row0 = bi * SEQ + qpos0;
            Kb = (const u16*)(p.ws + W_KBP) + (size_t)bi * SEQ * 1024 + head8 * 128; Vt = (const u16*)(p.ws + W_VTP) + (size_t)(bi * 8 + head8) * 128 * SEQ; ldv = SEQ;
        } else { const int s = item - 1024; sbi = s >> 3; head8 = s & 7; qpos0 = PAST; nw = 1; row0 = NP + sbi * 32;
            Kb = (const u16*)(p.ws + W_KBS) + (size_t)(layer * 8 + sbi) * SL * 1024 + head8 * 128; Vt = (const u16*)(p.ws + W_VTS) + (size_t)((layer * 8 + sbi) * 8 + head8) * 128 * SL; ldv = SL; }
        const bool fox = head8 >= 4; const int hf = head8 & 3;
        const float* ccum = (const float*)(p.ws + W_CCUM) + (size_t)(layer * 8 + sbi) * PAST * 4 + hf;
        if (fox && prompt) {
            const int nseg = (qpos0 + 256) >> 5; const float v = tid < nseg ? ((const float*)(p.ws + W_SEGTOT))[(size_t)(bi * 512 + tid) * 4 + hf] : 0.f; float x = v;
#pragma unroll
            for (int d = 1; d < 64; d <<= 1) { const float y = __shfl_up(x, d); if (lane >= d) x += y; }
            if (lane == 63) wtot[wid] = x;
            __syncthreads();
            float pre = 0.f; for (int w = 0; w < wid; ++w) pre += wtot[w];
            segpre[tid] = pre + x - v;
            __syncthreads();
        }
        auto getC = [&](int pos) -> float {
            if (prompt) return segpre[pos >> 5] + Cin[(size_t)(bi * SEQ + pos) * 4 + hf];
            if (pos < PAST) return ccum[(size_t)pos * 4];
            if (pos < PAST + 32) return ccum[(size_t)(PAST - 1) * 4] + Cin[(size_t)(NP + sbi * 32 + pos - PAST) * 4 + hf];
            return 0.f; };
        const bool wact = wid < nw;
        bf16x8 qf[8];
        float cq2 = 0.f;
        const int qlo = qpos0 + 32 * wid, qhi = qlo + 31, qpos = qlo + r;
        if (wact) { const u16* qrow = (const u16*)(p.ws + W_QB) + (size_t)(row0 + 32 * wid + r) * 1024 + head8 * 128 + 8 * h;
#pragma unroll
            for (int kk = 0; kk < 8; ++kk) qf[kk] = *(const bf16x8*)(qrow + 16 * kk);
            if (fox) cq2 = getC(qpos) * LOG2E; }
        else {
#pragma unroll
            for (int kk = 0; kk < 8; ++kk) qf[kk] = (bf16x8){0, 0, 0, 0, 0, 0, 0, 0}; }
        float qnK = 3.0e38f;
        if (fox && prompt) { const unsigned* ks = (const unsigned*)(p.ws + W_CTR) + 64 + ((layer * 2 + bi) * 4 + hf) * 4;
            const float kmax = sqrtf(__uint_as_float(ks[0]) + __uint_as_float(ks[1]) + __uint_as_float(ks[2]) + __uint_as_float(ks[3])) * 1.01f; float qn2 = 0.f;
#pragma unroll
            for (int kk = 0; kk < 8; ++kk)
#pragma unroll
                for (int i = 0; i < 8; ++i) { const float f = __uint_as_float(((unsigned)(unsigned short)qf[kk][i]) << 16); qn2 += f * f; }
            qn2 += __shfl_xor(qn2, 32); qnK = sqrtf(qn2) * 1.01f * kmax; }
        u32x4 kreg[2], vreg[2]; float ckreg = 0.f;
        const int krow_ = tid >> 4, kch = tid & 15, vrow_ = tid >> 3, vch = tid & 7;
#define LOAD_TILE(jt_) do { const int k0_ = (jt_) * 64; _Pragma("unroll") for (int pz = 0; pz < 2; ++pz) { \
            kreg[pz] = *(const u32x4*)(Kb + (size_t)(k0_ + krow_ + 32 * pz) * 1024 + kch * 8); \
            vreg[pz] = *(const u32x4*)(Vt + (size_t)(vrow_ + 64 * pz) * ldv + k0_ + vch * 8); } \
            if (fox && tid < 64) ckreg = getC(k0_ + tid) * LOG2E; } while (0)
#define STORE_TILE(buf_) do { _Pragma("unroll") for (int pz = 0; pz < 2; ++pz) { \
            *(LAS u32x4*)(lds + A_KB + (buf_) * 17408 + (krow_ + 32 * pz) * KROW + kch * 16) = kreg[pz]; \
            *(LAS u32x4*)(lds + A_VB + (buf_) * 18432 + (vrow_ + 64 * pz) * VROW + vch * 16) = vreg[pz]; } \
            if (fox && tid < 64) *(LAS float*)(lds + A_CK + (buf_) * 256 + tid * 4) = ckreg; } while (0)
        const int jt_top = (qpos0 + 32 * nw - 1) >> 6;
        LOAD_TILE(jt_top); STORE_TILE(0);
        __syncthreads();
        f32x16 o[4];
#pragma unroll
        for (int dt = 0; dt < 4; ++dt)
#pragma unroll
            for (int i = 0; i < 16; ++i) o[dt][i] = 0.f;
        float carry = 0.f, mrun = -1e30f, lsum = 0.f; bool wave_done = !wact;
        for (int jt = jt_top, it = 0; jt >= 0; --jt, ++it) {
            const int cur = it & 1; const bool more = jt > 0;
            if (more) LOAD_TILE(jt - 1);
            const int key0 = jt * 64;
            if (fox && prompt && !wave_done && key0 <= qhi) {
                const float ck63 = *(const LAS float*)(lds + A_CK + cur * 256 + 252);
                if (__all((qnK + cq2 - ck63) < (mrun - 155.f))) wave_done = true; }
            if (!wave_done && key0 <= qhi) {
                const bool diag = key0 + 63 >= qlo;
                const LAS unsigned char* kb = lds + A_KB + cur * 17408 + prow * KROW + 16 * h;
                const LAS unsigned char* vb = lds + A_VB + cur * 18432 + r * VROW + 16 * h;
                f32x16 sv[2];
#pragma unroll
                for (int i = 0; i < 16; ++i) { sv[0][i] = 0.f; sv[1][i] = 0.f; }
#pragma unroll
                for (int kk = 0; kk < 8; ++kk) { const bf16x8 a0 = *(const LAS bf16x8*)(kb + kk * 32); const bf16x8 a1 = *(const LAS bf16x8*)(kb + 32 * KROW + kk * 32);
                    sv[0] = __builtin_amdgcn_mfma_f32_32x32x16_bf16(a0, qf[kk], sv[0], 0, 0, 0); sv[1] = __builtin_amdgcn_mfma_f32_32x32x16_bf16(a1, qf[kk], sv[1], 0, 0, 0); }
                if (!fox) {
#pragma unroll
                    for (int kt = 1; kt >= 0; --kt) {
                        float sp[16], ex[16], tot[2];
#pragma unroll
                        for (int rg = 0; rg < 16; ++rg) { const int kpos = key0 + 32 * kt + 16 * (rg >> 3) + 8 * h + (rg & 7); const float z = sv[kt][rg];
                            const float spv = fmaxf(z, 0.f) + flog2(1.f + fexp2(-fabsf(z))); sp[rg] = (!diag || kpos < qpos) ? spv : 0.f; }
#pragma unroll
                        for (int c = 0; c < 2; ++c) { float run = 0.f;
#pragma unroll
                            for (int idx = 7; idx >= 0; --idx) { ex[8 * c + idx] = run; run += sp[8 * c + idx]; }
                            tot[c] = run; }
                        const float pt0 = __shfl_xor(tot[0], 32), pt1 = __shfl_xor(tot[1], 32);
                        const float off1 = carry + (h ? 0.f : pt1), off0 = carry + (h ? (pt1 + tot[1]) : (pt0 + tot[1] + pt1));
#pragma unroll
                        for (int rg = 0; rg < 16; ++rg) { const int kpos = key0 + 32 * kt + 16 * (rg >> 3) + 8 * h + (rg & 7);
                            const float e2 = sv[kt][rg] - sp[rg] - ((rg >= 8 ? off1 : off0) + ex[rg]);
                            sv[kt][rg] = (!diag || kpos < qpos) ? fexp2(e2) : 0.f; }
                        carry += (tot[0] + tot[1]) + (pt0 + pt1);
                    }
                    if (__all(carry > 152.f)) wave_done = true;
                } else {
                    const LAS float* ckb = (const LAS float*)(lds + A_CK + cur * 256) + 8 * h;
                    float mx = -1e30f;
#pragma unroll
                    for (int kt = 0; kt < 2; ++kt)
#pragma unroll
                        for (int q4 = 0; q4 < 4; ++q4) { const f32x4 ck = *(const LAS f32x4*)(ckb + 32 * kt + 16 * (q4 >> 1) + 4 * (q4 & 1));
#pragma unroll
                            for (int j = 0; j < 4; ++j) { const int rg = 4 * q4 + j; const int kpos = key0 + 32 * kt + 16 * (rg >> 3) + 8 * h + (rg & 7);
                                float x = sv[kt][rg] + (cq2 - ck[j]); if (diag && kpos > qpos) x = -1e30f; sv[kt][rg] = x; mx = fmaxf(mx, x); } }
                    mx = fmaxf(mx, __shfl_xor(mx, 32));
                    const float mnew = fmaxf(mrun, mx), alpha = fexp2(mrun - mnew); mrun = mnew; float ps = 0.f;
#pragma unroll
                    for (int kt = 0; kt < 2; ++kt)
#pragma unroll
                        for (int rg = 0; rg < 16; ++rg) { const float pv = fexp2(sv[kt][rg] - mnew); sv[kt][rg] = pv; ps += pv; }
                    lsum = lsum * alpha + ps;
                    if (!__all(alpha == 1.f)) {
#pragma unroll
                        for (int dt = 0; dt < 4; ++dt) o[dt] *= alpha; }
                }
#pragma unroll
                for (int kt = 0; kt < 2; ++kt)
#pragma unroll
                    for (int c = 0; c < 2; ++c) { union { u32x4 u; bf16x8 v; } pf;
                        pf.u.x = cvt_pk_bf16(sv[kt][8 * c + 0], sv[kt][8 * c + 1]); pf.u.y = cvt_pk_bf16(sv[kt][8 * c + 2], sv[kt][8 * c + 3]);
                        pf.u.z = cvt_pk_bf16(sv[kt][8 * c + 4], sv[kt][8 * c + 5]); pf.u.w = cvt_pk_bf16(sv[kt][8 * c + 6], sv[kt][8 * c + 7]);
#pragma unroll
                        for (int dt = 0; dt < 4; ++dt) { const bf16x8 vf = *(const LAS bf16x8*)(vb + dt * 32 * VROW + (32 * kt + 16 * c) * 2);
                            o[dt] = __builtin_amdgcn_mfma_f32_32x32x16_bf16(vf, pf.v, o[dt], 0, 0, 0); } }
            }
            if (more) STORE_TILE(cur ^ 1);
            if (lane == 0) misc[8 + cur * 8 + wid] = wave_done ? 1 : 0;
            __syncthreads();
            int alld = 1;
#pragma unroll
            for (int w = 0; w < 8; ++w) alld &= misc[8 + cur * 8 + w];
            if (alld) break;
        }
#undef LOAD_TILE
#undef STORE_TILE
        if (wact) {
            if (fox) { lsum += __shfl_xor(lsum, 32); const float inv = 1.f / lsum;
#pragma unroll
                for (int dt = 0; dt < 4; ++dt) o[dt] *= inv; }
            float ss = 0.f;
#pragma unroll
            for (int dt = 0; dt < 4; ++dt)
#pragma unroll
                for (int i = 0; i < 16; ++i) ss += o[dt][i] * o[dt][i];
            ss += __shfl_xor(ss, 32);
            const float rn = rsqrtf(ss * (1.f / 128.f) + EPS);
            const int row = row0 + 32 * wid + r;
            const float* gp = (fox ? p.g_ofox : p.g_osb) + layer * 512 + hf * 128 + 4 * h;
            const u16* zp = (const u16*)(p.ws + W_ZB) + (size_t)row * 1024 + head8 * 128 + 4 * h;
            u16* op = (u16*)(p.ws + W_OB) + (size_t)row * 1024 + head8 * 128 + 4 * h;
            u32x2 zz[16];
#pragma unroll
            for (int i = 0; i < 16; ++i) zz[i] = *(const u32x2*)(zp + 32 * (i >> 2) + 8 * (i & 3));
#pragma unroll
            for (int dt = 0; dt < 4; ++dt)
#pragma unroll
                for (int bb = 0; bb < 4; ++bb) { const int d = 32 * dt + 8 * bb; const f32x4 g = *(const f32x4*)(gp + d); const u32x2 z2 = zz[dt * 4 + bb];
                    const float v0 = o[dt][4 * bb + 0] * rn * g.x * bf_lo(z2.x), v1 = o[dt][4 * bb + 1] * rn * g.y * bf_hi(z2.x), v2 = o[dt][4 * bb + 2] * rn * g.z * bf_lo(z2.y), v3 = o[dt][4 * bb + 3] * rn * g.w * bf_hi(z2.y);
                    u32x2 w; w.x = cvt_pk_bf16(v0, v1); w.y = cvt_pk_bf16(v2, v3); *(u32x2*)(op + d) = w; }
        }
    }
}

__device__ __forceinline__ void final_phase(int wv, const P& p) {
    const int tid = opaque_tid(wv), wid = tid >> 6, lane = tid & 63;
    const float* ssqA = (const float*)(p.ws + W_SSQA);
    for (int row = blockIdx.x * 8 + wid; row < NR; row += gridDim.x * 8) {
        float s = lane < 32 ? ssqA[(size_t)row * 32 + lane] : 0.f;
#pragma unroll
        for (int d = 1; d < 64; d <<= 1) s += __shfl_xor(s, d);
        const float rs = rsqrtf(s * (1.f / 2048.f) + EPS);
        float* xo = p.out + (size_t)row * 2048; const u16* xb = (const u16*)(p.ws + W_XBA) + (size_t)row * 2048;
#pragma unroll
        for (int i = 0; i < 8; ++i) { const int c = (i * 64 + lane) * 4; const u32x2 xw = *(const u32x2*)(xb + c); const f32x4 g = *(const f32x4*)(p.g_final + c);
            f32x4 v; v.x = bf_lo(xw.x) * rs * g.x; v.y = bf_hi(xw.x) * rs * g.y; v.z = bf_lo(xw.y) * rs * g.z; v.w = bf_hi(xw.y) * rs * g.w; *(f32x4*)(xo + c) = v; }
    }
}

constexpr int LDS_BYTES = pg8::STAGE_BYTES;

__global__ __launch_bounds__(512, 2) void fwd_megakernel(P p) {
    extern __shared__ __attribute__((aligned(16))) unsigned char shm[];
    LAS unsigned char* lds = (LAS unsigned char*)shm;
    cg::grid_group grid = cg::this_grid();
    const int wv = __builtin_amdgcn_readfirstlane(threadIdx.x >> 6);
    prep_phase(wv, p, lds);
    grid.sync();
    pg8::StaticOrder S;
    for (int layer_ = 0; layer_ < DEPTH; ++layer_) {
        int layer = layer_, bid = (int)blockIdx.x, G = (int)gridDim.x; asm volatile("" : "+s"(layer), "+s"(bid), "+s"(G));
        {
            pg8::Gemm g{(const u16*)(p.ws + W_XBA), (const u16*)(p.ws + W_WTIN) + (size_t)layer * 4096 * 2048, NP, 4096, 2048};
            S.init(g.M, g.N, G, bid); EpiProj E{p, layer};
            pg8::gemm_phase(wv, lds, g, S, E);
            logf_items(wv, p, layer, lds, bid, NP / 128, G);
        }
        grid.sync();
        attn_phase(wv, p, layer, lds);
        grid.sync();
        {
            pg8::Gemm g{(const u16*)(p.ws + W_OB), (const u16*)(p.ws + W_WTOUT) + (size_t)layer * 2048 * 1024, NP, 2048, 1024};
            S.init(g.M, g.N, G, bid); EpiOut E{p};
            pg8::gemm_phase(wv, lds, g, S, E);
            pg8::Gemm g2{(const u16*)(p.ws + W_PB) + (size_t)layer * NR * 256, (const u16*)(p.ws + W_WTPLE) + (size_t)layer * 2048 * 256, NP, 2048, 256};
            S.init(g2.M, g2.N, G, bid); EpiPle E2{p};
            pg8::gemm_phase(wv, lds, g2, S, E2);
        }
        grid.sync();
        {
            pg8::Gemm g{(const u16*)(p.ws + W_XBB), (const u16*)(p.ws + W_WTGATE) + (size_t)layer * 2048 * 2048, NP, 2048, 2048};
            S.init(g.M, g.N, G, bid); EpiGate E{p};
            pg8::gemm_phase(wv, lds, g, S, E);
        }
        grid.sync();
    }
    final_phase(wv, p);
}

extern "C" void kernel_launch(void* const* d_in, const int* in_sizes, int n_in, void* d_out, int out_size, void* d_ws, size_t ws_size, hipStream_t stream) {
    static int grid_blocks = 0;
    if (!grid_blocks) {
        if (n_in != 19 || (size_t)out_size != OUT_TOTAL || ws_size < W_END) { fprintf(stderr, "kernel_launch: unexpected shapes: n_in %d out %d (want %zu) ws %zu (want %zu)\n", n_in, out_size, OUT_TOTAL, ws_size, W_END); grid_blocks = -1; return; }
        int dev = 0, cus = 0, per_cu = 0;
        hipGetDevice(&dev);
        hipDeviceGetAttribute(&cus, hipDeviceAttributeMultiprocessorCount, dev);
        if (hipFuncSetAttribute((const void*)fwd_megakernel, hipFuncAttributeMaxDynamicSharedMemorySize, LDS_BYTES) != hipSuccess) fprintf(stderr, "kernel_launch: hipFuncSetAttribute failed\n");
        if (hipOccupancyMaxActiveBlocksPerMultiprocessor(&per_cu, (const void*)fwd_megakernel, 512, LDS_BYTES) != hipSuccess || per_cu < 1) { fprintf(stderr, "kernel_launch: occupancy query gave %d\n", per_cu); per_cu = 1; }
        (void)hipGetLastError();
        grid_blocks = cus * per_cu;
    }
    if (grid_blocks < 0) return;
    P p{};
    const float** f = (const float**)&p;
    for (int i = 0; i < 19; ++i) f[i] = (const float*)d_in[i];
    p.out = (float*)d_out; p.ws = (unsigned char*)d_ws;
    void* args[] = {&p};
    hipError_t e = hipLaunchCooperativeKernel((const void*)fwd_megakernel, dim3(grid_blocks), dim3(512), args, LDS_BYTES, stream);
    if (e != hipSuccess) fprintf(stderr, "cooperative launch failed: %s (grid %d)\n", hipGetErrorString(e), grid_blocks);
}
```

```cpp
#include <hip/hip_runtime.h>
#include <hip/hip_cooperative_groups.h>
#include <cstdio>
namespace cg = cooperative_groups;

#define LAS __attribute__((address_space(3)))
typedef unsigned short u16;
typedef short bf16x8 __attribute__((ext_vector_type(8)));
typedef float f32x4 __attribute__((ext_vector_type(4)));
typedef float f32x16 __attribute__((ext_vector_type(16)));
typedef unsigned u32x2 __attribute__((ext_vector_type(2)));
typedef unsigned u32x4 __attribute__((ext_vector_type(4)));

constexpr int D_MODEL = 2048, SEQ = 16384, DEPTH = 4, DEC_BATCH = 8, DEC_SEQ = 32, PAST = 1024;
constexpr int NP = 2 * SEQ, NS = DEC_BATCH * DEC_SEQ, NR = NP + NS;
constexpr int DMIX = 1024, D_IN = 4100, PLE = 256;
constexpr int SL = 1088;
constexpr float EPS = 1e-6f;
constexpr float LOG2E = 1.4426950408889634f;
constexpr float QSCALE = 0.08838834764831845f * LOG2E;
constexpr int NITEMS = 1024 + 64;

constexpr size_t O_Y = 0;
constexpr size_t O_KV_P = (size_t)NR * D_MODEL;
constexpr size_t KVP = (size_t)DEPTH * NP * 512;
constexpr size_t O_LOGF_P = O_KV_P + 4 * KVP;
constexpr size_t O_KV_S = O_LOGF_P + (size_t)DEPTH * NP * 4;
constexpr size_t KVS = (size_t)DEPTH * NS * 512;
constexpr size_t O_LOGF_S = O_KV_S + 4 * KVS;
constexpr size_t OUT_TOTAL = O_LOGF_S + (size_t)DEPTH * NS * 4;

constexpr size_t al256(size_t x) { return (x + 255) & ~(size_t)255; }
constexpr size_t W_WTIN = 0;
constexpr size_t W_WTOUT = W_WTIN + (size_t)DEPTH * 4096 * 2048 * 2;
constexpr size_t W_WTPLE = W_WTOUT + (size_t)DEPTH * 2048 * 1024 * 2;
constexpr size_t W_WTGATE = W_WTPLE + (size_t)DEPTH * 2048 * 256 * 2;
constexpr size_t W_WF = W_WTGATE + (size_t)DEPTH * 2048 * 2048 * 2;
constexpr size_t W_XBA = W_WF + (size_t)DEPTH * 2048 * 4 * 4;
constexpr size_t W_PB = W_XBA + (size_t)NR * 2048 * 2;
constexpr size_t W_R = W_PB + (size_t)DEPTH * NR * 256 * 2;
constexpr size_t W_QB = W_R;
constexpr size_t W_KBP = W_QB + (size_t)NR * 1024 * 2;
constexpr size_t W_VTP = W_KBP + (size_t)NP * 1024 * 2;
constexpr size_t W_ZB = W_VTP + (size_t)NP * 1024 * 2;
constexpr size_t W_PLEB = W_R;
constexpr size_t W_XBB = W_R + al256((size_t)NR * 2048 * 2);
constexpr size_t R_SIZE = 2 * al256((size_t)NR * 2048 * 2) + 4096;
static_assert(W_ZB + (size_t)NR * 1024 * 2 <= W_R + R_SIZE, "region R too small");
constexpr size_t W_KBS = W_R + R_SIZE;
constexpr size_t W_VTS = W_KBS + (size_t)DEPTH * DEC_BATCH * SL * 1024 * 2;
constexpr size_t W_OB = W_VTS + (size_t)DEPTH * DEC_BATCH * 8 * 128 * SL * 2;
constexpr size_t W_SSQA = W_OB + (size_t)NR * 1024 * 2;
constexpr size_t W_SSQB = W_SSQA + (size_t)NR * 32 * 4;
constexpr size_t W_CIN = W_SSQB + (size_t)NR * 32 * 4;
constexpr size_t W_SEGTOT = W_CIN + (size_t)NR * 4 * 4;
constexpr size_t W_CCUM = W_SEGTOT + al256((size_t)(NR / 32) * 4 * 4);
constexpr size_t W_CTR = W_CCUM + (size_t)DEPTH * DEC_BATCH * PAST * 4 * 4;
constexpr size_t W_PLES = W_CTR + 4096;
constexpr size_t W_END = W_PLES + (size_t)NS * 2048 * 2;

struct P {
    const float *x_prompt, *x_sample, *p_prompt, *p_sample, *c_sbk, *c_sbv, *c_fxk, *c_fxv, *c_logf, *w_in, *b_f, *g_attn, *g_osb, *g_ofox, *w_out, *w_ple, *g_ple, *w_gate, *g_final;
    float* out;
    unsigned char* ws;
};

__device__ __forceinline__ unsigned cvt_pk_bf16(float lo, float hi) { unsigned r; asm volatile("v_cvt_pk_bf16_f32 %0, %1, %2" : "=v"(r) : "v"(lo), "v"(hi)); return r; }
__device__ __forceinline__ float bf_lo(unsigned w) { return __uint_as_float(w << 16); }
__device__ __forceinline__ float bf_hi(unsigned w) { return __uint_as_float(w & 0xffff0000u); }
__device__ __forceinline__ float fexp2(float x) { return __builtin_amdgcn_exp2f(x); }
__device__ __forceinline__ float flog2(float x) { return __builtin_amdgcn_logf(x); }
__device__ __forceinline__ int opaque_tid(int wv) { int l; asm volatile("v_mbcnt_lo_u32_b32 %0, -1, 0\n\tv_mbcnt_hi_u32_b32 %0, -1, %0" : "=v"(l)); return wv * 64 + l; }

namespace pg8 {
constexpr int BM = 256, BK = 64, HALF = 128, HTB = HALF * BK * 2, STAGE_BYTES = 8 * HTB, NXCD = 8, WGM = 8;
__host__ __device__ __forceinline__ int lds_byte(int r, int c) { const int st = (r >> 4) * 2 + (c >> 5), rr = r & 15, cc = c & 31, ob = rr * 64 + cc * 2; return st * 1024 + (ob ^ (((ob >> 9) & 1) << 5)); }
__host__ __device__ __forceinline__ void stage_rc(int b, int& R, int& C) { const int st = b / 1024, sb = b % 1024, swz = sb ^ (((sb >> 9) & 1) << 5); R = (st >> 1) * 16 + swz / 64; C = (st & 1) * 32 + (swz % 64) / 2; }
struct Unit { int pm, pn; };
struct Gemm { const u16* A; const u16* Bt; int M, N, K; };
struct StaticOrder {
    int nM, nN, nwg, G, c;
    int one_pm, one_pn;
    __device__ void init(int M, int N, int G_, int c_) { nM = M / BM; nN = N / BM; nwg = nM * nN; G = G_; c = c_; one_pm = -1; one_pn = 0; }
    __device__ void init_one(int pm, int pn) { nM = 1; nN = 1; nwg = 1; G = 1; c = 0; one_pm = pm; one_pn = pn; }
    __device__ bool next(int i, Unit& u) const {
        if (one_pm >= 0) { if (i > 0) return false; u.pm = one_pm; u.pn = one_pn; return true; }
        const long L = (long)i * G + c; if (L >= nwg) return false;
        int wgid = (int)L; { const int q = nwg / NXCD, r = nwg % NXCD, xcd = wgid % NXCD, off = wgid / NXCD; wgid = (xcd < r ? xcd * (q + 1) : r * (q + 1) + (xcd - r) * q) + off; }
        const int nig = WGM * nN, gid = wgid / nig, fm = gid * WGM, gsz = (nM - fm) < WGM ? (nM - fm) : WGM;
        u.pm = fm + ((wgid % nig) % gsz); u.pn = (wgid % nig) / gsz; return true;
    }
};

template <class Epi>
__device__ __forceinline__ void gemm_phase(int wv, LAS unsigned char* lds, const Gemm g, const StaticOrder& S, const Epi& E, const int skew_ticks = 0) {
    const int tid = opaque_tid(wv), wid = __builtin_amdgcn_readfirstlane(tid >> 6), lane = tid & 63, wr = wid >> 2, wc = wid & 3, fr = lane & 15, fq = lane >> 4;
    const int K = g.K, nt = K / BK;
    unsigned voffA[2], voffB0[2];
#pragma unroll
    for (int i = 0; i < 2; ++i) { int R, C; stage_rc(tid * 16 + i * 8192, R, C); voffA[i] = (unsigned)(R * K + C) * 2u;
        const int rho = R & 31, pr = 8 * ((rho & 15) >> 2) + 4 * (rho >> 4) + (rho & 3), Rb = 64 * (R >> 5) + pr;
        voffB0[i] = (unsigned)(Rb * K + C) * 2u; }
    const size_t b1step = (size_t)32 * K * 2;
    const size_t kstep = (size_t)(BK * 2);
    const size_t hstep = (size_t)HALF * K * 2;
    const size_t tstep = 2 * hstep;
    const unsigned ldsw = (unsigned)wid * 1024u;
    const int aoff = lds_byte(wr * 64 + fr, fq * 8), boff = lds_byte(wc * 32 + fr, fq * 8);
#define PG8_SA(b, h) (((b) * 2 + (h)) * HTB)
#define PG8_SB(b, h) ((4 + (b) * 2 + (h)) * HTB)
#define PG8_STAGE(bufoff, gbase, voff) do { _Pragma("unroll") for (int _i = 0; _i < 2; ++_i) \
        __builtin_amdgcn_global_load_lds((const unsigned*)((const char*)(gbase) + (voff)[_i]), (LAS unsigned*)(lds + (bufoff) + ldsw + _i * 8192), 16, 0, 0); } while (0)
#define PG8_LDA(dst, b, h) do { _Pragma("unroll") for (int m = 0; m < 4; ++m) _Pragma("unroll") for (int k = 0; k < 2; ++k) dst[m][k] = *(const LAS bf16x8*)(lds + PG8_SA(b, h) + aoff + m * 2048 + k * 1024); } while (0)
#define PG8_LDB(dst, b, h) do { _Pragma("unroll") for (int n = 0; n < 2; ++n) _Pragma("unroll") for (int k = 0; k < 2; ++k) dst[n][k] = *(const LAS bf16x8*)(lds + PG8_SB(b, h) + boff + n * 2048 + k * 1024); } while (0)
#define PG8_MMA(ai, bj, At, Bt) do { __builtin_amdgcn_s_setprio(1); _Pragma("unroll") for (int m = 0; m < 4; ++m) _Pragma("unroll") for (int n = 0; n < 2; ++n) _Pragma("unroll") for (int k = 0; k < 2; ++k) \
        acc[ai][bj][m][n] = __builtin_amdgcn_mfma_f32_16x16x32_bf16(Bt[n][k], At[m][k], acc[ai][bj][m][n], 0, 0, 0); __builtin_amdgcn_s_setprio(0); } while (0)
#define PG8_WAIT_V(n) asm volatile("s_waitcnt vmcnt(" #n ")" ::: "memory")
#define PG8_WAIT_L(n) asm volatile("s_waitcnt lgkmcnt(" #n ")" ::: "memory")
#define PG8_BAR __builtin_amdgcn_s_barrier()
#define PG8_SCHED __builtin_amdgcn_sched_barrier(0)
    Unit cur, nxt; int ui = 0;
    if (!S.next(0, cur)) return;
    if (skew_ticks > 0) {
        const unsigned long long t0 = __builtin_amdgcn_s_memrealtime();
        while ((long long)(__builtin_amdgcn_s_memrealtime() - t0) < (long long)skew_ticks) __builtin_amdgcn_s_sleep(32);
    }
    f32x4 acc[2][2][4][2];
#pragma unroll
    for (int a = 0; a < 2; ++a)
#pragma unroll
        for (int b = 0; b < 2; ++b)
#pragma unroll
            for (int m = 0; m < 4; ++m)
#pragma unroll
                for (int n = 0; n < 2; ++n) acc[a][b][m][n] = (f32x4){0.f, 0.f, 0.f, 0.f};
    bf16x8 At[4][2], B0[2][2], B1[2][2];
    const char* cA = (const char*)g.A + (size_t)cur.pm * tstep; const char* cB = (const char*)g.Bt + (size_t)cur.pn * tstep;
    PG8_STAGE(PG8_SB(0, 0), cB, voffB0); PG8_STAGE(PG8_SA(0, 0), cA, voffA); PG8_STAGE(PG8_SB(0, 1), cB + b1step, voffB0); PG8_STAGE(PG8_SA(0, 1), cA + hstep, voffA);
    if (wr == 1) PG8_BAR;
    PG8_WAIT_V(4); PG8_BAR;
    PG8_STAGE(PG8_SB(1, 0), cB + kstep, voffB0); PG8_STAGE(PG8_SA(1, 0), cA + kstep, voffA); PG8_STAGE(PG8_SB(1, 1), cB + kstep + b1step, voffB0);
    PG8_WAIT_V(6); PG8_BAR;
    for (;;) {
        const bool has_next = S.next(ui + 1, nxt);
        const char* nA = has_next ? (const char*)g.A + (size_t)nxt.pm * tstep : cA; const char* nB = has_next ? (const char*)g.Bt + (size_t)nxt.pn * tstep : cB;
        for (int t = 0; t < nt; t += 2) {
            const bool last = (t == nt - 2);
            const char* a1 = cA + (size_t)(t + 1) * kstep;
            const char* a2 = last ? nA : cA + (size_t)(t + 2) * kstep; const char* b2 = last ? nB : cB + (size_t)(t + 2) * kstep;
            const char* a3 = a2 + kstep; const char* b3 = b2 + kstep;
            PG8_LDB(B0, 0, 0); PG8_SCHED; PG8_LDA(At, 0, 0); PG8_STAGE(PG8_SA(1, 1), a1 + hstep, voffA);
            PG8_WAIT_L(8); PG8_BAR; PG8_WAIT_L(0); PG8_MMA(0, 0, At, B0); PG8_BAR; PG8_SCHED;
            PG8_LDB(B1, 0, 1); PG8_STAGE(PG8_SB(0, 0), b2, voffB0);
            PG8_BAR; PG8_WAIT_L(0); PG8_MMA(0, 1, At, B1); PG8_BAR;
            PG8_LDA(At, 0, 1); PG8_STAGE(PG8_SA(0, 0), a2, voffA);
            PG8_BAR; PG8_WAIT_L(0); PG8_MMA(1, 0, At, B0); PG8_BAR; PG8_SCHED;
            PG8_STAGE(PG8_SB(0, 1), b2 + b1step, voffB0);
            PG8_WAIT_V(6); PG8_BAR; PG8_MMA(1, 1, At, B1); PG8_BAR;
            PG8_LDB(B0, 1, 0); PG8_SCHED; PG8_LDA(At, 1, 0); PG8_STAGE(PG8_SA(0, 1), a2 + hstep, voffA);
            PG8_WAIT_L(8); PG8_BAR; PG8_WAIT_L(0); PG8_MMA(0, 0, At, B0); PG8_BAR; PG8_SCHED;
            PG8_LDB(B1, 1, 1); PG8_STAGE(PG8_SB(1, 0), b3, voffB0);
            PG8_BAR; PG8_WAIT_L(0); PG8_MMA(0, 1, At, B1); PG8_BAR;
            PG8_LDA(At, 1, 1); PG8_STAGE(PG8_SA(1, 0), a3, voffA);
            PG8_BAR; PG8_WAIT_L(0); PG8_MMA(1, 0, At, B0); PG8_BAR; PG8_SCHED;
            PG8_STAGE(PG8_SB(1, 1), b3 + b1step, voffB0);
            PG8_WAIT_V(6); PG8_BAR; PG8_MMA(1, 1, At, B1); PG8_BAR;
        }
        { int fr2 = fr, fq2 = fq; asm volatile("" : "+v"(fr2), "+v"(fq2)); E(acc, cur, wr, wc, fr2, fq2); }
        if (!has_next) break;
#pragma unroll
        for (int a = 0; a < 2; ++a)
#pragma unroll
            for (int b = 0; b < 2; ++b)
#pragma unroll
                for (int m = 0; m < 4; ++m)
#pragma unroll
                    for (int n = 0; n < 2; ++n) acc[a][b][m][n] = (f32x4){0.f, 0.f, 0.f, 0.f};
        cur = nxt; cA = nA; cB = nB; ++ui;
    }
    PG8_WAIT_V(0);
    if (wr == 0) PG8_BAR;
    PG8_BAR;
#undef PG8_SA
#undef PG8_SB
#undef PG8_STAGE
#undef PG8_LDA
#undef PG8_LDB
#undef PG8_MMA
#undef PG8_WAIT_V
#undef PG8_WAIT_L
#undef PG8_BAR
#undef PG8_SCHED
}
}


__device__ __forceinline__ float row_rstd(const float* ssq, int row, int fq) {
    const f32x4* q = (const f32x4*)(ssq + (size_t)row * 32 + fq * 8);
    const f32x4 a = q[0], b = q[1];
    float s = (a.x + a.y) + (a.z + a.w) + (b.x + b.y) + (b.z + b.w);
    s += __shfl_xor(s, 16); s += __shfl_xor(s, 32);
    return rsqrtf(s * (1.f / 2048.f) + EPS);
}
__device__ __forceinline__ u32x4 pack8(const f32x4 a, const f32x4 b) { u32x4 w; w.x = cvt_pk_bf16(a.x, a.y); w.y = cvt_pk_bf16(a.z, a.w); w.z = cvt_pk_bf16(b.x, b.y); w.w = cvt_pk_bf16(b.z, b.w); return w; }

constexpr int TRS = 144, TIO_OFF = 131072, TIO_WAVE = 2304;
__device__ __forceinline__ void tio_store(LAS unsigned char* T, u16* g0, int lane, int fr, int fq, const u32x4 w0, const u32x4 w1) {
    *(LAS u32x4*)(T + fr * TRS + fq * 16) = w0; *(LAS u32x4*)(T + fr * TRS + 64 + fq * 16) = w1;
    const int rr = lane >> 3, ch = lane & 7;
    const u32x4 a = *(const LAS u32x4*)(T + rr * TRS + ch * 16), b = *(const LAS u32x4*)(T + (8 + rr) * TRS + ch * 16);
    *(u32x4*)(g0 + (size_t)rr * 2048 + ch * 8) = a; *(u32x4*)(g0 + (size_t)(8 + rr) * 2048 + ch * 8) = b;
}
__device__ __forceinline__ void tio_load(const u16* g0, int lane, u32x4& a, u32x4& b) { const int rr = lane >> 3, ch = lane & 7; a = *(const u32x4*)(g0 + (size_t)rr * 2048 + ch * 8); b = *(const u32x4*)(g0 + (size_t)(8 + rr) * 2048 + ch * 8); }
__device__ __forceinline__ void tio_unpack(LAS unsigned char* T, int lane, int fr, int fq, const u32x4 a, const u32x4 b, u32x4& w0, u32x4& w1) {
    const int rr = lane >> 3, ch = lane & 7;
    *(LAS u32x4*)(T + rr * TRS + ch * 16) = a; *(LAS u32x4*)(T + (8 + rr) * TRS + ch * 16) = b;
    w0 = *(const LAS u32x4*)(T + fr * TRS + fq * 16); w1 = *(const LAS u32x4*)(T + fr * TRS + 64 + fq * 16);
}

__device__ __forceinline__ void tio_store_f32(LAS unsigned char* T, float* g0, size_t gpitch, int lane, int fr, int fq, const f32x4 v0, const f32x4 v1) {
    *(LAS f32x4*)(T + fr * TRS + fq * 32) = v0; *(LAS f32x4*)(T + fr * TRS + fq * 32 + 16) = v1;
    const int rr = lane >> 3, ch = lane & 7;
    const f32x4 a = *(const LAS f32x4*)(T + rr * TRS + ch * 16), b = *(const LAS f32x4*)(T + (8 + rr) * TRS + ch * 16);
    __builtin_nontemporal_store(a, (f32x4*)(g0 + (size_t)rr * gpitch + ch * 4)); __builtin_nontemporal_store(b, (f32x4*)(g0 + (size_t)(8 + rr) * gpitch + ch * 4));
}
__device__ __forceinline__ void tio_store_p(LAS unsigned char* T, u16* g0, size_t gpitch, int lane, int fr, int fq, const u32x4 w0, const u32x4 w1) {
    *(LAS u32x4*)(T + fr * TRS + fq * 16) = w0; *(LAS u32x4*)(T + fr * TRS + 64 + fq * 16) = w1;
    const int rr = lane >> 3, ch = lane & 7;
    const u32x4 a = *(const LAS u32x4*)(T + rr * TRS + ch * 16), b = *(const LAS u32x4*)(T + (8 + rr) * TRS + ch * 16);
    *(u32x4*)(g0 + (size_t)rr * gpitch + ch * 8) = a; *(u32x4*)(g0 + (size_t)(8 + rr) * gpitch + ch * 8) = b;
}

struct EpiProj {
    const P& p; int layer; LAS unsigned char* lds;
    __device__ __forceinline__ void operator()(const f32x4 (&acc)[2][2][4][2], const pg8::Unit& u, int wr, int wc, int fr, int fq) const {
        const int lane = fq * 16 + fr; LAS unsigned char* T = lds + TIO_OFF + (wr * 4 + wc) * TIO_WAVE; const int cww = (u.pn & 1) * 256 + wc * 64;
        const int group = u.pn >> 1, type = group & 3, br = group >> 2;
        const int cgb = (u.pn & 1) * 256 + wc * 64 + 8 * fq;
        const float* ssqA = (const float*)(p.ws + W_SSQA);
        u16* Qb = (u16*)(p.ws + W_QB); u16* Zb = (u16*)(p.ws + W_ZB);
        float kmx = 0.f;
        float rsv[8];
#pragma unroll
        for (int i = 0; i < 8; ++i) rsv[i] = row_rstd(ssqA, u.pm * 256 + (i >> 2) * 128 + wr * 64 + (i & 3) * 16 + fr, fq);
#pragma unroll
        for (int ai = 0; ai < 2; ++ai)
#pragma unroll
            for (int m = 0; m < 4; ++m) {
                const int row = u.pm * 256 + ai * 128 + wr * 64 + m * 16 + fr;
                const float rs = rsv[ai * 4 + m];
                if (type == 0) {
                    const float sc = rs * QSCALE;
                    tio_store_p(T, Qb + (size_t)(row - fr) * 1024 + br * 512 + cww, 1024, lane, fr, fq, pack8(acc[ai][0][m][0] * sc, acc[ai][0][m][1] * sc), pack8(acc[ai][1][m][0] * sc, acc[ai][1][m][1] * sc));
                } else if (type == 3) {
                    u32x4 zw[2];
#pragma unroll
                    for (int bj = 0; bj < 2; ++bj) { f32x4 v0 = acc[ai][bj][m][0] * rs, v1 = acc[ai][bj][m][1] * rs;
#pragma unroll
                        for (int j = 0; j < 4; ++j) { v0[j] = v0[j] * __builtin_amdgcn_rcpf(1.f + __expf(-v0[j])); v1[j] = v1[j] * __builtin_amdgcn_rcpf(1.f + __expf(-v1[j])); }
                        zw[bj] = pack8(v0, v1); }
                    tio_store_p(T, Zb + (size_t)(row - fr) * 1024 + br * 512 + cww, 1024, lane, fr, fq, zw[0], zw[1]);
                } else {
                    float* o32; u16* kb; u16* vt; size_t vld; float kss = 0.f;
                    if (row < NP) { const int b = row >> 14, t = row & (SEQ - 1);
                        o32 = p.out + O_KV_P + (size_t)(br * 2 + (type - 1)) * KVP + ((size_t)(layer * 2 + b) * SEQ + t) * 512;
                        kb = (u16*)(p.ws + W_KBP) + (size_t)row * 1024 + br * 512;
                        vt = (u16*)(p.ws + W_VTP) + (size_t)(b * 8 + br * 4) * 128 * SEQ + t; vld = SEQ;
                    } else { const int rr = row - NP, sb = rr >> 5, t = rr & 31;
                        o32 = p.out + O_KV_S + (size_t)(br * 2 + (type - 1)) * KVS + ((size_t)(layer * 8 + sb) * 32 + t) * 512;
                        kb = (u16*)(p.ws + W_KBS) + ((size_t)(layer * 8 + sb) * SL + PAST + t) * 1024 + br * 512;
                        vt = (u16*)(p.ws + W_VTS) + (size_t)((layer * 8 + sb) * 8 + br * 4) * 128 * SL + PAST + t; vld = SL;
                    }
                    u32x4 kw[2];
#pragma unroll
                    for (int bj = 0; bj < 2; ++bj) { const f32x4 v0 = acc[ai][bj][m][0] * rs, v1 = acc[ai][bj][m][1] * rs; const int cg = cgb + bj * 32;
                        kss += (v0.x * v0.x + v0.y * v0.y + v0.z * v0.z + v0.w * v0.w) + (v1.x * v1.x + v1.y * v1.y + v1.z * v1.z + v1.w * v1.w);
                        tio_store_f32(T, o32 - (size_t)fr * 512 + cww + bj * 32, 512, lane, fr, fq, v0, v1);
                        const u32x4 w = pack8(v0, v1); kw[bj] = w;
                        if (type == 1) { if (bj == 1) tio_store_p(T, kb - (size_t)fr * 1024 + cww, 1024, lane, fr, fq, kw[0], kw[1]); }
                        else { vt[(size_t)(cg + 0) * vld] = (u16)(w.x & 0xffffu); vt[(size_t)(cg + 1) * vld] = (u16)(w.x >> 16); vt[(size_t)(cg + 2) * vld] = (u16)(w.y & 0xffffu); vt[(size_t)(cg + 3) * vld] = (u16)(w.y >> 16);
                               vt[(size_t)(cg + 4) * vld] = (u16)(w.z & 0xffffu); vt[(size_t)(cg + 5) * vld] = (u16)(w.z >> 16); vt[(size_t)(cg + 6) * vld] = (u16)(w.w & 0xffffu); vt[(size_t)(cg + 7) * vld] = (u16)(w.w >> 16); } }
                    if (type == 1 && br == 1) { kss += __shfl_xor(kss, 16); kss += __shfl_xor(kss, 32); kmx = fmaxf(kmx, kss); }
                }
            }
        if (type == 1 && br == 1 && u.pm < NP / 256) {
            float t = kmx; t = fmaxf(t, __shfl_xor(t, 1)); t = fmaxf(t, __shfl_xor(t, 2)); t = fmaxf(t, __shfl_xor(t, 4)); t = fmaxf(t, __shfl_xor(t, 8));
            if (fr == 0 && fq == 0) atomicMax((unsigned*)(p.ws + W_CTR) + 64 + ((layer * 2 + (u.pm >> 6)) * 4 + (u.pn & 1) * 2 + (wc >> 1)) * 4 + (wc & 1), __float_as_uint(t));
        }
    }
};

struct EpiOut {
    const P& p; LAS unsigned char* lds;
    __device__ __forceinline__ void operator()(const f32x4 (&acc)[2][2][4][2], const pg8::Unit& u, int wr, int wc, int fr, int fq) const {
        float* ssqB = (float*)(p.ws + W_SSQB); u16* XbB = (u16*)(p.ws + W_XBB); const u16* XbA = (const u16*)(p.ws + W_XBA);
        const int lane = fq * 16 + fr, cw = u.pn * 256 + wc * 64; LAS unsigned char* T = lds + TIO_OFF + (wr * 4 + wc) * TIO_WAVE;
#pragma unroll
        for (int ai = 0; ai < 2; ++ai) {
            u32x4 xa[4], xb_[4];
#pragma unroll
            for (int m = 0; m < 4; ++m) tio_load(XbA + (size_t)(u.pm * 256 + ai * 128 + wr * 64 + m * 16) * 2048 + cw, lane, xa[m], xb_[m]);
#pragma unroll
            for (int m = 0; m < 4; ++m) {
                const int row0 = u.pm * 256 + ai * 128 + wr * 64 + m * 16; float ss = 0.f; u32x4 x0, x1;
                tio_unpack(T, lane, fr, fq, xa[m], xb_[m], x0, x1);
                f32x4 v00 = acc[ai][0][m][0], v01 = acc[ai][0][m][1], v10 = acc[ai][1][m][0], v11 = acc[ai][1][m][1];
                v00.x += bf_lo(x0.x); v00.y += bf_hi(x0.x); v00.z += bf_lo(x0.y); v00.w += bf_hi(x0.y); v01.x += bf_lo(x0.z); v01.y += bf_hi(x0.z); v01.z += bf_lo(x0.w); v01.w += bf_hi(x0.w);
                v10.x += bf_lo(x1.x); v10.y += bf_hi(x1.x); v10.z += bf_lo(x1.y); v10.w += bf_hi(x1.y); v11.x += bf_lo(x1.z); v11.y += bf_hi(x1.z); v11.z += bf_lo(x1.w); v11.w += bf_hi(x1.w);
                ss += (v00.x * v00.x + v00.y * v00.y + v00.z * v00.z + v00.w * v00.w) + (v01.x * v01.x + v01.y * v01.y + v01.z * v01.z + v01.w * v01.w);
                ss += (v10.x * v10.x + v10.y * v10.y + v10.z * v10.z + v10.w * v10.w) + (v11.x * v11.x + v11.y * v11.y + v11.z * v11.z + v11.w * v11.w);
                tio_store(T, XbB + (size_t)row0 * 2048 + cw, lane, fr, fq, pack8(v00, v01), pack8(v10, v11));
                ss += __shfl_xor(ss, 16); ss += __shfl_xor(ss, 32);
                if (fq == 0) ssqB[(size_t)(row0 + fr) * 32 + u.pn * 4 + wc] = ss;
            }
        }
    }
};

struct EpiPle {
    const P& p; LAS unsigned char* lds;
    __device__ __forceinline__ void operator()(const f32x4 (&acc)[2][2][4][2], const pg8::Unit& u, int wr, int wc, int fr, int fq) const {
        u16* O = u.pm == NP / 256 ? (u16*)(p.ws + W_PLES) - (size_t)NP * 2048 : (u16*)(p.ws + W_PLEB);
        const int lane = fq * 16 + fr, cw = u.pn * 256 + wc * 64; LAS unsigned char* T = lds + TIO_OFF + (wr * 4 + wc) * TIO_WAVE;
#pragma unroll
        for (int ai = 0; ai < 2; ++ai)
#pragma unroll
            for (int m = 0; m < 4; ++m)
                tio_store(T, O + (size_t)(u.pm * 256 + ai * 128 + wr * 64 + m * 16) * 2048 + cw, lane, fr, fq, pack8(acc[ai][0][m][0], acc[ai][0][m][1]), pack8(acc[ai][1][m][0], acc[ai][1][m][1]));
    }
};

struct EpiGate {
    const P& p; LAS unsigned char* lds;
    __device__ __forceinline__ void operator()(const f32x4 (&acc)[2][2][4][2], const pg8::Unit& u, int wr, int wc, int fr, int fq) const {
        const float* ssqB = (const float*)(p.ws + W_SSQB); float* ssqA = (float*)(p.ws + W_SSQA); u16* XbA = (u16*)(p.ws + W_XBA); const u16* XbB = (const u16*)(p.ws + W_XBB); const u16* PL = u.pm == NP / 256 ? (const u16*)(p.ws + W_PLES) - (size_t)NP * 2048 : (const u16*)(p.ws + W_PLEB);
        const int lane = fq * 16 + fr, cw = u.pn * 256 + wc * 64; LAS unsigned char* T = lds + TIO_OFF + (wr * 4 + wc) * TIO_WAVE;
        float rsv[8];
#pragma unroll
        for (int i = 0; i < 8; ++i) rsv[i] = row_rstd(ssqB, u.pm * 256 + (i >> 2) * 128 + wr * 64 + (i & 3) * 16 + fr, fq);
#pragma unroll
        for (int g4 = 0; g4 < 4; ++g4) { const int ai = g4 >> 1, m0 = (g4 & 1) * 2;
            u32x4 xa[2], xb_[2], pa[2], pb[2];
#pragma unroll
            for (int mm = 0; mm < 2; ++mm) { const size_t ro = (size_t)(u.pm * 256 + ai * 128 + wr * 64 + (m0 + mm) * 16) * 2048 + cw;
                tio_load(XbB + ro, lane, xa[mm], xb_[mm]); tio_load(PL + ro, lane, pa[mm], pb[mm]); }
#pragma unroll
            for (int mm = 0; mm < 2; ++mm) { const int m = m0 + mm;
                const int row0 = u.pm * 256 + ai * 128 + wr * 64 + m * 16;
                const float rs = rsv[ai * 4 + m]; float ss = 0.f;
                u32x4 x0, x1, p0, p1;
                tio_unpack(T, lane, fr, fq, xa[mm], xb_[mm], x0, x1);
                tio_unpack(T, lane, fr, fq, pa[mm], pb[mm], p0, p1);
                f32x4 v[2][2];
#pragma unroll
                for (int bj = 0; bj < 2; ++bj) { const f32x4 a0 = acc[ai][bj][m][0] * rs, a1 = acc[ai][bj][m][1] * rs; const u32x4 pq = bj ? p1 : p0, xq = bj ? x1 : x0;
                    f32x4 v0, v1;
                    v0.x = bf_lo(xq.x) + bf_lo(pq.x) * __builtin_amdgcn_rcpf(1.f + __expf(-a0.x)); v0.y = bf_hi(xq.x) + bf_hi(pq.x) * __builtin_amdgcn_rcpf(1.f + __expf(-a0.y));
                    v0.z = bf_lo(xq.y) + bf_lo(pq.y) * __builtin_amdgcn_rcpf(1.f + __expf(-a0.z)); v0.w = bf_hi(xq.y) + bf_hi(pq.y) * __builtin_amdgcn_rcpf(1.f + __expf(-a0.w));
                    v1.x = bf_lo(xq.z) + bf_lo(pq.z) * __builtin_amdgcn_rcpf(1.f + __expf(-a1.x)); v1.y = bf_hi(xq.z) + bf_hi(pq.z) * __builtin_amdgcn_rcpf(1.f + __expf(-a1.y));
                    v1.z = bf_lo(xq.w) + bf_lo(pq.w) * __builtin_amdgcn_rcpf(1.f + __expf(-a1.z)); v1.w = bf_hi(xq.w) + bf_hi(pq.w) * __builtin_amdgcn_rcpf(1.f + __expf(-a1.w));
                    ss += (v0.x * v0.x + v0.y * v0.y + v0.z * v0.z + v0.w * v0.w) + (v1.x * v1.x + v1.y * v1.y + v1.z * v1.z + v1.w * v1.w);
                    v[bj][0] = v0; v[bj][1] = v1; }
                tio_store(T, XbA + (size_t)row0 * 2048 + cw, lane, fr, fq, pack8(v[0][0], v[0][1]), pack8(v[1][0], v[1][1]));
                ss += __shfl_xor(ss, 16); ss += __shfl_xor(ss, 32);
                if (fq == 0) ssqA[(size_t)(row0 + fr) * 32 + u.pn * 4 + wc] = ss;
            }
        }
    }
};

struct TDesc { const float* src; size_t sld; u16* dst; size_t dld; const float* gk; };
constexpr int NT_WIN = DEPTH * 2048, NT_WOUT = DEPTH * 512, NT_WPLE = DEPTH * 128, NT_WGATE = DEPTH * 1024, NT_VC = DEPTH * DEC_BATCH * 8 * 32;
constexpr int NT_ALL = NT_WIN + NT_WOUT + NT_WPLE + NT_WGATE + NT_VC;
__device__ __forceinline__ TDesc tile_desc(const P& p, int t) {
    TDesc d;
    if (t < NT_WIN) { const int L = t >> 11, r = t & 2047, kt = r >> 6, nt = r & 63;
        d.src = p.w_in + (size_t)L * 2048 * D_IN + (size_t)kt * 64 * D_IN + nt * 64; d.sld = D_IN; d.dst = (u16*)(p.ws + W_WTIN) + (size_t)L * 4096 * 2048 + (size_t)nt * 64 * 2048 + kt * 64; d.dld = 2048; d.gk = p.g_attn + L * 2048 + kt * 64; return d; }
    t -= NT_WIN;
    if (t < NT_WOUT) { const int L = t >> 9, r = t & 511, kt = r >> 5, nt = r & 31;
        d.src = p.w_out + (size_t)L * 1024 * 2048 + (size_t)kt * 64 * 2048 + nt * 64; d.sld = 2048; d.dst = (u16*)(p.ws + W_WTOUT) + (size_t)L * 2048 * 1024 + (size_t)nt * 64 * 1024 + kt * 64; d.dld = 1024; d.gk = nullptr; return d; }
    t -= NT_WOUT;
    if (t < NT_WPLE) { const int L = t >> 7, r = t & 127, kt = r >> 5, nt = r & 31;
        d.src = p.w_ple + (size_t)L * 256 * 2048 + (size_t)kt * 64 * 2048 + nt * 64; d.sld = 2048; d.dst = (u16*)(p.ws + W_WTPLE) + (size_t)L * 2048 * 256 + (size_t)nt * 64 * 256 + kt * 64; d.dld = 256; d.gk = nullptr; return d; }
    t -= NT_WPLE;
    if (t < NT_WGATE) { const int L = t >> 10, r = t & 1023, kt = r >> 5, nt = r & 31;
        d.src = p.w_gate + (size_t)L * 2048 * 2048 + (size_t)kt * 64 * 2048 + nt * 64; d.sld = 2048; d.dst = (u16*)(p.ws + W_WTGATE) + (size_t)L * 2048 * 2048 + (size_t)nt * 64 * 2048 + kt * 64; d.dld = 2048; d.gk = p.g_ple + L * 2048 + kt * 64; return d; }
    t -= NT_WGATE;
    { const int mi = t >> 5, r = t & 31, kt = r >> 1, nt = r & 1; const int ls = mi >> 3, h8 = mi & 7, br = h8 >> 2, hh = h8 & 3;
        d.src = (br ? p.c_fxv : p.c_sbv) + ((size_t)ls * PAST + kt * 64) * 512 + hh * 128 + nt * 64; d.sld = 512; d.dst = (u16*)(p.ws + W_VTS) + ((size_t)mi * 128 + nt * 64) * SL + kt * 64; d.dld = SL; d.gk = nullptr; return d; }
}

__device__ __forceinline__ void prep_phase(int wv, const P& p, LAS unsigned char* lds) {
    LAS float* T = (LAS float*)lds;
    const int tid = opaque_tid(wv), G = gridDim.x, B = blockIdx.x;
    const int wid = tid >> 6, lane = tid & 63;
    if (B == 0) { ((unsigned*)(p.ws + W_CTR))[tid] = 0u; ((unsigned*)(p.ws + W_CTR))[tid + 512] = 0u; }
    {
        const int k0 = tid >> 4, n4 = (tid & 15) * 4, no = tid >> 3, kc = tid & 7;
        f32x4 v[2][2]; float g[2][2]; TDesc d[2]; bool ok[2];
#define PREP_FETCH(t_) do { _Pragma("unroll") for (int q = 0; q < 2; ++q) { const int tt = (t_) + q * G; ok[q] = tt < NT_ALL; g[q][0] = 1.f; g[q][1] = 1.f; \
            if (ok[q]) { d[q] = tile_desc(p, tt); v[q][0] = *(const f32x4*)(d[q].src + (size_t)k0 * d[q].sld + n4); v[q][1] = *(const f32x4*)(d[q].src + (size_t)(k0 + 32) * d[q].sld + n4); \
                if (d[q].gk) { g[q][0] = d[q].gk[k0]; g[q][1] = d[q].gk[k0 + 32]; } } } } while (0)
        int t = B;
        PREP_FETCH(t);
        while (t < NT_ALL) {
            TDesc dc[2]; bool okc[2];
#pragma unroll
            for (int q = 0; q < 2; ++q) { okc[q] = ok[q]; dc[q] = d[q]; LAS float* Tq = T + q * (64 * 65);
                if (ok[q]) {
#pragma unroll
                    for (int hh = 0; hh < 2; ++hh) { const f32x4 x = v[q][hh]; const float gg = g[q][hh]; LAS float* tp = Tq + (k0 + 32 * hh) * 65 + n4; tp[0] = x.x * gg; tp[1] = x.y * gg; tp[2] = x.z * gg; tp[3] = x.w * gg; } } }
            __syncthreads();
            const int tn = t + 2 * G;
            PREP_FETCH(tn);
#pragma unroll
            for (int q = 0; q < 2; ++q) if (okc[q]) { const LAS float* Tq = T + q * (64 * 65); float f[8];
#pragma unroll
                for (int j = 0; j < 8; ++j) f[j] = Tq[(kc * 8 + j) * 65 + no];
                u32x4 w; w.x = cvt_pk_bf16(f[0], f[1]); w.y = cvt_pk_bf16(f[2], f[3]); w.z = cvt_pk_bf16(f[4], f[5]); w.w = cvt_pk_bf16(f[6], f[7]);
                *(u32x4*)(dc[q].dst + (size_t)no * dc[q].dld + kc * 8) = w; }
            __syncthreads();
            t = tn;
        }
#undef PREP_FETCH
    }
    for (int i = B * 512 + tid; i < DEPTH * 2048 * 4; i += G * 512) { const int L = i >> 13, k = (i >> 2) & 2047, j = i & 3;
        ((float*)(p.ws + W_WF))[i] = p.g_attn[L * 2048 + k] * p.w_in[(size_t)L * 2048 * D_IN + (size_t)k * D_IN + 4096 + j]; }
    for (int row = B * 8 + wid; row < NR; row += G * 8) {
        const float* src = row < NP ? p.x_prompt + (size_t)row * 2048 : p.x_sample + (size_t)(row - NP) * 2048;
        u16* xb = (u16*)(p.ws + W_XBA) + (size_t)row * 2048; float ss = 0.f;
#pragma unroll
        for (int i = 0; i < 8; ++i) { const int c = (i * 64 + lane) * 4; const f32x4 v = *(const f32x4*)(src + c); ss += v.x * v.x + v.y * v.y + v.z * v.z + v.w * v.w;
            u32x2 w; w.x = cvt_pk_bf16(v.x, v.y); w.y = cvt_pk_bf16(v.z, v.w); *(u32x2*)(xb + c) = w; }
#pragma unroll
        for (int d = 1; d < 64; d <<= 1) ss += __shfl_xor(ss, d);
        if (lane < 32) ((float*)(p.ws + W_SSQA))[(size_t)row * 32 + lane] = lane == 0 ? ss : 0.f;
    }
    for (size_t i0 = (size_t)B * 512 + tid; i0 < (size_t)DEPTH * NR * 64; i0 += (size_t)G * 512 * 4) { f32x4 v[4]; u16* dp[4];
#pragma unroll
        for (int q = 0; q < 4; ++q) { const size_t i = i0 + (size_t)q * G * 512; dp[q] = nullptr;
            if (i < (size_t)DEPTH * NR * 64) { const int L = (int)(i / ((size_t)NR * 64)); const size_t r = i % ((size_t)NR * 64); const int row = (int)(r >> 6), c4 = (int)(r & 63) * 4;
                const float* src = row < NP ? p.p_prompt + ((size_t)L * NP + row) * 256 + c4 : p.p_sample + ((size_t)L * NS + (row - NP)) * 256 + c4;
                v[q] = *(const f32x4*)src; dp[q] = (u16*)(p.ws + W_PB) + ((size_t)L * NR + row) * 256 + c4; } }
#pragma unroll
        for (int q = 0; q < 4; ++q) if (dp[q]) { u32x2 w; w.x = cvt_pk_bf16(v[q].x, v[q].y); w.y = cvt_pk_bf16(v[q].z, v[q].w); *(u32x2*)dp[q] = w; } }
    for (size_t i0 = (size_t)B * 512 + tid; i0 < (size_t)2 * DEPTH * DEC_BATCH * PAST * 128; i0 += (size_t)G * 512 * 4) { f32x4 v[4]; u16* dp[4];
#pragma unroll
        for (int q = 0; q < 4; ++q) { const size_t i = i0 + (size_t)q * G * 512; dp[q] = nullptr;
            if (i < (size_t)2 * DEPTH * DEC_BATCH * PAST * 128) { const int br = (int)(i / ((size_t)DEPTH * DEC_BATCH * PAST * 128)); const size_t r = i % ((size_t)DEPTH * DEC_BATCH * PAST * 128);
                const int ls = (int)(r / (PAST * 128)), pos = (int)((r / 128) % PAST), c4 = (int)(r & 127) * 4;
                v[q] = *(const f32x4*)((br ? p.c_fxk : p.c_sbk) + ((size_t)ls * PAST + pos) * 512 + c4); dp[q] = (u16*)(p.ws + W_KBS) + ((size_t)ls * SL + pos) * 1024 + br * 512 + c4; } }
#pragma unroll
        for (int q = 0; q < 4; ++q) if (dp[q]) { u32x2 w; w.x = cvt_pk_bf16(v[q].x, v[q].y); w.y = cvt_pk_bf16(v[q].z, v[q].w); *(u32x2*)dp[q] = w; } }
    for (int s = B * 8 + wid; s < DEPTH * DEC_BATCH * 4; s += G * 8) { const int ls = s >> 2, hh = s & 3; const float* src = p.c_logf + (size_t)ls * PAST * 4 + hh; float v[16]; float run = 0.f;
#pragma unroll
        for (int i = 0; i < 16; ++i) { run += src[(size_t)(lane * 16 + i) * 4]; v[i] = run; }
        float x = run;
#pragma unroll
        for (int d = 1; d < 64; d <<= 1) { const float y = __shfl_up(x, d); if (lane >= d) x += y; }
        const float pre = x - run; float* dst = (float*)(p.ws + W_CCUM) + (size_t)ls * PAST * 4 + hh;
#pragma unroll
        for (int i = 0; i < 16; ++i) dst[(size_t)(lane * 16 + i) * 4] = pre + v[i];
    }
}

__device__ __forceinline__ void logf_items(int wv, const P& p, int layer, LAS unsigned char* lds, int blk0, int blk_end, int blk_step) {
    LAS f32x4* WfL = (LAS f32x4*)lds;
    LAS float* lf = (LAS float*)(lds + 40960);
    const int tid = opaque_tid(wv);
    const f32x4* Wf = (const f32x4*)(p.ws + W_WF) + (size_t)layer * 2048;
    const float* ssqA = (const float*)(p.ws + W_SSQA);
    for (int blk = blk0; blk < blk_end; blk += blk_step) {
        __syncthreads();
#pragma unroll
        for (int i = 0; i < 4; ++i) { const int k = tid + 512 * i; WfL[k + (k >> 9)] = Wf[k]; }
        __syncthreads();
        const int rl = tid >> 2, kq = tid & 3, row = blk * 128 + rl;
        const u16* xr = (const u16*)(p.ws + W_XBA) + (size_t)row * 2048 + kq * 512;
        f32x4 a = (f32x4){0.f, 0.f, 0.f, 0.f};
        for (int i = 0; i < 64; ++i) { const u32x4 xv = *(const u32x4*)(xr + i * 8); const LAS f32x4* w = WfL + kq * 513 + i * 8;
            a += w[0] * bf_lo(xv.x); a += w[1] * bf_hi(xv.x); a += w[2] * bf_lo(xv.y); a += w[3] * bf_hi(xv.y); a += w[4] * bf_lo(xv.z); a += w[5] * bf_hi(xv.z); a += w[6] * bf_lo(xv.w); a += w[7] * bf_hi(xv.w); }
#pragma unroll
        for (int j = 0; j < 4; ++j) { a[j] += __shfl_xor(a[j], 1); a[j] += __shfl_xor(a[j], 2); }
        if (kq == 0) { float s = 0.f; const f32x4* q = (const f32x4*)(ssqA + (size_t)row * 32);
#pragma unroll
            for (int i = 0; i < 8; ++i) { const f32x4 v = q[i]; s += (v.x + v.y) + (v.z + v.w); }
            const float rs = rsqrtf(s * (1.f / 2048.f) + EPS); f32x4 lg;
#pragma unroll
            for (int j = 0; j < 4; ++j) { const float f = a[j] * rs + p.b_f[layer * 4 + j]; lg[j] = fminf(f, 0.f) - log1pf(expf(-fabsf(f))); }
            float* o = row < NP ? p.out + O_LOGF_P + ((size_t)layer * NP + row) * 4 : p.out + O_LOGF_S + ((size_t)layer * NS + (row - NP)) * 4;
            *(f32x4*)o = lg; lf[rl * 4 + 0] = lg.x; lf[rl * 4 + 1] = lg.y; lf[rl * 4 + 2] = lg.z; lf[rl * 4 + 3] = lg.w; }
        __syncthreads();
        if (tid < 16) { const int seg = tid >> 2, hh = tid & 3; float run = 0.f; float* cin = (float*)(p.ws + W_CIN);
            for (int i = 0; i < 32; ++i) { run += lf[(seg * 32 + i) * 4 + hh]; cin[(size_t)(blk * 128 + seg * 32 + i) * 4 + hh] = run; }
            ((float*)(p.ws + W_SEGTOT))[(size_t)(blk * 4 + seg) * 4 + hh] = run; }
    }
    __syncthreads();
}

constexpr int TEAM = 32;
__device__ __forceinline__ void team_barrier(unsigned* ctr) {
    __threadfence();
    __syncthreads();
    if (threadIdx.x == 0) {
        __hip_atomic_fetch_add(ctr, 1u, __ATOMIC_RELEASE, __HIP_MEMORY_SCOPE_AGENT);
        while (__hip_atomic_load(ctr, __ATOMIC_ACQUIRE, __HIP_MEMORY_SCOPE_AGENT) < (unsigned)TEAM) __builtin_amdgcn_s_sleep(8);
    }
    __syncthreads();
    __threadfence();
}

constexpr int A_KB = 0, A_VB = 34816, A_CK = 71680, A_SEG = 72192, A_MISC = 74240;
constexpr int KROW = 272, VROW = 144;

__device__ __forceinline__ void attn_phase(int wv, const P& p, int layer, LAS unsigned char* lds) {
    LAS float* segpre = (LAS float*)(lds + A_SEG);
    LAS int* misc = (LAS int*)(lds + A_MISC);
    LAS float* wtot = (LAS float*)(lds + A_MISC + 128);
    unsigned* ctr = (unsigned*)(p.ws + W_CTR) + layer;
    const float* Cin = (const float*)(p.ws + W_CIN);
    const int bid = blockIdx.x; const bool team = bid < TEAM;
    unsigned* tbar = (unsigned*)(p.ws + W_CTR) + 16 + layer * 8;
    int sd_left = 0, tstate = team ? 0 : 2;
    if (team) {
        pg8::StaticOrder S1;
        if (layer > 0) {
            if (bid < 8) { pg8::Gemm g{(const u16*)(p.ws + W_OB), (const u16*)(p.ws + W_WTOUT) + (size_t)(layer - 1) * 2048 * 1024, NR, 2048, 1024}; S1.init_one(NP / 256, bid); EpiOut E{p, lds}; pg8::gemm_phase(wv, lds, g, S1, E); }
            else if (bid < 16) { pg8::Gemm g{(const u16*)(p.ws + W_PB) + (size_t)(layer - 1) * NR * 256, (const u16*)(p.ws + W_WTPLE) + (size_t)(layer - 1) * 2048 * 256, NR, 2048, 256}; S1.init_one(NP / 256, bid - 8); EpiPle E{p, lds}; pg8::gemm_phase(wv, lds, g, S1, E); }
            team_barrier(tbar + 0);
            if (bid < 8) { pg8::Gemm g{(const u16*)(p.ws + W_XBB), (const u16*)(p.ws + W_WTGATE) + (size_t)(layer - 1) * 2048 * 2048, NR, 2048, 2048}; S1.init_one(NP / 256, bid); EpiGate E{p, lds}; pg8::gemm_phase(wv, lds, g, S1, E); }
            team_barrier(tbar + 1);
        }
        if (bid < 16) { pg8::Gemm g{(const u16*)(p.ws + W_XBA), (const u16*)(p.ws + W_WTIN) + (size_t)layer * 4096 * 2048, NR, 4096, 2048}; S1.init_one(NP / 256, bid); EpiProj E{p, layer, lds}; pg8::gemm_phase(wv, lds, g, S1, E); }
        else if (bid < 18) logf_items(wv, p, layer, lds, NP / 128 + (bid - 16), NP / 128 + (bid - 16) + 1, 1);
        team_barrier(tbar + 2);
        sd_left = 2;
    }
    for (;;) {
        if (tstate == 0 && sd_left == 0) {
            if (layer == DEPTH - 1) {
                pg8::StaticOrder S1;
                team_barrier(tbar + 3);
                if (bid < 8) { pg8::Gemm g{(const u16*)(p.ws + W_OB), (const u16*)(p.ws + W_WTOUT) + (size_t)layer * 2048 * 1024, NR, 2048, 1024}; S1.init_one(NP / 256, bid); EpiOut E{p, lds}; pg8::gemm_phase(wv, lds, g, S1, E); }
                else if (bid < 16) { pg8::Gemm g{(const u16*)(p.ws + W_PB) + (size_t)layer * NR * 256, (const u16*)(p.ws + W_WTPLE) + (size_t)layer * 2048 * 256, NR, 2048, 256}; S1.init_one(NP / 256, bid - 8); EpiPle E{p, lds}; pg8::gemm_phase(wv, lds, g, S1, E); }
                team_barrier(tbar + 4);
                if (bid < 8) { pg8::Gemm g{(const u16*)(p.ws + W_XBB), (const u16*)(p.ws + W_WTGATE) + (size_t)layer * 2048 * 2048, NR, 2048, 2048}; S1.init_one(NP / 256, bid); EpiGate E{p, lds}; pg8::gemm_phase(wv, lds, g, S1, E); }
            }
            tstate = 2;
        }
        const int tid = opaque_tid(wv), wid = __builtin_amdgcn_readfirstlane(tid >> 6), lane = tid & 63, r = lane & 31, h = lane >> 5;
        const int prow = 16 * (r >> 4) + 8 * ((r >> 2) & 1) + 4 * ((r >> 3) & 1) + (r & 3);
        __syncthreads();
        if (tid == 0) misc[0] = sd_left > 0 ? 1024 + (2 - sd_left) * TEAM + bid : (int)atomicAdd(ctr, 1u);
        __syncthreads();
        int item = misc[0];
        if (sd_left > 0) --sd_left; else if (item >= 1024) break;
        int head8, qpos0, nw, row0, ldv, sbi = 0, bi = 0; const u16 *Kb, *Vt; const bool prompt = item < 1024;
        if (prompt) { const int qt = 63 - (item >> 4), rem = item & 15; bi = rem >> 3; head8 = rem & 7; qpos0 = qt * 256; nw = 8; row0 = bi * SEQ + qpos0;
            Kb = (const u16*)(p.ws + W_KBP) + (size_t)bi * SEQ * 1024 + head8 * 128; Vt = (const u16*)(p.ws + W_VTP) + (size_t)(bi * 8 + head8) * 128 * SEQ; ldv = SEQ;
        } else { const int s = item - 1024; sbi = s >> 3; head8 = s & 7; qpos0 = PAST; nw = 1; row0 = NP + sbi * 32;
            Kb = (const u16*)(p.ws + W_KBS) + (size_t)(layer * 8 + sbi) * SL * 1024 + head8 * 128; Vt = (const u16*)(p.ws + W_VTS) + (size_t)((layer * 8 + sbi) * 8 + head8) * 128 * SL; ldv = SL; }
        const bool fox = head8 >= 4; const int hf = head8 & 3;
        const float* ccum = (const float*)(p.ws + W_CCUM) + (size_t)(layer * 8 + sbi) * PAST * 4 + hf;
        if (fox && prompt) {
            const int nseg = (qpos0 + 256) >> 5; const float v = tid < nseg ? ((const float*)(p.ws + W_SEGTOT))[(size_t)(bi * 512 + tid) * 4 + hf] : 0.f; float x = v;
#pragma unroll
            for (int d = 1; d < 64; d <<= 1) { const float y = __shfl_up(x, d); if (lane >= d) x += y; }
            if (lane == 63) wtot[wid] = x;
            __syncthreads();
            float pre = 0.f; for (int w = 0; w < wid; ++w) pre += wtot[w];
            segpre[tid] = pre + x - v;
            __syncthreads();
        }
        auto getC = [&](int pos) -> float {
            if (prompt) return segpre[pos >> 5] + Cin[(size_t)(bi * SEQ + pos) * 4 + hf];
            if (pos < PAST) return ccum[(size_t)pos * 4];
            if (pos < PAST + 32) return ccum[(size_t)(PAST - 1) * 4] + Cin[(size_t)(NP + sbi * 32 + pos - PAST) * 4 + hf];
            return 0.f; };
        const bool wact = wid < nw;
        bf16x8 qf[8];
        float cq2 = 0.f;
        const int qlo = qpos0 + 32 * wid, qhi = qlo + 31, qpos = qlo + r;
        if (wact) { const u16* qrow = (const u16*)(p.ws + W_QB) + (size_t)(row0 + 32 * wid + r) * 1024 + head8 * 128 + 8 * h;
#pragma unroll
            for (int kk = 0; kk < 8; ++kk) qf[kk] = *(const bf16x8*)(qrow + 16 * kk);
            if (fox) cq2 = getC(qpos) * LOG2E; }
        else {
#pragma unroll
            for (int kk = 0; kk < 8; ++kk) qf[kk] = (bf16x8){0, 0, 0, 0, 0, 0, 0, 0}; }
        float qnK = 3.0e38f;
        if (fox && prompt) { const unsigned* ks = (const unsigned*)(p.ws + W_CTR) + 64 + ((layer * 2 + bi) * 4 + hf) * 4;
            const float kmax = sqrtf(__uint_as_float(ks[0]) + __uint_as_float(ks[1]) + __uint_as_float(ks[2]) + __uint_as_float(ks[3])) * 1.01f; float qn2 = 0.f;
#pragma unroll
            for (int kk = 0; kk < 8; ++kk)
#pragma unroll
                for (int i = 0; i < 8; ++i) { const float f = __uint_as_float(((unsigned)(unsigned short)qf[kk][i]) << 16); qn2 += f * f; }
            qn2 += __shfl_xor(qn2, 32); qnK = sqrtf(qn2) * 1.01f * kmax; }
        u32x4 kreg[2], vreg[2]; float ckreg = 0.f;
        const int krow_ = tid >> 4, kch = tid & 15, vrow_ = tid >> 3, vch = tid & 7;
#define LOAD_TILE(jt_) do { const int k0_ = (jt_) * 64; _Pragma("unroll") for (int pz = 0; pz < 2; ++pz) { \
            kreg[pz] = *(const u32x4*)(Kb + (size_t)(k0_ + krow_ + 32 * pz) * 1024 + kch * 8); \
            vreg[pz] = *(const u32x4*)(Vt + (size_t)(vrow_ + 64 * pz) * ldv + k0_ + vch * 8); } \
            if (fox && tid < 64) ckreg = getC(k0_ + tid) * LOG2E; } while (0)
#define STORE_TILE(buf_) do { _Pragma("unroll") for (int pz = 0; pz < 2; ++pz) { \
            *(LAS u32x4*)(lds + A_KB + (buf_) * 17408 + (krow_ + 32 * pz) * KROW + kch * 16) = kreg[pz]; \
            *(LAS u32x4*)(lds + A_VB + (buf_) * 18432 + (vrow_ + 64 * pz) * VROW + vch * 16) = vreg[pz]; } \
            if (fox && tid < 64) *(LAS float*)(lds + A_CK + (buf_) * 256 + tid * 4) = ckreg; } while (0)
        const int jt_top = (qpos0 + 32 * nw - 1) >> 6;
        LOAD_TILE(jt_top); STORE_TILE(0);
        __syncthreads();
        f32x16 o[4];
#pragma unroll
        for (int dt = 0; dt < 4; ++dt)
#pragma unroll
            for (int i = 0; i < 16; ++i) o[dt][i] = 0.f;
        float carry = 0.f, mrun = -1e30f, lsum = 0.f; bool wave_done = !wact;
        for (int jt = jt_top, it = 0; jt >= 0; --jt, ++it) {
            const int cur = it & 1; const bool more = jt > 0;
            if (more) LOAD_TILE(jt - 1);
            const int key0 = jt * 64;
            if (fox && prompt && !wave_done && key0 <= qhi) {
                const float ck63 = *(const LAS float*)(lds + A_CK + cur * 256 + 252);
                if (__all((qnK + cq2 - ck63) < (mrun - 155.f))) wave_done = true; }
            if (!wave_done && key0 <= qhi) {
                const bool diag = key0 + 63 >= qlo;
                const LAS unsigned char* kb = lds + A_KB + cur * 17408 + prow * KROW + 16 * h;
                const LAS unsigned char* vb = lds + A_VB + cur * 18432 + r * VROW + 16 * h;
                f32x16 sv[2];
#pragma unroll
                for (int i = 0; i < 16; ++i) { sv[0][i] = 0.f; sv[1][i] = 0.f; }
#pragma unroll
                for (int kk = 0; kk < 8; ++kk) { const bf16x8 a0 = *(const LAS bf16x8*)(kb + kk * 32); const bf16x8 a1 = *(const LAS bf16x8*)(kb + 32 * KROW + kk * 32);
                    sv[0] = __builtin_amdgcn_mfma_f32_32x32x16_bf16(a0, qf[kk], sv[0], 0, 0, 0); sv[1] = __builtin_amdgcn_mfma_f32_32x32x16_bf16(a1, qf[kk], sv[1], 0, 0, 0); }
                if (!fox) {
#pragma unroll
                    for (int kt = 1; kt >= 0; --kt) {
                        float sp[16], ex[16], tot[2];
#pragma unroll
                        for (int rg = 0; rg < 16; ++rg) { const int kpos = key0 + 32 * kt + 16 * (rg >> 3) + 8 * h + (rg & 7); const float z = sv[kt][rg];
                            const float spv = fmaxf(z, 0.f) + flog2(1.f + fexp2(-fabsf(z))); sp[rg] = (!diag || kpos < qpos) ? spv : 0.f; }
#pragma unroll
                        for (int c = 0; c < 2; ++c) { float run = 0.f;
#pragma unroll
                            for (int idx = 7; idx >= 0; --idx) { ex[8 * c + idx] = run; run += sp[8 * c + idx]; }
                            tot[c] = run; }
                        const float pt0 = __shfl_xor(tot[0], 32), pt1 = __shfl_xor(tot[1], 32);
                        const float off1 = carry + (h ? 0.f : pt1), off0 = carry + (h ? (pt1 + tot[1]) : (pt0 + tot[1] + pt1));
#pragma unroll
                        for (int rg = 0; rg < 16; ++rg) { const int kpos = key0 + 32 * kt + 16 * (rg >> 3) + 8 * h + (rg & 7);
                            const float e2 = sv[kt][rg] - sp[rg] - ((rg >= 8 ? off1 : off0) + ex[rg]);
                            sv[kt][rg] = (!diag || kpos < qpos) ? fexp2(e2) : 0.f; }
                        carry += (tot[0] + tot[1]) + (pt0 + pt1);
                    }
                    if (__all(carry > 152.f)) wave_done = true;
                } else {
                    const LAS float* ckb = (const LAS float*)(lds + A_CK + cur * 256) + 8 * h;
                    float mx = -1e30f;
#pragma unroll
                    for (int kt = 0; kt < 2; ++kt)
#pragma unroll
                        for (int q4 = 0; q4 < 4; ++q4) { const f32x4 ck = *(const LAS f32x4*)(ckb + 32 * kt + 16 * (q4 >> 1) + 4 * (q4 & 1));
#pragma unroll
                            for (int j = 0; j < 4; ++j) { const int rg = 4 * q4 + j; const int kpos = key0 + 32 * kt + 16 * (rg >> 3) + 8 * h + (rg & 7);
                                float x = sv[kt][rg] + (cq2 - ck[j]); if (diag && kpos > qpos) x = -1e30f; sv[kt][rg] = x; mx = fmaxf(mx, x); } }
                    mx = fmaxf(mx, __shfl_xor(mx, 32));
                    const float mnew = fmaxf(mrun, mx), alpha = fexp2(mrun - mnew); mrun = mnew; float ps = 0.f;
#pragma unroll
                    for (int kt = 0; kt < 2; ++kt)
#pragma unroll
                        for (int rg = 0; rg < 16; ++rg) { const float pv = fexp2(sv[kt][rg] - mnew); sv[kt][rg] = pv; ps += pv; }
                    lsum = lsum * alpha + ps;
                    if (!__all(alpha == 1.f)) {
#pragma unroll
                        for (int dt = 0; dt < 4; ++dt) o[dt] *= alpha; }
                }
#pragma unroll
                for (int kt = 0; kt < 2; ++kt)
#pragma unroll
                    for (int c = 0; c < 2; ++c) { union { u32x4 u; bf16x8 v; } pf;
                        pf.u.x = cvt_pk_bf16(sv[kt][8 * c + 0], sv[kt][8 * c + 1]); pf.u.y = cvt_pk_bf16(sv[kt][8 * c + 2], sv[kt][8 * c + 3]);
                        pf.u.z = cvt_pk_bf16(sv[kt][8 * c + 4], sv[kt][8 * c + 5]); pf.u.w = cvt_pk_bf16(sv[kt][8 * c + 6], sv[kt][8 * c + 7]);
#pragma unroll
                        for (int dt = 0; dt < 4; ++dt) { const bf16x8 vf = *(const LAS bf16x8*)(vb + dt * 32 * VROW + (32 * kt + 16 * c) * 2);
                            o[dt] = __builtin_amdgcn_mfma_f32_32x32x16_bf16(vf, pf.v, o[dt], 0, 0, 0); } }
            }
            if (more) STORE_TILE(cur ^ 1);
            if (lane == 0) misc[8 + cur * 8 + wid] = wave_done ? 1 : 0;
            __syncthreads();
            int alld = 1;
#pragma unroll
            for (int w = 0; w < 8; ++w) alld &= misc[8 + cur * 8 + w];
            if (alld) break;
        }
#undef LOAD_TILE
#undef STORE_TILE
        if (wact) {
            if (fox) { lsum += __shfl_xor(lsum, 32); const float inv = 1.f / lsum;
#pragma unroll
                for (int dt = 0; dt < 4; ++dt) o[dt] *= inv; }
            float ss = 0.f;
#pragma unroll
            for (int dt = 0; dt < 4; ++dt)
#pragma unroll
                for (int i = 0; i < 16; ++i) ss += o[dt][i] * o[dt][i];
            ss += __shfl_xor(ss, 32);
            const float rn = rsqrtf(ss * (1.f / 128.f) + EPS);
            const int row = row0 + 32 * wid + r;
            const float* gp = (fox ? p.g_ofox : p.g_osb) + layer * 512 + hf * 128 + 4 * h;
            const u16* zp = (const u16*)(p.ws + W_ZB) + (size_t)row * 1024 + head8 * 128 + 4 * h;
            u16* op = (u16*)(p.ws + W_OB) + (size_t)row * 1024 + head8 * 128 + 4 * h;
            u32x2 zz[16];
#pragma unroll
            for (int i = 0; i < 16; ++i) zz[i] = *(const u32x2*)(zp + 32 * (i >> 2) + 8 * (i & 3));
#pragma unroll
            for (int dt = 0; dt < 4; ++dt)
#pragma unroll
                for (int bb = 0; bb < 4; ++bb) { const int d = 32 * dt + 8 * bb; const f32x4 g = *(const f32x4*)(gp + d); const u32x2 z2 = zz[dt * 4 + bb];
                    const float v0 = o[dt][4 * bb + 0] * rn * g.x * bf_lo(z2.x), v1 = o[dt][4 * bb + 1] * rn * g.y * bf_hi(z2.x), v2 = o[dt][4 * bb + 2] * rn * g.z * bf_lo(z2.y), v3 = o[dt][4 * bb + 3] * rn * g.w * bf_hi(z2.y);
                    u32x2 w; w.x = cvt_pk_bf16(v0, v1); w.y = cvt_pk_bf16(v2, v3); *(u32x2*)(op + d) = w; }
        }
    }
}

__device__ __forceinline__ void final_phase(int wv, const P& p) {
    const int tid = opaque_tid(wv), wid = tid >> 6, lane = tid & 63;
    const float* ssqA = (const float*)(p.ws + W_SSQA);
    for (int row = blockIdx.x * 8 + wid; row < NR; row += gridDim.x * 8) {
        float s = lane < 32 ? ssqA[(size_t)row * 32 + lane] : 0.f;
#pragma unroll
        for (int d = 1; d < 64; d <<= 1) s += __shfl_xor(s, d);
        const float rs = rsqrtf(s * (1.f / 2048.f) + EPS);
        float* xo = p.out + (size_t)row * 2048; const u16* xb = (const u16*)(p.ws + W_XBA) + (size_t)row * 2048;
#pragma unroll
        for (int i = 0; i < 8; ++i) { const int c = (i * 64 + lane) * 4; const u32x2 xw = *(const u32x2*)(xb + c); const f32x4 g = *(const f32x4*)(p.g_final + c);
            f32x4 v; v.x = bf_lo(xw.x) * rs * g.x; v.y = bf_hi(xw.x) * rs * g.y; v.z = bf_lo(xw.y) * rs * g.z; v.w = bf_hi(xw.y) * rs * g.w; *(f32x4*)(xo + c) = v; }
    }
}

constexpr int LDS_BYTES = 131072 + 8 * 2304;

__global__ __launch_bounds__(512, 2) void fwd_megakernel(P p) {
    extern __shared__ __attribute__((aligned(16))) unsigned char shm[];
    LAS unsigned char* lds = (LAS unsigned char*)shm;
    cg::grid_group grid = cg::this_grid();
    const int wv = __builtin_amdgcn_readfirstlane(threadIdx.x >> 6);
    prep_phase(wv, p, lds);
    grid.sync();
    pg8::StaticOrder S;
    for (int layer_ = 0; layer_ < DEPTH; ++layer_) {
        int layer = layer_, bid = (int)blockIdx.x, G = (int)gridDim.x; asm volatile("" : "+s"(layer), "+s"(bid), "+s"(G));
        {
            pg8::Gemm g{(const u16*)(p.ws + W_XBA), (const u16*)(p.ws + W_WTIN) + (size_t)layer * 4096 * 2048, NP, 4096, 2048};
            S.init(g.M, g.N, G, bid); EpiProj E{p, layer, lds};
            pg8::gemm_phase(wv, lds, g, S, E);
            logf_items(wv, p, layer, lds, bid, NP / 128, G);
        }
        grid.sync();
        attn_phase(wv, p, layer, lds);
        grid.sync();
        {
            for (int rep = 0; rep < 2; ++rep) {
                if ((rep ^ ((bid >> 2) & 1)) == 0) {
                    pg8::Gemm g{(const u16*)(p.ws + W_OB), (const u16*)(p.ws + W_WTOUT) + (size_t)layer * 2048 * 1024, NP, 2048, 1024};
                    S.init(g.M, g.N, G, bid); EpiOut E{p, lds};
                    pg8::gemm_phase(wv, lds, g, S, E);
                } else {
                    pg8::Gemm g2{(const u16*)(p.ws + W_PB) + (size_t)layer * NR * 256, (const u16*)(p.ws + W_WTPLE) + (size_t)layer * 2048 * 256, NP, 2048, 256};
                    S.init(g2.M, g2.N, G, bid); EpiPle E2{p, lds};
                    pg8::gemm_phase(wv, lds, g2, S, E2);
                }
            }
        }
        grid.sync();
        {
            pg8::Gemm g{(const u16*)(p.ws + W_XBB), (const u16*)(p.ws + W_WTGATE) + (size_t)layer * 2048 * 2048, NP, 2048, 2048};
            S.init(g.M, g.N, G, bid); EpiGate E{p, lds};
            pg8::gemm_phase(wv, lds, g, S, E);
        }
        grid.sync();
    }
    final_phase(wv, p);
}

extern "C" void kernel_launch(void* const* d_in, const int* in_sizes, int n_in, void* d_out, int out_size, void* d_ws, size_t ws_size, hipStream_t stream) {
    static int grid_blocks = 0;
    if (!grid_blocks) {
        if (n_in != 19 || (size_t)out_size != OUT_TOTAL || ws_size < W_END) { fprintf(stderr, "kernel_launch: unexpected shapes: n_in %d out %d (want %zu) ws %zu (want %zu)\n", n_in, out_size, OUT_TOTAL, ws_size, W_END); grid_blocks = -1; return; }
        int dev = 0, cus = 0, per_cu = 0;
        hipGetDevice(&dev);
        hipDeviceGetAttribute(&cus, hipDeviceAttributeMultiprocessorCount, dev);
        if (hipFuncSetAttribute((const void*)fwd_megakernel, hipFuncAttributeMaxDynamicSharedMemorySize, LDS_BYTES) != hipSuccess) fprintf(stderr, "kernel_launch: hipFuncSetAttribute failed\n");
        if (hipOccupancyMaxActiveBlocksPerMultiprocessor(&per_cu, (const void*)fwd_megakernel, 512, LDS_BYTES) != hipSuccess || per_cu < 1) { fprintf(stderr, "kernel_launch: occupancy query gave %d\n", per_cu); per_cu = 1; }
        (void)hipGetLastError();
        grid_blocks = cus * per_cu;
    }
    if (grid_blocks < 0) return;
    P p{};
    const float** f = (const float**)&p;
    for (int i = 0; i < 19; ++i) f[i] = (const float*)d_in[i];
    p.out = (float*)d_out; p.ws = (unsigned char*)d_ws;
    void* args[] = {&p};
    hipError_t e = hipLaunchCooperativeKernel((const void*)fwd_megakernel, dim3(grid_blocks), dim3(512), args, LDS_BYTES, stream);
    if (e != hipSuccess) fprintf(stderr, "cooperative launch failed: %s (grid %d)\n", hipGetErrorString(e), grid_blocks);
}
```

```cpp
#include <hip/hip_runtime.h>
#include <hip/hip_cooperative_groups.h>
#include <cstdio>
namespace cg = cooperative_groups;

#define LAS __attribute__((address_space(3)))
typedef unsigned short u16;
typedef short bf16x8 __attribute__((ext_vector_type(8)));
typedef float f32x4 __attribute__((ext_vector_type(4)));
typedef float f32x16 __attribute__((ext_vector_type(16)));
typedef unsigned u32x2 __attribute__((ext_vector_type(2)));
typedef unsigned u32x4 __attribute__((ext_vector_type(4)));

constexpr int D_MODEL = 2048, SEQ = 16384, DEPTH = 4, DEC_BATCH = 8, DEC_SEQ = 32, PAST = 1024;
constexpr int NP = 2 * SEQ, NS = DEC_BATCH * DEC_SEQ, NR = NP + NS;
constexpr int DMIX = 1024, D_IN = 4100, PLE = 256;
constexpr int SL = 1088;
constexpr float EPS = 1e-6f;
constexpr float LOG2E = 1.4426950408889634f;
constexpr float QSCALE = 0.08838834764831845f * LOG2E;
constexpr int NITEMS = 1024 + 64;

constexpr size_t O_Y = 0;
constexpr size_t O_KV_P = (size_t)NR * D_MODEL;
constexpr size_t KVP = (size_t)DEPTH * NP * 512;
constexpr size_t O_LOGF_P = O_KV_P + 4 * KVP;
constexpr size_t O_KV_S = O_LOGF_P + (size_t)DEPTH * NP * 4;
constexpr size_t KVS = (size_t)DEPTH * NS * 512;
constexpr size_t O_LOGF_S = O_KV_S + 4 * KVS;
constexpr size_t OUT_TOTAL = O_LOGF_S + (size_t)DEPTH * NS * 4;

constexpr size_t al256(size_t x) { return (x + 255) & ~(size_t)255; }
constexpr size_t W_WTIN = 0;
constexpr size_t W_WTOUT = W_WTIN + (size_t)DEPTH * 4096 * 2048 * 2;
constexpr size_t W_WTPLE = W_WTOUT + (size_t)DEPTH * 2048 * 1024 * 2;
constexpr size_t W_WTGATE = W_WTPLE + (size_t)DEPTH * 2048 * 256 * 2;
constexpr size_t W_WF = W_WTGATE + (size_t)DEPTH * 2048 * 2048 * 2;
constexpr size_t W_XBA = W_WF + (size_t)DEPTH * 2048 * 4 * 4;
constexpr size_t W_PB = W_XBA + (size_t)NR * 2048 * 2;
constexpr size_t W_R = W_PB + (size_t)DEPTH * NR * 256 * 2;
constexpr size_t W_QB = W_R;
constexpr size_t W_KBP = W_QB + (size_t)NR * 1024 * 2;
constexpr size_t W_VTP = W_KBP + (size_t)NP * 1024 * 2;
constexpr size_t W_ZB = W_VTP + (size_t)NP * 1024 * 2;
constexpr size_t W_PLEB = W_R;
constexpr size_t W_XBB = W_R + al256((size_t)NR * 2048 * 2);
constexpr size_t R_SIZE = 2 * al256((size_t)NR * 2048 * 2) + 4096;
static_assert(W_ZB + (size_t)NR * 1024 * 2 <= W_R + R_SIZE, "region R too small");
constexpr size_t W_KBS = W_R + R_SIZE;
constexpr size_t W_VTS = W_KBS + (size_t)DEPTH * DEC_BATCH * SL * 1024 * 2;
constexpr size_t W_OB = W_VTS + (size_t)DEPTH * DEC_BATCH * 8 * 128 * SL * 2;
constexpr size_t W_SSQA = W_OB + (size_t)NR * 1024 * 2;
constexpr size_t W_SSQB = W_SSQA + (size_t)NR * 32 * 4;
constexpr size_t W_CIN = W_SSQB + (size_t)NR * 32 * 4;
constexpr size_t W_SEGTOT = W_CIN + (size_t)NR * 4 * 4;
constexpr size_t W_CCUM = W_SEGTOT + al256((size_t)(NR / 32) * 4 * 4);
constexpr size_t W_CTR = W_CCUM + (size_t)DEPTH * DEC_BATCH * PAST * 4 * 4;
constexpr size_t W_PLES = W_CTR + 4096;
constexpr size_t W_END = W_PLES + (size_t)NS * 2048 * 2;

struct P {
    const float *x_prompt, *x_sample, *p_prompt, *p_sample, *c_sbk, *c_sbv, *c_fxk, *c_fxv, *c_logf, *w_in, *b_f, *g_attn, *g_osb, *g_ofox, *w_out, *w_ple, *g_ple, *w_gate, *g_final;
    float* out;
    unsigned char* ws;
};

__device__ __forceinline__ unsigned cvt_pk_bf16(float lo, float hi) { unsigned r; asm volatile("v_cvt_pk_bf16_f32 %0, %1, %2" : "=v"(r) : "v"(lo), "v"(hi)); return r; }
__device__ __forceinline__ float bf_lo(unsigned w) { return __uint_as_float(w << 16); }
__device__ __forceinline__ float bf_hi(unsigned w) { return __uint_as_float(w & 0xffff0000u); }
__device__ __forceinline__ float fexp2(float x) { return __builtin_amdgcn_exp2f(x); }
__device__ __forceinline__ float flog2(float x) { return __builtin_amdgcn_logf(x); }
__device__ __forceinline__ float fmax3(float a, float b, float c) { float r; asm("v_max3_f32 %0, %1, %2, %3" : "=v"(r) : "v"(a), "v"(b), "v"(c)); return r; }
__device__ __forceinline__ int opaque_tid(int wv) { int l; asm volatile("v_mbcnt_lo_u32_b32 %0, -1, 0\n\tv_mbcnt_hi_u32_b32 %0, -1, %0" : "=v"(l)); return wv * 64 + l; }

namespace pg8 {
constexpr int BM = 256, BK = 64, HALF = 128, HTB = HALF * BK * 2, STAGE_BYTES = 8 * HTB, NXCD = 8, WGM = 8;
__host__ __device__ __forceinline__ int lds_byte(int r, int c) { const int st = (r >> 4) * 2 + (c >> 5), rr = r & 15, cc = c & 31, ob = rr * 64 + cc * 2; return st * 1024 + (ob ^ (((ob >> 9) & 1) << 5)); }
__host__ __device__ __forceinline__ void stage_rc(int b, int& R, int& C) { const int st = b / 1024, sb = b % 1024, swz = sb ^ (((sb >> 9) & 1) << 5); R = (st >> 1) * 16 + swz / 64; C = (st & 1) * 32 + (swz % 64) / 2; }
struct Unit { int pm, pn; };
struct Gemm { const u16* A; const u16* Bt; int M, N, K; };
struct StaticOrder {
    int nM, nN, nwg, G, c;
    int one_pm, one_pn;
    __device__ void init(int M, int N, int G_, int c_) { nM = M / BM; nN = N / BM; nwg = nM * nN; G = G_; c = c_; one_pm = -1; one_pn = 0; }
    __device__ void init_one(int pm, int pn) { nM = 1; nN = 1; nwg = 1; G = 1; c = 0; one_pm = pm; one_pn = pn; }
    __device__ bool next(int i, Unit& u) const {
        if (one_pm >= 0) { if (i > 0) return false; u.pm = one_pm; u.pn = one_pn; return true; }
        const long L = (long)i * G + c; if (L >= nwg) return false;
        int wgid = (int)L; { const int q = nwg / NXCD, r = nwg % NXCD, xcd = wgid % NXCD, off = wgid / NXCD; wgid = (xcd < r ? xcd * (q + 1) : r * (q + 1) + (xcd - r) * q) + off; }
        const int nig = WGM * nN, gid = wgid / nig, fm = gid * WGM, gsz = (nM - fm) < WGM ? (nM - fm) : WGM;
        u.pm = fm + ((wgid % nig) % gsz); u.pn = (wgid % nig) / gsz; return true;
    }
};

template <class Epi>
__device__ __forceinline__ void gemm_phase(int wv, LAS unsigned char* lds, const Gemm g, const StaticOrder& S, const Epi& E, const int skew_ticks = 0) {
    const int tid = opaque_tid(wv), wid = __builtin_amdgcn_readfirstlane(tid >> 6), lane = tid & 63, wr = wid >> 2, wc = wid & 3, fr = lane & 15, fq = lane >> 4;
    const int K = g.K, nt = K / BK;
    unsigned voffA[2], voffB0[2];
#pragma unroll
    for (int i = 0; i < 2; ++i) { int R, C; stage_rc(tid * 16 + i * 8192, R, C); voffA[i] = (unsigned)(R * K + C) * 2u;
        const int rho = R & 31, pr = 8 * ((rho & 15) >> 2) + 4 * (rho >> 4) + (rho & 3), Rb = 64 * (R >> 5) + pr;
        voffB0[i] = (unsigned)(Rb * K + C) * 2u; }
    const size_t b1step = (size_t)32 * K * 2;
    const size_t kstep = (size_t)(BK * 2);
    const size_t hstep = (size_t)HALF * K * 2;
    const size_t tstep = 2 * hstep;
    const unsigned ldsw = (unsigned)wid * 1024u;
    const int aoff = lds_byte(wr * 64 + fr, fq * 8), boff = lds_byte(wc * 32 + fr, fq * 8);
#define PG8_SA(b, h) (((b) * 2 + (h)) * HTB)
#define PG8_SB(b, h) ((4 + (b) * 2 + (h)) * HTB)
#define PG8_STAGE(bufoff, gbase, voff) do { _Pragma("unroll") for (int _i = 0; _i < 2; ++_i) \
        __builtin_amdgcn_global_load_lds((const unsigned*)((const char*)(gbase) + (voff)[_i]), (LAS unsigned*)(lds + (bufoff) + ldsw + _i * 8192), 16, 0, 0); } while (0)
#define PG8_LDA(dst, b, h) do { _Pragma("unroll") for (int m = 0; m < 4; ++m) _Pragma("unroll") for (int k = 0; k < 2; ++k) dst[m][k] = *(const LAS bf16x8*)(lds + PG8_SA(b, h) + aoff + m * 2048 + k * 1024); } while (0)
#define PG8_LDB(dst, b, h) do { _Pragma("unroll") for (int n = 0; n < 2; ++n) _Pragma("unroll") for (int k = 0; k < 2; ++k) dst[n][k] = *(const LAS bf16x8*)(lds + PG8_SB(b, h) + boff + n * 2048 + k * 1024); } while (0)
#define PG8_MMA(ai, bj, At, Bt) do { __builtin_amdgcn_s_setprio(1); _Pragma("unroll") for (int m = 0; m < 4; ++m) _Pragma("unroll") for (int n = 0; n < 2; ++n) _Pragma("unroll") for (int k = 0; k < 2; ++k) \
        acc[ai][bj][m][n] = __builtin_amdgcn_mfma_f32_16x16x32_bf16(Bt[n][k], At[m][k], acc[ai][bj][m][n], 0, 0, 0); __builtin_amdgcn_s_setprio(0); } while (0)
#define PG8_WAIT_V(n) asm volatile("s_waitcnt vmcnt(" #n ")" ::: "memory")
#define PG8_WAIT_L(n) asm volatile("s_waitcnt lgkmcnt(" #n ")" ::: "memory")
#define PG8_BAR __builtin_amdgcn_s_barrier()
#define PG8_SCHED __builtin_amdgcn_sched_barrier(0)
    Unit cur, nxt; int ui = 0;
    if (!S.next(0, cur)) return;
    if (skew_ticks > 0) {
        const unsigned long long t0 = __builtin_amdgcn_s_memrealtime();
        while ((long long)(__builtin_amdgcn_s_memrealtime() - t0) < (long long)skew_ticks) __builtin_amdgcn_s_sleep(32);
    }
    f32x4 acc[2][2][4][2];
#pragma unroll
    for (int a = 0; a < 2; ++a)
#pragma unroll
        for (int b = 0; b < 2; ++b)
#pragma unroll
            for (int m = 0; m < 4; ++m)
#pragma unroll
                for (int n = 0; n < 2; ++n) acc[a][b][m][n] = (f32x4){0.f, 0.f, 0.f, 0.f};
    bf16x8 At[4][2], B0[2][2], B1[2][2];
    const char* cA = (const char*)g.A + (size_t)cur.pm * tstep; const char* cB = (const char*)g.Bt + (size_t)cur.pn * tstep;
    PG8_STAGE(PG8_SB(0, 0), cB, voffB0); PG8_STAGE(PG8_SA(0, 0), cA, voffA); PG8_STAGE(PG8_SB(0, 1), cB + b1step, voffB0); PG8_STAGE(PG8_SA(0, 1), cA + hstep, voffA);
    if (wr == 1) PG8_BAR;
    PG8_WAIT_V(4); PG8_BAR;
    PG8_STAGE(PG8_SB(1, 0), cB + kstep, voffB0); PG8_STAGE(PG8_SA(1, 0), cA + kstep, voffA); PG8_STAGE(PG8_SB(1, 1), cB + kstep + b1step, voffB0);
    PG8_WAIT_V(6); PG8_BAR;
    for (;;) {
        const bool has_next = S.next(ui + 1, nxt);
        const char* nA = has_next ? (const char*)g.A + (size_t)nxt.pm * tstep : cA; const char* nB = has_next ? (const char*)g.Bt + (size_t)nxt.pn * tstep : cB;
        for (int t = 0; t < nt; t += 2) {
            const bool last = (t == nt - 2);
            const char* a1 = cA + (size_t)(t + 1) * kstep;
            const char* a2 = last ? nA : cA + (size_t)(t + 2) * kstep; const char* b2 = last ? nB : cB + (size_t)(t + 2) * kstep;
            const char* a3 = a2 + kstep; const char* b3 = b2 + kstep;
            PG8_LDB(B0, 0, 0); PG8_SCHED; PG8_LDA(At, 0, 0); PG8_STAGE(PG8_SA(1, 1), a1 + hstep, voffA);
            PG8_WAIT_L(8); PG8_BAR; PG8_WAIT_L(0); PG8_MMA(0, 0, At, B0); PG8_BAR; PG8_SCHED;
            PG8_LDB(B1, 0, 1); PG8_STAGE(PG8_SB(0, 0), b2, voffB0);
            PG8_BAR; PG8_WAIT_L(0); PG8_MMA(0, 1, At, B1); PG8_BAR;
            PG8_LDA(At, 0, 1); PG8_STAGE(PG8_SA(0, 0), a2, voffA);
            PG8_BAR; PG8_WAIT_L(0); PG8_MMA(1, 0, At, B0); PG8_BAR; PG8_SCHED;
            PG8_STAGE(PG8_SB(0, 1), b2 + b1step, voffB0);
            PG8_WAIT_V(6); PG8_BAR; PG8_MMA(1, 1, At, B1); PG8_BAR;
            PG8_LDB(B0, 1, 0); PG8_SCHED; PG8_LDA(At, 1, 0); PG8_STAGE(PG8_SA(0, 1), a2 + hstep, voffA);
            PG8_WAIT_L(8); PG8_BAR; PG8_WAIT_L(0); PG8_MMA(0, 0, At, B0); PG8_BAR; PG8_SCHED;
            PG8_LDB(B1, 1, 1); PG8_STAGE(PG8_SB(1, 0), b3, voffB0);
            PG8_BAR; PG8_WAIT_L(0); PG8_MMA(0, 1, At, B1); PG8_BAR;
            PG8_LDA(At, 1, 1); PG8_STAGE(PG8_SA(1, 0), a3, voffA);
            PG8_BAR; PG8_WAIT_L(0); PG8_MMA(1, 0, At, B0); PG8_BAR; PG8_SCHED;
            PG8_STAGE(PG8_SB(1, 1), b3 + b1step, voffB0);
            PG8_WAIT_V(6); PG8_BAR; PG8_MMA(1, 1, At, B1); PG8_BAR;
        }
        { int fr2 = fr, fq2 = fq; asm volatile("" : "+v"(fr2), "+v"(fq2)); E(acc, cur, wr, wc, fr2, fq2); }
        if (!has_next) break;
#pragma unroll
        for (int a = 0; a < 2; ++a)
#pragma unroll
            for (int b = 0; b < 2; ++b)
#pragma unroll
                for (int m = 0; m < 4; ++m)
#pragma unroll
                    for (int n = 0; n < 2; ++n) acc[a][b][m][n] = (f32x4){0.f, 0.f, 0.f, 0.f};
        cur = nxt; cA = nA; cB = nB; ++ui;
    }
    PG8_WAIT_V(0);
    if (wr == 0) PG8_BAR;
    PG8_BAR;
#undef PG8_SA
#undef PG8_SB
#undef PG8_STAGE
#undef PG8_LDA
#undef PG8_LDB
#undef PG8_MMA
#undef PG8_WAIT_V
#undef PG8_WAIT_L
#undef PG8_BAR
#undef PG8_SCHED
}
}


__device__ __forceinline__ float row_rstd(const float* ssq, int row, int fq) {
    const f32x4* q = (const f32x4*)(ssq + (size_t)row * 32 + fq * 8);
    const f32x4 a = q[0], b = q[1];
    float s = (a.x + a.y) + (a.z + a.w) + (b.x + b.y) + (b.z + b.w);
    s += __shfl_xor(s, 16); s += __shfl_xor(s, 32);
    return rsqrtf(s * (1.f / 2048.f) + EPS);
}
__device__ __forceinline__ u32x4 pack8(const f32x4 a, const f32x4 b) { u32x4 w; w.x = cvt_pk_bf16(a.x, a.y); w.y = cvt_pk_bf16(a.z, a.w); w.z = cvt_pk_bf16(b.x, b.y); w.w = cvt_pk_bf16(b.z, b.w); return w; }

constexpr int TRS = 144, TIO_OFF = 131072, TIO_WAVE = 2304;
__device__ __forceinline__ void tio_store(LAS unsigned char* T, u16* g0, int lane, int fr, int fq, const u32x4 w0, const u32x4 w1) {
    *(LAS u32x4*)(T + fr * TRS + fq * 16) = w0; *(LAS u32x4*)(T + fr * TRS + 64 + fq * 16) = w1;
    const int rr = lane >> 3, ch = lane & 7;
    const u32x4 a = *(const LAS u32x4*)(T + rr * TRS + ch * 16), b = *(const LAS u32x4*)(T + (8 + rr) * TRS + ch * 16);
    *(u32x4*)(g0 + (size_t)rr * 2048 + ch * 8) = a; *(u32x4*)(g0 + (size_t)(8 + rr) * 2048 + ch * 8) = b;
}
__device__ __forceinline__ void tio_load(const u16* g0, int lane, u32x4& a, u32x4& b) { const int rr = lane >> 3, ch = lane & 7; a = *(const u32x4*)(g0 + (size_t)rr * 2048 + ch * 8); b = *(const u32x4*)(g0 + (size_t)(8 + rr) * 2048 + ch * 8); }
__device__ __forceinline__ void tio_unpack(LAS unsigned char* T, int lane, int fr, int fq, const u32x4 a, const u32x4 b, u32x4& w0, u32x4& w1) {
    const int rr = lane >> 3, ch = lane & 7;
    *(LAS u32x4*)(T + rr * TRS + ch * 16) = a; *(LAS u32x4*)(T + (8 + rr) * TRS + ch * 16) = b;
    w0 = *(const LAS u32x4*)(T + fr * TRS + fq * 16); w1 = *(const LAS u32x4*)(T + fr * TRS + 64 + fq * 16);
}

__device__ __forceinline__ void tio_store_f32(LAS unsigned char* T, float* g0, size_t gpitch, int lane, int fr, int fq, const f32x4 v0, const f32x4 v1) {
    *(LAS f32x4*)(T + fr * TRS + fq * 32) = v0; *(LAS f32x4*)(T + fr * TRS + fq * 32 + 16) = v1;
    const int rr = lane >> 3, ch = lane & 7;
    const f32x4 a = *(const LAS f32x4*)(T + rr * TRS + ch * 16), b = *(const LAS f32x4*)(T + (8 + rr) * TRS + ch * 16);
    __builtin_nontemporal_store(a, (f32x4*)(g0 + (size_t)rr * gpitch + ch * 4)); __builtin_nontemporal_store(b, (f32x4*)(g0 + (size_t)(8 + rr) * gpitch + ch * 4));
}
__device__ __forceinline__ void tio_store_p(LAS unsigned char* T, u16* g0, size_t gpitch, int lane, int fr, int fq, const u32x4 w0, const u32x4 w1) {
    *(LAS u32x4*)(T + fr * TRS + fq * 16) = w0; *(LAS u32x4*)(T + fr * TRS + 64 + fq * 16) = w1;
    const int rr = lane >> 3, ch = lane & 7;
    const u32x4 a = *(const LAS u32x4*)(T + rr * TRS + ch * 16), b = *(const LAS u32x4*)(T + (8 + rr) * TRS + ch * 16);
    *(u32x4*)(g0 + (size_t)rr * gpitch + ch * 8) = a; *(u32x4*)(g0 + (size_t)(8 + rr) * gpitch + ch * 8) = b;
}

struct EpiProj {
    const P& p; int layer; LAS unsigned char* lds;
    __device__ __forceinline__ void operator()(const f32x4 (&acc)[2][2][4][2], const pg8::Unit& u, int wr, int wc, int fr, int fq) const {
        const int lane = fq * 16 + fr; LAS unsigned char* T = lds + TIO_OFF + (wr * 4 + wc) * TIO_WAVE; const int cww = (u.pn & 1) * 256 + wc * 64;
        const int group = u.pn >> 1, type = group & 3, br = group >> 2;
        const int cgb = (u.pn & 1) * 256 + wc * 64 + 8 * fq;
        const float* ssqA = (const float*)(p.ws + W_SSQA);
        u16* Qb = (u16*)(p.ws + W_QB); u16* Zb = (u16*)(p.ws + W_ZB);
        float kmx = 0.f;
        float rsv[8];
#pragma unroll
        for (int i = 0; i < 8; ++i) rsv[i] = row_rstd(ssqA, u.pm * 256 + (i >> 2) * 128 + wr * 64 + (i & 3) * 16 + fr, fq);
#pragma unroll
        for (int ai = 0; ai < 2; ++ai)
#pragma unroll
            for (int m = 0; m < 4; ++m) {
                const int row = u.pm * 256 + ai * 128 + wr * 64 + m * 16 + fr;
                const float rs = rsv[ai * 4 + m];
                if (type == 0) {
                    const float sc = rs * QSCALE;
                    tio_store_p(T, Qb + (size_t)(row - fr) * 1024 + br * 512 + cww, 1024, lane, fr, fq, pack8(acc[ai][0][m][0] * sc, acc[ai][0][m][1] * sc), pack8(acc[ai][1][m][0] * sc, acc[ai][1][m][1] * sc));
                } else if (type == 3) {
                    u32x4 zw[2];
#pragma unroll
                    for (int bj = 0; bj < 2; ++bj) { f32x4 v0 = acc[ai][bj][m][0] * rs, v1 = acc[ai][bj][m][1] * rs;
#pragma unroll
                        for (int j = 0; j < 4; ++j) { v0[j] = v0[j] * __builtin_amdgcn_rcpf(1.f + __expf(-v0[j])); v1[j] = v1[j] * __builtin_amdgcn_rcpf(1.f + __expf(-v1[j])); }
                        zw[bj] = pack8(v0, v1); }
                    tio_store_p(T, Zb + (size_t)(row - fr) * 1024 + br * 512 + cww, 1024, lane, fr, fq, zw[0], zw[1]);
                } else {
                    float* o32; u16* kb; u16* vt; size_t vld; float kss = 0.f;
                    if (row < NP) { const int b = row >> 14, t = row & (SEQ - 1);
                        o32 = p.out + O_KV_P + (size_t)(br * 2 + (type - 1)) * KVP + ((size_t)(layer * 2 + b) * SEQ + t) * 512;
                        kb = (u16*)(p.ws + W_KBP) + (size_t)row * 1024 + br * 512;
                        vt = (u16*)(p.ws + W_VTP) + (size_t)(b * 8 + br * 4) * 128 * SEQ + t; vld = SEQ;
                    } else { const int rr = row - NP, sb = rr >> 5, t = rr & 31;
                        o32 = p.out + O_KV_S + (size_t)(br * 2 + (type - 1)) * KVS + ((size_t)(layer * 8 + sb) * 32 + t) * 512;
                        kb = (u16*)(p.ws + W_KBS) + ((size_t)(layer * 8 + sb) * SL + PAST + t) * 1024 + br * 512;
                        vt = (u16*)(p.ws + W_VTS) + (size_t)((layer * 8 + sb) * 8 + br * 4) * 128 * SL + PAST + t; vld = SL;
                    }
                    u32x4 kw[2];
#pragma unroll
                    for (int bj = 0; bj < 2; ++bj) { const f32x4 v0 = acc[ai][bj][m][0] * rs, v1 = acc[ai][bj][m][1] * rs; const int cg = cgb + bj * 32;
                        kss += (v0.x * v0.x + v0.y * v0.y + v0.z * v0.z + v0.w * v0.w) + (v1.x * v1.x + v1.y * v1.y + v1.z * v1.z + v1.w * v1.w);
                        tio_store_f32(T, o32 - (size_t)fr * 512 + cww + bj * 32, 512, lane, fr, fq, v0, v1);
                        const u32x4 w = pack8(v0, v1); kw[bj] = w;
                        if (type == 1) { if (bj == 1) tio_store_p(T, kb - (size_t)fr * 1024 + cww, 1024, lane, fr, fq, kw[0], kw[1]); }
                        else { vt[(size_t)(cg + 0) * vld] = (u16)(w.x & 0xffffu); vt[(size_t)(cg + 1) * vld] = (u16)(w.x >> 16); vt[(size_t)(cg + 2) * vld] = (u16)(w.y & 0xffffu); vt[(size_t)(cg + 3) * vld] = (u16)(w.y >> 16);
                               vt[(size_t)(cg + 4) * vld] = (u16)(w.z & 0xffffu); vt[(size_t)(cg + 5) * vld] = (u16)(w.z >> 16); vt[(size_t)(cg + 6) * vld] = (u16)(w.w & 0xffffu); vt[(size_t)(cg + 7) * vld] = (u16)(w.w >> 16); } }
                    if (type == 1 && br == 1) { kss += __shfl_xor(kss, 16); kss += __shfl_xor(kss, 32); kmx = fmaxf(kmx, kss); }
                }
            }
        if (type == 1 && br == 1 && u.pm < NP / 256) {
            float t = kmx; t = fmaxf(t, __shfl_xor(t, 1)); t = fmaxf(t, __shfl_xor(t, 2)); t = fmaxf(t, __shfl_xor(t, 4)); t = fmaxf(t, __shfl_xor(t, 8));
            if (fr == 0 && fq == 0) atomicMax((unsigned*)(p.ws + W_CTR) + 64 + ((layer * 2 + (u.pm >> 6)) * 4 + (u.pn & 1) * 2 + (wc >> 1)) * 4 + (wc & 1), __float_as_uint(t));
        }
    }
};

struct EpiOut {
    const P& p; LAS unsigned char* lds;
    __device__ __forceinline__ void operator()(const f32x4 (&acc)[2][2][4][2], const pg8::Unit& u, int wr, int wc, int fr, int fq) const {
        float* ssqB = (float*)(p.ws + W_SSQB); u16* XbB = (u16*)(p.ws + W_XBB); const u16* XbA = (const u16*)(p.ws + W_XBA);
        const int lane = fq * 16 + fr, cw = u.pn * 256 + wc * 64; LAS unsigned char* T = lds + TIO_OFF + (wr * 4 + wc) * TIO_WAVE;
#pragma unroll
        for (int ai = 0; ai < 2; ++ai) {
            u32x4 xa[4], xb_[4];
#pragma unroll
            for (int m = 0; m < 4; ++m) tio_load(XbA + (size_t)(u.pm * 256 + ai * 128 + wr * 64 + m * 16) * 2048 + cw, lane, xa[m], xb_[m]);
#pragma unroll
            for (int m = 0; m < 4; ++m) {
                const int row0 = u.pm * 256 + ai * 128 + wr * 64 + m * 16; float ss = 0.f; u32x4 x0, x1;
                tio_unpack(T, lane, fr, fq, xa[m], xb_[m], x0, x1);
                f32x4 v00 = acc[ai][0][m][0], v01 = acc[ai][0][m][1], v10 = acc[ai][1][m][0], v11 = acc[ai][1][m][1];
                v00.x += bf_lo(x0.x); v00.y += bf_hi(x0.x); v00.z += bf_lo(x0.y); v00.w += bf_hi(x0.y); v01.x += bf_lo(x0.z); v01.y += bf_hi(x0.z); v01.z += bf_lo(x0.w); v01.w += bf_hi(x0.w);
                v10.x += bf_lo(x1.x); v10.y += bf_hi(x1.x); v10.z += bf_lo(x1.y); v10.w += bf_hi(x1.y); v11.x += bf_lo(x1.z); v11.y += bf_hi(x1.z); v11.z += bf_lo(x1.w); v11.w += bf_hi(x1.w);
                ss += (v00.x * v00.x + v00.y * v00.y + v00.z * v00.z + v00.w * v00.w) + (v01.x * v01.x + v01.y * v01.y + v01.z * v01.z + v01.w * v01.w);
                ss += (v10.x * v10.x + v10.y * v10.y + v10.z * v10.z + v10.w * v10.w) + (v11.x * v11.x + v11.y * v11.y + v11.z * v11.z + v11.w * v11.w);
                tio_store(T, XbB + (size_t)row0 * 2048 + cw, lane, fr, fq, pack8(v00, v01), pack8(v10, v11));
                ss += __shfl_xor(ss, 16); ss += __shfl_xor(ss, 32);
                if (fq == 0) ssqB[(size_t)(row0 + fr) * 32 + u.pn * 4 + wc] = ss;
            }
        }
    }
};

struct EpiPle {
    const P& p; LAS unsigned char* lds;
    __device__ __forceinline__ void operator()(const f32x4 (&acc)[2][2][4][2], const pg8::Unit& u, int wr, int wc, int fr, int fq) const {
        u16* O = u.pm == NP / 256 ? (u16*)(p.ws + W_PLES) - (size_t)NP * 2048 : (u16*)(p.ws + W_PLEB);
        const int lane = fq * 16 + fr, cw = u.pn * 256 + wc * 64; LAS unsigned char* T = lds + TIO_OFF + (wr * 4 + wc) * TIO_WAVE;
#pragma unroll
        for (int ai = 0; ai < 2; ++ai)
#pragma unroll
            for (int m = 0; m < 4; ++m)
                tio_store(T, O + (size_t)(u.pm * 256 + ai * 128 + wr * 64 + m * 16) * 2048 + cw, lane, fr, fq, pack8(acc[ai][0][m][0], acc[ai][0][m][1]), pack8(acc[ai][1][m][0], acc[ai][1][m][1]));
    }
};

struct EpiGate {
    const P& p; LAS unsigned char* lds;
    __device__ __forceinline__ void operator()(const f32x4 (&acc)[2][2][4][2], const pg8::Unit& u, int wr, int wc, int fr, int fq) const {
        const float* ssqB = (const float*)(p.ws + W_SSQB); float* ssqA = (float*)(p.ws + W_SSQA); u16* XbA = (u16*)(p.ws + W_XBA); const u16* XbB = (const u16*)(p.ws + W_XBB); const u16* PL = u.pm == NP / 256 ? (const u16*)(p.ws + W_PLES) - (size_t)NP * 2048 : (const u16*)(p.ws + W_PLEB);
        const int lane = fq * 16 + fr, cw = u.pn * 256 + wc * 64; LAS unsigned char* T = lds + TIO_OFF + (wr * 4 + wc) * TIO_WAVE;
        float rsv[8];
#pragma unroll
        for (int i = 0; i < 8; ++i) rsv[i] = row_rstd(ssqB, u.pm * 256 + (i >> 2) * 128 + wr * 64 + (i & 3) * 16 + fr, fq);
#pragma unroll
        for (int g4 = 0; g4 < 4; ++g4) { const int ai = g4 >> 1, m0 = (g4 & 1) * 2;
            u32x4 xa[2], xb_[2], pa[2], pb[2];
#pragma unroll
            for (int mm = 0; mm < 2; ++mm) { const size_t ro = (size_t)(u.pm * 256 + ai * 128 + wr * 64 + (m0 + mm) * 16) * 2048 + cw;
                tio_load(XbB + ro, lane, xa[mm], xb_[mm]); tio_load(PL + ro, lane, pa[mm], pb[mm]); }
#pragma unroll
            for (int mm = 0; mm < 2; ++mm) { const int m = m0 + mm;
                const int row0 = u.pm * 256 + ai * 128 + wr * 64 + m * 16;
                const float rs = rsv[ai * 4 + m]; float ss = 0.f;
                u32x4 x0, x1, p0, p1;
                tio_unpack(T, lane, fr, fq, xa[mm], xb_[mm], x0, x1);
                tio_unpack(T, lane, fr, fq, pa[mm], pb[mm], p0, p1);
                f32x4 v[2][2];
#pragma unroll
                for (int bj = 0; bj < 2; ++bj) { const f32x4 a0 = acc[ai][bj][m][0] * rs, a1 = acc[ai][bj][m][1] * rs; const u32x4 pq = bj ? p1 : p0, xq = bj ? x1 : x0;
                    f32x4 v0, v1;
                    v0.x = bf_lo(xq.x) + bf_lo(pq.x) * __builtin_amdgcn_rcpf(1.f + __expf(-a0.x)); v0.y = bf_hi(xq.x) + bf_hi(pq.x) * __builtin_amdgcn_rcpf(1.f + __expf(-a0.y));
                    v0.z = bf_lo(xq.y) + bf_lo(pq.y) * __builtin_amdgcn_rcpf(1.f + __expf(-a0.z)); v0.w = bf_hi(xq.y) + bf_hi(pq.y) * __builtin_amdgcn_rcpf(1.f + __expf(-a0.w));
                    v1.x = bf_lo(xq.z) + bf_lo(pq.z) * __builtin_amdgcn_rcpf(1.f + __expf(-a1.x)); v1.y = bf_hi(xq.z) + bf_hi(pq.z) * __builtin_amdgcn_rcpf(1.f + __expf(-a1.y));
                    v1.z = bf_lo(xq.w) + bf_lo(pq.w) * __builtin_amdgcn_rcpf(1.f + __expf(-a1.z)); v1.w = bf_hi(xq.w) + bf_hi(pq.w) * __builtin_amdgcn_rcpf(1.f + __expf(-a1.w));
                    ss += (v0.x * v0.x + v0.y * v0.y + v0.z * v0.z + v0.w * v0.w) + (v1.x * v1.x + v1.y * v1.y + v1.z * v1.z + v1.w * v1.w);
                    v[bj][0] = v0; v[bj][1] = v1; }
                tio_store(T, XbA + (size_t)row0 * 2048 + cw, lane, fr, fq, pack8(v[0][0], v[0][1]), pack8(v[1][0], v[1][1]));
                ss += __shfl_xor(ss, 16); ss += __shfl_xor(ss, 32);
                if (fq == 0) ssqA[(size_t)(row0 + fr) * 32 + u.pn * 4 + wc] = ss;
            }
        }
    }
};

struct TDesc { const float* src; size_t sld; u16* dst; size_t dld; const float* gk; };
constexpr int NT_WIN = DEPTH * 2048, NT_WOUT = DEPTH * 512, NT_WPLE = DEPTH * 128, NT_WGATE = DEPTH * 1024, NT_VC = DEPTH * DEC_BATCH * 8 * 32;
constexpr int NT_ALL = NT_WIN + NT_WOUT + NT_WPLE + NT_WGATE + NT_VC;
__device__ __forceinline__ TDesc tile_desc(const P& p, int t) {
    TDesc d;
    if (t < NT_WIN) { const int L = t >> 11, r = t & 2047, kt = r >> 6, nt = r & 63;
        d.src = p.w_in + (size_t)L * 2048 * D_IN + (size_t)kt * 64 * D_IN + nt * 64; d.sld = D_IN; d.dst = (u16*)(p.ws + W_WTIN) + (size_t)L * 4096 * 2048 + (size_t)nt * 64 * 2048 + kt * 64; d.dld = 2048; d.gk = p.g_attn + L * 2048 + kt * 64; return d; }
    t -= NT_WIN;
    if (t < NT_WOUT) { const int L = t >> 9, r = t & 511, kt = r >> 5, nt = r & 31;
        d.src = p.w_out + (size_t)L * 1024 * 2048 + (size_t)kt * 64 * 2048 + nt * 64; d.sld = 2048; d.dst = (u16*)(p.ws + W_WTOUT) + (size_t)L * 2048 * 1024 + (size_t)nt * 64 * 1024 + kt * 64; d.dld = 1024; d.gk = nullptr; return d; }
    t -= NT_WOUT;
    if (t < NT_WPLE) { const int L = t >> 7, r = t & 127, kt = r >> 5, nt = r & 31;
        d.src = p.w_ple + (size_t)L * 256 * 2048 + (size_t)kt * 64 * 2048 + nt * 64; d.sld = 2048; d.dst = (u16*)(p.ws + W_WTPLE) + (size_t)L * 2048 * 256 + (size_t)nt * 64 * 256 + kt * 64; d.dld = 256; d.gk = nullptr; return d; }
    t -= NT_WPLE;
    if (t < NT_WGATE) { const int L = t >> 10, r = t & 1023, kt = r >> 5, nt = r & 31;
        d.src = p.w_gate + (size_t)L * 2048 * 2048 + (size_t)kt * 64 * 2048 + nt * 64; d.sld = 2048; d.dst = (u16*)(p.ws + W_WTGATE) + (size_t)L * 2048 * 2048 + (size_t)nt * 64 * 2048 + kt * 64; d.dld = 2048; d.gk = p.g_ple + L * 2048 + kt * 64; return d; }
    t -= NT_WGATE;
    { const int mi = t >> 5, r = t & 31, kt = r >> 1, nt = r & 1; const int ls = mi >> 3, h8 = mi & 7, br = h8 >> 2, hh = h8 & 3;
        d.src = (br ? p.c_fxv : p.c_sbv) + ((size_t)ls * PAST + kt * 64) * 512 + hh * 128 + nt * 64; d.sld = 512; d.dst = (u16*)(p.ws + W_VTS) + ((size_t)mi * 128 + nt * 64) * SL + kt * 64; d.dld = SL; d.gk = nullptr; return d; }
}

__device__ __forceinline__ void prep_phase(int wv, const P& p, LAS unsigned char* lds) {
    LAS float* T = (LAS float*)lds;
    const int tid = opaque_tid(wv), G = gridDim.x, B = blockIdx.x;
    const int wid = tid >> 6, lane = tid & 63;
    if (B == 0) { ((unsigned*)(p.ws + W_CTR))[tid] = 0u; ((unsigned*)(p.ws + W_CTR))[tid + 512] = 0u; }
    {
        const int k0 = tid >> 4, n4 = (tid & 15) * 4, no = tid >> 3, kc = tid & 7;
        f32x4 v[2][2]; float g[2][2]; TDesc d[2]; bool ok[2];
#define PREP_FETCH(t_) do { _Pragma("unroll") for (int q = 0; q < 2; ++q) { const int tt = (t_) + q * G; ok[q] = tt < NT_ALL; g[q][0] = 1.f; g[q][1] = 1.f; \
            if (ok[q]) { d[q] = tile_desc(p, tt); v[q][0] = *(const f32x4*)(d[q].src + (size_t)k0 * d[q].sld + n4); v[q][1] = *(const f32x4*)(d[q].src + (size_t)(k0 + 32) * d[q].sld + n4); \
                if (d[q].gk) { g[q][0] = d[q].gk[k0]; g[q][1] = d[q].gk[k0 + 32]; } } } } while (0)
        int t = B;
        PREP_FETCH(t);
        while (t < NT_ALL) {
            TDesc dc[2]; bool okc[2];
#pragma unroll
            for (int q = 0; q < 2; ++q) { okc[q] = ok[q]; dc[q] = d[q]; LAS float* Tq = T + q * (64 * 65);
                if (ok[q]) {
#pragma unroll
                    for (int hh = 0; hh < 2; ++hh) { const f32x4 x = v[q][hh]; const float gg = g[q][hh]; LAS float* tp = Tq + (k0 + 32 * hh) * 65 + n4; tp[0] = x.x * gg; tp[1] = x.y * gg; tp[2] = x.z * gg; tp[3] = x.w * gg; } } }
            __syncthreads();
            const int tn = t + 2 * G;
            PREP_FETCH(tn);
#pragma unroll
            for (int q = 0; q < 2; ++q) if (okc[q]) { const LAS float* Tq = T + q * (64 * 65); float f[8];
#pragma unroll
                for (int j = 0; j < 8; ++j) f[j] = Tq[(kc * 8 + j) * 65 + no];
                u32x4 w; w.x = cvt_pk_bf16(f[0], f[1]); w.y = cvt_pk_bf16(f[2], f[3]); w.z = cvt_pk_bf16(f[4], f[5]); w.w = cvt_pk_bf16(f[6], f[7]);
                *(u32x4*)(dc[q].dst + (size_t)no * dc[q].dld + kc * 8) = w; }
            __syncthreads();
            t = tn;
        }
#undef PREP_FETCH
    }
    for (int i = B * 512 + tid; i < DEPTH * 2048 * 4; i += G * 512) { const int L = i >> 13, k = (i >> 2) & 2047, j = i & 3;
        ((float*)(p.ws + W_WF))[i] = p.g_attn[L * 2048 + k] * p.w_in[(size_t)L * 2048 * D_IN + (size_t)k * D_IN + 4096 + j]; }
    for (int row = B * 8 + wid; row < NR; row += G * 8) {
        const float* src = row < NP ? p.x_prompt + (size_t)row * 2048 : p.x_sample + (size_t)(row - NP) * 2048;
        u16* xb = (u16*)(p.ws + W_XBA) + (size_t)row * 2048; float ss = 0.f;
#pragma unroll
        for (int i = 0; i < 8; ++i) { const int c = (i * 64 + lane) * 4; const f32x4 v = *(const f32x4*)(src + c); ss += v.x * v.x + v.y * v.y + v.z * v.z + v.w * v.w;
            u32x2 w; w.x = cvt_pk_bf16(v.x, v.y); w.y = cvt_pk_bf16(v.z, v.w); *(u32x2*)(xb + c) = w; }
#pragma unroll
        for (int d = 1; d < 64; d <<= 1) ss += __shfl_xor(ss, d);
        if (lane < 32) ((float*)(p.ws + W_SSQA))[(size_t)row * 32 + lane] = lane == 0 ? ss : 0.f;
    }
    for (size_t i0 = (size_t)B * 512 + tid; i0 < (size_t)DEPTH * NR * 64; i0 += (size_t)G * 512 * 4) { f32x4 v[4]; u16* dp[4];
#pragma unroll
        for (int q = 0; q < 4; ++q) { const size_t i = i0 + (size_t)q * G * 512; dp[q] = nullptr;
            if (i < (size_t)DEPTH * NR * 64) { const int L = (int)(i / ((size_t)NR * 64)); const size_t r = i % ((size_t)NR * 64); const int row = (int)(r >> 6), c4 = (int)(r & 63) * 4;
                const float* src = row < NP ? p.p_prompt + ((size_t)L * NP + row) * 256 + c4 : p.p_sample + ((size_t)L * NS + (row - NP)) * 256 + c4;
                v[q] = *(const f32x4*)src; dp[q] = (u16*)(p.ws + W_PB) + ((size_t)L * NR + row) * 256 + c4; } }
#pragma unroll
        for (int q = 0; q < 4; ++q) if (dp[q]) { u32x2 w; w.x = cvt_pk_bf16(v[q].x, v[q].y); w.y = cvt_pk_bf16(v[q].z, v[q].w); *(u32x2*)dp[q] = w; } }
    for (size_t i0 = (size_t)B * 512 + tid; i0 < (size_t)2 * DEPTH * DEC_BATCH * PAST * 128; i0 += (size_t)G * 512 * 4) { f32x4 v[4]; u16* dp[4];
#pragma unroll
        for (int q = 0; q < 4; ++q) { const size_t i = i0 + (size_t)q * G * 512; dp[q] = nullptr;
            if (i < (size_t)2 * DEPTH * DEC_BATCH * PAST * 128) { const int br = (int)(i / ((size_t)DEPTH * DEC_BATCH * PAST * 128)); const size_t r = i % ((size_t)DEPTH * DEC_BATCH * PAST * 128);
                const int ls = (int)(r / (PAST * 128)), pos = (int)((r / 128) % PAST), c4 = (int)(r & 127) * 4;
                v[q] = *(const f32x4*)((br ? p.c_fxk : p.c_sbk) + ((size_t)ls * PAST + pos) * 512 + c4); dp[q] = (u16*)(p.ws + W_KBS) + ((size_t)ls * SL + pos) * 1024 + br * 512 + c4; } }
#pragma unroll
        for (int q = 0; q < 4; ++q) if (dp[q]) { u32x2 w; w.x = cvt_pk_bf16(v[q].x, v[q].y); w.y = cvt_pk_bf16(v[q].z, v[q].w); *(u32x2*)dp[q] = w; } }
    for (int s = B * 8 + wid; s < DEPTH * DEC_BATCH * 4; s += G * 8) { const int ls = s >> 2, hh = s & 3; const float* src = p.c_logf + (size_t)ls * PAST * 4 + hh; float v[16]; float run = 0.f;
#pragma unroll
        for (int i = 0; i < 16; ++i) { run += src[(size_t)(lane * 16 + i) * 4]; v[i] = run; }
        float x = run;
#pragma unroll
        for (int d = 1; d < 64; d <<= 1) { const float y = __shfl_up(x, d); if (lane >= d) x += y; }
        const float pre = x - run; float* dst = (float*)(p.ws + W_CCUM) + (size_t)ls * PAST * 4 + hh;
#pragma unroll
        for (int i = 0; i < 16; ++i) dst[(size_t)(lane * 16 + i) * 4] = pre + v[i];
    }
}

__device__ __forceinline__ void logf_items(int wv, const P& p, int layer, LAS unsigned char* lds, int blk0, int blk_end, int blk_step) {
    LAS f32x4* WfL = (LAS f32x4*)lds;
    LAS float* lf = (LAS float*)(lds + 40960);
    const int tid = opaque_tid(wv);
    const f32x4* Wf = (const f32x4*)(p.ws + W_WF) + (size_t)layer * 2048;
    const float* ssqA = (const float*)(p.ws + W_SSQA);
    for (int blk = blk0; blk < blk_end; blk += blk_step) {
        __syncthreads();
#pragma unroll
        for (int i = 0; i < 4; ++i) { const int k = tid + 512 * i; WfL[k + (k >> 9)] = Wf[k]; }
        __syncthreads();
        const int rl = tid >> 2, kq = tid & 3, row = blk * 128 + rl;
        const u16* xr = (const u16*)(p.ws + W_XBA) + (size_t)row * 2048 + kq * 512;
        f32x4 a = (f32x4){0.f, 0.f, 0.f, 0.f};
        for (int i = 0; i < 64; ++i) { const u32x4 xv = *(const u32x4*)(xr + i * 8); const LAS f32x4* w = WfL + kq * 513 + i * 8;
            a += w[0] * bf_lo(xv.x); a += w[1] * bf_hi(xv.x); a += w[2] * bf_lo(xv.y); a += w[3] * bf_hi(xv.y); a += w[4] * bf_lo(xv.z); a += w[5] * bf_hi(xv.z); a += w[6] * bf_lo(xv.w); a += w[7] * bf_hi(xv.w); }
#pragma unroll
        for (int j = 0; j < 4; ++j) { a[j] += __shfl_xor(a[j], 1); a[j] += __shfl_xor(a[j], 2); }
        if (kq == 0) { float s = 0.f; const f32x4* q = (const f32x4*)(ssqA + (size_t)row * 32);
#pragma unroll
            for (int i = 0; i < 8; ++i) { const f32x4 v = q[i]; s += (v.x + v.y) + (v.z + v.w); }
            const float rs = rsqrtf(s * (1.f / 2048.f) + EPS); f32x4 lg;
#pragma unroll
            for (int j = 0; j < 4; ++j) { const float f = a[j] * rs + p.b_f[layer * 4 + j]; lg[j] = fminf(f, 0.f) - log1pf(expf(-fabsf(f))); }
            float* o = row < NP ? p.out + O_LOGF_P + ((size_t)layer * NP + row) * 4 : p.out + O_LOGF_S + ((size_t)layer * NS + (row - NP)) * 4;
            *(f32x4*)o = lg; lf[rl * 4 + 0] = lg.x; lf[rl * 4 + 1] = lg.y; lf[rl * 4 + 2] = lg.z; lf[rl * 4 + 3] = lg.w; }
        __syncthreads();
        if (tid < 16) { const int seg = tid >> 2, hh = tid & 3; float run = 0.f; float* cin = (float*)(p.ws + W_CIN);
            for (int i = 0; i < 32; ++i) { run += lf[(seg * 32 + i) * 4 + hh]; cin[(size_t)(blk * 128 + seg * 32 + i) * 4 + hh] = run; }
            ((float*)(p.ws + W_SEGTOT))[(size_t)(blk * 4 + seg) * 4 + hh] = run; }
    }
    __syncthreads();
}

constexpr int TEAM = 32;
__device__ __forceinline__ void team_barrier(unsigned* ctr) {
    __threadfence();
    __syncthreads();
    if (threadIdx.x == 0) {
        __hip_atomic_fetch_add(ctr, 1u, __ATOMIC_RELEASE, __HIP_MEMORY_SCOPE_AGENT);
        while (__hip_atomic_load(ctr, __ATOMIC_ACQUIRE, __HIP_MEMORY_SCOPE_AGENT) < (unsigned)TEAM) __builtin_amdgcn_s_sleep(8);
    }
    __syncthreads();
    __threadfence();
}

constexpr int A_KB = 0, A_VB = 34816, A_CK = 71680, A_SEG = 72192, A_MISC = 74240, A_T = 76800;
constexpr int KROW = 272, VROW = 144;

__device__ __forceinline__ void attn_phase(int wv, const P& p, int layer, LAS unsigned char* lds) {
    LAS float* segpre = (LAS float*)(lds + A_SEG);
    LAS int* misc = (LAS int*)(lds + A_MISC);
    LAS float* wtot = (LAS float*)(lds + A_MISC + 128);
    unsigned* ctr = (unsigned*)(p.ws + W_CTR) + layer;
    const float* Cin = (const float*)(p.ws + W_CIN);
    const int bid = blockIdx.x; const bool team = bid < TEAM;
    unsigned* tbar = (unsigned*)(p.ws + W_CTR) + 16 + layer * 8;
    int sd_left = 0, tstate = team ? 0 : 2;
    if (team) {
        pg8::StaticOrder S1;
        if (layer > 0) {
            if (bid < 8) { pg8::Gemm g{(const u16*)(p.ws + W_OB), (const u16*)(p.ws + W_WTOUT) + (size_t)(layer - 1) * 2048 * 1024, NR, 2048, 1024}; S1.init_one(NP / 256, bid); EpiOut E{p, lds}; pg8::gemm_phase(wv, lds, g, S1, E); }
            else if (bid < 16) { pg8::Gemm g{(const u16*)(p.ws + W_PB) + (size_t)(layer - 1) * NR * 256, (const u16*)(p.ws + W_WTPLE) + (size_t)(layer - 1) * 2048 * 256, NR, 2048, 256}; S1.init_one(NP / 256, bid - 8); EpiPle E{p, lds}; pg8::gemm_phase(wv, lds, g, S1, E); }
            team_barrier(tbar + 0);
            if (bid < 8) { pg8::Gemm g{(const u16*)(p.ws + W_XBB), (const u16*)(p.ws + W_WTGATE) + (size_t)(layer - 1) * 2048 * 2048, NR, 2048, 2048}; S1.init_one(NP / 256, bid); EpiGate E{p, lds}; pg8::gemm_phase(wv, lds, g, S1, E); }
            team_barrier(tbar + 1);
        }
        if (bid < 16) { pg8::Gemm g{(const u16*)(p.ws + W_XBA), (const u16*)(p.ws + W_WTIN) + (size_t)layer * 4096 * 2048, NR, 4096, 2048}; S1.init_one(NP / 256, bid); EpiProj E{p, layer, lds}; pg8::gemm_phase(wv, lds, g, S1, E); }
        else if (bid < 18) logf_items(wv, p, layer, lds, NP / 128 + (bid - 16), NP / 128 + (bid - 16) + 1, 1);
        team_barrier(tbar + 2);
        sd_left = 2;
    }
    for (;;) {
        if (tstate == 0 && sd_left == 0) {
            if (layer == DEPTH - 1) {
                pg8::StaticOrder S1;
                team_barrier(tbar + 3);
                if (bid < 8) { pg8::Gemm g{(const u16*)(p.ws + W_OB), (const u16*)(p.ws + W_WTOUT) + (size_t)layer * 2048 * 1024, NR, 2048, 1024}; S1.init_one(NP / 256, bid); EpiOut E{p, lds}; pg8::gemm_phase(wv, lds, g, S1, E); }
                else if (bid < 16) { pg8::Gemm g{(const u16*)(p.ws + W_PB) + (size_t)layer * NR * 256, (const u16*)(p.ws + W_WTPLE) + (size_t)layer * 2048 * 256, NR, 2048, 256}; S1.init_one(NP / 256, bid - 8); EpiPle E{p, lds}; pg8::gemm_phase(wv, lds, g, S1, E); }
                team_barrier(tbar + 4);
                if (bid < 8) { pg8::Gemm g{(const u16*)(p.ws + W_XBB), (const u16*)(p.ws + W_WTGATE) + (size_t)layer * 2048 * 2048, NR, 2048, 2048}; S1.init_one(NP / 256, bid); EpiGate E{p, lds}; pg8::gemm_phase(wv, lds, g, S1, E); }
            }
            tstate = 2;
        }
        const int tid = opaque_tid(wv), wid = __builtin_amdgcn_readfirstlane(tid >> 6), lane = tid & 63, r = lane & 31, h = lane >> 5;
        const int prow = 16 * (r >> 4) + 8 * ((r >> 2) & 1) + 4 * ((r >> 3) & 1) + (r & 3);
        __syncthreads();
        if (tid == 0) misc[0] = sd_left > 0 ? 1024 + (2 - sd_left) * TEAM + bid : (int)atomicAdd(ctr, 1u);
        __syncthreads();
        int item = misc[0];
        if (sd_left > 0) --sd_left; else if (item >= 1024) break;
        int head8, qpos0, nw, row0, ldv, sbi = 0, bi = 0; const u16 *Kb, *Vt; const bool prompt = item < 1024;
        if (prompt) { const int qt = 63 - (item >> 4), rem = item & 15; bi = rem >> 3; head8 = rem & 7; qpos0 = qt * 256; nw = 8; row0 = bi * SEQ + qpos0;
            Kb = (const u16*)(p.ws + W_KBP) + (size_t)bi * SEQ * 1024 + head8 * 128; Vt = (const u16*)(p.ws + W_VTP) + (size_t)(bi * 8 + head8) * 128 * SEQ; ldv = SEQ;
        } else { const int s = item - 1024; sbi = s >> 3; head8 = s & 7; qpos0 = PAST; nw = 1; row0 = NP + sbi * 32;
            Kb = (const u16*)(p.ws + W_KBS) + (size_t)(layer * 8 + sbi) * SL * 1024 + head8 * 128; Vt = (const u16*)(p.ws + W_VTS) + (size_t)((layer * 8 + sbi) * 8 + head8) * 128 * SL; ldv = SL; }
        const bool fox = head8 >= 4; const int hf = head8 & 3;
        const float* ccum = (const float*)(p.ws + W_CCUM) + (size_t)(layer * 8 + sbi) * PAST * 4 + hf;
        if (fox && prompt) {
            const int nseg = (qpos0 + 256) >> 5; const float v = tid < nseg ? ((const float*)(p.ws + W_SEGTOT))[(size_t)(bi * 512 + tid) * 4 + hf] : 0.f; float x = v;
#pragma unroll
            for (int d = 1; d < 64; d <<= 1) { const float y = __shfl_up(x, d); if (lane >= d) x += y; }
            if (lane == 63) wtot[wid] = x;
            __syncthreads();
            float pre = 0.f; for (int w = 0; w < wid; ++w) pre += wtot[w];
            segpre[tid] = pre + x - v;
            __syncthreads();
        }
        auto getC = [&](int pos) -> float {
            if (prompt) return segpre[pos >> 5] + Cin[(size_t)(bi * SEQ + pos) * 4 + hf];
            if (pos < PAST) return ccum[(size_t)pos * 4];
            if (pos < PAST + 32) return ccum[(size_t)(PAST - 1) * 4] + Cin[(size_t)(NP + sbi * 32 + pos - PAST) * 4 + hf];
            return 0.f; };
        const bool wact = wid < nw;
        bf16x8 qf[8];
        float cq2 = 0.f;
        const int qlo = qpos0 + 32 * wid, qhi = qlo + 31, qpos = qlo + r;
        if (wact) { const u16* qg = (const u16*)(p.ws + W_QB) + (size_t)(row0 + 32 * wid) * 1024 + head8 * 128; LAS unsigned char* Tq = lds + A_T + wid * (32 * 272);
            { u32x4 qr[8];
#pragma unroll
              for (int i = 0; i < 8; ++i) qr[i] = *(const u32x4*)(qg + (size_t)(4 * i + (lane >> 4)) * 1024 + (lane & 15) * 8);
#pragma unroll
              for (int i = 0; i < 8; ++i) *(LAS u32x4*)(Tq + (4 * i + (lane >> 4)) * 272 + (lane & 15) * 16) = qr[i]; }
#pragma unroll
            for (int kk = 0; kk < 8; ++kk) qf[kk] = *(const LAS bf16x8*)(Tq + r * 272 + (16 * kk + 8 * h) * 2);
            if (fox) cq2 = getC(qpos) * LOG2E; }
        else {
#pragma unroll
            for (int kk = 0; kk < 8; ++kk) qf[kk] = (bf16x8){0, 0, 0, 0, 0, 0, 0, 0}; }
        float qnK = 3.0e38f;
        if (fox && prompt) { const unsigned* ks = (const unsigned*)(p.ws + W_CTR) + 64 + ((layer * 2 + bi) * 4 + hf) * 4;
            const float kmax = sqrtf(__uint_as_float(ks[0]) + __uint_as_float(ks[1]) + __uint_as_float(ks[2]) + __uint_as_float(ks[3])) * 1.01f; float qn2 = 0.f;
#pragma unroll
            for (int kk = 0; kk < 8; ++kk)
#pragma unroll
                for (int i = 0; i < 8; ++i) { const float f = __uint_as_float(((unsigned)(unsigned short)qf[kk][i]) << 16); qn2 += f * f; }
            qn2 += __shfl_xor(qn2, 32); qnK = sqrtf(qn2) * 1.01f * kmax; }
        u32x4 kreg[2], vreg[2]; float ckreg = 0.f;
        const int krow_ = tid >> 4, kch = tid & 15, vrow_ = tid >> 3, vch = tid & 7;
#define LOAD_TILE(jt_) do { const int k0_ = (jt_) * 64; _Pragma("unroll") for (int pz = 0; pz < 2; ++pz) { \
            kreg[pz] = *(const u32x4*)(Kb + (size_t)(k0_ + krow_ + 32 * pz) * 1024 + kch * 8); \
            vreg[pz] = *(const u32x4*)(Vt + (size_t)(vrow_ + 64 * pz) * ldv + k0_ + vch * 8); } \
            if (fox && tid < 64) ckreg = getC(k0_ + tid) * LOG2E; } while (0)
#define STORE_TILE(buf_) do { _Pragma("unroll") for (int pz = 0; pz < 2; ++pz) { \
            *(LAS u32x4*)(lds + A_KB + (buf_) * 17408 + (krow_ + 32 * pz) * KROW + kch * 16) = kreg[pz]; \
            *(LAS u32x4*)(lds + A_VB + (buf_) * 18432 + (vrow_ + 64 * pz) * VROW + vch * 16) = vreg[pz]; } \
            if (fox && tid < 64) *(LAS float*)(lds + A_CK + (buf_) * 256 + tid * 4) = ckreg; } while (0)
        const int jt_top = (qpos0 + 32 * nw - 1) >> 6;
        LOAD_TILE(jt_top); STORE_TILE(0);
        __syncthreads();
        f32x16 o[4];
#pragma unroll
        for (int dt = 0; dt < 4; ++dt)
#pragma unroll
            for (int i = 0; i < 16; ++i) o[dt][i] = 0.f;
        float carry = 0.f, mrun = -1e30f, mref = 0.f, lsum = 0.f; bool wave_done = !wact;
        for (int jt = jt_top, it = 0; jt >= 0; --jt, ++it) {
            const int cur = it & 1; const bool more = jt > 0;
            if (more) LOAD_TILE(jt - 1);
            const int key0 = jt * 64;
            if (fox && prompt && !wave_done && key0 <= qhi) {
                const float ck63 = *(const LAS float*)(lds + A_CK + cur * 256 + 252);
                if (__all((qnK + cq2 - ck63) < (mrun - 155.f))) wave_done = true; }
            if (!wave_done && key0 <= qhi) {
                const bool diag = key0 + 63 >= qlo;
                const LAS unsigned char* kb = lds + A_KB + cur * 17408 + prow * KROW + 16 * h;
                const LAS unsigned char* vb = lds + A_VB + cur * 18432 + r * VROW + 16 * h;
                f32x16 sv[2];
                typedef float f32x2 __attribute__((ext_vector_type(2)));
                if (fox) {
                    const LAS float* ckb = (const LAS float*)(lds + A_CK + cur * 256) + 8 * h;
                    const float cqm = cq2 - mref; const f32x2 cqv = {cqm, cqm};
#pragma unroll
                    for (int kt = 0; kt < 2; ++kt)
#pragma unroll
                        for (int q4 = 0; q4 < 4; ++q4) { const f32x4 ck = *(const LAS f32x4*)(ckb + 32 * kt + 16 * (q4 >> 1) + 4 * (q4 & 1));
                            const f32x2 x0 = cqv - (f32x2){ck.x, ck.y}, x1 = cqv - (f32x2){ck.z, ck.w};
                            sv[kt][4 * q4 + 0] = x0.x; sv[kt][4 * q4 + 1] = x0.y; sv[kt][4 * q4 + 2] = x1.x; sv[kt][4 * q4 + 3] = x1.y; }
                } else {
#pragma unroll
                    for (int i = 0; i < 16; ++i) { sv[0][i] = 0.f; sv[1][i] = 0.f; } }
#pragma unroll
                for (int kk = 0; kk < 8; ++kk) { const bf16x8 a0 = *(const LAS bf16x8*)(kb + kk * 32); const bf16x8 a1 = *(const LAS bf16x8*)(kb + 32 * KROW + kk * 32);
                    sv[0] = __builtin_amdgcn_mfma_f32_32x32x16_bf16(a0, qf[kk], sv[0], 0, 0, 0); sv[1] = __builtin_amdgcn_mfma_f32_32x32x16_bf16(a1, qf[kk], sv[1], 0, 0, 0); }
                if (!fox) {
#pragma unroll
                    for (int kt = 1; kt >= 0; --kt) {
                        float sp[16], ex[16], tot[2];
#pragma unroll
                        for (int rg = 0; rg < 16; ++rg) { const int kpos = key0 + 32 * kt + 16 * (rg >> 3) + 8 * h + (rg & 7); const float z = sv[kt][rg];
                            const float spv = fmaxf(z, 0.f) + flog2(1.f + fexp2(-fabsf(z))); sp[rg] = (!diag || kpos < qpos) ? spv : 0.f; }
#pragma unroll
                        for (int c = 0; c < 2; ++c) { float run = 0.f;
#pragma unroll
                            for (int idx = 7; idx >= 0; --idx) { ex[8 * c + idx] = run; run += sp[8 * c + idx]; }
                            tot[c] = run; }
                        const float pt0 = __shfl_xor(tot[0], 32), pt1 = __shfl_xor(tot[1], 32);
                        const float off1 = carry + (h ? 0.f : pt1), off0 = carry + (h ? (pt1 + tot[1]) : (pt0 + tot[1] + pt1));
#pragma unroll
                        for (int rg = 0; rg < 16; ++rg) { const int kpos = key0 + 32 * kt + 16 * (rg >> 3) + 8 * h + (rg & 7);
                            const float e2 = sv[kt][rg] - sp[rg] - ((rg >= 8 ? off1 : off0) + ex[rg]);
                            sv[kt][rg] = (!diag || kpos < qpos) ? fexp2(e2) : 0.f; }
                        carry += (tot[0] + tot[1]) + (pt0 + pt1);
                    }
                    if (__all(carry > 152.f)) wave_done = true;
                } else {
                    if (diag) {
#pragma unroll
                        for (int kt = 0; kt < 2; ++kt)
#pragma unroll
                            for (int rg = 0; rg < 16; ++rg) { const int kpos = key0 + 32 * kt + 16 * (rg >> 3) + 8 * h + (rg & 7); if (kpos > qpos) sv[kt][rg] = -1e30f; } }
                    float mx = -1e30f;
#pragma unroll
                    for (int kt = 0; kt < 2; ++kt)
#pragma unroll
                        for (int i = 0; i < 8; ++i) mx = fmax3(mx, sv[kt][2 * i], sv[kt][2 * i + 1]);
                    mx = fmaxf(mx, __shfl_xor(mx, 32));
                    const bool firstt = mrun < -1e29f;
                    mrun = fmaxf(mrun, mref + mx);
                    if (firstt || __any(mx > 0.f)) {
                        const float dlt = firstt ? mx : fmaxf(mx, 0.f), alpha = fexp2(-dlt); mref += dlt; lsum *= alpha; const f32x2 dv = {dlt, dlt};
#pragma unroll
                        for (int dt = 0; dt < 4; ++dt) o[dt] *= alpha;
#pragma unroll
                        for (int kt = 0; kt < 2; ++kt)
#pragma unroll
                            for (int i = 0; i < 8; ++i) { const f32x2 t = (f32x2){sv[kt][2 * i], sv[kt][2 * i + 1]} - dv; sv[kt][2 * i] = t.x; sv[kt][2 * i + 1] = t.y; } }
                    f32x2 ps2 = {0.f, 0.f};
#pragma unroll
                    for (int kt = 0; kt < 2; ++kt)
#pragma unroll
                        for (int i = 0; i < 8; ++i) { f32x2 e; e.x = fexp2(sv[kt][2 * i]); e.y = fexp2(sv[kt][2 * i + 1]); sv[kt][2 * i] = e.x; sv[kt][2 * i + 1] = e.y; ps2 += e; }
                    lsum += ps2.x + ps2.y;
                }
#pragma unroll
                for (int kt = 0; kt < 2; ++kt)
#pragma unroll
                    for (int c = 0; c < 2; ++c) { union { u32x4 u; bf16x8 v; } pf;
                        pf.u.x = cvt_pk_bf16(sv[kt][8 * c + 0], sv[kt][8 * c + 1]); pf.u.y = cvt_pk_bf16(sv[kt][8 * c + 2], sv[kt][8 * c + 3]);
                        pf.u.z = cvt_pk_bf16(sv[kt][8 * c + 4], sv[kt][8 * c + 5]); pf.u.w = cvt_pk_bf16(sv[kt][8 * c + 6], sv[kt][8 * c + 7]);
#pragma unroll
                        for (int dt = 0; dt < 4; ++dt) { const bf16x8 vf = *(const LAS bf16x8*)(vb + dt * 32 * VROW + (32 * kt + 16 * c) * 2);
                            o[dt] = __builtin_amdgcn_mfma_f32_32x32x16_bf16(vf, pf.v, o[dt], 0, 0, 0); } }
            }
            if (more) STORE_TILE(cur ^ 1);
            if (lane == 0) misc[8 + cur * 8 + wid] = wave_done ? 1 : 0;
            __syncthreads();
            int alld = 1;
#pragma unroll
            for (int w = 0; w < 8; ++w) alld &= misc[8 + cur * 8 + w];
            if (alld) break;
        }
#undef LOAD_TILE
#undef STORE_TILE
        if (wact) {
            if (fox) { lsum += __shfl_xor(lsum, 32); const float inv = 1.f / lsum;
#pragma unroll
                for (int dt = 0; dt < 4; ++dt) o[dt] *= inv; }
            float ss = 0.f;
#pragma unroll
            for (int dt = 0; dt < 4; ++dt)
#pragma unroll
                for (int i = 0; i < 16; ++i) ss += o[dt][i] * o[dt][i];
            ss += __shfl_xor(ss, 32);
            const float rn = rsqrtf(ss * (1.f / 128.f) + EPS);
            const float* gp = (fox ? p.g_ofox : p.g_osb) + layer * 512 + hf * 128 + 4 * h;
            const u16* zg = (const u16*)(p.ws + W_ZB) + (size_t)(row0 + 32 * wid) * 1024 + head8 * 128;
            u16* og = (u16*)(p.ws + W_OB) + (size_t)(row0 + 32 * wid) * 1024 + head8 * 128;
            LAS unsigned char* Tz = lds + A_T + wid * (32 * 272);
            { u32x4 zr[8];
#pragma unroll
              for (int i = 0; i < 8; ++i) zr[i] = *(const u32x4*)(zg + (size_t)(4 * i + (lane >> 4)) * 1024 + (lane & 15) * 8);
#pragma unroll
              for (int i = 0; i < 8; ++i) *(LAS u32x4*)(Tz + (4 * i + (lane >> 4)) * 272 + (lane & 15) * 16) = zr[i]; }
#pragma unroll
            for (int dt = 0; dt < 4; ++dt)
#pragma unroll
                for (int bb = 0; bb < 4; ++bb) { const int d = 32 * dt + 8 * bb; const f32x4 g = *(const f32x4*)(gp + d); LAS u32x2* tp = (LAS u32x2*)(Tz + r * 272 + (d + 4 * h) * 2); const u32x2 z2 = *tp;
                    const float v0 = o[dt][4 * bb + 0] * rn * g.x * bf_lo(z2.x), v1 = o[dt][4 * bb + 1] * rn * g.y * bf_hi(z2.x), v2 = o[dt][4 * bb + 2] * rn * g.z * bf_lo(z2.y), v3 = o[dt][4 * bb + 3] * rn * g.w * bf_hi(z2.y);
                    u32x2 w; w.x = cvt_pk_bf16(v0, v1); w.y = cvt_pk_bf16(v2, v3); *tp = w; }
#pragma unroll
            for (int i = 0; i < 8; ++i) { const u32x4 w = *(const LAS u32x4*)(Tz + (4 * i + (lane >> 4)) * 272 + (lane & 15) * 16); *(u32x4*)(og + (size_t)(4 * i + (lane >> 4)) * 1024 + (lane & 15) * 8) = w; }
        }
    }
}

__device__ __forceinline__ void final_phase(int wv, const P& p) {
    const int tid = opaque_tid(wv), wid = tid >> 6, lane = tid & 63;
    const float* ssqA = (const float*)(p.ws + W_SSQA);
    for (int row = blockIdx.x * 8 + wid; row < NR; row += gridDim.x * 8) {
        float s = lane < 32 ? ssqA[(size_t)row * 32 + lane] : 0.f;
#pragma unroll
        for (int d = 1; d < 64; d <<= 1) s += __shfl_xor(s, d);
        const float rs = rsqrtf(s * (1.f / 2048.f) + EPS);
        float* xo = p.out + (size_t)row * 2048; const u16* xb = (const u16*)(p.ws + W_XBA) + (size_t)row * 2048;
#pragma unroll
        for (int i = 0; i < 8; ++i) { const int c = (i * 64 + lane) * 4; const u32x2 xw = *(const u32x2*)(xb + c); const f32x4 g = *(const f32x4*)(p.g_final + c);
            f32x4 v; v.x = bf_lo(xw.x) * rs * g.x; v.y = bf_hi(xw.x) * rs * g.y; v.z = bf_lo(xw.y) * rs * g.z; v.w = bf_hi(xw.y) * rs * g.w; *(f32x4*)(xo + c) = v; }
    }
}

constexpr int LDS_BYTES = 131072 + 8 * 2304;

__global__ __launch_bounds__(512, 2) void fwd_megakernel(P p) {
    extern __shared__ __attribute__((aligned(16))) unsigned char shm[];
    LAS unsigned char* lds = (LAS unsigned char*)shm;
    cg::grid_group grid = cg::this_grid();
    const int wv = __builtin_amdgcn_readfirstlane(threadIdx.x >> 6);
    prep_phase(wv, p, lds);
    grid.sync();
    pg8::StaticOrder S;
    for (int layer_ = 0; layer_ < DEPTH; ++layer_) {
        int layer = layer_, bid = (int)blockIdx.x, G = (int)gridDim.x; asm volatile("" : "+s"(layer), "+s"(bid), "+s"(G));
        {
            pg8::Gemm g{(const u16*)(p.ws + W_XBA), (const u16*)(p.ws + W_WTIN) + (size_t)layer * 4096 * 2048, NP, 4096, 2048};
            S.init(g.M, g.N, G, bid); EpiProj E{p, layer, lds};
            pg8::gemm_phase(wv, lds, g, S, E);
            logf_items(wv, p, layer, lds, bid, NP / 128, G);
        }
        grid.sync();
        attn_phase(wv, p, layer, lds);
        grid.sync();
        {
            for (int rep = 0; rep < 2; ++rep) {
                if ((rep ^ ((bid >> 2) & 1)) == 0) {
                    pg8::Gemm g{(const u16*)(p.ws + W_OB), (const u16*)(p.ws + W_WTOUT) + (size_t)layer * 2048 * 1024, NP, 2048, 1024};
                    S.init(g.M, g.N, G, bid); EpiOut E{p, lds};
                    pg8::gemm_phase(wv, lds, g, S, E);
                } else {
                    pg8::Gemm g2{(const u16*)(p.ws + W_PB) + (size_t)layer * NR * 256, (const u16*)(p.ws + W_WTPLE) + (size_t)layer * 2048 * 256, NP, 2048, 256};
                    S.init(g2.M, g2.N, G, bid); EpiPle E2{p, lds};
                    pg8::gemm_phase(wv, lds, g2, S, E2);
                }
            }
        }
        grid.sync();
        {
            pg8::Gemm g{(const u16*)(p.ws + W_XBB), (const u16*)(p.ws + W_WTGATE) + (size_t)layer * 2048 * 2048, NP, 2048, 2048};
            S.init(g.M, g.N, G, bid); EpiGate E{p, lds};
            pg8::gemm_phase(wv, lds, g, S, E);
        }
        grid.sync();
    }
    final_phase(wv, p);
}

extern "C" void kernel_launch(void* const* d_in, const int* in_sizes, int n_in, void* d_out, int out_size, void* d_ws, size_t ws_size, hipStream_t stream) {
    static int grid_blocks = 0;
    if (!grid_blocks) {
        if (n_in != 19 || (size_t)out_size != OUT_TOTAL || ws_size < W_END) { fprintf(stderr, "kernel_launch: unexpected shapes: n_in %d out %d (want %zu) ws %zu (want %zu)\n", n_in, out_size, OUT_TOTAL, ws_size, W_END); grid_blocks = -1; return; }
        int dev = 0, cus = 0, per_cu = 0;
        hipGetDevice(&dev);
        hipDeviceGetAttribute(&cus, hipDeviceAttributeMultiprocessorCount, dev);
        if (hipFuncSetAttribute((const void*)fwd_megakernel, hipFuncAttributeMaxDynamicSharedMemorySize, LDS_BYTES) != hipSuccess) fprintf(stderr, "kernel_launch: hipFuncSetAttribute failed\n");
        if (hipOccupancyMaxActiveBlocksPerMultiprocessor(&per_cu, (const void*)fwd_megakernel, 512, LDS_BYTES) != hipSuccess || per_cu < 1) { fprintf(stderr, "kernel_launch: occupancy query gave %d\n", per_cu); per_cu = 1; }
        (void)hipGetLastError();
        grid_blocks = cus * per_cu;
    }
    if (grid_blocks < 0) return;
    P p{};
    const float** f = (const float**)&p;
    for (int i = 0; i < 19; ++i) f[i] = (const float*)d_in[i];
    p.out = (float*)d_out; p.ws = (unsigned char*)d_ws;
    void* args[] = {&p};
    hipError_t e = hipLaunchCooperativeKernel((const void*)fwd_megakernel, dim3(grid_blocks), dim3(512), args, LDS_BYTES, stream);
    if (e != hipSuccess) fprintf(stderr, "cooperative launch failed: %s (grid %d)\n", hipGetErrorString(e), grid_blocks);
}
```

```cpp
#include <hip/hip_runtime.h>
#include <hip/hip_cooperative_groups.h>
#include <cstdio>
namespace cg = cooperative_groups;

#define LAS __attribute__((address_space(3)))
typedef unsigned short u16;
typedef short bf16x8 __attribute__((ext_vector_type(8)));
typedef float f32x4 __attribute__((ext_vector_type(4)));
typedef float f32x16 __attribute__((ext_vector_type(16)));
typedef unsigned u32x2 __attribute__((ext_vector_type(2)));
typedef unsigned u32x4 __attribute__((ext_vector_type(4)));

constexpr int D_MODEL = 2048, SEQ = 16384, DEPTH = 4, DEC_BATCH = 8, DEC_SEQ = 32, PAST = 1024;
constexpr int NP = 2 * SEQ, NS = DEC_BATCH * DEC_SEQ, NR = NP + NS;
constexpr int DMIX = 1024, D_IN = 4100, PLE = 256;
constexpr int SL = 1088;
constexpr float EPS = 1e-6f;
constexpr float LOG2E = 1.4426950408889634f;
constexpr float QSCALE = 0.08838834764831845f * LOG2E;
constexpr int NITEMS = 1024 + 64;

constexpr size_t O_Y = 0;
constexpr size_t O_KV_P = (size_t)NR * D_MODEL;
constexpr size_t KVP = (size_t)DEPTH * NP * 512;
constexpr size_t O_LOGF_P = O_KV_P + 4 * KVP;
constexpr size_t O_KV_S = O_LOGF_P + (size_t)DEPTH * NP * 4;
constexpr size_t KVS = (size_t)DEPTH * NS * 512;
constexpr size_t O_LOGF_S = O_KV_S + 4 * KVS;
constexpr size_t OUT_TOTAL = O_LOGF_S + (size_t)DEPTH * NS * 4;

constexpr size_t al256(size_t x) { return (x + 255) & ~(size_t)255; }
constexpr size_t W_WTIN = 0;
constexpr size_t W_WTOUT = W_WTIN + (size_t)DEPTH * 4096 * 2048 * 2;
constexpr size_t W_WTPLE = W_WTOUT + (size_t)DEPTH * 2048 * 1024 * 2;
constexpr size_t W_WTGATE = W_WTPLE + (size_t)DEPTH * 2048 * 256 * 2;
constexpr size_t W_WF = W_WTGATE + (size_t)DEPTH * 2048 * 2048 * 2;
constexpr size_t W_XBA = W_WF + (size_t)DEPTH * 2048 * 4 * 4;
constexpr size_t W_PB = W_XBA + (size_t)NR * 2048 * 2;
constexpr size_t W_R = W_PB + (size_t)DEPTH * NR * 256 * 2;
constexpr size_t W_QB = W_R;
constexpr size_t W_KBP = W_QB + (size_t)NR * 1024 * 2;
constexpr size_t W_VTP = W_KBP + (size_t)NP * 1024 * 2;
constexpr size_t W_ZB = W_VTP + (size_t)NP * 1024 * 2;
constexpr size_t W_PLEB = W_R;
constexpr size_t W_XBB = W_R + al256((size_t)NR * 2048 * 2);
constexpr size_t R_SIZE = 2 * al256((size_t)NR * 2048 * 2) + 4096;
static_assert(W_ZB + (size_t)NR * 1024 * 2 <= W_R + R_SIZE, "region R too small");
constexpr size_t W_KBS = W_R + R_SIZE;
constexpr size_t W_VTS = W_KBS + (size_t)DEPTH * DEC_BATCH * SL * 1024 * 2;
constexpr size_t W_OB = W_VTS + (size_t)DEPTH * DEC_BATCH * 8 * 128 * SL * 2;
constexpr size_t W_SSQA = W_OB + (size_t)NR * 1024 * 2;
constexpr size_t W_SSQB = W_SSQA + (size_t)NR * 32 * 4;
constexpr size_t W_CIN = W_SSQB + (size_t)NR * 32 * 4;
constexpr size_t W_SEGTOT = W_CIN + (size_t)NR * 4 * 4;
constexpr size_t W_CCUM = W_SEGTOT + al256((size_t)(NR / 32) * 4 * 4);
constexpr size_t W_CTR = W_CCUM + (size_t)DEPTH * DEC_BATCH * PAST * 4 * 4;
constexpr size_t W_PLES = W_CTR + 4096;
constexpr size_t W_END = W_PLES + (size_t)NS * 2048 * 2;

struct P {
    const float *x_prompt, *x_sample, *p_prompt, *p_sample, *c_sbk, *c_sbv, *c_fxk, *c_fxv, *c_logf, *w_in, *b_f, *g_attn, *g_osb, *g_ofox, *w_out, *w_ple, *g_ple, *w_gate, *g_final;
    float* out;
    unsigned char* ws;
};

__device__ __forceinline__ unsigned cvt_pk_bf16(float lo, float hi) { unsigned r; asm volatile("v_cvt_pk_bf16_f32 %0, %1, %2" : "=v"(r) : "v"(lo), "v"(hi)); return r; }
__device__ __forceinline__ float bf_lo(unsigned w) { return __uint_as_float(w << 16); }
__device__ __forceinline__ float bf_hi(unsigned w) { return __uint_as_float(w & 0xffff0000u); }
__device__ __forceinline__ float fexp2(float x) { return __builtin_amdgcn_exp2f(x); }
__device__ __forceinline__ float flog2(float x) { return __builtin_amdgcn_logf(x); }
__device__ __forceinline__ float fmax3(float a, float b, float c) { float r; asm("v_max3_f32 %0, %1, %2, %3" : "=v"(r) : "v"(a), "v"(b), "v"(c)); return r; }
__device__ __forceinline__ int opaque_tid(int wv) { int l; asm volatile("v_mbcnt_lo_u32_b32 %0, -1, 0\n\tv_mbcnt_hi_u32_b32 %0, -1, %0" : "=v"(l)); return wv * 64 + l; }

namespace pg8 {
constexpr int BM = 256, BK = 64, HALF = 128, HTB = HALF * BK * 2, STAGE_BYTES = 8 * HTB, NXCD = 8, WGM = 8;
__host__ __device__ __forceinline__ int lds_byte(int r, int c) { const int st = (r >> 4) * 2 + (c >> 5), rr = r & 15, cc = c & 31, ob = rr * 64 + cc * 2; return st * 1024 + (ob ^ (((ob >> 9) & 1) << 5)); }
__host__ __device__ __forceinline__ void stage_rc(int b, int& R, int& C) { const int st = b / 1024, sb = b % 1024, swz = sb ^ (((sb >> 9) & 1) << 5); R = (st >> 1) * 16 + swz / 64; C = (st & 1) * 32 + (swz % 64) / 2; }
struct Unit { int pm, pn; };
struct Gemm { const u16* A; const u16* Bt; int M, N, K; };
struct StaticOrder {
    int nM, nN, nwg, G, c;
    int one_pm, one_pn;
    __device__ void init(int M, int N, int G_, int c_) { nM = M / BM; nN = N / BM; nwg = nM * nN; G = G_; c = c_; one_pm = -1; one_pn = 0; }
    __device__ void init_one(int pm, int pn) { nM = 1; nN = 1; nwg = 1; G = 1; c = 0; one_pm = pm; one_pn = pn; }
    __device__ bool next(int i, Unit& u) const {
        if (one_pm >= 0) { if (i > 0) return false; u.pm = one_pm; u.pn = one_pn; return true; }
        const long L = (long)i * G + c; if (L >= nwg) return false;
        int wgid = (int)L; { const int q = nwg / NXCD, r = nwg % NXCD, xcd = wgid % NXCD, off = wgid / NXCD; wgid = (xcd < r ? xcd * (q + 1) : r * (q + 1) + (xcd - r) * q) + off; }
        const int nig = WGM * nN, gid = wgid / nig, fm = gid * WGM, gsz = (nM - fm) < WGM ? (nM - fm) : WGM;
        u.pm = fm + ((wgid % nig) % gsz); u.pn = (wgid % nig) / gsz; return true;
    }
};

template <class Epi>
__device__ __forceinline__ void gemm_phase(int wv, LAS unsigned char* lds, const Gemm g, const StaticOrder& S, const Epi& E, const int skew_ticks = 0) {
    const int tid = opaque_tid(wv), wid = __builtin_amdgcn_readfirstlane(tid >> 6), lane = tid & 63, wr = wid >> 2, wc = wid & 3, fr = lane & 15, fq = lane >> 4;
    const int K = g.K, nt = K / BK;
    unsigned voffA[2], voffB0[2];
#pragma unroll
    for (int i = 0; i < 2; ++i) { int R, C; stage_rc(tid * 16 + i * 8192, R, C); voffA[i] = (unsigned)(R * K + C) * 2u;
        const int rho = R & 31, pr = 8 * ((rho & 15) >> 2) + 4 * (rho >> 4) + (rho & 3), Rb = 64 * (R >> 5) + pr;
        voffB0[i] = (unsigned)(Rb * K + C) * 2u; }
    const size_t b1step = (size_t)32 * K * 2;
    const size_t kstep = (size_t)(BK * 2);
    const size_t hstep = (size_t)HALF * K * 2;
    const size_t tstep = 2 * hstep;
    const unsigned ldsw = (unsigned)wid * 1024u;
    const int aoff = lds_byte(wr * 64 + fr, fq * 8), boff = lds_byte(wc * 32 + fr, fq * 8);
#define PG8_SA(b, h) (((b) * 2 + (h)) * HTB)
#define PG8_SB(b, h) ((4 + (b) * 2 + (h)) * HTB)
#define PG8_STAGE(bufoff, gbase, voff) do { _Pragma("unroll") for (int _i = 0; _i < 2; ++_i) \
        __builtin_amdgcn_global_load_lds((const unsigned*)((const char*)(gbase) + (voff)[_i]), (LAS unsigned*)(lds + (bufoff) + ldsw + _i * 8192), 16, 0, 0); } while (0)
#define PG8_LDA(dst, b, h) do { _Pragma("unroll") for (int m = 0; m < 4; ++m) _Pragma("unroll") for (int k = 0; k < 2; ++k) dst[m][k] = *(const LAS bf16x8*)(lds + PG8_SA(b, h) + aoff + m * 2048 + k * 1024); } while (0)
#define PG8_LDB(dst, b, h) do { _Pragma("unroll") for (int n = 0; n < 2; ++n) _Pragma("unroll") for (int k = 0; k < 2; ++k) dst[n][k] = *(const LAS bf16x8*)(lds + PG8_SB(b, h) + boff + n * 2048 + k * 1024); } while (0)
#define PG8_MMA(ai, bj, At, Bt) do { __builtin_amdgcn_s_setprio(1); _Pragma("unroll") for (int m = 0; m < 4; ++m) _Pragma("unroll") for (int n = 0; n < 2; ++n) _Pragma("unroll") for (int k = 0; k < 2; ++k) \
        acc[ai][bj][m][n] = __builtin_amdgcn_mfma_f32_16x16x32_bf16(Bt[n][k], At[m][k], acc[ai][bj][m][n], 0, 0, 0); __builtin_amdgcn_s_setprio(0); } while (0)
#define PG8_WAIT_V(n) asm volatile("s_waitcnt vmcnt(" #n ")" ::: "memory")
#define PG8_WAIT_L(n) asm volatile("s_waitcnt lgkmcnt(" #n ")" ::: "memory")
#define PG8_BAR __builtin_amdgcn_s_barrier()
#define PG8_SCHED __builtin_amdgcn_sched_barrier(0)
    Unit cur, nxt; int ui = 0;
    if (!S.next(0, cur)) return;
    if (skew_ticks > 0) {
        const unsigned long long t0 = __builtin_amdgcn_s_memrealtime();
        while ((long long)(__builtin_amdgcn_s_memrealtime() - t0) < (long long)skew_ticks) __builtin_amdgcn_s_sleep(32);
    }
    f32x4 acc[2][2][4][2];
#pragma unroll
    for (int a = 0; a < 2; ++a)
#pragma unroll
        for (int b = 0; b < 2; ++b)
#pragma unroll
            for (int m = 0; m < 4; ++m)
#pragma unroll
                for (int n = 0; n < 2; ++n) acc[a][b][m][n] = (f32x4){0.f, 0.f, 0.f, 0.f};
    bf16x8 At[4][2], B0[2][2], B1[2][2];
    const char* cA = (const char*)g.A + (size_t)cur.pm * tstep; const char* cB = (const char*)g.Bt + (size_t)cur.pn * tstep;
    PG8_STAGE(PG8_SB(0, 0), cB, voffB0); PG8_STAGE(PG8_SA(0, 0), cA, voffA); PG8_STAGE(PG8_SB(0, 1), cB + b1step, voffB0); PG8_STAGE(PG8_SA(0, 1), cA + hstep, voffA);
    if (wr == 1) PG8_BAR;
    PG8_WAIT_V(4); PG8_BAR;
    PG8_STAGE(PG8_SB(1, 0), cB + kstep, voffB0); PG8_STAGE(PG8_SA(1, 0), cA + kstep, voffA); PG8_STAGE(PG8_SB(1, 1), cB + kstep + b1step, voffB0);
    PG8_WAIT_V(6); PG8_BAR;
    for (;;) {
        const bool has_next = S.next(ui + 1, nxt);
        const char* nA = has_next ? (const char*)g.A + (size_t)nxt.pm * tstep : cA; const char* nB = has_next ? (const char*)g.Bt + (size_t)nxt.pn * tstep : cB;
        for (int t = 0; t < nt; t += 2) {
            const bool last = (t == nt - 2);
            const char* a1 = cA + (size_t)(t + 1) * kstep;
            const char* a2 = last ? nA : cA + (size_t)(t + 2) * kstep; const char* b2 = last ? nB : cB + (size_t)(t + 2) * kstep;
            const char* a3 = a2 + kstep; const char* b3 = b2 + kstep;
            PG8_LDB(B0, 0, 0); PG8_SCHED; PG8_LDA(At, 0, 0); PG8_STAGE(PG8_SA(1, 1), a1 + hstep, voffA);
            PG8_WAIT_L(8); PG8_BAR; PG8_WAIT_L(0); PG8_MMA(0, 0, At, B0); PG8_BAR; PG8_SCHED;
            PG8_LDB(B1, 0, 1); PG8_STAGE(PG8_SB(0, 0), b2, voffB0);
            PG8_BAR; PG8_WAIT_L(0); PG8_MMA(0, 1, At, B1); PG8_BAR;
            PG8_LDA(At, 0, 1); PG8_STAGE(PG8_SA(0, 0), a2, voffA);
            PG8_BAR; PG8_WAIT_L(0); PG8_MMA(1, 0, At, B0); PG8_BAR; PG8_SCHED;
            PG8_STAGE(PG8_SB(0, 1), b2 + b1step, voffB0);
            PG8_WAIT_V(6); PG8_BAR; PG8_MMA(1, 1, At, B1); PG8_BAR;
            PG8_LDB(B0, 1, 0); PG8_SCHED; PG8_LDA(At, 1, 0); PG8_STAGE(PG8_SA(0, 1), a2 + hstep, voffA);
            PG8_WAIT_L(8); PG8_BAR; PG8_WAIT_L(0); PG8_MMA(0, 0, At, B0); PG8_BAR; PG8_SCHED;
            PG8_LDB(B1, 1, 1); PG8_STAGE(PG8_SB(1, 0), b3, voffB0);
            PG8_BAR; PG8_WAIT_L(0); PG8_MMA(0, 1, At, B1); PG8_BAR;
            PG8_LDA(At, 1, 1); PG8_STAGE(PG8_SA(1, 0), a3, voffA);
            PG8_BAR; PG8_WAIT_L(0); PG8_MMA(1, 0, At, B0); PG8_BAR; PG8_SCHED;
            PG8_STAGE(PG8_SB(1, 1), b3 + b1step, voffB0);
            PG8_WAIT_V(6); PG8_BAR; PG8_MMA(1, 1, At, B1); PG8_BAR;
        }
        { int fr2 = fr, fq2 = fq; asm volatile("" : "+v"(fr2), "+v"(fq2)); E(acc, cur, wr, wc, fr2, fq2); }
        if (!has_next) break;
#pragma unroll
        for (int a = 0; a < 2; ++a)
#pragma unroll
            for (int b = 0; b < 2; ++b)
#pragma unroll
                for (int m = 0; m < 4; ++m)
#pragma unroll
                    for (int n = 0; n < 2; ++n) acc[a][b][m][n] = (f32x4){0.f, 0.f, 0.f, 0.f};
        cur = nxt; cA = nA; cB = nB; ++ui;
    }
    PG8_WAIT_V(0);
    if (wr == 0) PG8_BAR;
    PG8_BAR;
#undef PG8_SA
#undef PG8_SB
#undef PG8_STAGE
#undef PG8_LDA
#undef PG8_LDB
#undef PG8_MMA
#undef PG8_WAIT_V
#undef PG8_WAIT_L
#undef PG8_BAR
#undef PG8_SCHED
}
}


__device__ __forceinline__ float row_rstd(const float* ssq, int row, int fq) {
    const f32x4* q = (const f32x4*)(ssq + (size_t)row * 32 + fq * 8);
    const f32x4 a = q[0], b = q[1];
    float s = (a.x + a.y) + (a.z + a.w) + (b.x + b.y) + (b.z + b.w);
    s += __shfl_xor(s, 16); s += __shfl_xor(s, 32);
    return rsqrtf(s * (1.f / 2048.f) + EPS);
}
__device__ __forceinline__ u32x4 pack8(const f32x4 a, const f32x4 b) { u32x4 w; w.x = cvt_pk_bf16(a.x, a.y); w.y = cvt_pk_bf16(a.z, a.w); w.z = cvt_pk_bf16(b.x, b.y); w.w = cvt_pk_bf16(b.z, b.w); return w; }

constexpr int TRS = 144, TIO_OFF = 131072, TIO_WAVE = 2304;
__device__ __forceinline__ void tio_store(LAS unsigned char* T, u16* g0, int lane, int fr, int fq, const u32x4 w0, const u32x4 w1) {
    *(LAS u32x4*)(T + fr * TRS + fq * 16) = w0; *(LAS u32x4*)(T + fr * TRS + 64 + fq * 16) = w1;
    const int rr = lane >> 3, ch = lane & 7;
    const u32x4 a = *(const LAS u32x4*)(T + rr * TRS + ch * 16), b = *(const LAS u32x4*)(T + (8 + rr) * TRS + ch * 16);
    *(u32x4*)(g0 + (size_t)rr * 2048 + ch * 8) = a; *(u32x4*)(g0 + (size_t)(8 + rr) * 2048 + ch * 8) = b;
}
__device__ __forceinline__ void tio_load(const u16* g0, int lane, u32x4& a, u32x4& b) { const int rr = lane >> 3, ch = lane & 7; a = *(const u32x4*)(g0 + (size_t)rr * 2048 + ch * 8); b = *(const u32x4*)(g0 + (size_t)(8 + rr) * 2048 + ch * 8); }
__device__ __forceinline__ void tio_unpack(LAS unsigned char* T, int lane, int fr, int fq, const u32x4 a, const u32x4 b, u32x4& w0, u32x4& w1) {
    const int rr = lane >> 3, ch = lane & 7;
    *(LAS u32x4*)(T + rr * TRS + ch * 16) = a; *(LAS u32x4*)(T + (8 + rr) * TRS + ch * 16) = b;
    w0 = *(const LAS u32x4*)(T + fr * TRS + fq * 16); w1 = *(const LAS u32x4*)(T + fr * TRS + 64 + fq * 16);
}

__device__ __forceinline__ void tio_store_f32(LAS unsigned char* T, float* g0, size_t gpitch, int lane, int fr, int fq, const f32x4 v0, const f32x4 v1) {
    *(LAS f32x4*)(T + fr * TRS + fq * 32) = v0; *(LAS f32x4*)(T + fr * TRS + fq * 32 + 16) = v1;
    const int rr = lane >> 3, ch = lane & 7;
    const f32x4 a = *(const LAS f32x4*)(T + rr * TRS + ch * 16), b = *(const LAS f32x4*)(T + (8 + rr) * TRS + ch * 16);
    __builtin_nontemporal_store(a, (f32x4*)(g0 + (size_t)rr * gpitch + ch * 4)); __builtin_nontemporal_store(b, (f32x4*)(g0 + (size_t)(8 + rr) * gpitch + ch * 4));
}
__device__ __forceinline__ void tio_store_p(LAS unsigned char* T, u16* g0, size_t gpitch, int lane, int fr, int fq, const u32x4 w0, const u32x4 w1) {
    *(LAS u32x4*)(T + fr * TRS + fq * 16) = w0; *(LAS u32x4*)(T + fr * TRS + 64 + fq * 16) = w1;
    const int rr = lane >> 3, ch = lane & 7;
    const u32x4 a = *(const LAS u32x4*)(T + rr * TRS + ch * 16), b = *(const LAS u32x4*)(T + (8 + rr) * TRS + ch * 16);
    *(u32x4*)(g0 + (size_t)rr * gpitch + ch * 8) = a; *(u32x4*)(g0 + (size_t)(8 + rr) * gpitch + ch * 8) = b;
}

struct EpiProj {
    const P& p; int layer; LAS unsigned char* lds;
    __device__ __forceinline__ void operator()(const f32x4 (&acc)[2][2][4][2], const pg8::Unit& u, int wr, int wc, int fr, int fq) const {
        const int lane = fq * 16 + fr; LAS unsigned char* T = lds + TIO_OFF + (wr * 4 + wc) * TIO_WAVE; const int cww = (u.pn & 1) * 256 + wc * 64;
        const int group = u.pn >> 1, type = group & 3, br = group >> 2;
        const int cgb = (u.pn & 1) * 256 + wc * 64 + 8 * fq;
        const float* ssqA = (const float*)(p.ws + W_SSQA);
        u16* Qb = (u16*)(p.ws + W_QB); u16* Zb = (u16*)(p.ws + W_ZB);
        float kmx = 0.f;
        float rsv[8];
#pragma unroll
        for (int i = 0; i < 8; ++i) rsv[i] = row_rstd(ssqA, u.pm * 256 + (i >> 2) * 128 + wr * 64 + (i & 3) * 16 + fr, fq);
#pragma unroll
        for (int ai = 0; ai < 2; ++ai)
#pragma unroll
            for (int m = 0; m < 4; ++m) {
                const int row = u.pm * 256 + ai * 128 + wr * 64 + m * 16 + fr;
                const float rs = rsv[ai * 4 + m];
                if (type == 0) {
                    const float sc = rs * QSCALE;
                    tio_store_p(T, Qb + (size_t)(row - fr) * 1024 + br * 512 + cww, 1024, lane, fr, fq, pack8(acc[ai][0][m][0] * sc, acc[ai][0][m][1] * sc), pack8(acc[ai][1][m][0] * sc, acc[ai][1][m][1] * sc));
                } else if (type == 3) {
                    u32x4 zw[2];
#pragma unroll
                    for (int bj = 0; bj < 2; ++bj) { f32x4 v0 = acc[ai][bj][m][0] * rs, v1 = acc[ai][bj][m][1] * rs;
#pragma unroll
                        for (int j = 0; j < 4; ++j) { v0[j] = v0[j] * __builtin_amdgcn_rcpf(1.f + __expf(-v0[j])); v1[j] = v1[j] * __builtin_amdgcn_rcpf(1.f + __expf(-v1[j])); }
                        zw[bj] = pack8(v0, v1); }
                    tio_store_p(T, Zb + (size_t)(row - fr) * 1024 + br * 512 + cww, 1024, lane, fr, fq, zw[0], zw[1]);
                } else {
                    float* o32; u16* kb; u16* vt; size_t vld; float kss = 0.f;
                    if (row < NP) { const int b = row >> 14, t = row & (SEQ - 1);
                        o32 = p.out + O_KV_P + (size_t)(br * 2 + (type - 1)) * KVP + ((size_t)(layer * 2 + b) * SEQ + t) * 512;
                        kb = (u16*)(p.ws + W_KBP) + (size_t)row * 1024 + br * 512;
                        vt = (u16*)(p.ws + W_VTP) + (size_t)(b * 8 + br * 4) * 128 * SEQ + t; vld = SEQ;
                    } else { const int rr = row - NP, sb = rr >> 5, t = rr & 31;
                        o32 = p.out + O_KV_S + (size_t)(br * 2 + (type - 1)) * KVS + ((size_t)(layer * 8 + sb) * 32 + t) * 512;
                        kb = (u16*)(p.ws + W_KBS) + ((size_t)(layer * 8 + sb) * SL + PAST + t) * 1024 + br * 512;
                        vt = (u16*)(p.ws + W_VTS) + (size_t)((layer * 8 + sb) * 8 + br * 4) * 128 * SL + PAST + t; vld = SL;
                    }
                    u32x4 kw[2];
#pragma unroll
                    for (int bj = 0; bj < 2; ++bj) { const f32x4 v0 = acc[ai][bj][m][0] * rs, v1 = acc[ai][bj][m][1] * rs; const int cg = cgb + bj * 32;
                        kss += (v0.x * v0.x + v0.y * v0.y + v0.z * v0.z + v0.w * v0.w) + (v1.x * v1.x + v1.y * v1.y + v1.z * v1.z + v1.w * v1.w);
                        tio_store_f32(T, o32 - (size_t)fr * 512 + cww + bj * 32, 512, lane, fr, fq, v0, v1);
                        const u32x4 w = pack8(v0, v1); kw[bj] = w;
                        if (type == 1) { if (bj == 1) tio_store_p(T, kb - (size_t)fr * 1024 + cww, 1024, lane, fr, fq, kw[0], kw[1]); }
                        else { vt[(size_t)(cg + 0) * vld] = (u16)(w.x & 0xffffu); vt[(size_t)(cg + 1) * vld] = (u16)(w.x >> 16); vt[(size_t)(cg + 2) * vld] = (u16)(w.y & 0xffffu); vt[(size_t)(cg + 3) * vld] = (u16)(w.y >> 16);
                               vt[(size_t)(cg + 4) * vld] = (u16)(w.z & 0xffffu); vt[(size_t)(cg + 5) * vld] = (u16)(w.z >> 16); vt[(size_t)(cg + 6) * vld] = (u16)(w.w & 0xffffu); vt[(size_t)(cg + 7) * vld] = (u16)(w.w >> 16); } }
                    if (type == 1 && br == 1) { kss += __shfl_xor(kss, 16); kss += __shfl_xor(kss, 32); kmx = fmaxf(kmx, kss); }
                }
            }
        if (type == 1 && br == 1 && u.pm < NP / 256) {
            float t = kmx; t = fmaxf(t, __shfl_xor(t, 1)); t = fmaxf(t, __shfl_xor(t, 2)); t = fmaxf(t, __shfl_xor(t, 4)); t = fmaxf(t, __shfl_xor(t, 8));
            if (fr == 0 && fq == 0) atomicMax((unsigned*)(p.ws + W_CTR) + 64 + ((layer * 2 + (u.pm >> 6)) * 4 + (u.pn & 1) * 2 + (wc >> 1)) * 4 + (wc & 1), __float_as_uint(t));
        }
    }
};

struct EpiOut {
    const P& p; LAS unsigned char* lds;
    __device__ __forceinline__ void operator()(const f32x4 (&acc)[2][2][4][2], const pg8::Unit& u, int wr, int wc, int fr, int fq) const {
        float* ssqB = (float*)(p.ws + W_SSQB); u16* XbB = (u16*)(p.ws + W_XBB); const u16* XbA = (const u16*)(p.ws + W_XBA);
        const int lane = fq * 16 + fr, cw = u.pn * 256 + wc * 64; LAS unsigned char* T = lds + TIO_OFF + (wr * 4 + wc) * TIO_WAVE;
#pragma unroll
        for (int ai = 0; ai < 2; ++ai) {
            u32x4 xa[4], xb_[4];
#pragma unroll
            for (int m = 0; m < 4; ++m) tio_load(XbA + (size_t)(u.pm * 256 + ai * 128 + wr * 64 + m * 16) * 2048 + cw, lane, xa[m], xb_[m]);
#pragma unroll
            for (int m = 0; m < 4; ++m) {
                const int row0 = u.pm * 256 + ai * 128 + wr * 64 + m * 16; float ss = 0.f; u32x4 x0, x1;
                tio_unpack(T, lane, fr, fq, xa[m], xb_[m], x0, x1);
                f32x4 v00 = acc[ai][0][m][0], v01 = acc[ai][0][m][1], v10 = acc[ai][1][m][0], v11 = acc[ai][1][m][1];
                v00.x += bf_lo(x0.x); v00.y += bf_hi(x0.x); v00.z += bf_lo(x0.y); v00.w += bf_hi(x0.y); v01.x += bf_lo(x0.z); v01.y += bf_hi(x0.z); v01.z += bf_lo(x0.w); v01.w += bf_hi(x0.w);
                v10.x += bf_lo(x1.x); v10.y += bf_hi(x1.x); v10.z += bf_lo(x1.y); v10.w += bf_hi(x1.y); v11.x += bf_lo(x1.z); v11.y += bf_hi(x1.z); v11.z += bf_lo(x1.w); v11.w += bf_hi(x1.w);
                ss += (v00.x * v00.x + v00.y * v00.y + v00.z * v00.z + v00.w * v00.w) + (v01.x * v01.x + v01.y * v01.y + v01.z * v01.z + v01.w * v01.w);
                ss += (v10.x * v10.x + v10.y * v10.y + v10.z * v10.z + v10.w * v10.w) + (v11.x * v11.x + v11.y * v11.y + v11.z * v11.z + v11.w * v11.w);
                tio_store(T, XbB + (size_t)row0 * 2048 + cw, lane, fr, fq, pack8(v00, v01), pack8(v10, v11));
                ss += __shfl_xor(ss, 16); ss += __shfl_xor(ss, 32);
                if (fq == 0) ssqB[(size_t)(row0 + fr) * 32 + u.pn * 4 + wc] = ss;
            }
        }
    }
};

struct EpiPle {
    const P& p; LAS unsigned char* lds;
    __device__ __forceinline__ void operator()(const f32x4 (&acc)[2][2][4][2], const pg8::Unit& u, int wr, int wc, int fr, int fq) const {
        u16* O = u.pm == NP / 256 ? (u16*)(p.ws + W_PLES) - (size_t)NP * 2048 : (u16*)(p.ws + W_PLEB);
        const int lane = fq * 16 + fr, cw = u.pn * 256 + wc * 64; LAS unsigned char* T = lds + TIO_OFF + (wr * 4 + wc) * TIO_WAVE;
#pragma unroll
        for (int ai = 0; ai < 2; ++ai)
#pragma unroll
            for (int m = 0; m < 4; ++m)
                tio_store(T, O + (size_t)(u.pm * 256 + ai * 128 + wr * 64 + m * 16) * 2048 + cw, lane, fr, fq, pack8(acc[ai][0][m][0], acc[ai][0][m][1]), pack8(acc[ai][1][m][0], acc[ai][1][m][1]));
    }
};

struct EpiGate {
    const P& p; LAS unsigned char* lds;
    __device__ __forceinline__ void operator()(const f32x4 (&acc)[2][2][4][2], const pg8::Unit& u, int wr, int wc, int fr, int fq) const {
        const float* ssqB = (const float*)(p.ws + W_SSQB); float* ssqA = (float*)(p.ws + W_SSQA); u16* XbA = (u16*)(p.ws + W_XBA); const u16* XbB = (const u16*)(p.ws + W_XBB); const u16* PL = u.pm == NP / 256 ? (const u16*)(p.ws + W_PLES) - (size_t)NP * 2048 : (const u16*)(p.ws + W_PLEB);
        const int lane = fq * 16 + fr, cw = u.pn * 256 + wc * 64; LAS unsigned char* T = lds + TIO_OFF + (wr * 4 + wc) * TIO_WAVE;
        float rsv[8];
#pragma unroll
        for (int i = 0; i < 8; ++i) rsv[i] = row_rstd(ssqB, u.pm * 256 + (i >> 2) * 128 + wr * 64 + (i & 3) * 16 + fr, fq);
#pragma unroll
        for (int g4 = 0; g4 < 4; ++g4) { const int ai = g4 >> 1, m0 = (g4 & 1) * 2;
            u32x4 xa[2], xb_[2], pa[2], pb[2];
#pragma unroll
            for (int mm = 0; mm < 2; ++mm) { const size_t ro = (size_t)(u.pm * 256 + ai * 128 + wr * 64 + (m0 + mm) * 16) * 2048 + cw;
                tio_load(XbB + ro, lane, xa[mm], xb_[mm]); tio_load(PL + ro, lane, pa[mm], pb[mm]); }
#pragma unroll
            for (int mm = 0; mm < 2; ++mm) { const int m = m0 + mm;
                const int row0 = u.pm * 256 + ai * 128 + wr * 64 + m * 16;
                const float rs = rsv[ai * 4 + m]; float ss = 0.f;
                u32x4 x0, x1, p0, p1;
                tio_unpack(T, lane, fr, fq, xa[mm], xb_[mm], x0, x1);
                tio_unpack(T, lane, fr, fq, pa[mm], pb[mm], p0, p1);
                f32x4 v[2][2];
#pragma unroll
                for (int bj = 0; bj < 2; ++bj) { const f32x4 a0 = acc[ai][bj][m][0] * rs, a1 = acc[ai][bj][m][1] * rs; const u32x4 pq = bj ? p1 : p0, xq = bj ? x1 : x0;
                    f32x4 v0, v1;
                    v0.x = bf_lo(xq.x) + bf_lo(pq.x) * __builtin_amdgcn_rcpf(1.f + __expf(-a0.x)); v0.y = bf_hi(xq.x) + bf_hi(pq.x) * __builtin_amdgcn_rcpf(1.f + __expf(-a0.y));
                    v0.z = bf_lo(xq.y) + bf_lo(pq.y) * __builtin_amdgcn_rcpf(1.f + __expf(-a0.z)); v0.w = bf_hi(xq.y) + bf_hi(pq.y) * __builtin_amdgcn_rcpf(1.f + __expf(-a0.w));
                    v1.x = bf_lo(xq.z) + bf_lo(pq.z) * __builtin_amdgcn_rcpf(1.f + __expf(-a1.x)); v1.y = bf_hi(xq.z) + bf_hi(pq.z) * __builtin_amdgcn_rcpf(1.f + __expf(-a1.y));
                    v1.z = bf_lo(xq.w) + bf_lo(pq.w) * __builtin_amdgcn_rcpf(1.f + __expf(-a1.z)); v1.w = bf_hi(xq.w) + bf_hi(pq.w) * __builtin_amdgcn_rcpf(1.f + __expf(-a1.w));
                    ss += (v0.x * v0.x + v0.y * v0.y + v0.z * v0.z + v0.w * v0.w) + (v1.x * v1.x + v1.y * v1.y + v1.z * v1.z + v1.w * v1.w);
                    v[bj][0] = v0; v[bj][1] = v1; }
                tio_store(T, XbA + (size_t)row0 * 2048 + cw, lane, fr, fq, pack8(v[0][0], v[0][1]), pack8(v[1][0], v[1][1]));
                ss += __shfl_xor(ss, 16); ss += __shfl_xor(ss, 32);
                if (fq == 0) ssqA[(size_t)(row0 + fr) * 32 + u.pn * 4 + wc] = ss;
            }
        }
    }
};

struct TDesc { const float* src; size_t sld; u16* dst; size_t dld; const float* gk; };
constexpr int NT_WIN = DEPTH * 2048, NT_WOUT = DEPTH * 512, NT_WPLE = DEPTH * 128, NT_WGATE = DEPTH * 1024, NT_VC = DEPTH * DEC_BATCH * 8 * 32;
constexpr int NT_ALL = NT_WIN + NT_WOUT + NT_WPLE + NT_WGATE + NT_VC;
__device__ __forceinline__ TDesc tile_desc(const P& p, int t) {
    TDesc d;
    if (t < NT_WIN) { const int L = t >> 11, r = t & 2047, kt = r >> 6, nt = r & 63;
        d.src = p.w_in + (size_t)L * 2048 * D_IN + (size_t)kt * 64 * D_IN + nt * 64; d.sld = D_IN; d.dst = (u16*)(p.ws + W_WTIN) + (size_t)L * 4096 * 2048 + (size_t)nt * 64 * 2048 + kt * 64; d.dld = 2048; d.gk = p.g_attn + L * 2048 + kt * 64; return d; }
    t -= NT_WIN;
    if (t < NT_WOUT) { const int L = t >> 9, r = t & 511, kt = r >> 5, nt = r & 31;
        d.src = p.w_out + (size_t)L * 1024 * 2048 + (size_t)kt * 64 * 2048 + nt * 64; d.sld = 2048; d.dst = (u16*)(p.ws + W_WTOUT) + (size_t)L * 2048 * 1024 + (size_t)nt * 64 * 1024 + kt * 64; d.dld = 1024; d.gk = nullptr; return d; }
    t -= NT_WOUT;
    if (t < NT_WPLE) { const int L = t >> 7, r = t & 127, kt = r >> 5, nt = r & 31;
        d.src = p.w_ple + (size_t)L * 256 * 2048 + (size_t)kt * 64 * 2048 + nt * 64; d.sld = 2048; d.dst = (u16*)(p.ws + W_WTPLE) + (size_t)L * 2048 * 256 + (size_t)nt * 64 * 256 + kt * 64; d.dld = 256; d.gk = nullptr; return d; }
    t -= NT_WPLE;
    if (t < NT_WGATE) { const int L = t >> 10, r = t & 1023, kt = r >> 5, nt = r & 31;
        d.src = p.w_gate + (size_t)L * 2048 * 2048 + (size_t)kt * 64 * 2048 + nt * 64; d.sld = 2048; d.dst = (u16*)(p.ws + W_WTGATE) + (size_t)L * 2048 * 2048 + (size_t)nt * 64 * 2048 + kt * 64; d.dld = 2048; d.gk = p.g_ple + L * 2048 + kt * 64; return d; }
    t -= NT_WGATE;
    { const int mi = t >> 5, r = t & 31, kt = r >> 1, nt = r & 1; const int ls = mi >> 3, h8 = mi & 7, br = h8 >> 2, hh = h8 & 3;
        d.src = (br ? p.c_fxv : p.c_sbv) + ((size_t)ls * PAST + kt * 64) * 512 + hh * 128 + nt * 64; d.sld = 512; d.dst = (u16*)(p.ws + W_VTS) + ((size_t)mi * 128 + nt * 64) * SL + kt * 64; d.dld = SL; d.gk = nullptr; return d; }
}

__device__ __forceinline__ void prep_phase(int wv, const P& p, LAS unsigned char* lds) {
    LAS float* T = (LAS float*)lds;
    const int tid = opaque_tid(wv), G = gridDim.x, B = blockIdx.x;
    const int wid = tid >> 6, lane = tid & 63;
    if (B == 0) { ((unsigned*)(p.ws + W_CTR))[tid] = 0u; ((unsigned*)(p.ws + W_CTR))[tid + 512] = 0u; }
    {
        const int k0 = tid >> 4, n4 = (tid & 15) * 4, no = tid >> 3, kc = tid & 7;
        f32x4 v[2][2]; float g[2][2]; TDesc d[2]; bool ok[2];
#define PREP_FETCH(t_) do { _Pragma("unroll") for (int q = 0; q < 2; ++q) { const int tt = (t_) + q * G; ok[q] = tt < NT_ALL; g[q][0] = 1.f; g[q][1] = 1.f; \
            if (ok[q]) { d[q] = tile_desc(p, tt); v[q][0] = *(const f32x4*)(d[q].src + (size_t)k0 * d[q].sld + n4); v[q][1] = *(const f32x4*)(d[q].src + (size_t)(k0 + 32) * d[q].sld + n4); \
                if (d[q].gk) { g[q][0] = d[q].gk[k0]; g[q][1] = d[q].gk[k0 + 32]; } } } } while (0)
        int t = B;
        PREP_FETCH(t);
        while (t < NT_ALL) {
            TDesc dc[2]; bool okc[2];
#pragma unroll
            for (int q = 0; q < 2; ++q) { okc[q] = ok[q]; dc[q] = d[q]; LAS float* Tq = T + q * (64 * 65);
                if (ok[q]) {
#pragma unroll
                    for (int hh = 0; hh < 2; ++hh) { const f32x4 x = v[q][hh]; const float gg = g[q][hh]; LAS float* tp = Tq + (k0 + 32 * hh) * 65 + n4; tp[0] = x.x * gg; tp[1] = x.y * gg; tp[2] = x.z * gg; tp[3] = x.w * gg; } } }
            __syncthreads();
            const int tn = t + 2 * G;
            PREP_FETCH(tn);
#pragma unroll
            for (int q = 0; q < 2; ++q) if (okc[q]) { const LAS float* Tq = T + q * (64 * 65); float f[8];
#pragma unroll
                for (int j = 0; j < 8; ++j) f[j] = Tq[(kc * 8 + j) * 65 + no];
                u32x4 w; w.x = cvt_pk_bf16(f[0], f[1]); w.y = cvt_pk_bf16(f[2], f[3]); w.z = cvt_pk_bf16(f[4], f[5]); w.w = cvt_pk_bf16(f[6], f[7]);
                *(u32x4*)(dc[q].dst + (size_t)no * dc[q].dld + kc * 8) = w; }
            __syncthreads();
            t = tn;
        }
#undef PREP_FETCH
    }
    for (int i = B * 512 + tid; i < DEPTH * 2048 * 4; i += G * 512) { const int L = i >> 13, k = (i >> 2) & 2047, j = i & 3;
        ((float*)(p.ws + W_WF))[i] = p.g_attn[L * 2048 + k] * p.w_in[(size_t)L * 2048 * D_IN + (size_t)k * D_IN + 4096 + j]; }
    for (int row = B * 8 + wid; row < NR; row += G * 8) {
        const float* src = row < NP ? p.x_prompt + (size_t)row * 2048 : p.x_sample + (size_t)(row - NP) * 2048;
        u16* xb = (u16*)(p.ws + W_XBA) + (size_t)row * 2048; float ss = 0.f;
#pragma unroll
        for (int i = 0; i < 8; ++i) { const int c = (i * 64 + lane) * 4; const f32x4 v = *(const f32x4*)(src + c); ss += v.x * v.x + v.y * v.y + v.z * v.z + v.w * v.w;
            u32x2 w; w.x = cvt_pk_bf16(v.x, v.y); w.y = cvt_pk_bf16(v.z, v.w); *(u32x2*)(xb + c) = w; }
#pragma unroll
        for (int d = 1; d < 64; d <<= 1) ss += __shfl_xor(ss, d);
        if (lane < 32) ((float*)(p.ws + W_SSQA))[(size_t)row * 32 + lane] = lane == 0 ? ss : 0.f;
    }
    for (size_t i0 = (size_t)B * 512 + tid; i0 < (size_t)DEPTH * NR * 64; i0 += (size_t)G * 512 * 4) { f32x4 v[4]; u16* dp[4];
#pragma unroll
        for (int q = 0; q < 4; ++q) { const size_t i = i0 + (size_t)q * G * 512; dp[q] = nullptr;
            if (i < (size_t)DEPTH * NR * 64) { const int L = (int)(i / ((size_t)NR * 64)); const size_t r = i % ((size_t)NR * 64); const int row = (int)(r >> 6), c4 = (int)(r & 63) * 4;
                const float* src = row < NP ? p.p_prompt + ((size_t)L * NP + row) * 256 + c4 : p.p_sample + ((size_t)L * NS + (row - NP)) * 256 + c4;
                v[q] = *(const f32x4*)src; dp[q] = (u16*)(p.ws + W_PB) + ((size_t)L * NR + row) * 256 + c4; } }
#pragma unroll
        for (int q = 0; q < 4; ++q) if (dp[q]) { u32x2 w; w.x = cvt_pk_bf16(v[q].x, v[q].y); w.y = cvt_pk_bf16(v[q].z, v[q].w); *(u32x2*)dp[q] = w; } }
    for (size_t i0 = (size_t)B * 512 + tid; i0 < (size_t)2 * DEPTH * DEC_BATCH * PAST * 128; i0 += (size_t)G * 512 * 4) { f32x4 v[4]; u16* dp[4];
#pragma unroll
        for (int q = 0; q < 4; ++q) { const size_t i = i0 + (size_t)q * G * 512; dp[q] = nullptr;
            if (i < (size_t)2 * DEPTH * DEC_BATCH * PAST * 128) { const int br = (int)(i / ((size_t)DEPTH * DEC_BATCH * PAST * 128)); const size_t r = i % ((size_t)DEPTH * DEC_BATCH * PAST * 128);
                const int ls = (int)(r / (PAST * 128)), pos = (int)((r / 128) % PAST), c4 = (int)(r & 127) * 4;
                v[q] = *(const f32x4*)((br ? p.c_fxk : p.c_sbk) + ((size_t)ls * PAST + pos) * 512 + c4); dp[q] = (u16*)(p.ws + W_KBS) + ((size_t)ls * SL + pos) * 1024 + br * 512 + c4; } }
#pragma unroll
        for (int q = 0; q < 4; ++q) if (dp[q]) { u32x2 w; w.x = cvt_pk_bf16(v[q].x, v[q].y); w.y = cvt_pk_bf16(v[q].z, v[q].w); *(u32x2*)dp[q] = w; } }
    for (int s = B * 8 + wid; s < DEPTH * DEC_BATCH * 4; s += G * 8) { const int ls = s >> 2, hh = s & 3; const float* src = p.c_logf + (size_t)ls * PAST * 4 + hh; float v[16]; float run = 0.f;
#pragma unroll
        for (int i = 0; i < 16; ++i) { run += src[(size_t)(lane * 16 + i) * 4]; v[i] = run; }
        float x = run;
#pragma unroll
        for (int d = 1; d < 64; d <<= 1) { const float y = __shfl_up(x, d); if (lane >= d) x += y; }
        const float pre = x - run; float* dst = (float*)(p.ws + W_CCUM) + (size_t)ls * PAST * 4 + hh;
#pragma unroll
        for (int i = 0; i < 16; ++i) dst[(size_t)(lane * 16 + i) * 4] = pre + v[i];
    }
}

__device__ __forceinline__ void logf_items(int wv, const P& p, int layer, LAS unsigned char* lds, int blk0, int blk_end, int blk_step) {
    LAS f32x4* WfL = (LAS f32x4*)lds;
    LAS float* lf = (LAS float*)(lds + 40960);
    const int tid = opaque_tid(wv);
    const f32x4* Wf = (const f32x4*)(p.ws + W_WF) + (size_t)layer * 2048;
    const float* ssqA = (const float*)(p.ws + W_SSQA);
    for (int blk = blk0; blk < blk_end; blk += blk_step) {
        __syncthreads();
#pragma unroll
        for (int i = 0; i < 4; ++i) { const int k = tid + 512 * i; WfL[k + (k >> 9)] = Wf[k]; }
        __syncthreads();
        const int rl = tid >> 2, kq = tid & 3, row = blk * 128 + rl;
        const u16* xr = (const u16*)(p.ws + W_XBA) + (size_t)row * 2048 + kq * 512;
        f32x4 a = (f32x4){0.f, 0.f, 0.f, 0.f};
        for (int i = 0; i < 64; ++i) { const u32x4 xv = *(const u32x4*)(xr + i * 8); const LAS f32x4* w = WfL + kq * 513 + i * 8;
            a += w[0] * bf_lo(xv.x); a += w[1] * bf_hi(xv.x); a += w[2] * bf_lo(xv.y); a += w[3] * bf_hi(xv.y); a += w[4] * bf_lo(xv.z); a += w[5] * bf_hi(xv.z); a += w[6] * bf_lo(xv.w); a += w[7] * bf_hi(xv.w); }
#pragma unroll
        for (int j = 0; j < 4; ++j) { a[j] += __shfl_xor(a[j], 1); a[j] += __shfl_xor(a[j], 2); }
        if (kq == 0) { float s = 0.f; const f32x4* q = (const f32x4*)(ssqA + (size_t)row * 32);
#pragma unroll
            for (int i = 0; i < 8; ++i) { const f32x4 v = q[i]; s += (v.x + v.y) + (v.z + v.w); }
            const float rs = rsqrtf(s * (1.f / 2048.f) + EPS); f32x4 lg;
#pragma unroll
            for (int j = 0; j < 4; ++j) { const float f = a[j] * rs + p.b_f[layer * 4 + j]; lg[j] = fminf(f, 0.f) - log1pf(expf(-fabsf(f))); }
            float* o = row < NP ? p.out + O_LOGF_P + ((size_t)layer * NP + row) * 4 : p.out + O_LOGF_S + ((size_t)layer * NS + (row - NP)) * 4;
            *(f32x4*)o = lg; lf[rl * 4 + 0] = lg.x; lf[rl * 4 + 1] = lg.y; lf[rl * 4 + 2] = lg.z; lf[rl * 4 + 3] = lg.w; }
        __syncthreads();
        if (tid < 16) { const int seg = tid >> 2, hh = tid & 3; float run = 0.f; float* cin = (float*)(p.ws + W_CIN);
            for (int i = 0; i < 32; ++i) { run += lf[(seg * 32 + i) * 4 + hh]; cin[(size_t)(blk * 128 + seg * 32 + i) * 4 + hh] = run; }
            ((float*)(p.ws + W_SEGTOT))[(size_t)(blk * 4 + seg) * 4 + hh] = run; }
    }
    __syncthreads();
}

constexpr int TEAM = 32;
__device__ __forceinline__ void team_barrier(unsigned* ctr) {
    __threadfence();
    __syncthreads();
    if (threadIdx.x == 0) {
        __hip_atomic_fetch_add(ctr, 1u, __ATOMIC_RELEASE, __HIP_MEMORY_SCOPE_AGENT);
        while (__hip_atomic_load(ctr, __ATOMIC_ACQUIRE, __HIP_MEMORY_SCOPE_AGENT) < (unsigned)TEAM) __builtin_amdgcn_s_sleep(8);
    }
    __syncthreads();
    __threadfence();
}

constexpr int A_KB = 0, A_VB = 34816, A_CK = 71680, A_SEG = 72192, A_MISC = 74240, A_T = 76800;
constexpr int KROW = 272, VROW = 144;

__device__ __forceinline__ void attn_phase(int wv, const P& p, int layer, LAS unsigned char* lds) {
    LAS float* segpre = (LAS float*)(lds + A_SEG);
    LAS int* misc = (LAS int*)(lds + A_MISC);
    LAS float* wtot = (LAS float*)(lds + A_MISC + 128);
    unsigned* ctr = (unsigned*)(p.ws + W_CTR) + layer;
    const float* Cin = (const float*)(p.ws + W_CIN);
    const int bid = blockIdx.x; const bool team = bid < TEAM;
    unsigned* tbar = (unsigned*)(p.ws + W_CTR) + 16 + layer * 8;
    int sd_left = 0, tstate = team ? 0 : 2;
    if (team) {
        pg8::StaticOrder S1;
        if (layer > 0) {
            if (bid < 8) { pg8::Gemm g{(const u16*)(p.ws + W_OB), (const u16*)(p.ws + W_WTOUT) + (size_t)(layer - 1) * 2048 * 1024, NR, 2048, 1024}; S1.init_one(NP / 256, bid); EpiOut E{p, lds}; pg8::gemm_phase(wv, lds, g, S1, E); }
            else if (bid < 16) { pg8::Gemm g{(const u16*)(p.ws + W_PB) + (size_t)(layer - 1) * NR * 256, (const u16*)(p.ws + W_WTPLE) + (size_t)(layer - 1) * 2048 * 256, NR, 2048, 256}; S1.init_one(NP / 256, bid - 8); EpiPle E{p, lds}; pg8::gemm_phase(wv, lds, g, S1, E); }
            team_barrier(tbar + 0);
            if (bid < 8) { pg8::Gemm g{(const u16*)(p.ws + W_XBB), (const u16*)(p.ws + W_WTGATE) + (size_t)(layer - 1) * 2048 * 2048, NR, 2048, 2048}; S1.init_one(NP / 256, bid); EpiGate E{p, lds}; pg8::gemm_phase(wv, lds, g, S1, E); }
            team_barrier(tbar + 1);
        }
        if (bid < 16) { pg8::Gemm g{(const u16*)(p.ws + W_XBA), (const u16*)(p.ws + W_WTIN) + (size_t)layer * 4096 * 2048, NR, 4096, 2048}; S1.init_one(NP / 256, bid); EpiProj E{p, layer, lds}; pg8::gemm_phase(wv, lds, g, S1, E); }
        else if (bid < 18) logf_items(wv, p, layer, lds, NP / 128 + (bid - 16), NP / 128 + (bid - 16) + 1, 1);
        team_barrier(tbar + 2);
        sd_left = 2;
    }
    {
        const int t8 = opaque_tid(wv);
        __syncthreads();
        if (t8 < 8) { const float* st = (const float*)(p.ws + W_SEGTOT); float est[8];
#pragma unroll
            for (int q = 0; q < 8; ++q) { float e = 0.f; for (int i = 0; i < 16; ++i) e += st[(size_t)((q >> 2) * 512 + 256 + i) * 4 + (q & 3)]; est[q] = e; }
            int rk = 0; float mine = 0.f;
#pragma unroll
            for (int q = 0; q < 8; ++q) if (q == t8) mine = est[q];
#pragma unroll
            for (int q = 0; q < 8; ++q) rk += (est[q] > mine || (est[q] == mine && q < t8)) ? 1 : 0;
            misc[40 + rk] = t8; }
        __syncthreads();
    }
    for (;;) {
        if (tstate == 0 && sd_left == 0) {
            if (layer == DEPTH - 1) {
                pg8::StaticOrder S1;
                team_barrier(tbar + 3);
                if (bid < 8) { pg8::Gemm g{(const u16*)(p.ws + W_OB), (const u16*)(p.ws + W_WTOUT) + (size_t)layer * 2048 * 1024, NR, 2048, 1024}; S1.init_one(NP / 256, bid); EpiOut E{p, lds}; pg8::gemm_phase(wv, lds, g, S1, E); }
                else if (bid < 16) { pg8::Gemm g{(const u16*)(p.ws + W_PB) + (size_t)layer * NR * 256, (const u16*)(p.ws + W_WTPLE) + (size_t)layer * 2048 * 256, NR, 2048, 256}; S1.init_one(NP / 256, bid - 8); EpiPle E{p, lds}; pg8::gemm_phase(wv, lds, g, S1, E); }
                team_barrier(tbar + 4);
                if (bid < 8) { pg8::Gemm g{(const u16*)(p.ws + W_XBB), (const u16*)(p.ws + W_WTGATE) + (size_t)layer * 2048 * 2048, NR, 2048, 2048}; S1.init_one(NP / 256, bid); EpiGate E{p, lds}; pg8::gemm_phase(wv, lds, g, S1, E); }
            }
            tstate = 2;
        }
        const int tid = opaque_tid(wv), wid = __builtin_amdgcn_readfirstlane(tid >> 6), lane = tid & 63, r = lane & 31, h = lane >> 5;
        const int prow = 16 * (r >> 4) + 8 * ((r >> 2) & 1) + 4 * ((r >> 3) & 1) + (r & 3);
        __syncthreads();
        if (tid == 0) misc[0] = sd_left > 0 ? 1024 + (2 - sd_left) * TEAM + bid : (int)atomicAdd(ctr, 1u);
        __syncthreads();
        int item = misc[0];
        if (sd_left > 0) --sd_left; else if (item >= 1024) break;
        int head8, qpos0, nw, row0, ldv, sbi = 0, bi = 0; const u16 *Kb, *Vt; const bool prompt = item < 1024;
        if (prompt) { const int fx = item < 512, it2 = item & 511; int qt, rem; if (fx) { qt = 63 - (it2 & 63); rem = misc[40 + (it2 >> 6)]; } else { qt = 63 - (it2 >> 3); rem = it2 & 7; } bi = rem >> 2; head8 = (fx ? 4 : 0) + (rem & 3);     qpos0 = qt * 256; nw = 8; row0 = bi * SEQ + qpos0;
            Kb = (const u16*)(p.ws + W_KBP) + (size_t)bi * SEQ * 1024 + head8 * 128; Vt = (const u16*)(p.ws + W_VTP) + (size_t)(bi * 8 + head8) * 128 * SEQ; ldv = SEQ;
        } else { const int s = item - 1024; sbi = s >> 3; head8 = s & 7; qpos0 = PAST; nw = 1; row0 = NP + sbi * 32;
            Kb = (const u16*)(p.ws + W_KBS) + (size_t)(layer * 8 + sbi) * SL * 1024 + head8 * 128; Vt = (const u16*)(p.ws + W_VTS) + (size_t)((layer * 8 + sbi) * 8 + head8) * 128 * SL; ldv = SL; }
        const bool fox = head8 >= 4; const int hf = head8 & 3;
        const float* ccum = (const float*)(p.ws + W_CCUM) + (size_t)(layer * 8 + sbi) * PAST * 4 + hf;
        if (fox && prompt) {
            const int nseg = (qpos0 + 256) >> 5; const float v = tid < nseg ? ((const float*)(p.ws + W_SEGTOT))[(size_t)(bi * 512 + tid) * 4 + hf] : 0.f; float x = v;
#pragma unroll
            for (int d = 1; d < 64; d <<= 1) { const float y = __shfl_up(x, d); if (lane >= d) x += y; }
            if (lane == 63) wtot[wid] = x;
            __syncthreads();
            float pre = 0.f; for (int w = 0; w < wid; ++w) pre += wtot[w];
            segpre[tid] = pre + x - v;
            __syncthreads();
        }
        auto getC = [&](int pos) -> float {
            if (prompt) return segpre[pos >> 5] + Cin[(size_t)(bi * SEQ + pos) * 4 + hf];
            if (pos < PAST) return ccum[(size_t)pos * 4];
            if (pos < PAST + 32) return ccum[(size_t)(PAST - 1) * 4] + Cin[(size_t)(NP + sbi * 32 + pos - PAST) * 4 + hf];
            return 0.f; };
        const bool wact = wid < nw;
        bf16x8 qf[8];
        float cq2 = 0.f;
        const int qlo = qpos0 + 32 * wid, qhi = qlo + 31, qpos = qlo + r;
        if (wact) { const u16* qg = (const u16*)(p.ws + W_QB) + (size_t)(row0 + 32 * wid) * 1024 + head8 * 128; LAS unsigned char* Tq = lds + A_T + wid * (32 * 272);
            { u32x4 qr[8];
#pragma unroll
              for (int i = 0; i < 8; ++i) qr[i] = *(const u32x4*)(qg + (size_t)(4 * i + (lane >> 4)) * 1024 + (lane & 15) * 8);
#pragma unroll
              for (int i = 0; i < 8; ++i) *(LAS u32x4*)(Tq + (4 * i + (lane >> 4)) * 272 + (lane & 15) * 16) = qr[i]; }
#pragma unroll
            for (int kk = 0; kk < 8; ++kk) qf[kk] = *(const LAS bf16x8*)(Tq + r * 272 + (16 * kk + 8 * h) * 2);
            if (fox) cq2 = getC(qpos) * LOG2E; }
        else {
#pragma unroll
            for (int kk = 0; kk < 8; ++kk) qf[kk] = (bf16x8){0, 0, 0, 0, 0, 0, 0, 0}; }
        float qnK = 3.0e38f;
        if (fox && prompt) { const unsigned* ks = (const unsigned*)(p.ws + W_CTR) + 64 + ((layer * 2 + bi) * 4 + hf) * 4;
            const float kmax = sqrtf(__uint_as_float(ks[0]) + __uint_as_float(ks[1]) + __uint_as_float(ks[2]) + __uint_as_float(ks[3])) * 1.01f; float qn2 = 0.f;
#pragma unroll
            for (int kk = 0; kk < 8; ++kk)
#pragma unroll
                for (int i = 0; i < 8; ++i) { const float f = __uint_as_float(((unsigned)(unsigned short)qf[kk][i]) << 16); qn2 += f * f; }
            qn2 += __shfl_xor(qn2, 32); qnK = sqrtf(qn2) * 1.01f * kmax; }
        u32x4 kreg[2], vreg[2]; float ckreg = 0.f;
        const int krow_ = tid >> 4, kch = tid & 15, vrow_ = tid >> 3, vch = tid & 7;
#define LOAD_TILE(jt_) do { const int k0_ = (jt_) * 64; _Pragma("unroll") for (int pz = 0; pz < 2; ++pz) { \
            kreg[pz] = *(const u32x4*)(Kb + (size_t)(k0_ + krow_ + 32 * pz) * 1024 + kch * 8); \
            vreg[pz] = *(const u32x4*)(Vt + (size_t)(vrow_ + 64 * pz) * ldv + k0_ + vch * 8); } \
            if (fox && tid < 64) ckreg = getC(k0_ + tid) * LOG2E; } while (0)
#define STORE_TILE(buf_) do { _Pragma("unroll") for (int pz = 0; pz < 2; ++pz) { \
            *(LAS u32x4*)(lds + A_KB + (buf_) * 17408 + (krow_ + 32 * pz) * KROW + kch * 16) = kreg[pz]; \
            *(LAS u32x4*)(lds + A_VB + (buf_) * 18432 + (vrow_ + 64 * pz) * VROW + vch * 16) = vreg[pz]; } \
            if (fox && tid < 64) *(LAS float*)(lds + A_CK + (buf_) * 256 + tid * 4) = ckreg; } while (0)
        const int jt_top = (qpos0 + 32 * nw - 1) >> 6;
        LOAD_TILE(jt_top); STORE_TILE(0);
        __syncthreads();
        f32x16 o[4];
#pragma unroll
        for (int dt = 0; dt < 4; ++dt)
#pragma unroll
            for (int i = 0; i < 16; ++i) o[dt][i] = 0.f;
        float carry = 0.f, mrun = -1e30f, mref = 0.f, lsum = 0.f; bool wave_done = !wact;
        for (int jt = jt_top, it = 0; jt >= 0; --jt, ++it) {
            const int cur = it & 1; const bool more = jt > 0;
            if (more) LOAD_TILE(jt - 1);
            const int key0 = jt * 64;
            if (fox && prompt && !wave_done && key0 <= qhi) {
                const float ck63 = *(const LAS float*)(lds + A_CK + cur * 256 + 252);
                if (__all((qnK + cq2 - ck63) < (mrun - 155.f))) wave_done = true; }
            if (!wave_done && key0 <= qhi) {
                const bool diag = key0 + 63 >= qlo;
                const LAS unsigned char* kb = lds + A_KB + cur * 17408 + prow * KROW + 16 * h;
                const LAS unsigned char* vb = lds + A_VB + cur * 18432 + r * VROW + 16 * h;
                f32x16 sv[2];
                typedef float f32x2 __attribute__((ext_vector_type(2)));
                if (fox) {
                    const LAS float* ckb = (const LAS float*)(lds + A_CK + cur * 256) + 8 * h;
                    const float cqm = cq2 - mref; const f32x2 cqv = {cqm, cqm};
#pragma unroll
                    for (int kt = 0; kt < 2; ++kt)
#pragma unroll
                        for (int q4 = 0; q4 < 4; ++q4) { const f32x4 ck = *(const LAS f32x4*)(ckb + 32 * kt + 16 * (q4 >> 1) + 4 * (q4 & 1));
                            const f32x2 x0 = cqv - (f32x2){ck.x, ck.y}, x1 = cqv - (f32x2){ck.z, ck.w};
                            sv[kt][4 * q4 + 0] = x0.x; sv[kt][4 * q4 + 1] = x0.y; sv[kt][4 * q4 + 2] = x1.x; sv[kt][4 * q4 + 3] = x1.y; }
                } else {
#pragma unroll
                    for (int i = 0; i < 16; ++i) { sv[0][i] = 0.f; sv[1][i] = 0.f; } }
#pragma unroll
                for (int kk = 0; kk < 8; ++kk) { const bf16x8 a0 = *(const LAS bf16x8*)(kb + kk * 32); const bf16x8 a1 = *(const LAS bf16x8*)(kb + 32 * KROW + kk * 32);
                    sv[0] = __builtin_amdgcn_mfma_f32_32x32x16_bf16(a0, qf[kk], sv[0], 0, 0, 0); sv[1] = __builtin_amdgcn_mfma_f32_32x32x16_bf16(a1, qf[kk], sv[1], 0, 0, 0); }
                if (!fox) {
#pragma unroll
                    for (int kt = 1; kt >= 0; --kt) {
                        float sp[16], ex[16], tot[2];
#pragma unroll
                        for (int rg = 0; rg < 16; ++rg) { const int kpos = key0 + 32 * kt + 16 * (rg >> 3) + 8 * h + (rg & 7); const float z = sv[kt][rg];
                            const float spv = fmaxf(z, 0.f) + flog2(1.f + fexp2(-fabsf(z))); sp[rg] = (!diag || kpos < qpos) ? spv : 0.f; }
#pragma unroll
                        for (int c = 0; c < 2; ++c) { float run = 0.f;
#pragma unroll
                            for (int idx = 7; idx >= 0; --idx) { ex[8 * c + idx] = run; run += sp[8 * c + idx]; }
                            tot[c] = run; }
                        const float pt0 = __shfl_xor(tot[0], 32), pt1 = __shfl_xor(tot[1], 32);
                        const float off1 = carry + (h ? 0.f : pt1), off0 = carry + (h ? (pt1 + tot[1]) : (pt0 + tot[1] + pt1));
#pragma unroll
                        for (int rg = 0; rg < 16; ++rg) { const int kpos = key0 + 32 * kt + 16 * (rg >> 3) + 8 * h + (rg & 7);
                            const float e2 = sv[kt][rg] - sp[rg] - ((rg >= 8 ? off1 : off0) + ex[rg]);
                            sv[kt][rg] = (!diag || kpos < qpos) ? fexp2(e2) : 0.f; }
                        carry += (tot[0] + tot[1]) + (pt0 + pt1);
                    }
                    if (__all(carry > 152.f)) wave_done = true;
                } else {
                    if (diag) {
#pragma unroll
                        for (int kt = 0; kt < 2; ++kt)
#pragma unroll
                            for (int rg = 0; rg < 16; ++rg) { const int kpos = key0 + 32 * kt + 16 * (rg >> 3) + 8 * h + (rg & 7); if (kpos > qpos) sv[kt][rg] = -1e30f; } }
                    float mx = -1e30f;
#pragma unroll
                    for (int kt = 0; kt < 2; ++kt)
#pragma unroll
                        for (int i = 0; i < 8; ++i) mx = fmax3(mx, sv[kt][2 * i], sv[kt][2 * i + 1]);
                    mx = fmaxf(mx, __shfl_xor(mx, 32));
                    const bool firstt = mrun < -1e29f;
                    mrun = fmaxf(mrun, mref + mx);
                    if (firstt || __any(mx > 0.f)) {
                        const float dlt = firstt ? mx : fmaxf(mx, 0.f), alpha = fexp2(-dlt); mref += dlt; lsum *= alpha; const f32x2 dv = {dlt, dlt};
#pragma unroll
                        for (int dt = 0; dt < 4; ++dt) o[dt] *= alpha;
#pragma unroll
                        for (int kt = 0; kt < 2; ++kt)
#pragma unroll
                            for (int i = 0; i < 8; ++i) { const f32x2 t = (f32x2){sv[kt][2 * i], sv[kt][2 * i + 1]} - dv; sv[kt][2 * i] = t.x; sv[kt][2 * i + 1] = t.y; } }
                    f32x2 ps2 = {0.f, 0.f};
#pragma unroll
                    for (int kt = 0; kt < 2; ++kt)
#pragma unroll
                        for (int i = 0; i < 8; ++i) { f32x2 e; e.x = fexp2(sv[kt][2 * i]); e.y = fexp2(sv[kt][2 * i + 1]); sv[kt][2 * i] = e.x; sv[kt][2 * i + 1] = e.y; ps2 += e; }
                    lsum += ps2.x + ps2.y;
                }
#pragma unroll
                for (int kt = 0; kt < 2; ++kt)
#pragma unroll
                    for (int c = 0; c < 2; ++c) { union { u32x4 u; bf16x8 v; } pf;
                        pf.u.x = cvt_pk_bf16(sv[kt][8 * c + 0], sv[kt][8 * c + 1]); pf.u.y = cvt_pk_bf16(sv[kt][8 * c + 2], sv[kt][8 * c + 3]);
                        pf.u.z = cvt_pk_bf16(sv[kt][8 * c + 4], sv[kt][8 * c + 5]); pf.u.w = cvt_pk_bf16(sv[kt][8 * c + 6], sv[kt][8 * c + 7]);
#pragma unroll
                        for (int dt = 0; dt < 4; ++dt) { const bf16x8 vf = *(const LAS bf16x8*)(vb + dt * 32 * VROW + (32 * kt + 16 * c) * 2);
                            o[dt] = __builtin_amdgcn_mfma_f32_32x32x16_bf16(vf, pf.v, o[dt], 0, 0, 0); } }
            }
            if (more) STORE_TILE(cur ^ 1);
            if (lane == 0) misc[8 + cur * 8 + wid] = wave_done ? 1 : 0;
            __syncthreads();
            int alld = 1;
#pragma unroll
            for (int w = 0; w < 8; ++w) alld &= misc[8 + cur * 8 + w];
            if (alld) break;
        }
#undef LOAD_TILE
#undef STORE_TILE
        if (wact) {
            if (fox) { lsum += __shfl_xor(lsum, 32); const float inv = 1.f / lsum;
#pragma unroll
                for (int dt = 0; dt < 4; ++dt) o[dt] *= inv; }
            float ss = 0.f;
#pragma unroll
            for (int dt = 0; dt < 4; ++dt)
#pragma unroll
                for (int i = 0; i < 16; ++i) ss += o[dt][i] * o[dt][i];
            ss += __shfl_xor(ss, 32);
            const float rn = rsqrtf(ss * (1.f / 128.f) + EPS);
            const float* gp = (fox ? p.g_ofox : p.g_osb) + layer * 512 + hf * 128 + 4 * h;
            const u16* zg = (const u16*)(p.ws + W_ZB) + (size_t)(row0 + 32 * wid) * 1024 + head8 * 128;
            u16* og = (u16*)(p.ws + W_OB) + (size_t)(row0 + 32 * wid) * 1024 + head8 * 128;
            LAS unsigned char* Tz = lds + A_T + wid * (32 * 272);
            { u32x4 zr[8];
#pragma unroll
              for (int i = 0; i < 8; ++i) zr[i] = *(const u32x4*)(zg + (size_t)(4 * i + (lane >> 4)) * 1024 + (lane & 15) * 8);
#pragma unroll
              for (int i = 0; i < 8; ++i) *(LAS u32x4*)(Tz + (4 * i + (lane >> 4)) * 272 + (lane & 15) * 16) = zr[i]; }
#pragma unroll
            for (int dt = 0; dt < 4; ++dt)
#pragma unroll
                for (int bb = 0; bb < 4; ++bb) { const int d = 32 * dt + 8 * bb; const f32x4 g = *(const f32x4*)(gp + d); LAS u32x2* tp = (LAS u32x2*)(Tz + r * 272 + (d + 4 * h) * 2); const u32x2 z2 = *tp;
                    const float v0 = o[dt][4 * bb + 0] * rn * g.x * bf_lo(z2.x), v1 = o[dt][4 * bb + 1] * rn * g.y * bf_hi(z2.x), v2 = o[dt][4 * bb + 2] * rn * g.z * bf_lo(z2.y), v3 = o[dt][4 * bb + 3] * rn * g.w * bf_hi(z2.y);
                    u32x2 w; w.x = cvt_pk_bf16(v0, v1); w.y = cvt_pk_bf16(v2, v3); *tp = w; }
#pragma unroll
            for (int i = 0; i < 8; ++i) { const u32x4 w = *(const LAS u32x4*)(Tz + (4 * i + (lane >> 4)) * 272 + (lane & 15) * 16); *(u32x4*)(og + (size_t)(4 * i + (lane >> 4)) * 1024 + (lane & 15) * 8) = w; }
        }
    }
}

__device__ __forceinline__ void final_phase(int wv, const P& p) {
    const int tid = opaque_tid(wv), wid = tid >> 6, lane = tid & 63;
    const float* ssqA = (const float*)(p.ws + W_SSQA);
    for (int row = blockIdx.x * 8 + wid; row < NR; row += gridDim.x * 8) {
        float s = lane < 32 ? ssqA[(size_t)row * 32 + lane] : 0.f;
#pragma unroll
        for (int d = 1; d < 64; d <<= 1) s += __shfl_xor(s, d);
        const float rs = rsqrtf(s * (1.f / 2048.f) + EPS);
        float* xo = p.out + (size_t)row * 2048; const u16* xb = (const u16*)(p.ws + W_XBA) + (size_t)row * 2048;
#pragma unroll
        for (int i = 0; i < 8; ++i) { const int c = (i * 64 + lane) * 4; const u32x2 xw = *(const u32x2*)(xb + c); const f32x4 g = *(const f32x4*)(p.g_final + c);
            f32x4 v; v.x = bf_lo(xw.x) * rs * g.x; v.y = bf_hi(xw.x) * rs * g.y; v.z = bf_lo(xw.y) * rs * g.z; v.w = bf_hi(xw.y) * rs * g.w; *(f32x4*)(xo + c) = v; }
    }
}

constexpr int LDS_BYTES = 131072 + 8 * 2304;

__global__ __launch_bounds__(512, 2) void fwd_megakernel(P p) {
    extern __shared__ __attribute__((aligned(16))) unsigned char shm[];
    LAS unsigned char* lds = (LAS unsigned char*)shm;
    cg::grid_group grid = cg::this_grid();
    const int wv = __builtin_amdgcn_readfirstlane(threadIdx.x >> 6);
    prep_phase(wv, p, lds);
    grid.sync();
    pg8::StaticOrder S;
    for (int layer_ = 0; layer_ < DEPTH; ++layer_) {
        int layer = layer_, bid = (int)blockIdx.x, G = (int)gridDim.x; asm volatile("" : "+s"(layer), "+s"(bid), "+s"(G));
        {
            pg8::Gemm g{(const u16*)(p.ws + W_XBA), (const u16*)(p.ws + W_WTIN) + (size_t)layer * 4096 * 2048, NP, 4096, 2048};
            S.init(g.M, g.N, G, bid); EpiProj E{p, layer, lds};
            pg8::gemm_phase(wv, lds, g, S, E);
            logf_items(wv, p, layer, lds, bid, NP / 128, G);
        }
        grid.sync();
        attn_phase(wv, p, layer, lds);
        grid.sync();
        {
            for (int rep = 0; rep < 2; ++rep) {
                if ((rep ^ ((bid >> 2) & 1)) == 0) {
                    pg8::Gemm g{(const u16*)(p.ws + W_OB), (const u16*)(p.ws + W_WTOUT) + (size_t)layer * 2048 * 1024, NP, 2048, 1024};
                    S.init(g.M, g.N, G, bid); EpiOut E{p, lds};
                    pg8::gemm_phase(wv, lds, g, S, E);
                } else {
                    pg8::Gemm g2{(const u16*)(p.ws + W_PB) + (size_t)layer * NR * 256, (const u16*)(p.ws + W_WTPLE) + (size_t)layer * 2048 * 256, NP, 2048, 256};
                    S.init(g2.M, g2.N, G, bid); EpiPle E2{p, lds};
                    pg8::gemm_phase(wv, lds, g2, S, E2);
                }
            }
        }
        grid.sync();
        {
            pg8::Gemm g{(const u16*)(p.ws + W_XBB), (const u16*)(p.ws + W_WTGATE) + (size_t)layer * 2048 * 2048, NP, 2048, 2048};
            S.init(g.M, g.N, G, bid); EpiGate E{p, lds};
            pg8::gemm_phase(wv, lds, g, S, E);
        }
        grid.sync();
    }
    final_phase(wv, p);
}

extern "C" void kernel_launch(void* const* d_in, const int* in_sizes, int n_in, void* d_out, int out_size, void* d_ws, size_t ws_size, hipStream_t stream) {
    static int grid_blocks = 0;
    if (!grid_blocks) {
        if (n_in != 19 || (size_t)out_size != OUT_TOTAL || ws_size < W_END) { fprintf(stderr, "kernel_launch: unexpected shapes: n_in %d out %d (want %zu) ws %zu (want %zu)\n", n_in, out_size, OUT_TOTAL, ws_size, W_END); grid_blocks = -1; return; }
        int dev = 0, cus = 0, per_cu = 0;
        hipGetDevice(&dev);
        hipDeviceGetAttribute(&cus, hipDeviceAttributeMultiprocessorCount, dev);
        if (hipFuncSetAttribute((const void*)fwd_megakernel, hipFuncAttributeMaxDynamicSharedMemorySize, LDS_BYTES) != hipSuccess) fprintf(stderr, "kernel_launch: hipFuncSetAttribute failed\n");
        if (hipOccupancyMaxActiveBlocksPerMultiprocessor(&per_cu, (const void*)fwd_megakernel, 512, LDS_BYTES) != hipSuccess || per_cu < 1) { fprintf(stderr, "kernel_launch: occupancy query gave %d\n", per_cu); per_cu = 1; }
        (void)hipGetLastError();
        grid_blocks = cus * per_cu;
    }
    if (grid_blocks < 0) return;
    P p{};
    const float** f = (const float**)&p;
    for (int i = 0; i < 19; ++i) f[i] = (const float*)d_in[i];
    p.out = (float*)d_out; p.ws = (unsigned char*)d_ws;
    void* args[] = {&p};
    hipError_t e = hipLaunchCooperativeKernel((const void*)fwd_megakernel, dim3(grid_blocks), dim3(512), args, LDS_BYTES, stream);
    if (e != hipSuccess) fprintf(stderr, "cooperative launch failed: %s (grid %d)\n", hipGetErrorString(e), grid_blocks);
}
```

```cpp
#include <hip/hip_runtime.h>
#include <hip/hip_cooperative_groups.h>
#include <cstdio>
namespace cg = cooperative_groups;

#define LAS __attribute__((address_space(3)))
typedef unsigned short u16;
typedef short bf16x8 __attribute__((ext_vector_type(8)));
typedef float f32x4 __attribute__((ext_vector_type(4)));
typedef float f32x16 __attribute__((ext_vector_type(16)));
typedef unsigned u32x2 __attribute__((ext_vector_type(2)));
typedef unsigned u32x4 __attribute__((ext_vector_type(4)));

constexpr int D_MODEL = 2048, SEQ = 16384, DEPTH = 4, DEC_BATCH = 8, DEC_SEQ = 32, PAST = 1024;
constexpr int NP = 2 * SEQ, NS = DEC_BATCH * DEC_SEQ, NR = NP + NS;
constexpr int DMIX = 1024, D_IN = 4100, PLE = 256;
constexpr int SL = 1088;
constexpr float EPS = 1e-6f;
constexpr float LOG2E = 1.4426950408889634f;
constexpr float QSCALE = 0.08838834764831845f * LOG2E;
constexpr int NITEMS = 1024 + 64;

constexpr size_t O_Y = 0;
constexpr size_t O_KV_P = (size_t)NR * D_MODEL;
constexpr size_t KVP = (size_t)DEPTH * NP * 512;
constexpr size_t O_LOGF_P = O_KV_P + 4 * KVP;
constexpr size_t O_KV_S = O_LOGF_P + (size_t)DEPTH * NP * 4;
constexpr size_t KVS = (size_t)DEPTH * NS * 512;
constexpr size_t O_LOGF_S = O_KV_S + 4 * KVS;
constexpr size_t OUT_TOTAL = O_LOGF_S + (size_t)DEPTH * NS * 4;

constexpr size_t al256(size_t x) { return (x + 255) & ~(size_t)255; }
constexpr size_t W_WTIN = 0;
constexpr size_t W_WTOUT = W_WTIN + (size_t)DEPTH * 4096 * 2048 * 2;
constexpr size_t W_WTPLE = W_WTOUT + (size_t)DEPTH * 2048 * 1024 * 2;
constexpr size_t W_WTGATE = W_WTPLE + (size_t)DEPTH * 2048 * 256 * 2;
constexpr size_t W_WF = W_WTGATE + (size_t)DEPTH * 2048 * 2048 * 2;
constexpr size_t W_XBA = W_WF + (size_t)DEPTH * 2048 * 4 * 4;
constexpr size_t W_PB = W_XBA + (size_t)NR * 2048 * 2;
constexpr size_t W_R = W_PB + (size_t)DEPTH * NR * 256 * 2;
constexpr size_t W_QB = W_R;
constexpr size_t W_KBP = W_QB + (size_t)NR * 1024 * 2;
constexpr size_t W_VTP = W_KBP + (size_t)NP * 1024 * 2;
constexpr size_t W_ZB = W_VTP + (size_t)NP * 1024 * 2;
constexpr size_t W_PLEB = W_R;
constexpr size_t W_XBB = W_R + al256((size_t)NR * 2048 * 2);
constexpr size_t R_SIZE = 2 * al256((size_t)NR * 2048 * 2) + 4096;
static_assert(W_ZB + (size_t)NR * 1024 * 2 <= W_R + R_SIZE, "region R too small");
constexpr size_t W_KBS = W_R + R_SIZE;
constexpr size_t W_VTS = W_KBS + (size_t)DEPTH * DEC_BATCH * SL * 1024 * 2;
constexpr size_t W_OB = W_VTS + (size_t)DEPTH * DEC_BATCH * 8 * 128 * SL * 2;
constexpr size_t W_SSQA = W_OB + (size_t)NR * 1024 * 2;
constexpr size_t W_SSQB = W_SSQA + (size_t)NR * 32 * 4;
constexpr size_t W_CIN = W_SSQB + (size_t)NR * 32 * 4;
constexpr size_t W_SEGTOT = W_CIN + (size_t)NR * 4 * 4;
constexpr size_t W_CCUM = W_SEGTOT + al256((size_t)(NR / 32) * 4 * 4);
constexpr size_t W_CTR = W_CCUM + (size_t)DEPTH * DEC_BATCH * PAST * 4 * 4;
constexpr size_t W_PLES = W_CTR + 4096;
constexpr size_t W_END = W_PLES + (size_t)NS * 2048 * 2;

struct P {
    const float *x_prompt, *x_sample, *p_prompt, *p_sample, *c_sbk, *c_sbv, *c_fxk, *c_fxv, *c_logf, *w_in, *b_f, *g_attn, *g_osb, *g_ofox, *w_out, *w_ple, *g_ple, *w_gate, *g_final;
    float* out;
    unsigned char* ws;
};

__device__ __forceinline__ unsigned cvt_pk_bf16(float lo, float hi) { unsigned r; asm volatile("v_cvt_pk_bf16_f32 %0, %1, %2" : "=v"(r) : "v"(lo), "v"(hi)); return r; }
__device__ __forceinline__ float bf_lo(unsigned w) { return __uint_as_float(w << 16); }
__device__ __forceinline__ float bf_hi(unsigned w) { return __uint_as_float(w & 0xffff0000u); }
__device__ __forceinline__ float fexp2(float x) { return __builtin_amdgcn_exp2f(x); }
__device__ __forceinline__ float flog2(float x) { return __builtin_amdgcn_logf(x); }
__device__ __forceinline__ float fmax3(float a, float b, float c) { float r; asm("v_max3_f32 %0, %1, %2, %3" : "=v"(r) : "v"(a), "v"(b), "v"(c)); return r; }
__device__ __forceinline__ int opaque_tid(int wv) { int l; asm volatile("v_mbcnt_lo_u32_b32 %0, -1, 0\n\tv_mbcnt_hi_u32_b32 %0, -1, %0" : "=v"(l)); return wv * 64 + l; }

namespace pg8 {
constexpr int BM = 256, BK = 64, HALF = 128, HTB = HALF * BK * 2, STAGE_BYTES = 8 * HTB, NXCD = 8, WGM = 8;
__host__ __device__ __forceinline__ int lds_byte(int r, int c) { const int st = (r >> 4) * 2 + (c >> 5), rr = r & 15, cc = c & 31, ob = rr * 64 + cc * 2; return st * 1024 + (ob ^ (((ob >> 9) & 1) << 5)); }
__host__ __device__ __forceinline__ void stage_rc(int b, int& R, int& C) { const int st = b / 1024, sb = b % 1024, swz = sb ^ (((sb >> 9) & 1) << 5); R = (st >> 1) * 16 + swz / 64; C = (st & 1) * 32 + (swz % 64) / 2; }
struct Unit { int pm, pn; };
struct Gemm { const u16* A; const u16* Bt; int M, N, K; };
struct StaticOrder {
    int nM, nN, nwg, G, c;
    int one_pm, one_pn;
    __device__ void init(int M, int N, int G_, int c_) { nM = M / BM; nN = N / BM; nwg = nM * nN; G = G_; c = c_; one_pm = -1; one_pn = 0; }
    __device__ void init_one(int pm, int pn) { nM = 1; nN = 1; nwg = 1; G = 1; c = 0; one_pm = pm; one_pn = pn; }
    __device__ bool next(int i, Unit& u) const {
        if (one_pm >= 0) { if (i > 0) return false; u.pm = one_pm; u.pn = one_pn; return true; }
        const long L = (long)i * G + c; if (L >= nwg) return false;
        int wgid = (int)L; { const int q = nwg / NXCD, r = nwg % NXCD, xcd = wgid % NXCD, off = wgid / NXCD; wgid = (xcd < r ? xcd * (q + 1) : r * (q + 1) + (xcd - r) * q) + off; }
        const int nig = WGM * nN, gid = wgid / nig, fm = gid * WGM, gsz = (nM - fm) < WGM ? (nM - fm) : WGM;
        u.pm = fm + ((wgid % nig) % gsz); u.pn = (wgid % nig) / gsz; return true;
    }
};

template <class Epi>
__device__ __forceinline__ void gemm_phase(int wv, LAS unsigned char* lds, const Gemm g, const StaticOrder& S, const Epi& E, const int skew_ticks = 0) {
    const int tid = opaque_tid(wv), wid = __builtin_amdgcn_readfirstlane(tid >> 6), lane = tid & 63, wr = wid >> 2, wc = wid & 3, fr = lane & 15, fq = lane >> 4;
    const int K = g.K, nt = K / BK;
    unsigned voffA[2], voffB0[2];
#pragma unroll
    for (int i = 0; i < 2; ++i) { int R, C; stage_rc(tid * 16 + i * 8192, R, C); voffA[i] = (unsigned)(R * K + C) * 2u;
        const int rho = R & 31, pr = 8 * ((rho & 15) >> 2) + 4 * (rho >> 4) + (rho & 3), Rb = 64 * (R >> 5) + pr;
        voffB0[i] = (unsigned)(Rb * K + C) * 2u; }
    const size_t b1step = (size_t)32 * K * 2;
    const size_t kstep = (size_t)(BK * 2);
    const size_t hstep = (size_t)HALF * K * 2;
    const size_t tstep = 2 * hstep;
    const unsigned ldsw = (unsigned)wid * 1024u;
    const int aoff = lds_byte(wr * 64 + fr, fq * 8), boff = lds_byte(wc * 32 + fr, fq * 8);
#define PG8_SA(b, h) (((b) * 2 + (h)) * HTB)
#define PG8_SB(b, h) ((4 + (b) * 2 + (h)) * HTB)
#define PG8_STAGE(bufoff, gbase, voff) do { _Pragma("unroll") for (int _i = 0; _i < 2; ++_i) \
        __builtin_amdgcn_global_load_lds((const unsigned*)((const char*)(gbase) + (voff)[_i]), (LAS unsigned*)(lds + (bufoff) + ldsw + _i * 8192), 16, 0, 0); } while (0)
#define PG8_LDA(dst, b, h) do { _Pragma("unroll") for (int m = 0; m < 4; ++m) _Pragma("unroll") for (int k = 0; k < 2; ++k) dst[m][k] = *(const LAS bf16x8*)(lds + PG8_SA(b, h) + aoff + m * 2048 + k * 1024); } while (0)
#define PG8_LDB(dst, b, h) do { _Pragma("unroll") for (int n = 0; n < 2; ++n) _Pragma("unroll") for (int k = 0; k < 2; ++k) dst[n][k] = *(const LAS bf16x8*)(lds + PG8_SB(b, h) + boff + n * 2048 + k * 1024); } while (0)
#define PG8_MMA(ai, bj, At, Bt) do { __builtin_amdgcn_s_setprio(1); _Pragma("unroll") for (int m = 0; m < 4; ++m) _Pragma("unroll") for (int n = 0; n < 2; ++n) _Pragma("unroll") for (int k = 0; k < 2; ++k) \
        acc[ai][bj][m][n] = __builtin_amdgcn_mfma_f32_16x16x32_bf16(Bt[n][k], At[m][k], acc[ai][bj][m][n], 0, 0, 0); __builtin_amdgcn_s_setprio(0); } while (0)
#define PG8_WAIT_V(n) asm volatile("s_waitcnt vmcnt(" #n ")" ::: "memory")
#define PG8_WAIT_L(n) asm volatile("s_waitcnt lgkmcnt(" #n ")" ::: "memory")
#define PG8_BAR __builtin_amdgcn_s_barrier()
#define PG8_SCHED __builtin_amdgcn_sched_barrier(0)
    Unit cur, nxt; int ui = 0;
    if (!S.next(0, cur)) return;
    if (skew_ticks > 0) {
        const unsigned long long t0 = __builtin_amdgcn_s_memrealtime();
        while ((long long)(__builtin_amdgcn_s_memrealtime() - t0) < (long long)skew_ticks) __builtin_amdgcn_s_sleep(32);
    }
    f32x4 acc[2][2][4][2];
#pragma unroll
    for (int a = 0; a < 2; ++a)
#pragma unroll
        for (int b = 0; b < 2; ++b)
#pragma unroll
            for (int m = 0; m < 4; ++m)
#pragma unroll
                for (int n = 0; n < 2; ++n) acc[a][b][m][n] = (f32x4){0.f, 0.f, 0.f, 0.f};
    bf16x8 At[4][2], B0[2][2], B1[2][2];
    const char* cA = (const char*)g.A + (size_t)cur.pm * tstep; const char* cB = (const char*)g.Bt + (size_t)cur.pn * tstep;
    PG8_STAGE(PG8_SB(0, 0), cB, voffB0); PG8_STAGE(PG8_SA(0, 0), cA, voffA); PG8_STAGE(PG8_SB(0, 1), cB + b1step, voffB0); PG8_STAGE(PG8_SA(0, 1), cA + hstep, voffA);
    if (wr == 1) PG8_BAR;
    PG8_WAIT_V(4); PG8_BAR;
    PG8_STAGE(PG8_SB(1, 0), cB + kstep, voffB0); PG8_STAGE(PG8_SA(1, 0), cA + kstep, voffA); PG8_STAGE(PG8_SB(1, 1), cB + kstep + b1step, voffB0);
    PG8_WAIT_V(6); PG8_BAR;
    for (;;) {
        const bool has_next = S.next(ui + 1, nxt);
        const char* nA = has_next ? (const char*)g.A + (size_t)nxt.pm * tstep : cA; const char* nB = has_next ? (const char*)g.Bt + (size_t)nxt.pn * tstep : cB;
        for (int t = 0; t < nt; t += 2) {
            const bool last = (t == nt - 2);
            const char* a1 = cA + (size_t)(t + 1) * kstep;
            const char* a2 = last ? nA : cA + (size_t)(t + 2) * kstep; const char* b2 = last ? nB : cB + (size_t)(t + 2) * kstep;
            const char* a3 = a2 + kstep; const char* b3 = b2 + kstep;
            PG8_LDB(B0, 0, 0); PG8_SCHED; PG8_LDA(At, 0, 0); PG8_STAGE(PG8_SA(1, 1), a1 + hstep, voffA);
            PG8_WAIT_L(8); PG8_BAR; PG8_WAIT_L(0); PG8_MMA(0, 0, At, B0); PG8_BAR; PG8_SCHED;
            PG8_LDB(B1, 0, 1); PG8_STAGE(PG8_SB(0, 0), b2, voffB0);
            PG8_BAR; PG8_WAIT_L(0); PG8_MMA(0, 1, At, B1); PG8_BAR;
            PG8_LDA(At, 0, 1); PG8_STAGE(PG8_SA(0, 0), a2, voffA);
            PG8_BAR; PG8_WAIT_L(0); PG8_MMA(1, 0, At, B0); PG8_BAR; PG8_SCHED;
            PG8_STAGE(PG8_SB(0, 1), b2 + b1step, voffB0);
            PG8_WAIT_V(6); PG8_BAR; PG8_MMA(1, 1, At, B1); PG8_BAR;
            PG8_LDB(B0, 1, 0); PG8_SCHED; PG8_LDA(At, 1, 0); PG8_STAGE(PG8_SA(0, 1), a2 + hstep, voffA);
            PG8_WAIT_L(8); PG8_BAR; PG8_WAIT_L(0); PG8_MMA(0, 0, At, B0); PG8_BAR; PG8_SCHED;
            PG8_LDB(B1, 1, 1); PG8_STAGE(PG8_SB(1, 0), b3, voffB0);
            PG8_BAR; PG8_WAIT_L(0); PG8_MMA(0, 1, At, B1); PG8_BAR;
            PG8_LDA(At, 1, 1); PG8_STAGE(PG8_SA(1, 0), a3, voffA);
            PG8_BAR; PG8_WAIT_L(0); PG8_MMA(1, 0, At, B0); PG8_BAR; PG8_SCHED;
            PG8_STAGE(PG8_SB(1, 1), b3 + b1step, voffB0);
            PG8_WAIT_V(6); PG8_BAR; PG8_MMA(1, 1, At, B1); PG8_BAR;
        }
        { int fr2 = fr, fq2 = fq; asm volatile("" : "+v"(fr2), "+v"(fq2)); E(acc, cur, wr, wc, fr2, fq2); }
        if (!has_next) break;
#pragma unroll
        for (int a = 0; a < 2; ++a)
#pragma unroll
            for (int b = 0; b < 2; ++b)
#pragma unroll
                for (int m = 0; m < 4; ++m)
#pragma unroll
                    for (int n = 0; n < 2; ++n) acc[a][b][m][n] = (f32x4){0.f, 0.f, 0.f, 0.f};
        cur = nxt; cA = nA; cB = nB; ++ui;
    }
    PG8_WAIT_V(0);
    if (wr == 0) PG8_BAR;
    PG8_BAR;
#undef PG8_SA
#undef PG8_SB
#undef PG8_STAGE
#undef PG8_LDA
#undef PG8_LDB
#undef PG8_MMA
#undef PG8_WAIT_V
#undef PG8_WAIT_L
#undef PG8_BAR
#undef PG8_SCHED
}
}


__device__ __forceinline__ float row_rstd(const float* ssq, int row, int fq) {
    const f32x4* q = (const f32x4*)(ssq + (size_t)row * 32 + fq * 8);
    const f32x4 a = q[0], b = q[1];
    float s = (a.x + a.y) + (a.z + a.w) + (b.x + b.y) + (b.z + b.w);
    s += __shfl_xor(s, 16); s += __shfl_xor(s, 32);
    return rsqrtf(s * (1.f / 2048.f) + EPS);
}
__device__ __forceinline__ u32x4 pack8(const f32x4 a, const f32x4 b) { u32x4 w; w.x = cvt_pk_bf16(a.x, a.y); w.y = cvt_pk_bf16(a.z, a.w); w.z = cvt_pk_bf16(b.x, b.y); w.w = cvt_pk_bf16(b.z, b.w); return w; }

constexpr int TRS = 144, TIO_OFF = 131072, TIO_WAVE = 2304;
__device__ __forceinline__ void tio_store(LAS unsigned char* T, u16* g0, int lane, int fr, int fq, const u32x4 w0, const u32x4 w1) {
    *(LAS u32x4*)(T + fr * TRS + fq * 16) = w0; *(LAS u32x4*)(T + fr * TRS + 64 + fq * 16) = w1;
    const int rr = lane >> 3, ch = lane & 7;
    const u32x4 a = *(const LAS u32x4*)(T + rr * TRS + ch * 16), b = *(const LAS u32x4*)(T + (8 + rr) * TRS + ch * 16);
    *(u32x4*)(g0 + (size_t)rr * 2048 + ch * 8) = a; *(u32x4*)(g0 + (size_t)(8 + rr) * 2048 + ch * 8) = b;
}
__device__ __forceinline__ void tio_load(const u16* g0, int lane, u32x4& a, u32x4& b) { const int rr = lane >> 3, ch = lane & 7; a = *(const u32x4*)(g0 + (size_t)rr * 2048 + ch * 8); b = *(const u32x4*)(g0 + (size_t)(8 + rr) * 2048 + ch * 8); }
__device__ __forceinline__ void tio_unpack(LAS unsigned char* T, int lane, int fr, int fq, const u32x4 a, const u32x4 b, u32x4& w0, u32x4& w1) {
    const int rr = lane >> 3, ch = lane & 7;
    *(LAS u32x4*)(T + rr * TRS + ch * 16) = a; *(LAS u32x4*)(T + (8 + rr) * TRS + ch * 16) = b;
    w0 = *(const LAS u32x4*)(T + fr * TRS + fq * 16); w1 = *(const LAS u32x4*)(T + fr * TRS + 64 + fq * 16);
}

__device__ __forceinline__ void tio_store_f32(LAS unsigned char* T, float* g0, size_t gpitch, int lane, int fr, int fq, const f32x4 v0, const f32x4 v1) {
    *(LAS f32x4*)(T + fr * TRS + fq * 32) = v0; *(LAS f32x4*)(T + fr * TRS + fq * 32 + 16) = v1;
    const int rr = lane >> 3, ch = lane & 7;
    const f32x4 a = *(const LAS f32x4*)(T + rr * TRS + ch * 16), b = *(const LAS f32x4*)(T + (8 + rr) * TRS + ch * 16);
    __builtin_nontemporal_store(a, (f32x4*)(g0 + (size_t)rr * gpitch + ch * 4)); __builtin_nontemporal_store(b, (f32x4*)(g0 + (size_t)(8 + rr) * gpitch + ch * 4));
}
__device__ __forceinline__ void tio_store_p(LAS unsigned char* T, u16* g0, size_t gpitch, int lane, int fr, int fq, const u32x4 w0, const u32x4 w1) {
    *(LAS u32x4*)(T + fr * TRS + fq * 16) = w0; *(LAS u32x4*)(T + fr * TRS + 64 + fq * 16) = w1;
    const int rr = lane >> 3, ch = lane & 7;
    const u32x4 a = *(const LAS u32x4*)(T + rr * TRS + ch * 16), b = *(const LAS u32x4*)(T + (8 + rr) * TRS + ch * 16);
    *(u32x4*)(g0 + (size_t)rr * gpitch + ch * 8) = a; *(u32x4*)(g0 + (size_t)(8 + rr) * gpitch + ch * 8) = b;
}

struct EpiProj {
    const P& p; int layer; LAS unsigned char* lds;
    __device__ __forceinline__ void operator()(const f32x4 (&acc)[2][2][4][2], const pg8::Unit& u, int wr, int wc, int fr, int fq) const {
        const int lane = fq * 16 + fr; LAS unsigned char* T = lds + TIO_OFF + (wr * 4 + wc) * TIO_WAVE; const int cww = (u.pn & 1) * 256 + wc * 64;
        const int group = u.pn >> 1, type = group & 3, br = group >> 2;
        const int cgb = (u.pn & 1) * 256 + wc * 64 + 8 * fq;
        const float* ssqA = (const float*)(p.ws + W_SSQA);
        u16* Qb = (u16*)(p.ws + W_QB); u16* Zb = (u16*)(p.ws + W_ZB);
        float kmx = 0.f;
        float rsv[8];
#pragma unroll
        for (int i = 0; i < 8; ++i) rsv[i] = row_rstd(ssqA, u.pm * 256 + (i >> 2) * 128 + wr * 64 + (i & 3) * 16 + fr, fq);
#pragma unroll
        for (int ai = 0; ai < 2; ++ai)
#pragma unroll
            for (int m = 0; m < 4; ++m) {
                const int row = u.pm * 256 + ai * 128 + wr * 64 + m * 16 + fr;
                const float rs = rsv[ai * 4 + m];
                if (type == 0) {
                    const float sc = rs * QSCALE;
                    tio_store_p(T, Qb + (size_t)(row - fr) * 1024 + br * 512 + cww, 1024, lane, fr, fq, pack8(acc[ai][0][m][0] * sc, acc[ai][0][m][1] * sc), pack8(acc[ai][1][m][0] * sc, acc[ai][1][m][1] * sc));
                } else if (type == 3) {
                    u32x4 zw[2];
#pragma unroll
                    for (int bj = 0; bj < 2; ++bj) { f32x4 v0 = acc[ai][bj][m][0] * rs, v1 = acc[ai][bj][m][1] * rs;
#pragma unroll
                        for (int j = 0; j < 4; ++j) { v0[j] = v0[j] * __builtin_amdgcn_rcpf(1.f + __expf(-v0[j])); v1[j] = v1[j] * __builtin_amdgcn_rcpf(1.f + __expf(-v1[j])); }
                        zw[bj] = pack8(v0, v1); }
                    tio_store_p(T, Zb + (size_t)(row - fr) * 1024 + br * 512 + cww, 1024, lane, fr, fq, zw[0], zw[1]);
                } else {
                    float* o32; u16* kb; u16* vt; size_t vld; float kss = 0.f;
                    if (row < NP) { const int b = row >> 14, t = row & (SEQ - 1);
                        o32 = p.out + O_KV_P + (size_t)(br * 2 + (type - 1)) * KVP + ((size_t)(layer * 2 + b) * SEQ + t) * 512;
                        kb = (u16*)(p.ws + W_KBP) + (size_t)row * 1024 + br * 512;
                        vt = (u16*)(p.ws + W_VTP) + (size_t)(b * 8 + br * 4) * 128 * SEQ + t; vld = SEQ;
                    } else { const int rr = row - NP, sb = rr >> 5, t = rr & 31;
                        o32 = p.out + O_KV_S + (size_t)(br * 2 + (type - 1)) * KVS + ((size_t)(layer * 8 + sb) * 32 + t) * 512;
                        kb = (u16*)(p.ws + W_KBS) + ((size_t)(layer * 8 + sb) * SL + PAST + t) * 1024 + br * 512;
                        vt = (u16*)(p.ws + W_VTS) + (size_t)((layer * 8 + sb) * 8 + br * 4) * 128 * SL + PAST + t; vld = SL;
                    }
                    u32x4 kw[2];
#pragma unroll
                    for (int bj = 0; bj < 2; ++bj) { const f32x4 v0 = acc[ai][bj][m][0] * rs, v1 = acc[ai][bj][m][1] * rs; const int cg = cgb + bj * 32;
                        kss += (v0.x * v0.x + v0.y * v0.y + v0.z * v0.z + v0.w * v0.w) + (v1.x * v1.x + v1.y * v1.y + v1.z * v1.z + v1.w * v1.w);
                        tio_store_f32(T, o32 - (size_t)fr * 512 + cww + bj * 32, 512, lane, fr, fq, v0, v1);
                        const u32x4 w = pack8(v0, v1); kw[bj] = w;
                        if (type == 1) { if (bj == 1) tio_store_p(T, kb - (size_t)fr * 1024 + cww, 1024, lane, fr, fq, kw[0], kw[1]); }
                        else { vt[(size_t)(cg + 0) * vld] = (u16)(w.x & 0xffffu); vt[(size_t)(cg + 1) * vld] = (u16)(w.x >> 16); vt[(size_t)(cg + 2) * vld] = (u16)(w.y & 0xffffu); vt[(size_t)(cg + 3) * vld] = (u16)(w.y >> 16);
                               vt[(size_t)(cg + 4) * vld] = (u16)(w.z & 0xffffu); vt[(size_t)(cg + 5) * vld] = (u16)(w.z >> 16); vt[(size_t)(cg + 6) * vld] = (u16)(w.w & 0xffffu); vt[(size_t)(cg + 7) * vld] = (u16)(w.w >> 16); } }
                    if (type == 1 && br == 1) { kss += __shfl_xor(kss, 16); kss += __shfl_xor(kss, 32); kmx = fmaxf(kmx, kss); }
                }
            }
        if (type == 1 && br == 1 && u.pm < NP / 256) {
            float t = kmx; t = fmaxf(t, __shfl_xor(t, 1)); t = fmaxf(t, __shfl_xor(t, 2)); t = fmaxf(t, __shfl_xor(t, 4)); t = fmaxf(t, __shfl_xor(t, 8));
            if (fr == 0 && fq == 0) atomicMax((unsigned*)(p.ws + W_CTR) + 64 + ((layer * 2 + (u.pm >> 6)) * 4 + (u.pn & 1) * 2 + (wc >> 1)) * 4 + (wc & 1), __float_as_uint(t));
        }
    }
};

struct EpiOut {
    const P& p; LAS unsigned char* lds;
    __device__ __forceinline__ void operator()(const f32x4 (&acc)[2][2][4][2], const pg8::Unit& u, int wr, int wc, int fr, int fq) const {
        float* ssqB = (float*)(p.ws + W_SSQB); u16* XbB = (u16*)(p.ws + W_XBB); const u16* XbA = (const u16*)(p.ws + W_XBA);
        const int lane = fq * 16 + fr, cw = u.pn * 256 + wc * 64; LAS unsigned char* T = lds + TIO_OFF + (wr * 4 + wc) * TIO_WAVE;
#pragma unroll
        for (int ai = 0; ai < 2; ++ai) {
            u32x4 xa[4], xb_[4];
#pragma unroll
            for (int m = 0; m < 4; ++m) tio_load(XbA + (size_t)(u.pm * 256 + ai * 128 + wr * 64 + m * 16) * 2048 + cw, lane, xa[m], xb_[m]);
#pragma unroll
            for (int m = 0; m < 4; ++m) {
                const int row0 = u.pm * 256 + ai * 128 + wr * 64 + m * 16; float ss = 0.f; u32x4 x0, x1;
                tio_unpack(T, lane, fr, fq, xa[m], xb_[m], x0, x1);
                f32x4 v00 = acc[ai][0][m][0], v01 = acc[ai][0][m][1], v10 = acc[ai][1][m][0], v11 = acc[ai][1][m][1];
                v00.x += bf_lo(x0.x); v00.y += bf_hi(x0.x); v00.z += bf_lo(x0.y); v00.w += bf_hi(x0.y); v01.x += bf_lo(x0.z); v01.y += bf_hi(x0.z); v01.z += bf_lo(x0.w); v01.w += bf_hi(x0.w);
                v10.x += bf_lo(x1.x); v10.y += bf_hi(x1.x); v10.z += bf_lo(x1.y); v10.w += bf_hi(x1.y); v11.x += bf_lo(x1.z); v11.y += bf_hi(x1.z); v11.z += bf_lo(x1.w); v11.w += bf_hi(x1.w);
                ss += (v00.x * v00.x + v00.y * v00.y + v00.z * v00.z + v00.w * v00.w) + (v01.x * v01.x + v01.y * v01.y + v01.z * v01.z + v01.w * v01.w);
                ss += (v10.x * v10.x + v10.y * v10.y + v10.z * v10.z + v10.w * v10.w) + (v11.x * v11.x + v11.y * v11.y + v11.z * v11.z + v11.w * v11.w);
                tio_store(T, XbB + (size_t)row0 * 2048 + cw, lane, fr, fq, pack8(v00, v01), pack8(v10, v11));
                ss += __shfl_xor(ss, 16); ss += __shfl_xor(ss, 32);
                if (fq == 0) ssqB[(size_t)(row0 + fr) * 32 + u.pn * 4 + wc] = ss;
            }
        }
    }
};

struct EpiPle {
    const P& p; LAS unsigned char* lds;
    __device__ __forceinline__ void operator()(const f32x4 (&acc)[2][2][4][2], const pg8::Unit& u, int wr, int wc, int fr, int fq) const {
        u16* O = u.pm == NP / 256 ? (u16*)(p.ws + W_PLES) - (size_t)NP * 2048 : (u16*)(p.ws + W_PLEB);
        const int lane = fq * 16 + fr, cw = u.pn * 256 + wc * 64; LAS unsigned char* T = lds + TIO_OFF + (wr * 4 + wc) * TIO_WAVE;
#pragma unroll
        for (int ai = 0; ai < 2; ++ai)
#pragma unroll
            for (int m = 0; m < 4; ++m)
                tio_store(T, O + (size_t)(u.pm * 256 + ai * 128 + wr * 64 + m * 16) * 2048 + cw, lane, fr, fq, pack8(acc[ai][0][m][0], acc[ai][0][m][1]), pack8(acc[ai][1][m][0], acc[ai][1][m][1]));
    }
};

struct EpiGate {
    const P& p; LAS unsigned char* lds;
    __device__ __forceinline__ void operator()(const f32x4 (&acc)[2][2][4][2], const pg8::Unit& u, int wr, int wc, int fr, int fq) const {
        const float* ssqB = (const float*)(p.ws + W_SSQB); float* ssqA = (float*)(p.ws + W_SSQA); u16* XbA = (u16*)(p.ws + W_XBA); const u16* XbB = (const u16*)(p.ws + W_XBB); const u16* PL = u.pm == NP / 256 ? (const u16*)(p.ws + W_PLES) - (size_t)NP * 2048 : (const u16*)(p.ws + W_PLEB);
        const int lane = fq * 16 + fr, cw = u.pn * 256 + wc * 64; LAS unsigned char* T = lds + TIO_OFF + (wr * 4 + wc) * TIO_WAVE;
        float rsv[8];
#pragma unroll
        for (int i = 0; i < 8; ++i) rsv[i] = row_rstd(ssqB, u.pm * 256 + (i >> 2) * 128 + wr * 64 + (i & 3) * 16 + fr, fq);
#pragma unroll
        for (int g4 = 0; g4 < 4; ++g4) { const int ai = g4 >> 1, m0 = (g4 & 1) * 2;
            u32x4 xa[2], xb_[2], pa[2], pb[2];
#pragma unroll
            for (int mm = 0; mm < 2; ++mm) { const size_t ro = (size_t)(u.pm * 256 + ai * 128 + wr * 64 + (m0 + mm) * 16) * 2048 + cw;
                tio_load(XbB + ro, lane, xa[mm], xb_[mm]); tio_load(PL + ro, lane, pa[mm], pb[mm]); }
#pragma unroll
            for (int mm = 0; mm < 2; ++mm) { const int m = m0 + mm;
                const int row0 = u.pm * 256 + ai * 128 + wr * 64 + m * 16;
                const float rs = rsv[ai * 4 + m]; float ss = 0.f;
                u32x4 x0, x1, p0, p1;
                tio_unpack(T, lane, fr, fq, xa[mm], xb_[mm], x0, x1);
                tio_unpack(T, lane, fr, fq, pa[mm], pb[mm], p0, p1);
                f32x4 v[2][2];
#pragma unroll
                for (int bj = 0; bj < 2; ++bj) { const f32x4 a0 = acc[ai][bj][m][0] * rs, a1 = acc[ai][bj][m][1] * rs; const u32x4 pq = bj ? p1 : p0, xq = bj ? x1 : x0;
                    f32x4 v0, v1;
                    v0.x = bf_lo(xq.x) + bf_lo(pq.x) * __builtin_amdgcn_rcpf(1.f + __expf(-a0.x)); v0.y = bf_hi(xq.x) + bf_hi(pq.x) * __builtin_amdgcn_rcpf(1.f + __expf(-a0.y));
                    v0.z = bf_lo(xq.y) + bf_lo(pq.y) * __builtin_amdgcn_rcpf(1.f + __expf(-a0.z)); v0.w = bf_hi(xq.y) + bf_hi(pq.y) * __builtin_amdgcn_rcpf(1.f + __expf(-a0.w));
                    v1.x = bf_lo(xq.z) + bf_lo(pq.z) * __builtin_amdgcn_rcpf(1.f + __expf(-a1.x)); v1.y = bf_hi(xq.z) + bf_hi(pq.z) * __builtin_amdgcn_rcpf(1.f + __expf(-a1.y));
                    v1.z = bf_lo(xq.w) + bf_lo(pq.w) * __builtin_amdgcn_rcpf(1.f + __expf(-a1.z)); v1.w = bf_hi(xq.w) + bf_hi(pq.w) * __builtin_amdgcn_rcpf(1.f + __expf(-a1.w));
                    ss += (v0.x * v0.x + v0.y * v0.y + v0.z * v0.z + v0.w * v0.w) + (v1.x * v1.x + v1.y * v1.y + v1.z * v1.z + v1.w * v1.w);
                    v[bj][0] = v0; v[bj][1] = v1; }
                tio_store(T, XbA + (size_t)row0 * 2048 + cw, lane, fr, fq, pack8(v[0][0], v[0][1]), pack8(v[1][0], v[1][1]));
                ss += __shfl_xor(ss, 16); ss += __shfl_xor(ss, 32);
                if (fq == 0) ssqA[(size_t)(row0 + fr) * 32 + u.pn * 4 + wc] = ss;
            }
        }
    }
};

struct TDesc { const float* src; size_t sld; u16* dst; size_t dld; const float* gk; };
constexpr int NT_WIN = DEPTH * 2048, NT_WOUT = DEPTH * 512, NT_WPLE = DEPTH * 128, NT_WGATE = DEPTH * 1024, NT_VC = DEPTH * DEC_BATCH * 8 * 32;
constexpr int NT_ALL = NT_WIN + NT_WOUT + NT_WPLE + NT_WGATE + NT_VC;
__device__ __forceinline__ TDesc tile_desc(const P& p, int t) {
    TDesc d;
    if (t < NT_WIN) { const int L = t >> 11, r = t & 2047, kt = r >> 6, nt = r & 63;
        d.src = p.w_in + (size_t)L * 2048 * D_IN + (size_t)kt * 64 * D_IN + nt * 64; d.sld = D_IN; d.dst = (u16*)(p.ws + W_WTIN) + (size_t)L * 4096 * 2048 + (size_t)nt * 64 * 2048 + kt * 64; d.dld = 2048; d.gk = p.g_attn + L * 2048 + kt * 64; return d; }
    t -= NT_WIN;
    if (t < NT_WOUT) { const int L = t >> 9, r = t & 511, kt = r >> 5, nt = r & 31;
        d.src = p.w_out + (size_t)L * 1024 * 2048 + (size_t)kt * 64 * 2048 + nt * 64; d.sld = 2048; d.dst = (u16*)(p.ws + W_WTOUT) + (size_t)L * 2048 * 1024 + (size_t)nt * 64 * 1024 + kt * 64; d.dld = 1024; d.gk = nullptr; return d; }
    t -= NT_WOUT;
    if (t < NT_WPLE) { const int L = t >> 7, r = t & 127, kt = r >> 5, nt = r & 31;
        d.src = p.w_ple + (size_t)L * 256 * 2048 + (size_t)kt * 64 * 2048 + nt * 64; d.sld = 2048; d.dst = (u16*)(p.ws + W_WTPLE) + (size_t)L * 2048 * 256 + (size_t)nt * 64 * 256 + kt * 64; d.dld = 256; d.gk = nullptr; return d; }
    t -= NT_WPLE;
    if (t < NT_WGATE) { const int L = t >> 10, r = t & 1023, kt = r >> 5, nt = r & 31;
        d.src = p.w_gate + (size_t)L * 2048 * 2048 + (size_t)kt * 64 * 2048 + nt * 64; d.sld = 2048; d.dst = (u16*)(p.ws + W_WTGATE) + (size_t)L * 2048 * 2048 + (size_t)nt * 64 * 2048 + kt * 64; d.dld = 2048; d.gk = p.g_ple + L * 2048 + kt * 64; return d; }
    t -= NT_WGATE;
    { const int mi = t >> 5, r = t & 31, kt = r >> 1, nt = r & 1; const int ls = mi >> 3, h8 = mi & 7, br = h8 >> 2, hh = h8 & 3;
        d.src = (br ? p.c_fxv : p.c_sbv) + ((size_t)ls * PAST + kt * 64) * 512 + hh * 128 + nt * 64; d.sld = 512; d.dst = (u16*)(p.ws + W_VTS) + ((size_t)mi * 128 + nt * 64) * SL + kt * 64; d.dld = SL; d.gk = nullptr; return d; }
}

__device__ __forceinline__ void prep_phase(int wv, const P& p, LAS unsigned char* lds) {
    LAS float* T = (LAS float*)lds;
    const int tid = opaque_tid(wv), G = gridDim.x, B = blockIdx.x;
    const int wid = tid >> 6, lane = tid & 63;
    if (B == 0) { ((unsigned*)(p.ws + W_CTR))[tid] = 0u; ((unsigned*)(p.ws + W_CTR))[tid + 512] = 0u; }
    {
        const int k0 = tid >> 4, n4 = (tid & 15) * 4, no = tid >> 3, kc = tid & 7;
        f32x4 v[2][2]; float g[2][2]; TDesc d[2]; bool ok[2];
#define PREP_FETCH(t_) do { _Pragma("unroll") for (int q = 0; q < 2; ++q) { const int tt = (t_) + q * G; ok[q] = tt < NT_ALL; g[q][0] = 1.f; g[q][1] = 1.f; \
            if (ok[q]) { d[q] = tile_desc(p, tt); v[q][0] = *(const f32x4*)(d[q].src + (size_t)k0 * d[q].sld + n4); v[q][1] = *(const f32x4*)(d[q].src + (size_t)(k0 + 32) * d[q].sld + n4); \
                if (d[q].gk) { g[q][0] = d[q].gk[k0]; g[q][1] = d[q].gk[k0 + 32]; } } } } while (0)
        int t = B;
        PREP_FETCH(t);
        while (t < NT_ALL) {
            TDesc dc[2]; bool okc[2];
#pragma unroll
            for (int q = 0; q < 2; ++q) { okc[q] = ok[q]; dc[q] = d[q]; LAS float* Tq = T + q * (64 * 65);
                if (ok[q]) {
#pragma unroll
                    for (int hh = 0; hh < 2; ++hh) { const f32x4 x = v[q][hh]; const float gg = g[q][hh]; LAS float* tp = Tq + (k0 + 32 * hh) * 65 + n4; tp[0] = x.x * gg; tp[1] = x.y * gg; tp[2] = x.z * gg; tp[3] = x.w * gg; } } }
            __syncthreads();
            const int tn = t + 2 * G;
            PREP_FETCH(tn);
#pragma unroll
            for (int q = 0; q < 2; ++q) if (okc[q]) { const LAS float* Tq = T + q * (64 * 65); float f[8];
#pragma unroll
                for (int j = 0; j < 8; ++j) f[j] = Tq[(kc * 8 + j) * 65 + no];
                u32x4 w; w.x = cvt_pk_bf16(f[0], f[1]); w.y = cvt_pk_bf16(f[2], f[3]); w.z = cvt_pk_bf16(f[4], f[5]); w.w = cvt_pk_bf16(f[6], f[7]);
                *(u32x4*)(dc[q].dst + (size_t)no * dc[q].dld + kc * 8) = w; }
            __syncthreads();
            t = tn;
        }
#undef PREP_FETCH
    }
    for (int i = B * 512 + tid; i < DEPTH * 2048 * 4; i += G * 512) { const int L = i >> 13, k = (i >> 2) & 2047, j = i & 3;
        ((float*)(p.ws + W_WF))[i] = p.g_attn[L * 2048 + k] * p.w_in[(size_t)L * 2048 * D_IN + (size_t)k * D_IN + 4096 + j]; }
    for (int row = B * 8 + wid; row < NR; row += G * 8) {
        const float* src = row < NP ? p.x_prompt + (size_t)row * 2048 : p.x_sample + (size_t)(row - NP) * 2048;
        u16* xb = (u16*)(p.ws + W_XBA) + (size_t)row * 2048; float ss = 0.f;
#pragma unroll
        for (int i = 0; i < 8; ++i) { const int c = (i * 64 + lane) * 4; const f32x4 v = *(const f32x4*)(src + c); ss += v.x * v.x + v.y * v.y + v.z * v.z + v.w * v.w;
            u32x2 w; w.x = cvt_pk_bf16(v.x, v.y); w.y = cvt_pk_bf16(v.z, v.w); *(u32x2*)(xb + c) = w; }
#pragma unroll
        for (int d = 1; d < 64; d <<= 1) ss += __shfl_xor(ss, d);
        if (lane < 32) ((float*)(p.ws + W_SSQA))[(size_t)row * 32 + lane] = lane == 0 ? ss : 0.f;
    }
    for (size_t i0 = (size_t)B * 512 + tid; i0 < (size_t)DEPTH * NR * 64; i0 += (size_t)G * 512 * 4) { f32x4 v[4]; u16* dp[4];
#pragma unroll
        for (int q = 0; q < 4; ++q) { const size_t i = i0 + (size_t)q * G * 512; dp[q] = nullptr;
            if (i < (size_t)DEPTH * NR * 64) { const int L = (int)(i / ((size_t)NR * 64)); const size_t r = i % ((size_t)NR * 64); const int row = (int)(r >> 6), c4 = (int)(r & 63) * 4;
                const float* src = row < NP ? p.p_prompt + ((size_t)L * NP + row) * 256 + c4 : p.p_sample + ((size_t)L * NS + (row - NP)) * 256 + c4;
                v[q] = *(const f32x4*)src; dp[q] = (u16*)(p.ws + W_PB) + ((size_t)L * NR + row) * 256 + c4; } }
#pragma unroll
        for (int q = 0; q < 4; ++q) if (dp[q]) { u32x2 w; w.x = cvt_pk_bf16(v[q].x, v[q].y); w.y = cvt_pk_bf16(v[q].z, v[q].w); *(u32x2*)dp[q] = w; } }
    for (size_t i0 = (size_t)B * 512 + tid; i0 < (size_t)2 * DEPTH * DEC_BATCH * PAST * 128; i0 += (size_t)G * 512 * 4) { f32x4 v[4]; u16* dp[4];
#pragma unroll
        for (int q = 0; q < 4; ++q) { const size_t i = i0 + (size_t)q * G * 512; dp[q] = nullptr;
            if (i < (size_t)2 * DEPTH * DEC_BATCH * PAST * 128) { const int br = (int)(i / ((size_t)DEPTH * DEC_BATCH * PAST * 128)); const size_t r = i % ((size_t)DEPTH * DEC_BATCH * PAST * 128);
                const int ls = (int)(r / (PAST * 128)), pos = (int)((r / 128) % PAST), c4 = (int)(r & 127) * 4;
                v[q] = *(const f32x4*)((br ? p.c_fxk : p.c_sbk) + ((size_t)ls * PAST + pos) * 512 + c4); dp[q] = (u16*)(p.ws + W_KBS) + ((size_t)ls * SL + pos) * 1024 + br * 512 + c4; } }
#pragma unroll
        for (int q = 0; q < 4; ++q) if (dp[q]) { u32x2 w; w.x = cvt_pk_bf16(v[q].x, v[q].y); w.y = cvt_pk_bf16(v[q].z, v[q].w); *(u32x2*)dp[q] = w; } }
    for (int s = B * 8 + wid; s < DEPTH * DEC_BATCH * 4; s += G * 8) { const int ls = s >> 2, hh = s & 3; const float* src = p.c_logf + (size_t)ls * PAST * 4 + hh; float v[16]; float run = 0.f;
#pragma unroll
        for (int i = 0; i < 16; ++i) { run += src[(size_t)(lane * 16 + i) * 4]; v[i] = run; }
        float x = run;
#pragma unroll
        for (int d = 1; d < 64; d <<= 1) { const float y = __shfl_up(x, d); if (lane >= d) x += y; }
        const float pre = x - run; float* dst = (float*)(p.ws + W_CCUM) + (size_t)ls * PAST * 4 + hh;
#pragma unroll
        for (int i = 0; i < 16; ++i) dst[(size_t)(lane * 16 + i) * 4] = pre + v[i];
    }
}

__device__ __forceinline__ void logf_items(int wv, const P& p, int layer, LAS unsigned char* lds, int blk0, int blk_end, int blk_step) {
    LAS f32x4* WfL = (LAS f32x4*)lds;
    LAS float* lf = (LAS float*)(lds + 40960);
    const int tid = opaque_tid(wv);
    const f32x4* Wf = (const f32x4*)(p.ws + W_WF) + (size_t)layer * 2048;
    const float* ssqA = (const float*)(p.ws + W_SSQA);
    for (int blk = blk0; blk < blk_end; blk += blk_step) {
        __syncthreads();
#pragma unroll
        for (int i = 0; i < 4; ++i) { const int k = tid + 512 * i; WfL[k + (k >> 9)] = Wf[k]; }
        __syncthreads();
        const int rl = tid >> 2, kq = tid & 3, row = blk * 128 + rl;
        const u16* xr = (const u16*)(p.ws + W_XBA) + (size_t)row * 2048 + kq * 512;
        f32x4 a = (f32x4){0.f, 0.f, 0.f, 0.f};
        for (int i = 0; i < 64; ++i) { const u32x4 xv = *(const u32x4*)(xr + i * 8); const LAS f32x4* w = WfL + kq * 513 + i * 8;
            a += w[0] * bf_lo(xv.x); a += w[1] * bf_hi(xv.x); a += w[2] * bf_lo(xv.y); a += w[3] * bf_hi(xv.y); a += w[4] * bf_lo(xv.z); a += w[5] * bf_hi(xv.z); a += w[6] * bf_lo(xv.w); a += w[7] * bf_hi(xv.w); }
#pragma unroll
        for (int j = 0; j < 4; ++j) { a[j] += __shfl_xor(a[j], 1); a[j] += __shfl_xor(a[j], 2); }
        if (kq == 0) { float s = 0.f; const f32x4* q = (const f32x4*)(ssqA + (size_t)row * 32);
#pragma unroll
            for (int i = 0; i < 8; ++i) { const f32x4 v = q[i]; s += (v.x + v.y) + (v.z + v.w); }
            const float rs = rsqrtf(s * (1.f / 2048.f) + EPS); f32x4 lg;
#pragma unroll
            for (int j = 0; j < 4; ++j) { const float f = a[j] * rs + p.b_f[layer * 4 + j]; lg[j] = fminf(f, 0.f) - log1pf(expf(-fabsf(f))); }
            float* o = row < NP ? p.out + O_LOGF_P + ((size_t)layer * NP + row) * 4 : p.out + O_LOGF_S + ((size_t)layer * NS + (row - NP)) * 4;
            *(f32x4*)o = lg; lf[rl * 4 + 0] = lg.x; lf[rl * 4 + 1] = lg.y; lf[rl * 4 + 2] = lg.z; lf[rl * 4 + 3] = lg.w; }
        __syncthreads();
        if (tid < 16) { const int seg = tid >> 2, hh = tid & 3; float run = 0.f; float* cin = (float*)(p.ws + W_CIN);
            for (int i = 0; i < 32; ++i) { run += lf[(seg * 32 + i) * 4 + hh]; cin[(size_t)(blk * 128 + seg * 32 + i) * 4 + hh] = run; }
            ((float*)(p.ws + W_SEGTOT))[(size_t)(blk * 4 + seg) * 4 + hh] = run; }
    }
    __syncthreads();
}

constexpr int TEAM = 32;
__device__ __forceinline__ void team_barrier(unsigned* ctr) {
    __threadfence();
    __syncthreads();
    if (threadIdx.x == 0) {
        __hip_atomic_fetch_add(ctr, 1u, __ATOMIC_RELEASE, __HIP_MEMORY_SCOPE_AGENT);
        while (__hip_atomic_load(ctr, __ATOMIC_ACQUIRE, __HIP_MEMORY_SCOPE_AGENT) < (unsigned)TEAM) __builtin_amdgcn_s_sleep(8);
    }
    __syncthreads();
    __threadfence();
}

constexpr int A_KB = 0, A_VB = 34816, A_CK = 71680, A_SEG = 72192, A_MISC = 74240, A_T = 76800;
constexpr int KROW = 272, VROW = 144;

__device__ __forceinline__ void attn_phase(int wv, const P& p, int layer, LAS unsigned char* lds) {
    LAS float* segpre = (LAS float*)(lds + A_SEG);
    LAS int* misc = (LAS int*)(lds + A_MISC);
    LAS float* wtot = (LAS float*)(lds + A_MISC + 128);
    unsigned* ctr = (unsigned*)(p.ws + W_CTR) + layer;
    const float* Cin = (const float*)(p.ws + W_CIN);
    const int bid = blockIdx.x; const bool team = bid < TEAM;
    unsigned* tbar = (unsigned*)(p.ws + W_CTR) + 16 + layer * 8;
    int sd_left = 0, tstate = team ? 0 : 2;
    if (team) {
        pg8::StaticOrder S1;
        if (layer > 0) {
            if (bid < 8) { pg8::Gemm g{(const u16*)(p.ws + W_OB), (const u16*)(p.ws + W_WTOUT) + (size_t)(layer - 1) * 2048 * 1024, NR, 2048, 1024}; S1.init_one(NP / 256, bid); EpiOut E{p, lds}; pg8::gemm_phase(wv, lds, g, S1, E); }
            else if (bid < 16) { pg8::Gemm g{(const u16*)(p.ws + W_PB) + (size_t)(layer - 1) * NR * 256, (const u16*)(p.ws + W_WTPLE) + (size_t)(layer - 1) * 2048 * 256, NR, 2048, 256}; S1.init_one(NP / 256, bid - 8); EpiPle E{p, lds}; pg8::gemm_phase(wv, lds, g, S1, E); }
            team_barrier(tbar + 0);
            if (bid < 8) { pg8::Gemm g{(const u16*)(p.ws + W_XBB), (const u16*)(p.ws + W_WTGATE) + (size_t)(layer - 1) * 2048 * 2048, NR, 2048, 2048}; S1.init_one(NP / 256, bid); EpiGate E{p, lds}; pg8::gemm_phase(wv, lds, g, S1, E); }
            team_barrier(tbar + 1);
        }
        if (bid < 16) { pg8::Gemm g{(const u16*)(p.ws + W_XBA), (const u16*)(p.ws + W_WTIN) + (size_t)layer * 4096 * 2048, NR, 4096, 2048}; S1.init_one(NP / 256, bid); EpiProj E{p, layer, lds}; pg8::gemm_phase(wv, lds, g, S1, E); }
        else if (bid < 18) logf_items(wv, p, layer, lds, NP / 128 + (bid - 16), NP / 128 + (bid - 16) + 1, 1);
        team_barrier(tbar + 2);
        sd_left = 2;
    }
    {
        const int t8 = opaque_tid(wv);
        __syncthreads();
        if (t8 < 8) { const float* st = (const float*)(p.ws + W_SEGTOT); float est[8];
#pragma unroll
            for (int q = 0; q < 8; ++q) { float e = 0.f; for (int i = 0; i < 16; ++i) e += st[(size_t)((q >> 2) * 512 + 256 + i) * 4 + (q & 3)]; est[q] = e; }
            int rk = 0; float mine = 0.f;
#pragma unroll
            for (int q = 0; q < 8; ++q) if (q == t8) mine = est[q];
#pragma unroll
            for (int q = 0; q < 8; ++q) rk += (est[q] > mine || (est[q] == mine && q < t8)) ? 1 : 0;
            misc[40 + rk] = t8; }
        __syncthreads();
    }
    for (;;) {
        if (tstate == 0 && sd_left == 0) {
            if (layer == DEPTH - 1) {
                pg8::StaticOrder S1;
                team_barrier(tbar + 3);
                if (bid < 8) { pg8::Gemm g{(const u16*)(p.ws + W_OB), (const u16*)(p.ws + W_WTOUT) + (size_t)layer * 2048 * 1024, NR, 2048, 1024}; S1.init_one(NP / 256, bid); EpiOut E{p, lds}; pg8::gemm_phase(wv, lds, g, S1, E); }
                else if (bid < 16) { pg8::Gemm g{(const u16*)(p.ws + W_PB) + (size_t)layer * NR * 256, (const u16*)(p.ws + W_WTPLE) + (size_t)layer * 2048 * 256, NR, 2048, 256}; S1.init_one(NP / 256, bid - 8); EpiPle E{p, lds}; pg8::gemm_phase(wv, lds, g, S1, E); }
                team_barrier(tbar + 4);
                if (bid < 8) { pg8::Gemm g{(const u16*)(p.ws + W_XBB), (const u16*)(p.ws + W_WTGATE) + (size_t)layer * 2048 * 2048, NR, 2048, 2048}; S1.init_one(NP / 256, bid); EpiGate E{p, lds}; pg8::gemm_phase(wv, lds, g, S1, E); }
            }
            tstate = 2;
        }
        const int tid = opaque_tid(wv), wid = __builtin_amdgcn_readfirstlane(tid >> 6), lane = tid & 63, r = lane & 31, h = lane >> 5;
        const int prow = 16 * (r >> 4) + 8 * ((r >> 2) & 1) + 4 * ((r >> 3) & 1) + (r & 3);
        __syncthreads();
        if (tid == 0) misc[0] = sd_left > 0 ? 1024 + (2 - sd_left) * TEAM + bid : (int)atomicAdd(ctr, 1u);
        __syncthreads();
        int item = misc[0];
        if (sd_left > 0) --sd_left; else if (item >= 1024) break;
        int head8, qpos0, nw, row0, ldv, sbi = 0, bi = 0; const u16 *Kb, *Vt; const bool prompt = item < 1024;
        if (prompt) { const int fx = item < 512, it2 = item & 511; int qt, rem; if (fx) { qt = 63 - (it2 & 63); rem = misc[40 + (it2 >> 6)]; } else { qt = 63 - (it2 >> 3); rem = it2 & 7; } bi = rem >> 2; head8 = (fx ? 4 : 0) + (rem & 3);     qpos0 = qt * 256; nw = 8; row0 = bi * SEQ + qpos0;
            Kb = (const u16*)(p.ws + W_KBP) + (size_t)bi * SEQ * 1024 + head8 * 128; Vt = (const u16*)(p.ws + W_VTP) + (size_t)(bi * 8 + head8) * 128 * SEQ; ldv = SEQ;
        } else { const int s = item - 1024; sbi = s >> 3; head8 = s & 7; qpos0 = PAST; nw = 1; row0 = NP + sbi * 32;
            Kb = (const u16*)(p.ws + W_KBS) + (size_t)(layer * 8 + sbi) * SL * 1024 + head8 * 128; Vt = (const u16*)(p.ws + W_VTS) + (size_t)((layer * 8 + sbi) * 8 + head8) * 128 * SL; ldv = SL; }
        const bool fox = head8 >= 4; const int hf = head8 & 3;
        u32x4 kreg[2], vreg[2]; float ckreg = 0.f;
        const int krow_ = tid >> 4, kch = tid & 15, vrow_ = tid >> 3, vch = tid & 7;
        const int jt_top = (qpos0 + 32 * nw - 1) >> 6;
#pragma unroll
        for (int pz = 0; pz < 2; ++pz) { kreg[pz] = *(const u32x4*)(Kb + (size_t)(jt_top * 64 + krow_ + 32 * pz) * 1024 + kch * 8); vreg[pz] = *(const u32x4*)(Vt + (size_t)(vrow_ + 64 * pz) * ldv + jt_top * 64 + vch * 8); }
        const float* ccum = (const float*)(p.ws + W_CCUM) + (size_t)(layer * 8 + sbi) * PAST * 4 + hf;
        if (fox && prompt) {
            const int nseg = (qpos0 + 256) >> 5; const float v = tid < nseg ? ((const float*)(p.ws + W_SEGTOT))[(size_t)(bi * 512 + tid) * 4 + hf] : 0.f; float x = v;
#pragma unroll
            for (int d = 1; d < 64; d <<= 1) { const float y = __shfl_up(x, d); if (lane >= d) x += y; }
            if (lane == 63) wtot[wid] = x;
            __syncthreads();
            float pre = 0.f; for (int w = 0; w < wid; ++w) pre += wtot[w];
            segpre[tid] = pre + x - v;
            __syncthreads();
        }
        auto getC = [&](int pos) -> float {
            if (prompt) return segpre[pos >> 5] + Cin[(size_t)(bi * SEQ + pos) * 4 + hf];
            if (pos < PAST) return ccum[(size_t)pos * 4];
            if (pos < PAST + 32) return ccum[(size_t)(PAST - 1) * 4] + Cin[(size_t)(NP + sbi * 32 + pos - PAST) * 4 + hf];
            return 0.f; };
        const bool wact = wid < nw;
        bf16x8 qf[8];
        float cq2 = 0.f;
        const int qlo = qpos0 + 32 * wid, qhi = qlo + 31, qpos = qlo + r;
        if (wact) { const u16* qg = (const u16*)(p.ws + W_QB) + (size_t)(row0 + 32 * wid) * 1024 + head8 * 128; LAS unsigned char* Tq = lds + A_T + wid * (32 * 272);
            { u32x4 qr[8];
#pragma unroll
              for (int i = 0; i < 8; ++i) qr[i] = *(const u32x4*)(qg + (size_t)(4 * i + (lane >> 4)) * 1024 + (lane & 15) * 8);
#pragma unroll
              for (int i = 0; i < 8; ++i) *(LAS u32x4*)(Tq + (4 * i + (lane >> 4)) * 272 + (lane & 15) * 16) = qr[i]; }
#pragma unroll
            for (int kk = 0; kk < 8; ++kk) qf[kk] = *(const LAS bf16x8*)(Tq + r * 272 + (16 * kk + 8 * h) * 2);
            if (fox) cq2 = getC(qpos) * LOG2E; }
        else {
#pragma unroll
            for (int kk = 0; kk < 8; ++kk) qf[kk] = (bf16x8){0, 0, 0, 0, 0, 0, 0, 0}; }
        float qnK = 3.0e38f;
        if (fox && prompt) { const unsigned* ks = (const unsigned*)(p.ws + W_CTR) + 64 + ((layer * 2 + bi) * 4 + hf) * 4;
            const float kmax = sqrtf(__uint_as_float(ks[0]) + __uint_as_float(ks[1]) + __uint_as_float(ks[2]) + __uint_as_float(ks[3])) * 1.01f; float qn2 = 0.f;
#pragma unroll
            for (int kk = 0; kk < 8; ++kk)
#pragma unroll
                for (int i = 0; i < 8; ++i) { const float f = __uint_as_float(((unsigned)(unsigned short)qf[kk][i]) << 16); qn2 += f * f; }
            qn2 += __shfl_xor(qn2, 32); qnK = sqrtf(qn2) * 1.01f * kmax; }
#define LOAD_TILE(jt_) do { const int k0_ = (jt_) * 64; _Pragma("unroll") for (int pz = 0; pz < 2; ++pz) { \
            kreg[pz] = *(const u32x4*)(Kb + (size_t)(k0_ + krow_ + 32 * pz) * 1024 + kch * 8); \
            vreg[pz] = *(const u32x4*)(Vt + (size_t)(vrow_ + 64 * pz) * ldv + k0_ + vch * 8); } \
            if (fox && tid < 64) ckreg = getC(k0_ + tid) * LOG2E; } while (0)
#define STORE_TILE(buf_) do { _Pragma("unroll") for (int pz = 0; pz < 2; ++pz) { \
            *(LAS u32x4*)(lds + A_KB + (buf_) * 17408 + (krow_ + 32 * pz) * KROW + kch * 16) = kreg[pz]; \
            *(LAS u32x4*)(lds + A_VB + (buf_) * 18432 + (vrow_ + 64 * pz) * VROW + vch * 16) = vreg[pz]; } \
            if (fox && tid < 64) *(LAS float*)(lds + A_CK + (buf_) * 256 + tid * 4) = ckreg; } while (0)
        if (fox && tid < 64) ckreg = getC(jt_top * 64 + tid) * LOG2E;
        STORE_TILE(0);
        __syncthreads();
        f32x16 o[4];
#pragma unroll
        for (int dt = 0; dt < 4; ++dt)
#pragma unroll
            for (int i = 0; i < 16; ++i) o[dt][i] = 0.f;
        float carry = 0.f, mrun = -1e30f, mref = 0.f, lsum = 0.f; bool wave_done = !wact;
        for (int jt = jt_top, it = 0; jt >= 0; --jt, ++it) {
            const int cur = it & 1; const bool more = jt > 0;
            if (more) LOAD_TILE(jt - 1);
            const int key0 = jt * 64;
            if (fox && prompt && !wave_done && key0 <= qhi) {
                const float ck63 = *(const LAS float*)(lds + A_CK + cur * 256 + 252);
                if (__all((qnK + cq2 - ck63) < (mrun - 155.f))) wave_done = true; }
            if (!wave_done && key0 <= qhi) {
                const bool diag = key0 + 63 >= qlo;
                const LAS unsigned char* kb = lds + A_KB + cur * 17408 + prow * KROW + 16 * h;
                const LAS unsigned char* vb = lds + A_VB + cur * 18432 + r * VROW + 16 * h;
                f32x16 sv[2];
                typedef float f32x2 __attribute__((ext_vector_type(2)));
                if (fox) {
                    const LAS float* ckb = (const LAS float*)(lds + A_CK + cur * 256) + 8 * h;
                    const float cqm = cq2 - mref; const f32x2 cqv = {cqm, cqm};
#pragma unroll
                    for (int kt = 0; kt < 2; ++kt)
#pragma unroll
                        for (int q4 = 0; q4 < 4; ++q4) { const f32x4 ck = *(const LAS f32x4*)(ckb + 32 * kt + 16 * (q4 >> 1) + 4 * (q4 & 1));
                            const f32x2 x0 = cqv - (f32x2){ck.x, ck.y}, x1 = cqv - (f32x2){ck.z, ck.w};
                            sv[kt][4 * q4 + 0] = x0.x; sv[kt][4 * q4 + 1] = x0.y; sv[kt][4 * q4 + 2] = x1.x; sv[kt][4 * q4 + 3] = x1.y; }
                } else {
#pragma unroll
                    for (int i = 0; i < 16; ++i) { sv[0][i] = 0.f; sv[1][i] = 0.f; } }
#pragma unroll
                for (int kk = 0; kk < 8; ++kk) { const bf16x8 a0 = *(const LAS bf16x8*)(kb + kk * 32); const bf16x8 a1 = *(const LAS bf16x8*)(kb + 32 * KROW + kk * 32);
                    sv[0] = __builtin_amdgcn_mfma_f32_32x32x16_bf16(a0, qf[kk], sv[0], 0, 0, 0); sv[1] = __builtin_amdgcn_mfma_f32_32x32x16_bf16(a1, qf[kk], sv[1], 0, 0, 0); }
                if (!fox) {
#pragma unroll
                    for (int kt = 1; kt >= 0; --kt) {
                        float sp[16], ex[16], tot[2];
#pragma unroll
                        for (int rg = 0; rg < 16; ++rg) { const int kpos = key0 + 32 * kt + 16 * (rg >> 3) + 8 * h + (rg & 7); const float z = sv[kt][rg];
                            const float spv = fmaxf(z, 0.f) + flog2(1.f + fexp2(-fabsf(z))); sp[rg] = (!diag || kpos < qpos) ? spv : 0.f; }
#pragma unroll
                        for (int c = 0; c < 2; ++c) { float run = 0.f;
#pragma unroll
                            for (int idx = 7; idx >= 0; --idx) { ex[8 * c + idx] = run; run += sp[8 * c + idx]; }
                            tot[c] = run; }
                        const float pt0 = __shfl_xor(tot[0], 32), pt1 = __shfl_xor(tot[1], 32);
                        const float off1 = carry + (h ? 0.f : pt1), off0 = carry + (h ? (pt1 + tot[1]) : (pt0 + tot[1] + pt1));
#pragma unroll
                        for (int rg = 0; rg < 16; ++rg) { const int kpos = key0 + 32 * kt + 16 * (rg >> 3) + 8 * h + (rg & 7);
                            const float e2 = sv[kt][rg] - sp[rg] - ((rg >= 8 ? off1 : off0) + ex[rg]);
                            sv[kt][rg] = (!diag || kpos < qpos) ? fexp2(e2) : 0.f; }
                        carry += (tot[0] + tot[1]) + (pt0 + pt1);
                    }
                    if (__all(carry > 152.f)) wave_done = true;
                } else {
                    if (diag) {
#pragma unroll
                        for (int kt = 0; kt < 2; ++kt)
#pragma unroll
                            for (int rg = 0; rg < 16; ++rg) { const int kpos = key0 + 32 * kt + 16 * (rg >> 3) + 8 * h + (rg & 7); if (kpos > qpos) sv[kt][rg] = -1e30f; } }
                    float mx = -1e30f;
#pragma unroll
                    for (int kt = 0; kt < 2; ++kt)
#pragma unroll
                        for (int i = 0; i < 8; ++i) mx = fmax3(mx, sv[kt][2 * i], sv[kt][2 * i + 1]);
                    mx = fmaxf(mx, __shfl_xor(mx, 32));
                    const bool firstt = mrun < -1e29f;
                    mrun = fmaxf(mrun, mref + mx);
                    if (firstt || __any(mx > 0.f)) {
                        const float dlt = firstt ? mx : fmaxf(mx, 0.f), alpha = fexp2(-dlt); mref += dlt; lsum *= alpha; const f32x2 dv = {dlt, dlt};
#pragma unroll
                        for (int dt = 0; dt < 4; ++dt) o[dt] *= alpha;
#pragma unroll
                        for (int kt = 0; kt < 2; ++kt)
#pragma unroll
                            for (int i = 0; i < 8; ++i) { const f32x2 t = (f32x2){sv[kt][2 * i], sv[kt][2 * i + 1]} - dv; sv[kt][2 * i] = t.x; sv[kt][2 * i + 1] = t.y; } }
                    f32x2 ps2 = {0.f, 0.f};
#pragma unroll
                    for (int kt = 0; kt < 2; ++kt)
#pragma unroll
                        for (int i = 0; i < 8; ++i) { f32x2 e; e.x = fexp2(sv[kt][2 * i]); e.y = fexp2(sv[kt][2 * i + 1]); sv[kt][2 * i] = e.x; sv[kt][2 * i + 1] = e.y; ps2 += e; }
                    lsum += ps2.x + ps2.y;
                }
#pragma unroll
                for (int kt = 0; kt < 2; ++kt)
#pragma unroll
                    for (int c = 0; c < 2; ++c) { union { u32x4 u; bf16x8 v; } pf;
                        pf.u.x = cvt_pk_bf16(sv[kt][8 * c + 0], sv[kt][8 * c + 1]); pf.u.y = cvt_pk_bf16(sv[kt][8 * c + 2], sv[kt][8 * c + 3]);
                        pf.u.z = cvt_pk_bf16(sv[kt][8 * c + 4], sv[kt][8 * c + 5]); pf.u.w = cvt_pk_bf16(sv[kt][8 * c + 6], sv[kt][8 * c + 7]);
#pragma unroll
                        for (int dt = 0; dt < 4; ++dt) { const bf16x8 vf = *(const LAS bf16x8*)(vb + dt * 32 * VROW + (32 * kt + 16 * c) * 2);
                            o[dt] = __builtin_amdgcn_mfma_f32_32x32x16_bf16(vf, pf.v, o[dt], 0, 0, 0); } }
            }
            if (more) STORE_TILE(cur ^ 1);
            if (lane == 0) misc[8 + cur * 8 + wid] = wave_done ? 1 : 0;
            __syncthreads();
            int alld = 1;
#pragma unroll
            for (int w = 0; w < 8; ++w) alld &= misc[8 + cur * 8 + w];
            if (alld) break;
        }
#undef LOAD_TILE
#undef STORE_TILE
        if (wact) {
            if (fox) { lsum += __shfl_xor(lsum, 32); const float inv = 1.f / lsum;
#pragma unroll
                for (int dt = 0; dt < 4; ++dt) o[dt] *= inv; }
            float ss = 0.f;
#pragma unroll
            for (int dt = 0; dt < 4; ++dt)
#pragma unroll
                for (int i = 0; i < 16; ++i) ss += o[dt][i] * o[dt][i];
            ss += __shfl_xor(ss, 32);
            const float rn = rsqrtf(ss * (1.f / 128.f) + EPS);
            const float* gp = (fox ? p.g_ofox : p.g_osb) + layer * 512 + hf * 128 + 4 * h;
            const u16* zg = (const u16*)(p.ws + W_ZB) + (size_t)(row0 + 32 * wid) * 1024 + head8 * 128;
            u16* og = (u16*)(p.ws + W_OB) + (size_t)(row0 + 32 * wid) * 1024 + head8 * 128;
            LAS unsigned char* Tz = lds + A_T + wid * (32 * 272);
            { u32x4 zr[8];
#pragma unroll
              for (int i = 0; i < 8; ++i) zr[i] = *(const u32x4*)(zg + (size_t)(4 * i + (lane >> 4)) * 1024 + (lane & 15) * 8);
#pragma unroll
              for (int i = 0; i < 8; ++i) *(LAS u32x4*)(Tz + (4 * i + (lane >> 4)) * 272 + (lane & 15) * 16) = zr[i]; }
#pragma unroll
            for (int dt = 0; dt < 4; ++dt)
#pragma unroll
                for (int bb = 0; bb < 4; ++bb) { const int d = 32 * dt + 8 * bb; const f32x4 g = *(const f32x4*)(gp + d); LAS u32x2* tp = (LAS u32x2*)(Tz + r * 272 + (d + 4 * h) * 2); const u32x2 z2 = *tp;
                    const float v0 = o[dt][4 * bb + 0] * rn * g.x * bf_lo(z2.x), v1 = o[dt][4 * bb + 1] * rn * g.y * bf_hi(z2.x), v2 = o[dt][4 * bb + 2] * rn * g.z * bf_lo(z2.y), v3 = o[dt][4 * bb + 3] * rn * g.w * bf_hi(z2.y);
                    u32x2 w; w.x = cvt_pk_bf16(v0, v1); w.y = cvt_pk_bf16(v2, v3); *tp = w; }
#pragma unroll
            for (int i = 0; i < 8; ++i) { const u32x4 w = *(const LAS u32x4*)(Tz + (4 * i + (lane >> 4)) * 272 + (lane & 15) * 16); *(u32x4*)(og + (size_t)(4 * i + (lane >> 4)) * 1024 + (lane & 15) * 8) = w; }
        }
    }
}

__device__ __forceinline__ void final_phase(int wv, const P& p) {
    const int tid = opaque_tid(wv), wid = tid >> 6, lane = tid & 63;
    const float* ssqA = (const float*)(p.ws + W_SSQA);
    for (int row = blockIdx.x * 8 + wid; row < NR; row += gridDim.x * 8) {
        float s = lane < 32 ? ssqA[(size_t)row * 32 + lane] : 0.f;
#pragma unroll
        for (int d = 1; d < 64; d <<= 1) s += __shfl_xor(s, d);
        const float rs = rsqrtf(s * (1.f / 2048.f) + EPS);
        float* xo = p.out + (size_t)row * 2048; const u16* xb = (const u16*)(p.ws + W_XBA) + (size_t)row * 2048;
#pragma unroll
        for (int i = 0; i < 8; ++i) { const int c = (i * 64 + lane) * 4; const u32x2 xw = *(const u32x2*)(xb + c); const f32x4 g = *(const f32x4*)(p.g_final + c);
            f32x4 v; v.x = bf_lo(xw.x) * rs * g.x; v.y = bf_hi(xw.x) * rs * g.y; v.z = bf_lo(xw.y) * rs * g.z; v.w = bf_hi(xw.y) * rs * g.w; *(f32x4*)(xo + c) = v; }
    }
}

constexpr int LDS_BYTES = 131072 + 8 * 2304;

__global__ __launch_bounds__(512, 2) void fwd_megakernel(P p) {
    extern __shared__ __attribute__((aligned(16))) unsigned char shm[];
    LAS unsigned char* lds = (LAS unsigned char*)shm;
    cg::grid_group grid = cg::this_grid();
    const int wv = __builtin_amdgcn_readfirstlane(threadIdx.x >> 6);
    prep_phase(wv, p, lds);
    grid.sync();
    pg8::StaticOrder S;
    for (int layer_ = 0; layer_ < DEPTH; ++layer_) {
        int layer = layer_, bid = (int)blockIdx.x, G = (int)gridDim.x; asm volatile("" : "+s"(layer), "+s"(bid), "+s"(G));
        {
            pg8::Gemm g{(const u16*)(p.ws + W_XBA), (const u16*)(p.ws + W_WTIN) + (size_t)layer * 4096 * 2048, NP, 4096, 2048};
            S.init(g.M, g.N, G, bid); EpiProj E{p, layer, lds};
            pg8::gemm_phase(wv, lds, g, S, E);
            logf_items(wv, p, layer, lds, bid, NP / 128, G);
        }
        grid.sync();
        attn_phase(wv, p, layer, lds);
        grid.sync();
        {
            for (int rep = 0; rep < 2; ++rep) {
                if ((rep ^ ((bid >> 2) & 1)) == 0) {
                    pg8::Gemm g{(const u16*)(p.ws + W_OB), (const u16*)(p.ws + W_WTOUT) + (size_t)layer * 2048 * 1024, NP, 2048, 1024};
                    S.init(g.M, g.N, G, bid); EpiOut E{p, lds};
                    pg8::gemm_phase(wv, lds, g, S, E);
                } else {
                    pg8::Gemm g2{(const u16*)(p.ws + W_PB) + (size_t)layer * NR * 256, (const u16*)(p.ws + W_WTPLE) + (size_t)layer * 2048 * 256, NP, 2048, 256};
                    S.init(g2.M, g2.N, G, bid); EpiPle E2{p, lds};
                    pg8::gemm_phase(wv, lds, g2, S, E2);
                }
            }
        }
        grid.sync();
        {
            pg8::Gemm g{(const u16*)(p.ws + W_XBB), (const u16*)(p.ws + W_WTGATE) + (size_t)layer * 2048 * 2048, NP, 2048, 2048};
            S.init(g.M, g.N, G, bid); EpiGate E{p, lds};
            pg8::gemm_phase(wv, lds, g, S, E);
        }
        grid.sync();
    }
    final_phase(wv, p);
}

extern "C" void kernel_launch(void* const* d_in, const int* in_sizes, int n_in, void* d_out, int out_size, void* d_ws, size_t ws_size, hipStream_t stream) {
    static int grid_blocks = 0;
    if (!grid_blocks) {
        if (n_in != 19 || (size_t)out_size != OUT_TOTAL || ws_size < W_END) { fprintf(stderr, "kernel_launch: unexpected shapes: n_in %d out %d (want %zu) ws %zu (want %zu)\n", n_in, out_size, OUT_TOTAL, ws_size, W_END); grid_blocks = -1; return; }
        int dev = 0, cus = 0, per_cu = 0;
        hipGetDevice(&dev);
        hipDeviceGetAttribute(&cus, hipDeviceAttributeMultiprocessorCount, dev);
        if (hipFuncSetAttribute((const void*)fwd_megakernel, hipFuncAttributeMaxDynamicSharedMemorySize, LDS_BYTES) != hipSuccess) fprintf(stderr, "kernel_launch: hipFuncSetAttribute failed\n");
        if (hipOccupancyMaxActiveBlocksPerMultiprocessor(&per_cu, (const void*)fwd_megakernel, 512, LDS_BYTES) != hipSuccess || per_cu < 1) { fprintf(stderr, "kernel_launch: occupancy query gave %d\n", per_cu); per_cu = 1; }
        (void)hipGetLastError();
        grid_blocks = cus * per_cu;
    }
    if (grid_blocks < 0) return;
    P p{};
    const float** f = (const float**)&p;
    for (int i = 0; i < 19; ++i) f[i] = (const float*)d_in[i];
    p.out = (float*)d_out; p.ws = (unsigned char*)d_ws;
    void* args[] = {&p};
    hipError_t e = hipLaunchCooperativeKernel((const void*)fwd_megakernel, dim3(grid_blocks), dim3(512), args, LDS_BYTES, stream);
    if (e != hipSuccess) fprintf(stderr, "cooperative launch failed: %s (grid %d)\n", hipGetErrorString(e), grid_blocks);
}
```

```cpp
#include <hip/hip_runtime.h>
#include <hip/hip_cooperative_groups.h>
#include <cstdio>
namespace cg = cooperative_groups;

#define LAS __attribute__((address_space(3)))
typedef unsigned short u16;
typedef short bf16x8 __attribute__((ext_vector_type(8)));
typedef float f32x4 __attribute__((ext_vector_type(4)));
typedef float f32x16 __attribute__((ext_vector_type(16)));
typedef unsigned u32x2 __attribute__((ext_vector_type(2)));
typedef unsigned u32x4 __attribute__((ext_vector_type(4)));

constexpr int D_MODEL = 2048, SEQ = 16384, DEPTH = 4, DEC_BATCH = 8, DEC_SEQ = 32, PAST = 1024;
constexpr int NP = 2 * SEQ, NS = DEC_BATCH * DEC_SEQ, NR = NP + NS;
constexpr int DMIX = 1024, D_IN = 4100, PLE = 256;
constexpr int SL = 1088;
constexpr float EPS = 1e-6f;
constexpr float LOG2E = 1.4426950408889634f;
constexpr float QSCALE = 0.08838834764831845f * LOG2E;
constexpr int NITEMS = 1024 + 64;

constexpr size_t O_Y = 0;
constexpr size_t O_KV_P = (size_t)NR * D_MODEL;
constexpr size_t KVP = (size_t)DEPTH * NP * 512;
constexpr size_t O_LOGF_P = O_KV_P + 4 * KVP;
constexpr size_t O_KV_S = O_LOGF_P + (size_t)DEPTH * NP * 4;
constexpr size_t KVS = (size_t)DEPTH * NS * 512;
constexpr size_t O_LOGF_S = O_KV_S + 4 * KVS;
constexpr size_t OUT_TOTAL = O_LOGF_S + (size_t)DEPTH * NS * 4;

constexpr size_t al256(size_t x) { return (x + 255) & ~(size_t)255; }
constexpr size_t W_WTIN = 0;
constexpr size_t W_WTOUT = W_WTIN + (size_t)DEPTH * 4096 * 2048 * 2;
constexpr size_t W_WTPLE = W_WTOUT + (size_t)DEPTH * 2048 * 1024 * 2;
constexpr size_t W_WTGATE = W_WTPLE + (size_t)DEPTH * 2048 * 256 * 2;
constexpr size_t W_WF = W_WTGATE + (size_t)DEPTH * 2048 * 2048 * 2;
constexpr size_t W_XBA = W_WF + (size_t)DEPTH * 2048 * 4 * 4;
constexpr size_t W_PB = W_XBA + (size_t)NR * 2048 * 2;
constexpr size_t W_R = W_PB + (size_t)DEPTH * NR * 256 * 2;
constexpr size_t W_QB = W_R;
constexpr size_t W_KBP = W_QB + (size_t)NR * 1024 * 2;
constexpr size_t W_VTP = W_KBP + (size_t)NP * 1024 * 2;
constexpr size_t W_ZB = W_VTP + (size_t)NP * 1024 * 2;
constexpr size_t W_PLEB = W_R;
constexpr size_t W_XBB = W_R + al256((size_t)NR * 2048 * 2);
constexpr size_t R_SIZE = 2 * al256((size_t)NR * 2048 * 2) + 4096;
static_assert(W_ZB + (size_t)NR * 1024 * 2 <= W_R + R_SIZE, "region R too small");
constexpr size_t W_KBS = W_R + R_SIZE;
constexpr size_t W_VTS = W_KBS + (size_t)DEPTH * DEC_BATCH * SL * 1024 * 2;
constexpr size_t W_OB = W_VTS + (size_t)DEPTH * DEC_BATCH * 8 * 128 * SL * 2;
constexpr size_t W_SSQA = W_OB + (size_t)NR * 1024 * 2;
constexpr size_t W_SSQB = W_SSQA + (size_t)NR * 32 * 4;
constexpr size_t W_CIN = W_SSQB + (size_t)NR * 32 * 4;
constexpr size_t W_SEGTOT = W_CIN + (size_t)NR * 4 * 4;
constexpr size_t W_CCUM = W_SEGTOT + al256((size_t)(NR / 32) * 4 * 4);
constexpr size_t W_CTR = W_CCUM + (size_t)DEPTH * DEC_BATCH * PAST * 4 * 4;
constexpr size_t W_PLES = W_CTR + 4096;
constexpr size_t W_END = W_PLES + (size_t)NS * 2048 * 2;

struct P {
    const float *x_prompt, *x_sample, *p_prompt, *p_sample, *c_sbk, *c_sbv, *c_fxk, *c_fxv, *c_logf, *w_in, *b_f, *g_attn, *g_osb, *g_ofox, *w_out, *w_ple, *g_ple, *w_gate, *g_final;
    float* out;
    unsigned char* ws;
};

__device__ __forceinline__ unsigned cvt_pk_bf16(float lo, float hi) { unsigned r; asm volatile("v_cvt_pk_bf16_f32 %0, %1, %2" : "=v"(r) : "v"(lo), "v"(hi)); return r; }
__device__ __forceinline__ float bf_lo(unsigned w) { return __uint_as_float(w << 16); }
__device__ __forceinline__ float bf_hi(unsigned w) { return __uint_as_float(w & 0xffff0000u); }
__device__ __forceinline__ float fexp2(float x) { return __builtin_amdgcn_exp2f(x); }
__device__ __forceinline__ float flog2(float x) { return __builtin_amdgcn_logf(x); }
__device__ __forceinline__ float fmax3(float a, float b, float c) { float r; asm("v_max3_f32 %0, %1, %2, %3" : "=v"(r) : "v"(a), "v"(b), "v"(c)); return r; }
__device__ __forceinline__ int opaque_tid(int wv) { int l; asm volatile("v_mbcnt_lo_u32_b32 %0, -1, 0\n\tv_mbcnt_hi_u32_b32 %0, -1, %0" : "=v"(l)); return wv * 64 + l; }

namespace pg8 {
constexpr int BM = 256, BK = 64, HALF = 128, HTB = HALF * BK * 2, STAGE_BYTES = 8 * HTB, NXCD = 8, WGM = 8;
__host__ __device__ __forceinline__ int lds_byte(int r, int c) { const int st = (r >> 4) * 2 + (c >> 5), rr = r & 15, cc = c & 31, ob = rr * 64 + cc * 2; return st * 1024 + (ob ^ (((ob >> 9) & 1) << 5)); }
__host__ __device__ __forceinline__ void stage_rc(int b, int& R, int& C) { const int st = b / 1024, sb = b % 1024, swz = sb ^ (((sb >> 9) & 1) << 5); R = (st >> 1) * 16 + swz / 64; C = (st & 1) * 32 + (swz % 64) / 2; }
struct Unit { int pm, pn; };
struct Gemm { const u16* A; const u16* Bt; int M, N, K; };
struct StaticOrder {
    int nM, nN, nwg, G, c;
    int one_pm, one_pn;
    __device__ void init(int M, int N, int G_, int c_) { nM = M / BM; nN = N / BM; nwg = nM * nN; G = G_; c = c_; one_pm = -1; one_pn = 0; }
    __device__ void init_one(int pm, int pn) { nM = 1; nN = 1; nwg = 1; G = 1; c = 0; one_pm = pm; one_pn = pn; }
    __device__ bool next(int i, Unit& u) const {
        if (one_pm >= 0) { if (i > 0) return false; u.pm = one_pm; u.pn = one_pn; return true; }
        const long L = (long)i * G + c; if (L >= nwg) return false;
        int wgid = (int)L; { const int q = nwg / NXCD, r = nwg % NXCD, xcd = wgid % NXCD, off = wgid / NXCD; wgid = (xcd < r ? xcd * (q + 1) : r * (q + 1) + (xcd - r) * q) + off; }
        const int nig = WGM * nN, gid = wgid / nig, fm = gid * WGM, gsz = (nM - fm) < WGM ? (nM - fm) : WGM;
        u.pm = fm + ((wgid % nig) % gsz); u.pn = (wgid % nig) / gsz; return true;
    }
};

template <class Epi>
__device__ __forceinline__ void gemm_phase(int wv, LAS unsigned char* lds, const Gemm g, const StaticOrder& S, const Epi& E, const int skew_ticks = 0) {
    const int tid = opaque_tid(wv), wid = __builtin_amdgcn_readfirstlane(tid >> 6), lane = tid & 63, wr = wid >> 2, wc = wid & 3, fr = lane & 15, fq = lane >> 4;
    const int K = g.K, nt = K / BK;
    unsigned voffA[2], voffB0[2];
#pragma unroll
    for (int i = 0; i < 2; ++i) { int R, C; stage_rc(tid * 16 + i * 8192, R, C); voffA[i] = (unsigned)(R * K + C) * 2u;
        const int rho = R & 31, pr = 8 * ((rho & 15) >> 2) + 4 * (rho >> 4) + (rho & 3), Rb = 64 * (R >> 5) + pr;
        voffB0[i] = (unsigned)(Rb * K + C) * 2u; }
    const size_t b1step = (size_t)32 * K * 2;
    const size_t kstep = (size_t)(BK * 2);
    const size_t hstep = (size_t)HALF * K * 2;
    const size_t tstep = 2 * hstep;
    const unsigned ldsw = (unsigned)wid * 1024u;
    const int aoff = lds_byte(wr * 64 + fr, fq * 8), boff = lds_byte(wc * 32 + fr, fq * 8);
#define PG8_SA(b, h) (((b) * 2 + (h)) * HTB)
#define PG8_SB(b, h) ((4 + (b) * 2 + (h)) * HTB)
#define PG8_STAGE(bufoff, gbase, voff) do { _Pragma("unroll") for (int _i = 0; _i < 2; ++_i) \
        __builtin_amdgcn_global_load_lds((const unsigned*)((const char*)(gbase) + (voff)[_i]), (LAS unsigned*)(lds + (bufoff) + ldsw + _i * 8192), 16, 0, 0); } while (0)
#define PG8_LDA(dst, b, h) do { _Pragma("unroll") for (int m = 0; m < 4; ++m) _Pragma("unroll") for (int k = 0; k < 2; ++k) dst[m][k] = *(const LAS bf16x8*)(lds + PG8_SA(b, h) + aoff + m * 2048 + k * 1024); } while (0)
#define PG8_LDB(dst, b, h) do { _Pragma("unroll") for (int n = 0; n < 2; ++n) _Pragma("unroll") for (int k = 0; k < 2; ++k) dst[n][k] = *(const LAS bf16x8*)(lds + PG8_SB(b, h) + boff + n * 2048 + k * 1024); } while (0)
#define PG8_MMA(ai, bj, At, Bt) do { __builtin_amdgcn_s_setprio(1); _Pragma("unroll") for (int m = 0; m < 4; ++m) _Pragma("unroll") for (int n = 0; n < 2; ++n) _Pragma("unroll") for (int k = 0; k < 2; ++k) \
        acc[ai][bj][m][n] = __builtin_amdgcn_mfma_f32_16x16x32_bf16(Bt[n][k], At[m][k], acc[ai][bj][m][n], 0, 0, 0); __builtin_amdgcn_s_setprio(0); } while (0)
#define PG8_WAIT_V(n) asm volatile("s_waitcnt vmcnt(" #n ")" ::: "memory")
#define PG8_WAIT_L(n) asm volatile("s_waitcnt lgkmcnt(" #n ")" ::: "memory")
#define PG8_BAR __builtin_amdgcn_s_barrier()
#define PG8_SCHED __builtin_amdgcn_sched_barrier(0)
    Unit cur, nxt; int ui = 0;
    if (!S.next(0, cur)) return;
    if (skew_ticks > 0) {
        const unsigned long long t0 = __builtin_amdgcn_s_memrealtime();
        while ((long long)(__builtin_amdgcn_s_memrealtime() - t0) < (long long)skew_ticks) __builtin_amdgcn_s_sleep(32);
    }
    f32x4 acc[2][2][4][2];
#pragma unroll
    for (int a = 0; a < 2; ++a)
#pragma unroll
        for (int b = 0; b < 2; ++b)
#pragma unroll
            for (int m = 0; m < 4; ++m)
#pragma unroll
                for (int n = 0; n < 2; ++n) acc[a][b][m][n] = (f32x4){0.f, 0.f, 0.f, 0.f};
    bf16x8 At[4][2], B0[2][2], B1[2][2];
    const char* cA = (const char*)g.A + (size_t)cur.pm * tstep; const char* cB = (const char*)g.Bt + (size_t)cur.pn * tstep;
    PG8_STAGE(PG8_SB(0, 0), cB, voffB0); PG8_STAGE(PG8_SA(0, 0), cA, voffA); PG8_STAGE(PG8_SB(0, 1), cB + b1step, voffB0); PG8_STAGE(PG8_SA(0, 1), cA + hstep, voffA);
    if (wr == 1) PG8_BAR;
    PG8_WAIT_V(4); PG8_BAR;
    PG8_STAGE(PG8_SB(1, 0), cB + kstep, voffB0); PG8_STAGE(PG8_SA(1, 0), cA + kstep, voffA); PG8_STAGE(PG8_SB(1, 1), cB + kstep + b1step, voffB0);
    PG8_WAIT_V(6); PG8_BAR;
    for (;;) {
        const bool has_next = S.next(ui + 1, nxt);
        const char* nA = has_next ? (const char*)g.A + (size_t)nxt.pm * tstep : cA; const char* nB = has_next ? (const char*)g.Bt + (size_t)nxt.pn * tstep : cB;
        for (int t = 0; t < nt; t += 2) {
            const bool last = (t == nt - 2);
            const char* a1 = cA + (size_t)(t + 1) * kstep;
            const char* a2 = last ? nA : cA + (size_t)(t + 2) * kstep; const char* b2 = last ? nB : cB + (size_t)(t + 2) * kstep;
            const char* a3 = a2 + kstep; const char* b3 = b2 + kstep;
            PG8_LDB(B0, 0, 0); PG8_SCHED; PG8_LDA(At, 0, 0); PG8_STAGE(PG8_SA(1, 1), a1 + hstep, voffA);
            PG8_WAIT_L(8); PG8_BAR; PG8_WAIT_L(0); PG8_MMA(0, 0, At, B0); PG8_BAR; PG8_SCHED;
            PG8_LDB(B1, 0, 1); PG8_STAGE(PG8_SB(0, 0), b2, voffB0);
            PG8_BAR; PG8_WAIT_L(0); PG8_MMA(0, 1, At, B1); PG8_BAR;
            PG8_LDA(At, 0, 1); PG8_STAGE(PG8_SA(0, 0), a2, voffA);
            PG8_BAR; PG8_WAIT_L(0); PG8_MMA(1, 0, At, B0); PG8_BAR; PG8_SCHED;
            PG8_STAGE(PG8_SB(0, 1), b2 + b1step, voffB0);
            PG8_WAIT_V(6); PG8_BAR; PG8_MMA(1, 1, At, B1); PG8_BAR;
            PG8_LDB(B0, 1, 0); PG8_SCHED; PG8_LDA(At, 1, 0); PG8_STAGE(PG8_SA(0, 1), a2 + hstep, voffA);
            PG8_WAIT_L(8); PG8_BAR; PG8_WAIT_L(0); PG8_MMA(0, 0, At, B0); PG8_BAR; PG8_SCHED;
            PG8_LDB(B1, 1, 1); PG8_STAGE(PG8_SB(1, 0), b3, voffB0);
            PG8_BAR; PG8_WAIT_L(0); PG8_MMA(0, 1, At, B1); PG8_BAR;
            PG8_LDA(At, 1, 1); PG8_STAGE(PG8_SA(1, 0), a3, voffA);
            PG8_BAR; PG8_WAIT_L(0); PG8_MMA(1, 0, At, B0); PG8_BAR; PG8_SCHED;
            PG8_STAGE(PG8_SB(1, 1), b3 + b1step, voffB0);
            PG8_WAIT_V(6); PG8_BAR; PG8_MMA(1, 1, At, B1); PG8_BAR;
        }
        { int fr2 = fr, fq2 = fq; asm volatile("" : "+v"(fr2), "+v"(fq2)); E(acc, cur, wr, wc, fr2, fq2); }
        if (!has_next) break;
#pragma unroll
        for (int a = 0; a < 2; ++a)
#pragma unroll
            for (int b = 0; b < 2; ++b)
#pragma unroll
                for (int m = 0; m < 4; ++m)
#pragma unroll
                    for (int n = 0; n < 2; ++n) acc[a][b][m][n] = (f32x4){0.f, 0.f, 0.f, 0.f};
        cur = nxt; cA = nA; cB = nB; ++ui;
    }
    PG8_WAIT_V(0);
    if (wr == 0) PG8_BAR;
    PG8_BAR;
#undef PG8_SA
#undef PG8_SB
#undef PG8_STAGE
#undef PG8_LDA
#undef PG8_LDB
#undef PG8_MMA
#undef PG8_WAIT_V
#undef PG8_WAIT_L
#undef PG8_BAR
#undef PG8_SCHED
}
}


__device__ __forceinline__ float row_rstd(const float* ssq, int row, int fq) {
    const f32x4* q = (const f32x4*)(ssq + (size_t)row * 32 + fq * 8);
    const f32x4 a = q[0], b = q[1];
    float s = (a.x + a.y) + (a.z + a.w) + (b.x + b.y) + (b.z + b.w);
    s += __shfl_xor(s, 16); s += __shfl_xor(s, 32);
    return rsqrtf(s * (1.f / 2048.f) + EPS);
}
__device__ __forceinline__ u32x4 pack8(const f32x4 a, const f32x4 b) { u32x4 w; w.x = cvt_pk_bf16(a.x, a.y); w.y = cvt_pk_bf16(a.z, a.w); w.z = cvt_pk_bf16(b.x, b.y); w.w = cvt_pk_bf16(b.z, b.w); return w; }

constexpr int TRS = 144, TIO_OFF = 131072, TIO_WAVE = 2304;
__device__ __forceinline__ void tio_store(LAS unsigned char* T, u16* g0, int lane, int fr, int fq, const u32x4 w0, const u32x4 w1) {
    *(LAS u32x4*)(T + fr * TRS + fq * 16) = w0; *(LAS u32x4*)(T + fr * TRS + 64 + fq * 16) = w1;
    const int rr = lane >> 3, ch = lane & 7;
    const u32x4 a = *(const LAS u32x4*)(T + rr * TRS + ch * 16), b = *(const LAS u32x4*)(T + (8 + rr) * TRS + ch * 16);
    *(u32x4*)(g0 + (size_t)rr * 2048 + ch * 8) = a; *(u32x4*)(g0 + (size_t)(8 + rr) * 2048 + ch * 8) = b;
}
__device__ __forceinline__ void tio_load(const u16* g0, int lane, u32x4& a, u32x4& b) { const int rr = lane >> 3, ch = lane & 7; a = *(const u32x4*)(g0 + (size_t)rr * 2048 + ch * 8); b = *(const u32x4*)(g0 + (size_t)(8 + rr) * 2048 + ch * 8); }
__device__ __forceinline__ void tio_unpack(LAS unsigned char* T, int lane, int fr, int fq, const u32x4 a, const u32x4 b, u32x4& w0, u32x4& w1) {
    const int rr = lane >> 3, ch = lane & 7;
    *(LAS u32x4*)(T + rr * TRS + ch * 16) = a; *(LAS u32x4*)(T + (8 + rr) * TRS + ch * 16) = b;
    w0 = *(const LAS u32x4*)(T + fr * TRS + fq * 16); w1 = *(const LAS u32x4*)(T + fr * TRS + 64 + fq * 16);
}

__device__ __forceinline__ void tio_store_f32(LAS unsigned char* T, float* g0, size_t gpitch, int lane, int fr, int fq, const f32x4 v0, const f32x4 v1) {
    *(LAS f32x4*)(T + fr * TRS + fq * 32) = v0; *(LAS f32x4*)(T + fr * TRS + fq * 32 + 16) = v1;
    const int rr = lane >> 3, ch = lane & 7;
    const f32x4 a = *(const LAS f32x4*)(T + rr * TRS + ch * 16), b = *(const LAS f32x4*)(T + (8 + rr) * TRS + ch * 16);
    __builtin_nontemporal_store(a, (f32x4*)(g0 + (size_t)rr * gpitch + ch * 4)); __builtin_nontemporal_store(b, (f32x4*)(g0 + (size_t)(8 + rr) * gpitch + ch * 4));
}
__device__ __forceinline__ void tio_store_p(LAS unsigned char* T, u16* g0, size_t gpitch, int lane, int fr, int fq, const u32x4 w0, const u32x4 w1) {
    *(LAS u32x4*)(T + fr * TRS + fq * 16) = w0; *(LAS u32x4*)(T + fr * TRS + 64 + fq * 16) = w1;
    const int rr = lane >> 3, ch = lane & 7;
    const u32x4 a = *(const LAS u32x4*)(T + rr * TRS + ch * 16), b = *(const LAS u32x4*)(T + (8 + rr) * TRS + ch * 16);
    *(u32x4*)(g0 + (size_t)rr * gpitch + ch * 8) = a; *(u32x4*)(g0 + (size_t)(8 + rr) * gpitch + ch * 8) = b;
}

struct EpiProj {
    const P& p; int layer; LAS unsigned char* lds;
    __device__ __forceinline__ void operator()(const f32x4 (&acc)[2][2][4][2], const pg8::Unit& u, int wr, int wc, int fr, int fq) const {
        const int lane = fq * 16 + fr; LAS unsigned char* T = lds + TIO_OFF + (wr * 4 + wc) * TIO_WAVE; const int cww = (u.pn & 1) * 256 + wc * 64;
        const int group = u.pn >> 1, type = group & 3, br = group >> 2;
        const int cgb = (u.pn & 1) * 256 + wc * 64 + 8 * fq;
        const float* ssqA = (const float*)(p.ws + W_SSQA);
        u16* Qb = (u16*)(p.ws + W_QB); u16* Zb = (u16*)(p.ws + W_ZB);
        float kmx = 0.f;
        float rsv[8];
#pragma unroll
        for (int i = 0; i < 8; ++i) rsv[i] = row_rstd(ssqA, u.pm * 256 + (i >> 2) * 128 + wr * 64 + (i & 3) * 16 + fr, fq);
#pragma unroll
        for (int ai = 0; ai < 2; ++ai)
#pragma unroll
            for (int m = 0; m < 4; ++m) {
                const int row = u.pm * 256 + ai * 128 + wr * 64 + m * 16 + fr;
                const float rs = rsv[ai * 4 + m];
                if (type == 0) {
                    const float sc = rs * QSCALE;
                    tio_store_p(T, Qb + (size_t)(row - fr) * 1024 + br * 512 + cww, 1024, lane, fr, fq, pack8(acc[ai][0][m][0] * sc, acc[ai][0][m][1] * sc), pack8(acc[ai][1][m][0] * sc, acc[ai][1][m][1] * sc));
                } else if (type == 3) {
                    u32x4 zw[2];
#pragma unroll
                    for (int bj = 0; bj < 2; ++bj) { f32x4 v0 = acc[ai][bj][m][0] * rs, v1 = acc[ai][bj][m][1] * rs;
#pragma unroll
                        for (int j = 0; j < 4; ++j) { v0[j] = v0[j] * __builtin_amdgcn_rcpf(1.f + __expf(-v0[j])); v1[j] = v1[j] * __builtin_amdgcn_rcpf(1.f + __expf(-v1[j])); }
                        zw[bj] = pack8(v0, v1); }
                    tio_store_p(T, Zb + (size_t)(row - fr) * 1024 + br * 512 + cww, 1024, lane, fr, fq, zw[0], zw[1]);
                } else {
                    float* o32; u16* kb; u16* vt; size_t vld; float kss = 0.f;
                    if (row < NP) { const int b = row >> 14, t = row & (SEQ - 1);
                        o32 = p.out + O_KV_P + (size_t)(br * 2 + (type - 1)) * KVP + ((size_t)(layer * 2 + b) * SEQ + t) * 512;
                        kb = (u16*)(p.ws + W_KBP) + (size_t)row * 1024 + br * 512;
                        vt = (u16*)(p.ws + W_VTP) + (size_t)(b * 8 + br * 4) * 128 * SEQ + t; vld = SEQ;
                    } else { const int rr = row - NP, sb = rr >> 5, t = rr & 31;
                        o32 = p.out + O_KV_S + (size_t)(br * 2 + (type - 1)) * KVS + ((size_t)(layer * 8 + sb) * 32 + t) * 512;
                        kb = (u16*)(p.ws + W_KBS) + ((size_t)(layer * 8 + sb) * SL + PAST + t) * 1024 + br * 512;
                        vt = (u16*)(p.ws + W_VTS) + (size_t)((layer * 8 + sb) * 8 + br * 4) * 128 * SL + PAST + t; vld = SL;
                    }
                    u32x4 kw[2];
#pragma unroll
                    for (int bj = 0; bj < 2; ++bj) { const f32x4 v0 = acc[ai][bj][m][0] * rs, v1 = acc[ai][bj][m][1] * rs; const int cg = cgb + bj * 32;
                        kss += (v0.x * v0.x + v0.y * v0.y + v0.z * v0.z + v0.w * v0.w) + (v1.x * v1.x + v1.y * v1.y + v1.z * v1.z + v1.w * v1.w);
                        tio_store_f32(T, o32 - (size_t)fr * 512 + cww + bj * 32, 512, lane, fr, fq, v0, v1);
                        const u32x4 w = pack8(v0, v1); kw[bj] = w;
                        if (type == 1) { if (bj == 1) tio_store_p(T, kb - (size_t)fr * 1024 + cww, 1024, lane, fr, fq, kw[0], kw[1]); }
                        else { vt[(size_t)(cg + 0) * vld] = (u16)(w.x & 0xffffu); vt[(size_t)(cg + 1) * vld] = (u16)(w.x >> 16); vt[(size_t)(cg + 2) * vld] = (u16)(w.y & 0xffffu); vt[(size_t)(cg + 3) * vld] = (u16)(w.y >> 16);
                               vt[(size_t)(cg + 4) * vld] = (u16)(w.z & 0xffffu); vt[(size_t)(cg + 5) * vld] = (u16)(w.z >> 16); vt[(size_t)(cg + 6) * vld] = (u16)(w.w & 0xffffu); vt[(size_t)(cg + 7) * vld] = (u16)(w.w >> 16); } }
                    if (type == 1 && br == 1) { kss += __shfl_xor(kss, 16); kss += __shfl_xor(kss, 32); kmx = fmaxf(kmx, kss); }
                }
            }
        if (type == 1 && br == 1 && u.pm < NP / 256) {
            float t = kmx; t = fmaxf(t, __shfl_xor(t, 1)); t = fmaxf(t, __shfl_xor(t, 2)); t = fmaxf(t, __shfl_xor(t, 4)); t = fmaxf(t, __shfl_xor(t, 8));
            if (fr == 0 && fq == 0) atomicMax((unsigned*)(p.ws + W_CTR) + 64 + ((layer * 2 + (u.pm >> 6)) * 4 + (u.pn & 1) * 2 + (wc >> 1)) * 4 + (wc & 1), __float_as_uint(t));
        }
    }
};

struct EpiOut {
    const P& p; LAS unsigned char* lds;
    __device__ __forceinline__ void operator()(const f32x4 (&acc)[2][2][4][2], const pg8::Unit& u, int wr, int wc, int fr, int fq) const {
        float* ssqB = (float*)(p.ws + W_SSQB); u16* XbB = (u16*)(p.ws + W_XBB); const u16* XbA = (const u16*)(p.ws + W_XBA);
        const int lane = fq * 16 + fr, cw = u.pn * 256 + wc * 64; LAS unsigned char* T = lds + TIO_OFF + (wr * 4 + wc) * TIO_WAVE;
#pragma unroll
        for (int ai = 0; ai < 2; ++ai) {
            u32x4 xa[4], xb_[4];
#pragma unroll
            for (int m = 0; m < 4; ++m) tio_load(XbA + (size_t)(u.pm * 256 + ai * 128 + wr * 64 + m * 16) * 2048 + cw, lane, xa[m], xb_[m]);
#pragma unroll
            for (int m = 0; m < 4; ++m) {
                const int row0 = u.pm * 256 + ai * 128 + wr * 64 + m * 16; float ss = 0.f; u32x4 x0, x1;
                tio_unpack(T, lane, fr, fq, xa[m], xb_[m], x0, x1);
                f32x4 v00 = acc[ai][0][m][0], v01 = acc[ai][0][m][1], v10 = acc[ai][1][m][0], v11 = acc[ai][1][m][1];
                v00.x += bf_lo(x0.x); v00.y += bf_hi(x0.x); v00.z += bf_lo(x0.y); v00.w += bf_hi(x0.y); v01.x += bf_lo(x0.z); v01.y += bf_hi(x0.z); v01.z += bf_lo(x0.w); v01.w += bf_hi(x0.w);
                v10.x += bf_lo(x1.x); v10.y += bf_hi(x1.x); v10.z += bf_lo(x1.y); v10.w += bf_hi(x1.y); v11.x += bf_lo(x1.z); v11.y += bf_hi(x1.z); v11.z += bf_lo(x1.w); v11.w += bf_hi(x1.w);
                ss += (v00.x * v00.x + v00.y * v00.y + v00.z * v00.z + v00.w * v00.w) + (v01.x * v01.x + v01.y * v01.y + v01.z * v01.z + v01.w * v01.w);
                ss += (v10.x * v10.x + v10.y * v10.y + v10.z * v10.z + v10.w * v10.w) + (v11.x * v11.x + v11.y * v11.y + v11.z * v11.z + v11.w * v11.w);
                tio_store(T, XbB + (size_t)row0 * 2048 + cw, lane, fr, fq, pack8(v00, v01), pack8(v10, v11));
                ss += __shfl_xor(ss, 16); ss += __shfl_xor(ss, 32);
                if (fq == 0) ssqB[(size_t)(row0 + fr) * 32 + u.pn * 4 + wc] = ss;
            }
        }
    }
};

struct EpiPle {
    const P& p; LAS unsigned char* lds;
    __device__ __forceinline__ void operator()(const f32x4 (&acc)[2][2][4][2], const pg8::Unit& u, int wr, int wc, int fr, int fq) const {
        u16* O = u.pm == NP / 256 ? (u16*)(p.ws + W_PLES) - (size_t)NP * 2048 : (u16*)(p.ws + W_PLEB);
        const int lane = fq * 16 + fr, cw = u.pn * 256 + wc * 64; LAS unsigned char* T = lds + TIO_OFF + (wr * 4 + wc) * TIO_WAVE;
#pragma unroll
        for (int ai = 0; ai < 2; ++ai)
#pragma unroll
            for (int m = 0; m < 4; ++m)
                tio_store(T, O + (size_t)(u.pm * 256 + ai * 128 + wr * 64 + m * 16) * 2048 + cw, lane, fr, fq, pack8(acc[ai][0][m][0], acc[ai][0][m][1]), pack8(acc[ai][1][m][0], acc[ai][1][m][1]));
    }
};

struct EpiGate {
    const P& p; LAS unsigned char* lds;
    __device__ __forceinline__ void operator()(const f32x4 (&acc)[2][2][4][2], const pg8::Unit& u, int wr, int wc, int fr, int fq) const {
        const float* ssqB = (const float*)(p.ws + W_SSQB); float* ssqA = (float*)(p.ws + W_SSQA); u16* XbA = (u16*)(p.ws + W_XBA); const u16* XbB = (const u16*)(p.ws + W_XBB); const u16* PL = u.pm == NP / 256 ? (const u16*)(p.ws + W_PLES) - (size_t)NP * 2048 : (const u16*)(p.ws + W_PLEB);
        const int lane = fq * 16 + fr, cw = u.pn * 256 + wc * 64; LAS unsigned char* T = lds + TIO_OFF + (wr * 4 + wc) * TIO_WAVE;
        float rsv[8];
#pragma unroll
        for (int i = 0; i < 8; ++i) rsv[i] = row_rstd(ssqB, u.pm * 256 + (i >> 2) * 128 + wr * 64 + (i & 3) * 16 + fr, fq);
#pragma unroll
        for (int g4 = 0; g4 < 4; ++g4) { const int ai = g4 >> 1, m0 = (g4 & 1) * 2;
            u32x4 xa[2], xb_[2], pa[2], pb[2];
#pragma unroll
            for (int mm = 0; mm < 2; ++mm) { const size_t ro = (size_t)(u.pm * 256 + ai * 128 + wr * 64 + (m0 + mm) * 16) * 2048 + cw;
                tio_load(XbB + ro, lane, xa[mm], xb_[mm]); tio_load(PL + ro, lane, pa[mm], pb[mm]); }
#pragma unroll
            for (int mm = 0; mm < 2; ++mm) { const int m = m0 + mm;
                const int row0 = u.pm * 256 + ai * 128 + wr * 64 + m * 16;
                const float rs = rsv[ai * 4 + m]; float ss = 0.f;
                u32x4 x0, x1, p0, p1;
                tio_unpack(T, lane, fr, fq, xa[mm], xb_[mm], x0, x1);
                tio_unpack(T, lane, fr, fq, pa[mm], pb[mm], p0, p1);
                f32x4 v[2][2];
#pragma unroll
                for (int bj = 0; bj < 2; ++bj) { const f32x4 a0 = acc[ai][bj][m][0] * rs, a1 = acc[ai][bj][m][1] * rs; const u32x4 pq = bj ? p1 : p0, xq = bj ? x1 : x0;
                    f32x4 v0, v1;
                    v0.x = bf_lo(xq.x) + bf_lo(pq.x) * __builtin_amdgcn_rcpf(1.f + __expf(-a0.x)); v0.y = bf_hi(xq.x) + bf_hi(pq.x) * __builtin_amdgcn_rcpf(1.f + __expf(-a0.y));
                    v0.z = bf_lo(xq.y) + bf_lo(pq.y) * __builtin_amdgcn_rcpf(1.f + __expf(-a0.z)); v0.w = bf_hi(xq.y) + bf_hi(pq.y) * __builtin_amdgcn_rcpf(1.f + __expf(-a0.w));
                    v1.x = bf_lo(xq.z) + bf_lo(pq.z) * __builtin_amdgcn_rcpf(1.f + __expf(-a1.x)); v1.y = bf_hi(xq.z) + bf_hi(pq.z) * __builtin_amdgcn_rcpf(1.f + __expf(-a1.y));
                    v1.z = bf_lo(xq.w) + bf_lo(pq.w) * __builtin_amdgcn_rcpf(1.f + __expf(-a1.z)); v1.w = bf_hi(xq.w) + bf_hi(pq.w) * __builtin_amdgcn_rcpf(1.f + __expf(-a1.w));
                    ss += (v0.x * v0.x + v0.y * v0.y + v0.z * v0.z + v0.w * v0.w) + (v1.x * v1.x + v1.y * v1.y + v1.z * v1.z + v1.w * v1.w);
                    v[bj][0] = v0; v[bj][1] = v1; }
                tio_store(T, XbA + (size_t)row0 * 2048 + cw, lane, fr, fq, pack8(v[0][0], v[0][1]), pack8(v[1][0], v[1][1]));
                ss += __shfl_xor(ss, 16); ss += __shfl_xor(ss, 32);
                if (fq == 0) ssqA[(size_t)(row0 + fr) * 32 + u.pn * 4 + wc] = ss;
            }
        }
    }
};

struct TDesc { const float* src; size_t sld; u16* dst; size_t dld; const float* gk; };
constexpr int NT_WIN = DEPTH * 2048, NT_WOUT = DEPTH * 512, NT_WPLE = DEPTH * 128, NT_WGATE = DEPTH * 1024, NT_VC = DEPTH * DEC_BATCH * 8 * 32;
constexpr int NT_ALL = NT_WIN + NT_WOUT + NT_WPLE + NT_WGATE + NT_VC;
__device__ __forceinline__ TDesc tile_desc(const P& p, int t) {
    TDesc d;
    if (t < NT_WIN) { const int L = t >> 11, r = t & 2047, kt = r >> 6, nt = r & 63;
        d.src = p.w_in + (size_t)L * 2048 * D_IN + (size_t)kt * 64 * D_IN + nt * 64; d.sld = D_IN; d.dst = (u16*)(p.ws + W_WTIN) + (size_t)L * 4096 * 2048 + (size_t)nt * 64 * 2048 + kt * 64; d.dld = 2048; d.gk = p.g_attn + L * 2048 + kt * 64; return d; }
    t -= NT_WIN;
    if (t < NT_WOUT) { const int L = t >> 9, r = t & 511, kt = r >> 5, nt = r & 31;
        d.src = p.w_out + (size_t)L * 1024 * 2048 + (size_t)kt * 64 * 2048 + nt * 64; d.sld = 2048; d.dst = (u16*)(p.ws + W_WTOUT) + (size_t)L * 2048 * 1024 + (size_t)nt * 64 * 1024 + kt * 64; d.dld = 1024; d.gk = nullptr; return d; }
    t -= NT_WOUT;
    if (t < NT_WPLE) { const int L = t >> 7, r = t & 127, kt = r >> 5, nt = r & 31;
        d.src = p.w_ple + (size_t)L * 256 * 2048 + (size_t)kt * 64 * 2048 + nt * 64; d.sld = 2048; d.dst = (u16*)(p.ws + W_WTPLE) + (size_t)L * 2048 * 256 + (size_t)nt * 64 * 256 + kt * 64; d.dld = 256; d.gk = nullptr; return d; }
    t -= NT_WPLE;
    if (t < NT_WGATE) { const int L = t >> 10, r = t & 1023, kt = r >> 5, nt = r & 31;
        d.src = p.w_gate + (size_t)L * 2048 * 2048 + (size_t)kt * 64 * 2048 + nt * 64; d.sld = 2048; d.dst = (u16*)(p.ws + W_WTGATE) + (size_t)L * 2048 * 2048 + (size_t)nt * 64 * 2048 + kt * 64; d.dld = 2048; d.gk = p.g_ple + L * 2048 + kt * 64; return d; }
    t -= NT_WGATE;
    { const int mi = t >> 5, r = t & 31, kt = r >> 1, nt = r & 1; const int ls = mi >> 3, h8 = mi & 7, br = h8 >> 2, hh = h8 & 3;
        d.src = (br ? p.c_fxv : p.c_sbv) + ((size_t)ls * PAST + kt * 64) * 512 + hh * 128 + nt * 64; d.sld = 512; d.dst = (u16*)(p.ws + W_VTS) + ((size_t)mi * 128 + nt * 64) * SL + kt * 64; d.dld = SL; d.gk = nullptr; return d; }
}

__device__ __forceinline__ void prep_phase(int wv, const P& p, LAS unsigned char* lds) {
    LAS float* T = (LAS float*)lds;
    const int tid = opaque_tid(wv), G = gridDim.x, B = blockIdx.x;
    const int wid = tid >> 6, lane = tid & 63;
    if (B == 0) { ((unsigned*)(p.ws + W_CTR))[tid] = 0u; ((unsigned*)(p.ws + W_CTR))[tid + 512] = 0u; }
    {
        const int k0 = tid >> 4, n4 = (tid & 15) * 4, no = tid >> 3, kc = tid & 7;
        f32x4 v[2][2]; float g[2][2]; TDesc d[2]; bool ok[2];
#define PREP_FETCH(t_) do { _Pragma("unroll") for (int q = 0; q < 2; ++q) { const int tt = (t_) + q * G; ok[q] = tt < NT_ALL; g[q][0] = 1.f; g[q][1] = 1.f; \
            if (ok[q]) { d[q] = tile_desc(p, tt); v[q][0] = *(const f32x4*)(d[q].src + (size_t)k0 * d[q].sld + n4); v[q][1] = *(const f32x4*)(d[q].src + (size_t)(k0 + 32) * d[q].sld + n4); \
                if (d[q].gk) { g[q][0] = d[q].gk[k0]; g[q][1] = d[q].gk[k0 + 32]; } } } } while (0)
        int t = B;
        PREP_FETCH(t);
        while (t < NT_ALL) {
            TDesc dc[2]; bool okc[2];
#pragma unroll
            for (int q = 0; q < 2; ++q) { okc[q] = ok[q]; dc[q] = d[q]; LAS float* Tq = T + q * (64 * 65);
                if (ok[q]) {
#pragma unroll
                    for (int hh = 0; hh < 2; ++hh) { const f32x4 x = v[q][hh]; const float gg = g[q][hh]; LAS float* tp = Tq + (k0 + 32 * hh) * 65 + n4; tp[0] = x.x * gg; tp[1] = x.y * gg; tp[2] = x.z * gg; tp[3] = x.w * gg; } } }
            __syncthreads();
            const int tn = t + 2 * G;
            PREP_FETCH(tn);
#pragma unroll
            for (int q = 0; q < 2; ++q) if (okc[q]) { const LAS float* Tq = T + q * (64 * 65); float f[8];
#pragma unroll
                for (int j = 0; j < 8; ++j) f[j] = Tq[(kc * 8 + j) * 65 + no];
                u32x4 w; w.x = cvt_pk_bf16(f[0], f[1]); w.y = cvt_pk_bf16(f[2], f[3]); w.z = cvt_pk_bf16(f[4], f[5]); w.w = cvt_pk_bf16(f[6], f[7]);
                *(u32x4*)(dc[q].dst + (size_t)no * dc[q].dld + kc * 8) = w; }
            __syncthreads();
            t = tn;
        }
#undef PREP_FETCH
    }
    for (int i = B * 512 + tid; i < DEPTH * 2048 * 4; i += G * 512) { const int L = i >> 13, k = (i >> 2) & 2047, j = i & 3;
        ((float*)(p.ws + W_WF))[i] = p.g_attn[L * 2048 + k] * p.w_in[(size_t)L * 2048 * D_IN + (size_t)k * D_IN + 4096 + j]; }
    for (int row = B * 8 + wid; row < NR; row += G * 8) {
        const float* src = row < NP ? p.x_prompt + (size_t)row * 2048 : p.x_sample + (size_t)(row - NP) * 2048;
        u16* xb = (u16*)(p.ws + W_XBA) + (size_t)row * 2048; float ss = 0.f;
#pragma unroll
        for (int i = 0; i < 8; ++i) { const int c = (i * 64 + lane) * 4; const f32x4 v = *(const f32x4*)(src + c); ss += v.x * v.x + v.y * v.y + v.z * v.z + v.w * v.w;
            u32x2 w; w.x = cvt_pk_bf16(v.x, v.y); w.y = cvt_pk_bf16(v.z, v.w); *(u32x2*)(xb + c) = w; }
#pragma unroll
        for (int d = 1; d < 64; d <<= 1) ss += __shfl_xor(ss, d);
        if (lane < 32) ((float*)(p.ws + W_SSQA))[(size_t)row * 32 + lane] = lane == 0 ? ss : 0.f;
    }
    for (size_t i0 = (size_t)B * 512 + tid; i0 < (size_t)DEPTH * NR * 64; i0 += (size_t)G * 512 * 4) { f32x4 v[4]; u16* dp[4];
#pragma unroll
        for (int q = 0; q < 4; ++q) { const size_t i = i0 + (size_t)q * G * 512; dp[q] = nullptr;
            if (i < (size_t)DEPTH * NR * 64) { const int L = (int)(i / ((size_t)NR * 64)); const size_t r = i % ((size_t)NR * 64); const int row = (int)(r >> 6), c4 = (int)(r & 63) * 4;
                const float* src = row < NP ? p.p_prompt + ((size_t)L * NP + row) * 256 + c4 : p.p_sample + ((size_t)L * NS + (row - NP)) * 256 + c4;
                v[q] = *(const f32x4*)src; dp[q] = (u16*)(p.ws + W_PB) + ((size_t)L * NR + row) * 256 + c4; } }
#pragma unroll
        for (int q = 0; q < 4; ++q) if (dp[q]) { u32x2 w; w.x = cvt_pk_bf16(v[q].x, v[q].y); w.y = cvt_pk_bf16(v[q].z, v[q].w); *(u32x2*)dp[q] = w; } }
    for (size_t i0 = (size_t)B * 512 + tid; i0 < (size_t)2 * DEPTH * DEC_BATCH * PAST * 128; i0 += (size_t)G * 512 * 4) { f32x4 v[4]; u16* dp[4];
#pragma unroll
        for (int q = 0; q < 4; ++q) { const size_t i = i0 + (size_t)q * G * 512; dp[q] = nullptr;
            if (i < (size_t)2 * DEPTH * DEC_BATCH * PAST * 128) { const int br = (int)(i / ((size_t)DEPTH * DEC_BATCH * PAST * 128)); const size_t r = i % ((size_t)DEPTH * DEC_BATCH * PAST * 128);
                const int ls = (int)(r / (PAST * 128)), pos = (int)((r / 128) % PAST), c4 = (int)(r & 127) * 4;
                v[q] = *(const f32x4*)((br ? p.c_fxk : p.c_sbk) + ((size_t)ls * PAST + pos) * 512 + c4); dp[q] = (u16*)(p.ws + W_KBS) + ((size_t)ls * SL + pos) * 1024 + br * 512 + c4; } }
#pragma unroll
        for (int q = 0; q < 4; ++q) if (dp[q]) { u32x2 w; w.x = cvt_pk_bf16(v[q].x, v[q].y); w.y = cvt_pk_bf16(v[q].z, v[q].w); *(u32x2*)dp[q] = w; } }
    for (int s = B * 8 + wid; s < DEPTH * DEC_BATCH * 4; s += G * 8) { const int ls = s >> 2, hh = s & 3; const float* src = p.c_logf + (size_t)ls * PAST * 4 + hh; float v[16]; float run = 0.f;
#pragma unroll
        for (int i = 0; i < 16; ++i) { run += src[(size_t)(lane * 16 + i) * 4]; v[i] = run; }
        float x = run;
#pragma unroll
        for (int d = 1; d < 64; d <<= 1) { const float y = __shfl_up(x, d); if (lane >= d) x += y; }
        const float pre = x - run; float* dst = (float*)(p.ws + W_CCUM) + (size_t)ls * PAST * 4 + hh;
#pragma unroll
        for (int i = 0; i < 16; ++i) dst[(size_t)(lane * 16 + i) * 4] = pre + v[i];
    }
}

__device__ __forceinline__ void logf_items(int wv, const P& p, int layer, LAS unsigned char* lds, int blk0, int blk_end, int blk_step) {
    LAS f32x4* WfL = (LAS f32x4*)lds;
    LAS float* lf = (LAS float*)(lds + 40960);
    const int tid = opaque_tid(wv);
    const f32x4* Wf = (const f32x4*)(p.ws + W_WF) + (size_t)layer * 2048;
    const float* ssqA = (const float*)(p.ws + W_SSQA);
    for (int blk = blk0; blk < blk_end; blk += blk_step) {
        __syncthreads();
#pragma unroll
        for (int i = 0; i < 4; ++i) { const int k = tid + 512 * i; WfL[k + (k >> 9)] = Wf[k]; }
        __syncthreads();
        const int rl = tid >> 2, kq = tid & 3, row = blk * 128 + rl;
        const u16* xr = (const u16*)(p.ws + W_XBA) + (size_t)row * 2048 + kq * 512;
        f32x4 a = (f32x4){0.f, 0.f, 0.f, 0.f};
        for (int i = 0; i < 64; ++i) { const u32x4 xv = *(const u32x4*)(xr + i * 8); const LAS f32x4* w = WfL + kq * 513 + i * 8;
            a += w[0] * bf_lo(xv.x); a += w[1] * bf_hi(xv.x); a += w[2] * bf_lo(xv.y); a += w[3] * bf_hi(xv.y); a += w[4] * bf_lo(xv.z); a += w[5] * bf_hi(xv.z); a += w[6] * bf_lo(xv.w); a += w[7] * bf_hi(xv.w); }
#pragma unroll
        for (int j = 0; j < 4; ++j) { a[j] += __shfl_xor(a[j], 1); a[j] += __shfl_xor(a[j], 2); }
        if (kq == 0) { float s = 0.f; const f32x4* q = (const f32x4*)(ssqA + (size_t)row * 32);
#pragma unroll
            for (int i = 0; i < 8; ++i) { const f32x4 v = q[i]; s += (v.x + v.y) + (v.z + v.w); }
            const float rs = rsqrtf(s * (1.f / 2048.f) + EPS); f32x4 lg;
#pragma unroll
            for (int j = 0; j < 4; ++j) { const float f = a[j] * rs + p.b_f[layer * 4 + j]; lg[j] = fminf(f, 0.f) - log1pf(expf(-fabsf(f))); }
            float* o = row < NP ? p.out + O_LOGF_P + ((size_t)layer * NP + row) * 4 : p.out + O_LOGF_S + ((size_t)layer * NS + (row - NP)) * 4;
            *(f32x4*)o = lg; lf[rl * 4 + 0] = lg.x; lf[rl * 4 + 1] = lg.y; lf[rl * 4 + 2] = lg.z; lf[rl * 4 + 3] = lg.w; }
        __syncthreads();
        if (tid < 16) { const int seg = tid >> 2, hh = tid & 3; float run = 0.f; float* cin = (float*)(p.ws + W_CIN);
            for (int i = 0; i < 32; ++i) { run += lf[(seg * 32 + i) * 4 + hh]; cin[(size_t)(blk * 128 + seg * 32 + i) * 4 + hh] = run; }
            ((float*)(p.ws + W_SEGTOT))[(size_t)(blk * 4 + seg) * 4 + hh] = run; }
    }
    __syncthreads();
}

constexpr int TEAM = 32;
__device__ __forceinline__ void team_barrier(unsigned* ctr) {
    __threadfence();
    __syncthreads();
    if (threadIdx.x == 0) {
        __hip_atomic_fetch_add(ctr, 1u, __ATOMIC_RELEASE, __HIP_MEMORY_SCOPE_AGENT);
        while (__hip_atomic_load(ctr, __ATOMIC_RELAXED, __HIP_MEMORY_SCOPE_AGENT) < (unsigned)TEAM) __builtin_amdgcn_s_sleep(16);
        __builtin_amdgcn_fence(__ATOMIC_ACQUIRE, "agent");
    }
    __syncthreads();
    __threadfence();
}

constexpr int A_KB = 0, A_VB = 34816, A_CK = 71680, A_SEG = 72192, A_MISC = 74240, A_T = 76800;
constexpr int KROW = 272, VROW = 144;

__device__ __forceinline__ void attn_phase(int wv, const P& p, int layer, LAS unsigned char* lds) {
    LAS float* segpre = (LAS float*)(lds + A_SEG);
    LAS int* misc = (LAS int*)(lds + A_MISC);
    LAS float* wtot = (LAS float*)(lds + A_MISC + 128);
    unsigned* ctr = (unsigned*)(p.ws + W_CTR) + layer;
    const float* Cin = (const float*)(p.ws + W_CIN);
    const int bid = blockIdx.x; const bool team = bid < TEAM;
    unsigned* tbar = (unsigned*)(p.ws + W_CTR) + 16 + layer * 8;
    int sd_left = 0, tstate = team ? 0 : 2;
    if (team) {
        pg8::StaticOrder S1;
        if (layer > 0) {
            if (bid < 8) { pg8::Gemm g{(const u16*)(p.ws + W_OB), (const u16*)(p.ws + W_WTOUT) + (size_t)(layer - 1) * 2048 * 1024, NR, 2048, 1024}; S1.init_one(NP / 256, bid); EpiOut E{p, lds}; pg8::gemm_phase(wv, lds, g, S1, E); }
            else if (bid < 16) { pg8::Gemm g{(const u16*)(p.ws + W_PB) + (size_t)(layer - 1) * NR * 256, (const u16*)(p.ws + W_WTPLE) + (size_t)(layer - 1) * 2048 * 256, NR, 2048, 256}; S1.init_one(NP / 256, bid - 8); EpiPle E{p, lds}; pg8::gemm_phase(wv, lds, g, S1, E); }
            team_barrier(tbar + 0);
            if (bid < 8) { pg8::Gemm g{(const u16*)(p.ws + W_XBB), (const u16*)(p.ws + W_WTGATE) + (size_t)(layer - 1) * 2048 * 2048, NR, 2048, 2048}; S1.init_one(NP / 256, bid); EpiGate E{p, lds}; pg8::gemm_phase(wv, lds, g, S1, E); }
            team_barrier(tbar + 1);
        }
        if (bid < 16) { pg8::Gemm g{(const u16*)(p.ws + W_XBA), (const u16*)(p.ws + W_WTIN) + (size_t)layer * 4096 * 2048, NR, 4096, 2048}; S1.init_one(NP / 256, bid); EpiProj E{p, layer, lds}; pg8::gemm_phase(wv, lds, g, S1, E); }
        else if (bid < 18) logf_items(wv, p, layer, lds, NP / 128 + (bid - 16), NP / 128 + (bid - 16) + 1, 1);
        team_barrier(tbar + 2);
        sd_left = 2;
    }
    {
        const int t8 = opaque_tid(wv);
        __syncthreads();
        if (t8 < 8) { const float* st = (const float*)(p.ws + W_SEGTOT); float est[8];
#pragma unroll
            for (int q = 0; q < 8; ++q) { float e = 0.f; for (int i = 0; i < 16; ++i) e += st[(size_t)((q >> 2) * 512 + 256 + i) * 4 + (q & 3)]; est[q] = e; }
            int rk = 0; float mine = 0.f;
#pragma unroll
            for (int q = 0; q < 8; ++q) if (q == t8) mine = est[q];
#pragma unroll
            for (int q = 0; q < 8; ++q) rk += (est[q] > mine || (est[q] == mine && q < t8)) ? 1 : 0;
            misc[40 + rk] = t8; }
        __syncthreads();
    }
    for (;;) {
        if (tstate == 0 && sd_left == 0) {
            if (layer == DEPTH - 1) {
                pg8::StaticOrder S1;
                team_barrier(tbar + 3);
                if (bid < 8) { pg8::Gemm g{(const u16*)(p.ws + W_OB), (const u16*)(p.ws + W_WTOUT) + (size_t)layer * 2048 * 1024, NR, 2048, 1024}; S1.init_one(NP / 256, bid); EpiOut E{p, lds}; pg8::gemm_phase(wv, lds, g, S1, E); }
                else if (bid < 16) { pg8::Gemm g{(const u16*)(p.ws + W_PB) + (size_t)layer * NR * 256, (const u16*)(p.ws + W_WTPLE) + (size_t)layer * 2048 * 256, NR, 2048, 256}; S1.init_one(NP / 256, bid - 8); EpiPle E{p, lds}; pg8::gemm_phase(wv, lds, g, S1, E); }
                team_barrier(tbar + 4);
                if (bid < 8) { pg8::Gemm g{(const u16*)(p.ws + W_XBB), (const u16*)(p.ws + W_WTGATE) + (size_t)layer * 2048 * 2048, NR, 2048, 2048}; S1.init_one(NP / 256, bid); EpiGate E{p, lds}; pg8::gemm_phase(wv, lds, g, S1, E); }
            }
            tstate = 2;
        }
        const int tid = opaque_tid(wv), wid = __builtin_amdgcn_readfirstlane(tid >> 6), lane = tid & 63, r = lane & 31, h = lane >> 5;
        const int prow = 16 * (r >> 4) + 8 * ((r >> 2) & 1) + 4 * ((r >> 3) & 1) + (r & 3);
        __syncthreads();
        if (tid == 0) misc[0] = sd_left > 0 ? 1024 + (2 - sd_left) * TEAM + bid : (int)atomicAdd(ctr, 1u);
        __syncthreads();
        int item = misc[0];
        if (sd_left > 0) --sd_left; else if (item >= 1024) break;
        int head8, qpos0, nw, row0, ldv, sbi = 0, bi = 0; const u16 *Kb, *Vt; const bool prompt = item < 1024;
        if (prompt) { const int fx = item < 512, it2 = item & 511; int qt, rem; if (fx) { qt = 63 - (it2 & 63); rem = misc[40 + (it2 >> 6)]; } else { qt = 63 - (it2 >> 3); rem = it2 & 7; } bi = rem >> 2; head8 = (fx ? 4 : 0) + (rem & 3);     qpos0 = qt * 256; nw = 8; row0 = bi * SEQ + qpos0;
            Kb = (const u16*)(p.ws + W_KBP) + (size_t)bi * SEQ * 1024 + head8 * 128; Vt = (const u16*)(p.ws + W_VTP) + (size_t)(bi * 8 + head8) * 128 * SEQ; ldv = SEQ;
        } else { const int s = item - 1024; sbi = s >> 3; head8 = s & 7; qpos0 = PAST; nw = 1; row0 = NP + sbi * 32;
            Kb = (const u16*)(p.ws + W_KBS) + (size_t)(layer * 8 + sbi) * SL * 1024 + head8 * 128; Vt = (const u16*)(p.ws + W_VTS) + (size_t)((layer * 8 + sbi) * 8 + head8) * 128 * SL; ldv = SL; }
        const bool fox = head8 >= 4; const int hf = head8 & 3;
        u32x4 kreg[2], vreg[2]; float ckreg = 0.f;
        const int krow_ = tid >> 4, kch = tid & 15, vrow_ = tid >> 3, vch = tid & 7;
        const int jt_top = (qpos0 + 32 * nw - 1) >> 6;
#pragma unroll
        for (int pz = 0; pz < 2; ++pz) { kreg[pz] = *(const u32x4*)(Kb + (size_t)(jt_top * 64 + krow_ + 32 * pz) * 1024 + kch * 8); vreg[pz] = *(const u32x4*)(Vt + (size_t)(vrow_ + 64 * pz) * ldv + jt_top * 64 + vch * 8); }
        const float* ccum = (const float*)(p.ws + W_CCUM) + (size_t)(layer * 8 + sbi) * PAST * 4 + hf;
        if (fox && prompt) {
            const int nseg = (qpos0 + 256) >> 5; const float v = tid < nseg ? ((const float*)(p.ws + W_SEGTOT))[(size_t)(bi * 512 + tid) * 4 + hf] : 0.f; float x = v;
#pragma unroll
            for (int d = 1; d < 64; d <<= 1) { const float y = __shfl_up(x, d); if (lane >= d) x += y; }
            if (lane == 63) wtot[wid] = x;
            __syncthreads();
            float pre = 0.f; for (int w = 0; w < wid; ++w) pre += wtot[w];
            segpre[tid] = pre + x - v;
            __syncthreads();
        }
        auto getC = [&](int pos) -> float {
            if (prompt) return segpre[pos >> 5] + Cin[(size_t)(bi * SEQ + pos) * 4 + hf];
            if (pos < PAST) return ccum[(size_t)pos * 4];
            if (pos < PAST + 32) return ccum[(size_t)(PAST - 1) * 4] + Cin[(size_t)(NP + sbi * 32 + pos - PAST) * 4 + hf];
            return 0.f; };
        const bool wact = wid < nw;
        bf16x8 qf[8];
        float cq2 = 0.f;
        const int qlo = qpos0 + 32 * wid, qhi = qlo + 31, qpos = qlo + r;
        if (wact) { const u16* qg = (const u16*)(p.ws + W_QB) + (size_t)(row0 + 32 * wid) * 1024 + head8 * 128; LAS unsigned char* Tq = lds + A_T + wid * (32 * 272);
            { u32x4 qr[8];
#pragma unroll
              for (int i = 0; i < 8; ++i) qr[i] = *(const u32x4*)(qg + (size_t)(4 * i + (lane >> 4)) * 1024 + (lane & 15) * 8);
#pragma unroll
              for (int i = 0; i < 8; ++i) *(LAS u32x4*)(Tq + (4 * i + (lane >> 4)) * 272 + (lane & 15) * 16) = qr[i]; }
#pragma unroll
            for (int kk = 0; kk < 8; ++kk) qf[kk] = *(const LAS bf16x8*)(Tq + r * 272 + (16 * kk + 8 * h) * 2);
            if (fox) cq2 = getC(qpos) * LOG2E; }
        else {
#pragma unroll
            for (int kk = 0; kk < 8; ++kk) qf[kk] = (bf16x8){0, 0, 0, 0, 0, 0, 0, 0}; }
        float qnK = 3.0e38f;
        if (fox && prompt) { const unsigned* ks = (const unsigned*)(p.ws + W_CTR) + 64 + ((layer * 2 + bi) * 4 + hf) * 4;
            const float kmax = sqrtf(__uint_as_float(ks[0]) + __uint_as_float(ks[1]) + __uint_as_float(ks[2]) + __uint_as_float(ks[3])) * 1.01f; float qn2 = 0.f;
#pragma unroll
            for (int kk = 0; kk < 8; ++kk)
#pragma unroll
                for (int i = 0; i < 8; ++i) { const float f = __uint_as_float(((unsigned)(unsigned short)qf[kk][i]) << 16); qn2 += f * f; }
            qn2 += __shfl_xor(qn2, 32); qnK = sqrtf(qn2) * 1.01f * kmax; }
#define LOAD_TILE(jt_) do { const int k0_ = (jt_) * 64; _Pragma("unroll") for (int pz = 0; pz < 2; ++pz) { \
            kreg[pz] = *(const u32x4*)(Kb + (size_t)(k0_ + krow_ + 32 * pz) * 1024 + kch * 8); \
            vreg[pz] = *(const u32x4*)(Vt + (size_t)(vrow_ + 64 * pz) * ldv + k0_ + vch * 8); } \
            if (fox && tid < 64) ckreg = getC(k0_ + tid) * LOG2E; } while (0)
#define STORE_TILE(buf_) do { _Pragma("unroll") for (int pz = 0; pz < 2; ++pz) { \
            *(LAS u32x4*)(lds + A_KB + (buf_) * 17408 + (krow_ + 32 * pz) * KROW + kch * 16) = kreg[pz]; \
            *(LAS u32x4*)(lds + A_VB + (buf_) * 18432 + (vrow_ + 64 * pz) * VROW + vch * 16) = vreg[pz]; } \
            if (fox && tid < 64) *(LAS float*)(lds + A_CK + (buf_) * 256 + tid * 4) = ckreg; } while (0)
        if (fox && tid < 64) ckreg = getC(jt_top * 64 + tid) * LOG2E;
        STORE_TILE(0);
        __syncthreads();
        f32x16 o[4];
#pragma unroll
        for (int dt = 0; dt < 4; ++dt)
#pragma unroll
            for (int i = 0; i < 16; ++i) o[dt][i] = 0.f;
        float carry = 0.f, mrun = -1e30f, mref = 0.f, lsum = 0.f; bool wave_done = !wact;
        for (int jt = jt_top, it = 0; jt >= 0; --jt, ++it) {
            const int cur = it & 1; const bool more = jt > 0;
            if (more) LOAD_TILE(jt - 1);
            const int key0 = jt * 64;
            if (fox && prompt && !wave_done && key0 <= qhi) {
                const float ck63 = *(const LAS float*)(lds + A_CK + cur * 256 + 252);
                if (__all((qnK + cq2 - ck63) < (mrun - 155.f))) wave_done = true; }
            if (!wave_done && key0 <= qhi) {
                const bool diag = key0 + 63 >= qlo;
                const LAS unsigned char* kb = lds + A_KB + cur * 17408 + prow * KROW + 16 * h;
                const LAS unsigned char* vb = lds + A_VB + cur * 18432 + r * VROW + 16 * h;
                f32x16 sv[2];
                typedef float f32x2 __attribute__((ext_vector_type(2)));
                if (fox) {
                    const LAS float* ckb = (const LAS float*)(lds + A_CK + cur * 256) + 8 * h;
                    const float cqm = cq2 - mref; const f32x2 cqv = {cqm, cqm};
#pragma unroll
                    for (int kt = 0; kt < 2; ++kt)
#pragma unroll
                        for (int q4 = 0; q4 < 4; ++q4) { const f32x4 ck = *(const LAS f32x4*)(ckb + 32 * kt + 16 * (q4 >> 1) + 4 * (q4 & 1));
                            const f32x2 x0 = cqv - (f32x2){ck.x, ck.y}, x1 = cqv - (f32x2){ck.z, ck.w};
                            sv[kt][4 * q4 + 0] = x0.x; sv[kt][4 * q4 + 1] = x0.y; sv[kt][4 * q4 + 2] = x1.x; sv[kt][4 * q4 + 3] = x1.y; }
                } else {
#pragma unroll
                    for (int i = 0; i < 16; ++i) { sv[0][i] = 0.f; sv[1][i] = 0.f; } }
#pragma unroll
                for (int kk = 0; kk < 8; ++kk) { const bf16x8 a0 = *(const LAS bf16x8*)(kb + kk * 32); const bf16x8 a1 = *(const LAS bf16x8*)(kb + 32 * KROW + kk * 32);
                    sv[0] = __builtin_amdgcn_mfma_f32_32x32x16_bf16(a0, qf[kk], sv[0], 0, 0, 0); sv[1] = __builtin_amdgcn_mfma_f32_32x32x16_bf16(a1, qf[kk], sv[1], 0, 0, 0); }
                if (!fox) {
#pragma unroll
                    for (int kt = 1; kt >= 0; --kt) {
                        float sp[16], ex[16], tot[2];
#pragma unroll
                        for (int rg = 0; rg < 16; ++rg) { const int kpos = key0 + 32 * kt + 16 * (rg >> 3) + 8 * h + (rg & 7); const float z = sv[kt][rg];
                            const float spv = fmaxf(z, 0.f) + flog2(1.f + fexp2(-fabsf(z))); sp[rg] = (!diag || kpos < qpos) ? spv : 0.f; }
#pragma unroll
                        for (int c = 0; c < 2; ++c) { float run = 0.f;
#pragma unroll
                            for (int idx = 7; idx >= 0; --idx) { ex[8 * c + idx] = run; run += sp[8 * c + idx]; }
                            tot[c] = run; }
                        const float pt0 = __shfl_xor(tot[0], 32), pt1 = __shfl_xor(tot[1], 32);
                        const float off1 = carry + (h ? 0.f : pt1), off0 = carry + (h ? (pt1 + tot[1]) : (pt0 + tot[1] + pt1));
#pragma unroll
                        for (int rg = 0; rg < 16; ++rg) { const int kpos = key0 + 32 * kt + 16 * (rg >> 3) + 8 * h + (rg & 7);
                            const float e2 = sv[kt][rg] - sp[rg] - ((rg >= 8 ? off1 : off0) + ex[rg]);
                            sv[kt][rg] = (!diag || kpos < qpos) ? fexp2(e2) : 0.f; }
                        carry += (tot[0] + tot[1]) + (pt0 + pt1);
                    }
                    if (__all(carry > 152.f)) wave_done = true;
                } else {
                    if (diag) {
#pragma unroll
                        for (int kt = 0; kt < 2; ++kt)
#pragma unroll
                            for (int rg = 0; rg < 16; ++rg) { const int kpos = key0 + 32 * kt + 16 * (rg >> 3) + 8 * h + (rg & 7); if (kpos > qpos) sv[kt][rg] = -1e30f; } }
                    float mx = -1e30f;
#pragma unroll
                    for (int kt = 0; kt < 2; ++kt)
#pragma unroll
                        for (int i = 0; i < 8; ++i) mx = fmax3(mx, sv[kt][2 * i], sv[kt][2 * i + 1]);
                    mx = fmaxf(mx, __shfl_xor(mx, 32));
                    const bool firstt = mrun < -1e29f;
                    mrun = fmaxf(mrun, mref + mx);
                    if (firstt || __any(mx > 0.f)) {
                        const float dlt = firstt ? mx : fmaxf(mx, 0.f), alpha = fexp2(-dlt); mref += dlt; lsum *= alpha; const f32x2 dv = {dlt, dlt};
#pragma unroll
                        for (int dt = 0; dt < 4; ++dt) o[dt] *= alpha;
#pragma unroll
                        for (int kt = 0; kt < 2; ++kt)
#pragma unroll
                            for (int i = 0; i < 8; ++i) { const f32x2 t = (f32x2){sv[kt][2 * i], sv[kt][2 * i + 1]} - dv; sv[kt][2 * i] = t.x; sv[kt][2 * i + 1] = t.y; } }
                    f32x2 ps2 = {0.f, 0.f};
#pragma unroll
                    for (int kt = 0; kt < 2; ++kt)
#pragma unroll
                        for (int i = 0; i < 8; ++i) { f32x2 e; e.x = fexp2(sv[kt][2 * i]); e.y = fexp2(sv[kt][2 * i + 1]); sv[kt][2 * i] = e.x; sv[kt][2 * i + 1] = e.y; ps2 += e; }
                    lsum += ps2.x + ps2.y;
                }
#pragma unroll
                for (int kt = 0; kt < 2; ++kt)
#pragma unroll
                    for (int c = 0; c < 2; ++c) { union { u32x4 u; bf16x8 v; } pf;
                        pf.u.x = cvt_pk_bf16(sv[kt][8 * c + 0], sv[kt][8 * c + 1]); pf.u.y = cvt_pk_bf16(sv[kt][8 * c + 2], sv[kt][8 * c + 3]);
                        pf.u.z = cvt_pk_bf16(sv[kt][8 * c + 4], sv[kt][8 * c + 5]); pf.u.w = cvt_pk_bf16(sv[kt][8 * c + 6], sv[kt][8 * c + 7]);
#pragma unroll
                        for (int dt = 0; dt < 4; ++dt) { const bf16x8 vf = *(const LAS bf16x8*)(vb + dt * 32 * VROW + (32 * kt + 16 * c) * 2);
                            o[dt] = __builtin_amdgcn_mfma_f32_32x32x16_bf16(vf, pf.v, o[dt], 0, 0, 0); } }
            }
            if (more) STORE_TILE(cur ^ 1);
            if (lane == 0) misc[8 + cur * 8 + wid] = wave_done ? 1 : 0;
            __syncthreads();
            int alld = 1;
#pragma unroll
            for (int w = 0; w < 8; ++w) alld &= misc[8 + cur * 8 + w];
            if (alld) break;
        }
#undef LOAD_TILE
#undef STORE_TILE
        if (wact) {
            if (fox) { lsum += __shfl_xor(lsum, 32); const float inv = 1.f / lsum;
#pragma unroll
                for (int dt = 0; dt < 4; ++dt) o[dt] *= inv; }
            float ss = 0.f;
#pragma unroll
            for (int dt = 0; dt < 4; ++dt)
#pragma unroll
                for (int i = 0; i < 16; ++i) ss += o[dt][i] * o[dt][i];
            ss += __shfl_xor(ss, 32);
            const float rn = rsqrtf(ss * (1.f / 128.f) + EPS);
            const float* gp = (fox ? p.g_ofox : p.g_osb) + layer * 512 + hf * 128 + 4 * h;
            const u16* zg = (const u16*)(p.ws + W_ZB) + (size_t)(row0 + 32 * wid) * 1024 + head8 * 128;
            u16* og = (u16*)(p.ws + W_OB) + (size_t)(row0 + 32 * wid) * 1024 + head8 * 128;
            LAS unsigned char* Tz = lds + A_T + wid * (32 * 272);
            { u32x4 zr[8];
#pragma unroll
              for (int i = 0; i < 8; ++i) zr[i] = *(const u32x4*)(zg + (size_t)(4 * i + (lane >> 4)) * 1024 + (lane & 15) * 8);
#pragma unroll
              for (int i = 0; i < 8; ++i) *(LAS u32x4*)(Tz + (4 * i + (lane >> 4)) * 272 + (lane & 15) * 16) = zr[i]; }
#pragma unroll
            for (int dt = 0; dt < 4; ++dt)
#pragma unroll
                for (int bb = 0; bb < 4; ++bb) { const int d = 32 * dt + 8 * bb; const f32x4 g = *(const f32x4*)(gp + d); LAS u32x2* tp = (LAS u32x2*)(Tz + r * 272 + (d + 4 * h) * 2); const u32x2 z2 = *tp;
                    const float v0 = o[dt][4 * bb + 0] * rn * g.x * bf_lo(z2.x), v1 = o[dt][4 * bb + 1] * rn * g.y * bf_hi(z2.x), v2 = o[dt][4 * bb + 2] * rn * g.z * bf_lo(z2.y), v3 = o[dt][4 * bb + 3] * rn * g.w * bf_hi(z2.y);
                    u32x2 w; w.x = cvt_pk_bf16(v0, v1); w.y = cvt_pk_bf16(v2, v3); *tp = w; }
#pragma unroll
            for (int i = 0; i < 8; ++i) { const u32x4 w = *(const LAS u32x4*)(Tz + (4 * i + (lane >> 4)) * 272 + (lane & 15) * 16); *(u32x4*)(og + (size_t)(4 * i + (lane >> 4)) * 1024 + (lane & 15) * 8) = w; }
        }
    }
}

__device__ __forceinline__ void final_phase(int wv, const P& p) {
    const int tid = opaque_tid(wv), wid = tid >> 6, lane = tid & 63;
    const float* ssqA = (const float*)(p.ws + W_SSQA);
    for (int row = blockIdx.x * 8 + wid; row < NR; row += gridDim.x * 8) {
        float s = lane < 32 ? ssqA[(size_t)row * 32 + lane] : 0.f;
#pragma unroll
        for (int d = 1; d < 64; d <<= 1) s += __shfl_xor(s, d);
        const float rs = rsqrtf(s * (1.f / 2048.f) + EPS);
        float* xo = p.out + (size_t)row * 2048; const u16* xb = (const u16*)(p.ws + W_XBA) + (size_t)row * 2048;
#pragma unroll
        for (int i = 0; i < 8; ++i) { const int c = (i * 64 + lane) * 4; const u32x2 xw = *(const u32x2*)(xb + c); const f32x4 g = *(const f32x4*)(p.g_final + c);
            f32x4 v; v.x = bf_lo(xw.x) * rs * g.x; v.y = bf_hi(xw.x) * rs * g.y; v.z = bf_lo(xw.y) * rs * g.z; v.w = bf_hi(xw.y) * rs * g.w; *(f32x4*)(xo + c) = v; }
    }
}

constexpr int LDS_BYTES = 131072 + 8 * 2304;

__global__ __launch_bounds__(512, 2) void fwd_megakernel(P p) {
    extern __shared__ __attribute__((aligned(16))) unsigned char shm[];
    LAS unsigned char* lds = (LAS unsigned char*)shm;
    cg::grid_group grid = cg::this_grid();
    const int wv = __builtin_amdgcn_readfirstlane(threadIdx.x >> 6);
    prep_phase(wv, p, lds);
    grid.sync();
    pg8::StaticOrder S;
    for (int layer_ = 0; layer_ < DEPTH; ++layer_) {
        int layer = layer_, bid = (int)blockIdx.x, G = (int)gridDim.x; asm volatile("" : "+s"(layer), "+s"(bid), "+s"(G));
        {
            pg8::Gemm g{(const u16*)(p.ws + W_XBA), (const u16*)(p.ws + W_WTIN) + (size_t)layer * 4096 * 2048, NP, 4096, 2048};
            S.init(g.M, g.N, G, bid); EpiProj E{p, layer, lds};
            pg8::gemm_phase(wv, lds, g, S, E);
            logf_items(wv, p, layer, lds, bid, NP / 128, G);
        }
        grid.sync();
        attn_phase(wv, p, layer, lds);
        grid.sync();
        {
            for (int rep = 0; rep < 2; ++rep) {
                if ((rep ^ ((bid >> 2) & 1)) == 0) {
                    pg8::Gemm g{(const u16*)(p.ws + W_OB), (const u16*)(p.ws + W_WTOUT) + (size_t)layer * 2048 * 1024, NP, 2048, 1024};
                    S.init(g.M, g.N, G, bid); EpiOut E{p, lds};
                    pg8::gemm_phase(wv, lds, g, S, E);
                } else {
                    pg8::Gemm g2{(const u16*)(p.ws + W_PB) + (size_t)layer * NR * 256, (const u16*)(p.ws + W_WTPLE) + (size_t)layer * 2048 * 256, NP, 2048, 256};
                    S.init(g2.M, g2.N, G, bid); EpiPle E2{p, lds};
                    pg8::gemm_phase(wv, lds, g2, S, E2);
                }
            }
        }
        grid.sync();
        {
            pg8::Gemm g{(const u16*)(p.ws + W_XBB), (const u16*)(p.ws + W_WTGATE) + (size_t)layer * 2048 * 2048, NP, 2048, 2048};
            S.init(g.M, g.N, G, bid); EpiGate E{p, lds};
            pg8::gemm_phase(wv, lds, g, S, E);
        }
        grid.sync();
    }
    final_phase(wv, p);
}

extern "C" void kernel_launch(void* const* d_in, const int* in_sizes, int n_in, void* d_out, int out_size, void* d_ws, size_t ws_size, hipStream_t stream) {
    static int grid_blocks = 0;
    if (!grid_blocks) {
        if (n_in != 19 || (size_t)out_size != OUT_TOTAL || ws_size < W_END) { fprintf(stderr, "kernel_launch: unexpected shapes: n_in %d out %d (want %zu) ws %zu (want %zu)\n", n_in, out_size, OUT_TOTAL, ws_size, W_END); grid_blocks = -1; return; }
        int dev = 0, cus = 0, per_cu = 0;
        hipGetDevice(&dev);
        hipDeviceGetAttribute(&cus, hipDeviceAttributeMultiprocessorCount, dev);
        if (hipFuncSetAttribute((const void*)fwd_megakernel, hipFuncAttributeMaxDynamicSharedMemorySize, LDS_BYTES) != hipSuccess) fprintf(stderr, "kernel_launch: hipFuncSetAttribute failed\n");
        if (hipOccupancyMaxActiveBlocksPerMultiprocessor(&per_cu, (const void*)fwd_megakernel, 512, LDS_BYTES) != hipSuccess || per_cu < 1) { fprintf(stderr, "kernel_launch: occupancy query gave %d\n", per_cu); per_cu = 1; }
        (void)hipGetLastError();
        grid_blocks = cus * per_cu;
    }
    if (grid_blocks < 0) return;
    P p{};
    const float** f = (const float**)&p;
    for (int i = 0; i < 19; ++i) f[i] = (const float*)d_in[i];
    p.out = (float*)d_out; p.ws = (unsigned char*)d_ws;
    void* args[] = {&p};
    hipError_t e = hipLaunchCooperativeKernel((const void*)fwd_megakernel, dim3(grid_blocks), dim3(512), args, LDS_BYTES, stream);
    if (e != hipSuccess) fprintf(stderr, "cooperative launch failed: %s (grid %d)\n", hipGetErrorString(e), grid_blocks);
}
```

```cpp
#include <hip/hip_runtime.h>
#include <hip/hip_cooperative_groups.h>
#include <cstdio>
namespace cg = cooperative_groups;

#define LAS __attribute__((address_space(3)))
typedef unsigned short u16;
typedef short bf16x8 __attribute__((ext_vector_type(8)));
typedef float f32x4 __attribute__((ext_vector_type(4)));
typedef float f32x16 __attribute__((ext_vector_type(16)));
typedef unsigned u32x2 __attribute__((ext_vector_type(2)));
typedef unsigned u32x4 __attribute__((ext_vector_type(4)));

constexpr int D_MODEL = 2048, SEQ = 16384, DEPTH = 4, DEC_BATCH = 8, DEC_SEQ = 32, PAST = 1024;
constexpr int NP = 2 * SEQ, NS = DEC_BATCH * DEC_SEQ, NR = NP + NS;
constexpr int DMIX = 1024, D_IN = 4100, PLE = 256;
constexpr int SL = 1088;
constexpr float EPS = 1e-6f;
constexpr float LOG2E = 1.4426950408889634f;
constexpr float QSCALE = 0.08838834764831845f * LOG2E;
constexpr int NITEMS = 1024 + 64;

constexpr size_t O_Y = 0;
constexpr size_t O_KV_P = (size_t)NR * D_MODEL;
constexpr size_t KVP = (size_t)DEPTH * NP * 512;
constexpr size_t O_LOGF_P = O_KV_P + 4 * KVP;
constexpr size_t O_KV_S = O_LOGF_P + (size_t)DEPTH * NP * 4;
constexpr size_t KVS = (size_t)DEPTH * NS * 512;
constexpr size_t O_LOGF_S = O_KV_S + 4 * KVS;
constexpr size_t OUT_TOTAL = O_LOGF_S + (size_t)DEPTH * NS * 4;

constexpr size_t al256(size_t x) { return (x + 255) & ~(size_t)255; }
constexpr size_t W_WTIN = 0;
constexpr size_t W_WTOUT = W_WTIN + (size_t)DEPTH * 4096 * 2048 * 2;
constexpr size_t W_WTPLE = W_WTOUT + (size_t)DEPTH * 2048 * 1024 * 2;
constexpr size_t W_WTGATE = W_WTPLE + (size_t)DEPTH * 2048 * 256 * 2;
constexpr size_t W_WF = W_WTGATE + (size_t)DEPTH * 2048 * 2048 * 2;
constexpr size_t W_XBA = W_WF + (size_t)DEPTH * 2048 * 4 * 4;
constexpr size_t W_PB = W_XBA + (size_t)NR * 2048 * 2;
constexpr size_t W_R = W_PB + (size_t)DEPTH * NR * 256 * 2;
constexpr size_t W_QB = W_R;
constexpr size_t W_KBP = W_QB + (size_t)NR * 1024 * 2;
constexpr size_t W_VTP = W_KBP + (size_t)NP * 1024 * 2;
constexpr size_t W_ZB = W_VTP + (size_t)NP * 1024 * 2;
constexpr size_t W_PLEB = W_R;
constexpr size_t W_XBB = W_R + al256((size_t)NR * 2048 * 2);
constexpr size_t R_SIZE = 2 * al256((size_t)NR * 2048 * 2) + 4096;
static_assert(W_ZB + (size_t)NR * 1024 * 2 <= W_R + R_SIZE, "region R too small");
constexpr size_t W_KBS = W_R + R_SIZE;
constexpr size_t W_VTS = W_KBS + (size_t)DEPTH * DEC_BATCH * SL * 1024 * 2;
constexpr size_t W_OB = W_VTS + (size_t)DEPTH * DEC_BATCH * 8 * 128 * SL * 2;
constexpr size_t W_SSQA = W_OB + (size_t)NR * 1024 * 2;
constexpr size_t W_SSQB = W_SSQA + (size_t)NR * 32 * 4;
constexpr size_t W_CIN = W_SSQB + (size_t)NR * 32 * 4;
constexpr size_t W_SEGTOT = W_CIN + (size_t)NR * 4 * 4;
constexpr size_t W_CCUM = W_SEGTOT + al256((size_t)(NR / 32) * 4 * 4);
constexpr size_t W_CTR = W_CCUM + (size_t)DEPTH * DEC_BATCH * PAST * 4 * 4;
constexpr size_t W_PLES = W_CTR + 4096;
constexpr size_t W_END = W_PLES + (size_t)NS * 2048 * 2;

struct P {
    const float *x_prompt, *x_sample, *p_prompt, *p_sample, *c_sbk, *c_sbv, *c_fxk, *c_fxv, *c_logf, *w_in, *b_f, *g_attn, *g_osb, *g_ofox, *w_out, *w_ple, *g_ple, *w_gate, *g_final;
    float* out;
    unsigned char* ws;
};

__device__ __forceinline__ unsigned cvt_pk_bf16(float lo, float hi) { unsigned r; asm volatile("v_cvt_pk_bf16_f32 %0, %1, %2" : "=v"(r) : "v"(lo), "v"(hi)); return r; }
__device__ __forceinline__ float bf_lo(unsigned w) { return __uint_as_float(w << 16); }
__device__ __forceinline__ float bf_hi(unsigned w) { return __uint_as_float(w & 0xffff0000u); }
__device__ __forceinline__ float fexp2(float x) { return __builtin_amdgcn_exp2f(x); }
__device__ __forceinline__ float flog2(float x) { return __builtin_amdgcn_logf(x); }
__device__ __forceinline__ float fmax3(float a, float b, float c) { float r; asm("v_max3_f32 %0, %1, %2, %3" : "=v"(r) : "v"(a), "v"(b), "v"(c)); return r; }
__device__ __forceinline__ int opaque_tid(int wv) { int l; asm volatile("v_mbcnt_lo_u32_b32 %0, -1, 0\n\tv_mbcnt_hi_u32_b32 %0, -1, %0" : "=v"(l)); return wv * 64 + l; }

namespace pg8 {
constexpr int BM = 256, BK = 64, HALF = 128, HTB = HALF * BK * 2, STAGE_BYTES = 8 * HTB, NXCD = 8, WGM = 8;
__host__ __device__ __forceinline__ int lds_byte(int r, int c) { const int st = (r >> 4) * 2 + (c >> 5), rr = r & 15, cc = c & 31, ob = rr * 64 + cc * 2; return st * 1024 + (ob ^ (((ob >> 9) & 1) << 5)); }
__host__ __device__ __forceinline__ void stage_rc(int b, int& R, int& C) { const int st = b / 1024, sb = b % 1024, swz = sb ^ (((sb >> 9) & 1) << 5); R = (st >> 1) * 16 + swz / 64; C = (st & 1) * 32 + (swz % 64) / 2; }
struct Unit { int pm, pn; };
struct Gemm { const u16* A; const u16* Bt; int M, N, K; };
struct StaticOrder {
    int nM, nN, nwg, G, c;
    int one_pm, one_pn;
    __device__ void init(int M, int N, int G_, int c_) { nM = M / BM; nN = N / BM; nwg = nM * nN; G = G_; c = c_; one_pm = -1; one_pn = 0; }
    __device__ void init_one(int pm, int pn) { nM = 1; nN = 1; nwg = 1; G = 1; c = 0; one_pm = pm; one_pn = pn; }
    __device__ bool next(int i, Unit& u) const {
        if (one_pm >= 0) { if (i > 0) return false; u.pm = one_pm; u.pn = one_pn; return true; }
        const long L = (long)i * G + c; if (L >= nwg) return false;
        int wgid = (int)L; { const int q = nwg / NXCD, r = nwg % NXCD, xcd = wgid % NXCD, off = wgid / NXCD; wgid = (xcd < r ? xcd * (q + 1) : r * (q + 1) + (xcd - r) * q) + off; }
        const int nig = WGM * nN, gid = wgid / nig, fm = gid * WGM, gsz = (nM - fm) < WGM ? (nM - fm) : WGM;
        u.pm = fm + ((wgid % nig) % gsz); u.pn = (wgid % nig) / gsz; return true;
    }
};

template <class Epi>
__device__ __forceinline__ void gemm_phase(int wv, LAS unsigned char* lds, const Gemm g, const StaticOrder& S, const Epi& E, const int skew_ticks = 0) {
    const int tid = opaque_tid(wv), wid = __builtin_amdgcn_readfirstlane(tid >> 6), lane = tid & 63, wr = wid >> 2, wc = wid & 3, fr = lane & 15, fq = lane >> 4;
    const int K = g.K, nt = K / BK;
    unsigned voffA[2], voffB0[2];
#pragma unroll
    for (int i = 0; i < 2; ++i) { int R, C; stage_rc(tid * 16 + i * 8192, R, C); voffA[i] = (unsigned)(R * K + C) * 2u;
        const int rho = R & 31, pr = 8 * ((rho & 15) >> 2) + 4 * (rho >> 4) + (rho & 3), Rb = 64 * (R >> 5) + pr;
        voffB0[i] = (unsigned)(Rb * K + C) * 2u; }
    const size_t b1step = (size_t)32 * K * 2;
    const size_t kstep = (size_t)(BK * 2);
    const size_t hstep = (size_t)HALF * K * 2;
    const size_t tstep = 2 * hstep;
    const unsigned ldsw = (unsigned)wid * 1024u;
    const int aoff = lds_byte(wr * 64 + fr, fq * 8), boff = lds_byte(wc * 32 + fr, fq * 8);
#define PG8_SA(b, h) (((b) * 2 + (h)) * HTB)
#define PG8_SB(b, h) ((4 + (b) * 2 + (h)) * HTB)
#define PG8_STAGE(bufoff, gbase, voff) do { _Pragma("unroll") for (int _i = 0; _i < 2; ++_i) \
        __builtin_amdgcn_global_load_lds((const unsigned*)((const char*)(gbase) + (voff)[_i]), (LAS unsigned*)(lds + (bufoff) + ldsw + _i * 8192), 16, 0, 0); } while (0)
#define PG8_LDA(dst, b, h) do { _Pragma("unroll") for (int m = 0; m < 4; ++m) _Pragma("unroll") for (int k = 0; k < 2; ++k) dst[m][k] = *(const LAS bf16x8*)(lds + PG8_SA(b, h) + aoff + m * 2048 + k * 1024); } while (0)
#define PG8_LDB(dst, b, h) do { _Pragma("unroll") for (int n = 0; n < 2; ++n) _Pragma("unroll") for (int k = 0; k < 2; ++k) dst[n][k] = *(const LAS bf16x8*)(lds + PG8_SB(b, h) + boff + n * 2048 + k * 1024); } while (0)
#define PG8_MMA(ai, bj, At, Bt) do { __builtin_amdgcn_s_setprio(1); _Pragma("unroll") for (int m = 0; m < 4; ++m) _Pragma("unroll") for (int n = 0; n < 2; ++n) _Pragma("unroll") for (int k = 0; k < 2; ++k) \
        acc[ai][bj][m][n] = __builtin_amdgcn_mfma_f32_16x16x32_bf16(Bt[n][k], At[m][k], acc[ai][bj][m][n], 0, 0, 0); __builtin_amdgcn_s_setprio(0); } while (0)
#define PG8_WAIT_V(n) asm volatile("s_waitcnt vmcnt(" #n ")" ::: "memory")
#define PG8_WAIT_L(n) asm volatile("s_waitcnt lgkmcnt(" #n ")" ::: "memory")
#define PG8_BAR __builtin_amdgcn_s_barrier()
#define PG8_SCHED __builtin_amdgcn_sched_barrier(0)
    Unit cur, nxt; int ui = 0;
    if (!S.next(0, cur)) return;
    if (skew_ticks > 0) {
        const unsigned long long t0 = __builtin_amdgcn_s_memrealtime();
        while ((long long)(__builtin_amdgcn_s_memrealtime() - t0) < (long long)skew_ticks) __builtin_amdgcn_s_sleep(32);
    }
    f32x4 acc[2][2][4][2];
#pragma unroll
    for (int a = 0; a < 2; ++a)
#pragma unroll
        for (int b = 0; b < 2; ++b)
#pragma unroll
            for (int m = 0; m < 4; ++m)
#pragma unroll
                for (int n = 0; n < 2; ++n) acc[a][b][m][n] = (f32x4){0.f, 0.f, 0.f, 0.f};
    bf16x8 At[4][2], B0[2][2], B1[2][2];
    const char* cA = (const char*)g.A + (size_t)cur.pm * tstep; const char* cB = (const char*)g.Bt + (size_t)cur.pn * tstep;
    PG8_STAGE(PG8_SB(0, 0), cB, voffB0); PG8_STAGE(PG8_SA(0, 0), cA, voffA); PG8_STAGE(PG8_SB(0, 1), cB + b1step, voffB0); PG8_STAGE(PG8_SA(0, 1), cA + hstep, voffA);
    if (wr == 1) PG8_BAR;
    PG8_WAIT_V(4); PG8_BAR;
    PG8_STAGE(PG8_SB(1, 0), cB + kstep, voffB0); PG8_STAGE(PG8_SA(1, 0), cA + kstep, voffA); PG8_STAGE(PG8_SB(1, 1), cB + kstep + b1step, voffB0);
    PG8_WAIT_V(6); PG8_BAR;
    for (;;) {
        const bool has_next = S.next(ui + 1, nxt);
        const char* nA = has_next ? (const char*)g.A + (size_t)nxt.pm * tstep : cA; const char* nB = has_next ? (const char*)g.Bt + (size_t)nxt.pn * tstep : cB;
        for (int t = 0; t < nt; t += 2) {
            const bool last = (t == nt - 2);
            const char* a1 = cA + (size_t)(t + 1) * kstep;
            const char* a2 = last ? nA : cA + (size_t)(t + 2) * kstep; const char* b2 = last ? nB : cB + (size_t)(t + 2) * kstep;
            const char* a3 = a2 + kstep; const char* b3 = b2 + kstep;
            PG8_LDB(B0, 0, 0); PG8_SCHED; PG8_LDA(At, 0, 0); PG8_STAGE(PG8_SA(1, 1), a1 + hstep, voffA);
            PG8_WAIT_L(8); PG8_BAR; PG8_WAIT_L(0); PG8_MMA(0, 0, At, B0); PG8_BAR; PG8_SCHED;
            PG8_LDB(B1, 0, 1); PG8_STAGE(PG8_SB(0, 0), b2, voffB0);
            PG8_BAR; PG8_WAIT_L(0); PG8_MMA(0, 1, At, B1); PG8_BAR;
            PG8_LDA(At, 0, 1); PG8_STAGE(PG8_SA(0, 0), a2, voffA);
            PG8_BAR; PG8_WAIT_L(0); PG8_MMA(1, 0, At, B0); PG8_BAR; PG8_SCHED;
            PG8_STAGE(PG8_SB(0, 1), b2 + b1step, voffB0);
            PG8_WAIT_V(6); PG8_BAR; PG8_MMA(1, 1, At, B1); PG8_BAR;
            PG8_LDB(B0, 1, 0); PG8_SCHED; PG8_LDA(At, 1, 0); PG8_STAGE(PG8_SA(0, 1), a2 + hstep, voffA);
            PG8_WAIT_L(8); PG8_BAR; PG8_WAIT_L(0); PG8_MMA(0, 0, At, B0); PG8_BAR; PG8_SCHED;
            PG8_LDB(B1, 1, 1); PG8_STAGE(PG8_SB(1, 0), b3, voffB0);
            PG8_BAR; PG8_WAIT_L(0); PG8_MMA(0, 1, At, B1); PG8_BAR;
            PG8_LDA(At, 1, 1); PG8_STAGE(PG8_SA(1, 0), a3, voffA);
            PG8_BAR; PG8_WAIT_L(0); PG8_MMA(1, 0, At, B0); PG8_BAR; PG8_SCHED;
            PG8_STAGE(PG8_SB(1, 1), b3 + b1step, voffB0);
            PG8_WAIT_V(6); PG8_BAR; PG8_MMA(1, 1, At, B1); PG8_BAR;
        }
        { int fr2 = fr, fq2 = fq; asm volatile("" : "+v"(fr2), "+v"(fq2)); E(acc, cur, wr, wc, fr2, fq2); }
        if (!has_next) break;
#pragma unroll
        for (int a = 0; a < 2; ++a)
#pragma unroll
            for (int b = 0; b < 2; ++b)
#pragma unroll
                for (int m = 0; m < 4; ++m)
#pragma unroll
                    for (int n = 0; n < 2; ++n) acc[a][b][m][n] = (f32x4){0.f, 0.f, 0.f, 0.f};
        cur = nxt; cA = nA; cB = nB; ++ui;
    }
    PG8_WAIT_V(0);
    if (wr == 0) PG8_BAR;
    PG8_BAR;
#undef PG8_SA
#undef PG8_SB
#undef PG8_STAGE
#undef PG8_LDA
#undef PG8_LDB
#undef PG8_MMA
#undef PG8_WAIT_V
#undef PG8_WAIT_L
#undef PG8_BAR
#undef PG8_SCHED
}
}


__device__ __forceinline__ float row_rstd(const float* ssq, int row, int fq) {
    const f32x4* q = (const f32x4*)(ssq + (size_t)row * 32 + fq * 8);
    const f32x4 a = q[0], b = q[1];
    float s = (a.x + a.y) + (a.z + a.w) + (b.x + b.y) + (b.z + b.w);
    s += __shfl_xor(s, 16); s += __shfl_xor(s, 32);
    return rsqrtf(s * (1.f / 2048.f) + EPS);
}
__device__ __forceinline__ u32x4 pack8(const f32x4 a, const f32x4 b) { u32x4 w; w.x = cvt_pk_bf16(a.x, a.y); w.y = cvt_pk_bf16(a.z, a.w); w.z = cvt_pk_bf16(b.x, b.y); w.w = cvt_pk_bf16(b.z, b.w); return w; }

constexpr int TRS = 144, TIO_OFF = 131072, TIO_WAVE = 2304;
__device__ __forceinline__ void tio_store(LAS unsigned char* T, u16* g0, int lane, int fr, int fq, const u32x4 w0, const u32x4 w1) {
    *(LAS u32x4*)(T + fr * TRS + fq * 16) = w0; *(LAS u32x4*)(T + fr * TRS + 64 + fq * 16) = w1;
    const int rr = lane >> 3, ch = lane & 7;
    const u32x4 a = *(const LAS u32x4*)(T + rr * TRS + ch * 16), b = *(const LAS u32x4*)(T + (8 + rr) * TRS + ch * 16);
    *(u32x4*)(g0 + (size_t)rr * 2048 + ch * 8) = a; *(u32x4*)(g0 + (size_t)(8 + rr) * 2048 + ch * 8) = b;
}
__device__ __forceinline__ void tio_load(const u16* g0, int lane, u32x4& a, u32x4& b) { const int rr = lane >> 3, ch = lane & 7; a = *(const u32x4*)(g0 + (size_t)rr * 2048 + ch * 8); b = *(const u32x4*)(g0 + (size_t)(8 + rr) * 2048 + ch * 8); }
__device__ __forceinline__ void tio_unpack(LAS unsigned char* T, int lane, int fr, int fq, const u32x4 a, const u32x4 b, u32x4& w0, u32x4& w1) {
    const int rr = lane >> 3, ch = lane & 7;
    *(LAS u32x4*)(T + rr * TRS + ch * 16) = a; *(LAS u32x4*)(T + (8 + rr) * TRS + ch * 16) = b;
    w0 = *(const LAS u32x4*)(T + fr * TRS + fq * 16); w1 = *(const LAS u32x4*)(T + fr * TRS + 64 + fq * 16);
}

__device__ __forceinline__ void tio_store_f32(LAS unsigned char* T, float* g0, size_t gpitch, int lane, int fr, int fq, const f32x4 v0, const f32x4 v1) {
    *(LAS f32x4*)(T + fr * TRS + fq * 32) = v0; *(LAS f32x4*)(T + fr * TRS + fq * 32 + 16) = v1;
    const int rr = lane >> 3, ch = lane & 7;
    const f32x4 a = *(const LAS f32x4*)(T + rr * TRS + ch * 16), b = *(const LAS f32x4*)(T + (8 + rr) * TRS + ch * 16);
    __builtin_nontemporal_store(a, (f32x4*)(g0 + (size_t)rr * gpitch + ch * 4)); __builtin_nontemporal_store(b, (f32x4*)(g0 + (size_t)(8 + rr) * gpitch + ch * 4));
}
__device__ __forceinline__ void tio_store_p(LAS unsigned char* T, u16* g0, size_t gpitch, int lane, int fr, int fq, const u32x4 w0, const u32x4 w1) {
    *(LAS u32x4*)(T + fr * TRS + fq * 16) = w0; *(LAS u32x4*)(T + fr * TRS + 64 + fq * 16) = w1;
    const int rr = lane >> 3, ch = lane & 7;
    const u32x4 a = *(const LAS u32x4*)(T + rr * TRS + ch * 16), b = *(const LAS u32x4*)(T + (8 + rr) * TRS + ch * 16);
    *(u32x4*)(g0 + (size_t)rr * gpitch + ch * 8) = a; *(u32x4*)(g0 + (size_t)(8 + rr) * gpitch + ch * 8) = b;
}

struct EpiProj {
    const P& p; int layer; LAS unsigned char* lds;
    __device__ __forceinline__ void operator()(const f32x4 (&acc)[2][2][4][2], const pg8::Unit& u, int wr, int wc, int fr, int fq) const {
        const int lane = fq * 16 + fr; LAS unsigned char* T = lds + TIO_OFF + (wr * 4 + wc) * TIO_WAVE; const int cww = (u.pn & 1) * 256 + wc * 64;
        const int group = u.pn >> 1, type = group & 3, br = group >> 2;
        const int cgb = (u.pn & 1) * 256 + wc * 64 + 8 * fq;
        const float* ssqA = (const float*)(p.ws + W_SSQA);
        u16* Qb = (u16*)(p.ws + W_QB); u16* Zb = (u16*)(p.ws + W_ZB);
        float kmx = 0.f;
        float rsv[8];
#pragma unroll
        for (int i = 0; i < 8; ++i) rsv[i] = row_rstd(ssqA, u.pm * 256 + (i >> 2) * 128 + wr * 64 + (i & 3) * 16 + fr, fq);
#pragma unroll
        for (int ai = 0; ai < 2; ++ai)
#pragma unroll
            for (int m = 0; m < 4; ++m) {
                const int row = u.pm * 256 + ai * 128 + wr * 64 + m * 16 + fr;
                const float rs = rsv[ai * 4 + m];
                if (type == 0) {
                    const float sc = rs * QSCALE;
                    tio_store_p(T, Qb + (size_t)(row - fr) * 1024 + br * 512 + cww, 1024, lane, fr, fq, pack8(acc[ai][0][m][0] * sc, acc[ai][0][m][1] * sc), pack8(acc[ai][1][m][0] * sc, acc[ai][1][m][1] * sc));
                } else if (type == 3) {
                    u32x4 zw[2];
#pragma unroll
                    for (int bj = 0; bj < 2; ++bj) { f32x4 v0 = acc[ai][bj][m][0] * rs, v1 = acc[ai][bj][m][1] * rs;
#pragma unroll
                        for (int j = 0; j < 4; ++j) { v0[j] = v0[j] * __builtin_amdgcn_rcpf(1.f + __expf(-v0[j])); v1[j] = v1[j] * __builtin_amdgcn_rcpf(1.f + __expf(-v1[j])); }
                        zw[bj] = pack8(v0, v1); }
                    tio_store_p(T, Zb + (size_t)(row - fr) * 1024 + br * 512 + cww, 1024, lane, fr, fq, zw[0], zw[1]);
                } else {
                    float* o32; u16* kb; u16* vt; size_t vld; float kss = 0.f;
                    if (row < NP) { const int b = row >> 14, t = row & (SEQ - 1);
                        o32 = p.out + O_KV_P + (size_t)(br * 2 + (type - 1)) * KVP + ((size_t)(layer * 2 + b) * SEQ + t) * 512;
                        kb = (u16*)(p.ws + W_KBP) + (size_t)row * 1024 + br * 512;
                        vt = (u16*)(p.ws + W_VTP) + (size_t)(b * 8 + br * 4) * 128 * SEQ + t; vld = SEQ;
                    } else { const int rr = row - NP, sb = rr >> 5, t = rr & 31;
                        o32 = p.out + O_KV_S + (size_t)(br * 2 + (type - 1)) * KVS + ((size_t)(layer * 8 + sb) * 32 + t) * 512;
                        kb = (u16*)(p.ws + W_KBS) + ((size_t)(layer * 8 + sb) * SL + PAST + t) * 1024 + br * 512;
                        vt = (u16*)(p.ws + W_VTS) + (size_t)((layer * 8 + sb) * 8 + br * 4) * 128 * SL + PAST + t; vld = SL;
                    }
                    u32x4 kw[2];
#pragma unroll
                    for (int bj = 0; bj < 2; ++bj) { const f32x4 v0 = acc[ai][bj][m][0] * rs, v1 = acc[ai][bj][m][1] * rs; const int cg = cgb + bj * 32;
                        kss += (v0.x * v0.x + v0.y * v0.y + v0.z * v0.z + v0.w * v0.w) + (v1.x * v1.x + v1.y * v1.y + v1.z * v1.z + v1.w * v1.w);
                        tio_store_f32(T, o32 - (size_t)fr * 512 + cww + bj * 32, 512, lane, fr, fq, v0, v1);
                        const u32x4 w = pack8(v0, v1); kw[bj] = w;
                        if (type == 1) { if (bj == 1) tio_store_p(T, kb - (size_t)fr * 1024 + cww, 1024, lane, fr, fq, kw[0], kw[1]); }
                        else { vt[(size_t)(cg + 0) * vld] = (u16)(w.x & 0xffffu); vt[(size_t)(cg + 1) * vld] = (u16)(w.x >> 16); vt[(size_t)(cg + 2) * vld] = (u16)(w.y & 0xffffu); vt[(size_t)(cg + 3) * vld] = (u16)(w.y >> 16);
                               vt[(size_t)(cg + 4) * vld] = (u16)(w.z & 0xffffu); vt[(size_t)(cg + 5) * vld] = (u16)(w.z >> 16); vt[(size_t)(cg + 6) * vld] = (u16)(w.w & 0xffffu); vt[(size_t)(cg + 7) * vld] = (u16)(w.w >> 16); } }
                    if (type == 1 && br == 1) { kss += __shfl_xor(kss, 16); kss += __shfl_xor(kss, 32); kmx = fmaxf(kmx, kss); }
                }
            }
        if (type == 1 && br == 1 && u.pm < NP / 256) {
            float t = kmx; t = fmaxf(t, __shfl_xor(t, 1)); t = fmaxf(t, __shfl_xor(t, 2)); t = fmaxf(t, __shfl_xor(t, 4)); t = fmaxf(t, __shfl_xor(t, 8));
            if (fr == 0 && fq == 0) atomicMax((unsigned*)(p.ws + W_CTR) + 64 + ((layer * 2 + (u.pm >> 6)) * 4 + (u.pn & 1) * 2 + (wc >> 1)) * 4 + (wc & 1), __float_as_uint(t));
        }
    }
};

struct EpiOut {
    const P& p; LAS unsigned char* lds;
    __device__ __forceinline__ void operator()(const f32x4 (&acc)[2][2][4][2], const pg8::Unit& u, int wr, int wc, int fr, int fq) const {
        float* ssqB = (float*)(p.ws + W_SSQB); u16* XbB = (u16*)(p.ws + W_XBB); const u16* XbA = (const u16*)(p.ws + W_XBA);
        const int lane = fq * 16 + fr, cw = u.pn * 256 + wc * 64; LAS unsigned char* T = lds + TIO_OFF + (wr * 4 + wc) * TIO_WAVE;
#pragma unroll
        for (int ai = 0; ai < 2; ++ai) {
            u32x4 xa[4], xb_[4];
#pragma unroll
            for (int m = 0; m < 4; ++m) tio_load(XbA + (size_t)(u.pm * 256 + ai * 128 + wr * 64 + m * 16) * 2048 + cw, lane, xa[m], xb_[m]);
#pragma unroll
            for (int m = 0; m < 4; ++m) {
                const int row0 = u.pm * 256 + ai * 128 + wr * 64 + m * 16; float ss = 0.f; u32x4 x0, x1;
                tio_unpack(T, lane, fr, fq, xa[m], xb_[m], x0, x1);
                f32x4 v00 = acc[ai][0][m][0], v01 = acc[ai][0][m][1], v10 = acc[ai][1][m][0], v11 = acc[ai][1][m][1];
                v00.x += bf_lo(x0.x); v00.y += bf_hi(x0.x); v00.z += bf_lo(x0.y); v00.w += bf_hi(x0.y); v01.x += bf_lo(x0.z); v01.y += bf_hi(x0.z); v01.z += bf_lo(x0.w); v01.w += bf_hi(x0.w);
                v10.x += bf_lo(x1.x); v10.y += bf_hi(x1.x); v10.z += bf_lo(x1.y); v10.w += bf_hi(x1.y); v11.x += bf_lo(x1.z); v11.y += bf_hi(x1.z); v11.z += bf_lo(x1.w); v11.w += bf_hi(x1.w);
                ss += (v00.x * v00.x + v00.y * v00.y + v00.z * v00.z + v00.w * v00.w) + (v01.x * v01.x + v01.y * v01.y + v01.z * v01.z + v01.w * v01.w);
                ss += (v10.x * v10.x + v10.y * v10.y + v10.z * v10.z + v10.w * v10.w) + (v11.x * v11.x + v11.y * v11.y + v11.z * v11.z + v11.w * v11.w);
                tio_store(T, XbB + (size_t)row0 * 2048 + cw, lane, fr, fq, pack8(v00, v01), pack8(v10, v11));
                ss += __shfl_xor(ss, 16); ss += __shfl_xor(ss, 32);
                if (fq == 0) ssqB[(size_t)(row0 + fr) * 32 + u.pn * 4 + wc] = ss;
            }
        }
    }
};

struct EpiPle {
    const P& p; LAS unsigned char* lds;
    __device__ __forceinline__ void operator()(const f32x4 (&acc)[2][2][4][2], const pg8::Unit& u, int wr, int wc, int fr, int fq) const {
        u16* O = u.pm == NP / 256 ? (u16*)(p.ws + W_PLES) - (size_t)NP * 2048 : (u16*)(p.ws + W_PLEB);
        const int lane = fq * 16 + fr, cw = u.pn * 256 + wc * 64; LAS unsigned char* T = lds + TIO_OFF + (wr * 4 + wc) * TIO_WAVE;
#pragma unroll
        for (int ai = 0; ai < 2; ++ai)
#pragma unroll
            for (int m = 0; m < 4; ++m)
                tio_store(T, O + (size_t)(u.pm * 256 + ai * 128 + wr * 64 + m * 16) * 2048 + cw, lane, fr, fq, pack8(acc[ai][0][m][0], acc[ai][0][m][1]), pack8(acc[ai][1][m][0], acc[ai][1][m][1]));
    }
};

struct EpiGate {
    const P& p; LAS unsigned char* lds;
    __device__ __forceinline__ void operator()(const f32x4 (&acc)[2][2][4][2], const pg8::Unit& u, int wr, int wc, int fr, int fq) const {
        const float* ssqB = (const float*)(p.ws + W_SSQB); float* ssqA = (float*)(p.ws + W_SSQA); u16* XbA = (u16*)(p.ws + W_XBA); const u16* XbB = (const u16*)(p.ws + W_XBB); const u16* PL = u.pm == NP / 256 ? (const u16*)(p.ws + W_PLES) - (size_t)NP * 2048 : (const u16*)(p.ws + W_PLEB);
        const int lane = fq * 16 + fr, cw = u.pn * 256 + wc * 64; LAS unsigned char* T = lds + TIO_OFF + (wr * 4 + wc) * TIO_WAVE;
        float rsv[8];
#pragma unroll
        for (int i = 0; i < 8; ++i) rsv[i] = row_rstd(ssqB, u.pm * 256 + (i >> 2) * 128 + wr * 64 + (i & 3) * 16 + fr, fq);
#pragma unroll
        for (int g4 = 0; g4 < 4; ++g4) { const int ai = g4 >> 1, m0 = (g4 & 1) * 2;
            u32x4 xa[2], xb_[2], pa[2], pb[2];
#pragma unroll
            for (int mm = 0; mm < 2; ++mm) { const size_t ro = (size_t)(u.pm * 256 + ai * 128 + wr * 64 + (m0 + mm) * 16) * 2048 + cw;
                tio_load(XbB + ro, lane, xa[mm], xb_[mm]); tio_load(PL + ro, lane, pa[mm], pb[mm]); }
#pragma unroll
            for (int mm = 0; mm < 2; ++mm) { const int m = m0 + mm;
                const int row0 = u.pm * 256 + ai * 128 + wr * 64 + m * 16;
                const float rs = rsv[ai * 4 + m]; float ss = 0.f;
                u32x4 x0, x1, p0, p1;
                tio_unpack(T, lane, fr, fq, xa[mm], xb_[mm], x0, x1);
                tio_unpack(T, lane, fr, fq, pa[mm], pb[mm], p0, p1);
                f32x4 v[2][2];
#pragma unroll
                for (int bj = 0; bj < 2; ++bj) { const f32x4 a0 = acc[ai][bj][m][0] * rs, a1 = acc[ai][bj][m][1] * rs; const u32x4 pq = bj ? p1 : p0, xq = bj ? x1 : x0;
                    f32x4 v0, v1;
                    v0.x = bf_lo(xq.x) + bf_lo(pq.x) * __builtin_amdgcn_rcpf(1.f + __expf(-a0.x)); v0.y = bf_hi(xq.x) + bf_hi(pq.x) * __builtin_amdgcn_rcpf(1.f + __expf(-a0.y));
                    v0.z = bf_lo(xq.y) + bf_lo(pq.y) * __builtin_amdgcn_rcpf(1.f + __expf(-a0.z)); v0.w = bf_hi(xq.y) + bf_hi(pq.y) * __builtin_amdgcn_rcpf(1.f + __expf(-a0.w));
                    v1.x = bf_lo(xq.z) + bf_lo(pq.z) * __builtin_amdgcn_rcpf(1.f + __expf(-a1.x)); v1.y = bf_hi(xq.z) + bf_hi(pq.z) * __builtin_amdgcn_rcpf(1.f + __expf(-a1.y));
                    v1.z = bf_lo(xq.w) + bf_lo(pq.w) * __builtin_amdgcn_rcpf(1.f + __expf(-a1.z)); v1.w = bf_hi(xq.w) + bf_hi(pq.w) * __builtin_amdgcn_rcpf(1.f + __expf(-a1.w));
                    ss += (v0.x * v0.x + v0.y * v0.y + v0.z * v0.z + v0.w * v0.w) + (v1.x * v1.x + v1.y * v1.y + v1.z * v1.z + v1.w * v1.w);
                    v[bj][0] = v0; v[bj][1] = v1; }
                tio_store(T, XbA + (size_t)row0 * 2048 + cw, lane, fr, fq, pack8(v[0][0], v[0][1]), pack8(v[1][0], v[1][1]));
                ss += __shfl_xor(ss, 16); ss += __shfl_xor(ss, 32);
                if (fq == 0) ssqA[(size_t)(row0 + fr) * 32 + u.pn * 4 + wc] = ss;
            }
        }
    }
};

struct TDesc { const float* src; size_t sld; u16* dst; size_t dld; const float* gk; };
constexpr int NT_WIN = DEPTH * 2048, NT_WOUT = DEPTH * 512, NT_WPLE = DEPTH * 128, NT_WGATE = DEPTH * 1024, NT_VC = DEPTH * DEC_BATCH * 8 * 32;
constexpr int NT_ALL = NT_WIN + NT_WOUT + NT_WPLE + NT_WGATE + NT_VC;
__device__ __forceinline__ TDesc tile_desc(const P& p, int t) {
    TDesc d;
    if (t < NT_WIN) { const int L = t >> 11, r = t & 2047, kt = r >> 6, nt = r & 63;
        d.src = p.w_in + (size_t)L * 2048 * D_IN + (size_t)kt * 64 * D_IN + nt * 64; d.sld = D_IN; d.dst = (u16*)(p.ws + W_WTIN) + (size_t)L * 4096 * 2048 + (size_t)nt * 64 * 2048 + kt * 64; d.dld = 2048; d.gk = p.g_attn + L * 2048 + kt * 64; return d; }
    t -= NT_WIN;
    if (t < NT_WOUT) { const int L = t >> 9, r = t & 511, kt = r >> 5, nt = r & 31;
        d.src = p.w_out + (size_t)L * 1024 * 2048 + (size_t)kt * 64 * 2048 + nt * 64; d.sld = 2048; d.dst = (u16*)(p.ws + W_WTOUT) + (size_t)L * 2048 * 1024 + (size_t)nt * 64 * 1024 + kt * 64; d.dld = 1024; d.gk = nullptr; return d; }
    t -= NT_WOUT;
    if (t < NT_WPLE) { const int L = t >> 7, r = t & 127, kt = r >> 5, nt = r & 31;
        d.src = p.w_ple + (size_t)L * 256 * 2048 + (size_t)kt * 64 * 2048 + nt * 64; d.sld = 2048; d.dst = (u16*)(p.ws + W_WTPLE) + (size_t)L * 2048 * 256 + (size_t)nt * 64 * 256 + kt * 64; d.dld = 256; d.gk = nullptr; return d; }
    t -= NT_WPLE;
    if (t < NT_WGATE) { const int L = t >> 10, r = t & 1023, kt = r >> 5, nt = r & 31;
        d.src = p.w_gate + (size_t)L * 2048 * 2048 + (size_t)kt * 64 * 2048 + nt * 64; d.sld = 2048; d.dst = (u16*)(p.ws + W_WTGATE) + (size_t)L * 2048 * 2048 + (size_t)nt * 64 * 2048 + kt * 64; d.dld = 2048; d.gk = p.g_ple + L * 2048 + kt * 64; return d; }
    t -= NT_WGATE;
    { const int mi = t >> 5, r = t & 31, kt = r >> 1, nt = r & 1; const int ls = mi >> 3, h8 = mi & 7, br = h8 >> 2, hh = h8 & 3;
        d.src = (br ? p.c_fxv : p.c_sbv) + ((size_t)ls * PAST + kt * 64) * 512 + hh * 128 + nt * 64; d.sld = 512; d.dst = (u16*)(p.ws + W_VTS) + ((size_t)mi * 128 + nt * 64) * SL + kt * 64; d.dld = SL; d.gk = nullptr; return d; }
}

__device__ __forceinline__ void prep_phase(int wv, const P& p, LAS unsigned char* lds) {
    LAS float* T = (LAS float*)lds;
    const int tid = opaque_tid(wv), G = gridDim.x, B = blockIdx.x;
    const int wid = tid >> 6, lane = tid & 63;
    if (B == 0) { ((unsigned*)(p.ws + W_CTR))[tid] = 0u; ((unsigned*)(p.ws + W_CTR))[tid + 512] = 0u; }
    {
        const int k0 = tid >> 4, n4 = (tid & 15) * 4, no = tid >> 3, kc = tid & 7;
        f32x4 v[2][2]; float g[2][2]; TDesc d[2]; bool ok[2];
#define PREP_FETCH(t_) do { _Pragma("unroll") for (int q = 0; q < 2; ++q) { const int tt = (t_) + q * G; ok[q] = tt < NT_ALL; g[q][0] = 1.f; g[q][1] = 1.f; \
            if (ok[q]) { d[q] = tile_desc(p, tt); v[q][0] = __builtin_nontemporal_load((const f32x4*)(d[q].src + (size_t)k0 * d[q].sld + n4)); v[q][1] = __builtin_nontemporal_load((const f32x4*)(d[q].src + (size_t)(k0 + 32) * d[q].sld + n4)); \
                if (d[q].gk) { g[q][0] = d[q].gk[k0]; g[q][1] = d[q].gk[k0 + 32]; } } } } while (0)
        int t = B;
        PREP_FETCH(t);
        while (t < NT_ALL) {
            TDesc dc[2]; bool okc[2];
#pragma unroll
            for (int q = 0; q < 2; ++q) { okc[q] = ok[q]; dc[q] = d[q]; LAS float* Tq = T + q * (64 * 65);
                if (ok[q]) {
#pragma unroll
                    for (int hh = 0; hh < 2; ++hh) { const f32x4 x = v[q][hh]; const float gg = g[q][hh]; LAS float* tp = Tq + (k0 + 32 * hh) * 65 + n4; tp[0] = x.x * gg; tp[1] = x.y * gg; tp[2] = x.z * gg; tp[3] = x.w * gg; } } }
            __syncthreads();
            const int tn = t + 2 * G;
            PREP_FETCH(tn);
#pragma unroll
            for (int q = 0; q < 2; ++q) if (okc[q]) { const LAS float* Tq = T + q * (64 * 65); float f[8];
#pragma unroll
                for (int j = 0; j < 8; ++j) f[j] = Tq[(kc * 8 + j) * 65 + no];
                u32x4 w; w.x = cvt_pk_bf16(f[0], f[1]); w.y = cvt_pk_bf16(f[2], f[3]); w.z = cvt_pk_bf16(f[4], f[5]); w.w = cvt_pk_bf16(f[6], f[7]);
                *(u32x4*)(dc[q].dst + (size_t)no * dc[q].dld + kc * 8) = w; }
            __syncthreads();
            t = tn;
        }
#undef PREP_FETCH
    }
    for (int i = B * 512 + tid; i < DEPTH * 2048 * 4; i += G * 512) { const int L = i >> 13, k = (i >> 2) & 2047, j = i & 3;
        ((float*)(p.ws + W_WF))[i] = p.g_attn[L * 2048 + k] * p.w_in[(size_t)L * 2048 * D_IN + (size_t)k * D_IN + 4096 + j]; }
    for (int row = B * 8 + wid; row < NR; row += G * 8) {
        const float* src = row < NP ? p.x_prompt + (size_t)row * 2048 : p.x_sample + (size_t)(row - NP) * 2048;
        u16* xb = (u16*)(p.ws + W_XBA) + (size_t)row * 2048; float ss = 0.f;
#pragma unroll
        for (int i = 0; i < 8; ++i) { const int c = (i * 64 + lane) * 4; const f32x4 v = __builtin_nontemporal_load((const f32x4*)(src + c)); ss += v.x * v.x + v.y * v.y + v.z * v.z + v.w * v.w;
            u32x2 w; w.x = cvt_pk_bf16(v.x, v.y); w.y = cvt_pk_bf16(v.z, v.w); *(u32x2*)(xb + c) = w; }
#pragma unroll
        for (int d = 1; d < 64; d <<= 1) ss += __shfl_xor(ss, d);
        if (lane < 32) ((float*)(p.ws + W_SSQA))[(size_t)row * 32 + lane] = lane == 0 ? ss : 0.f;
    }
    for (size_t i0 = (size_t)B * 512 + tid; i0 < (size_t)DEPTH * NR * 64; i0 += (size_t)G * 512 * 4) { f32x4 v[4]; u16* dp[4];
#pragma unroll
        for (int q = 0; q < 4; ++q) { const size_t i = i0 + (size_t)q * G * 512; dp[q] = nullptr;
            if (i < (size_t)DEPTH * NR * 64) { const int L = (int)(i / ((size_t)NR * 64)); const size_t r = i % ((size_t)NR * 64); const int row = (int)(r >> 6), c4 = (int)(r & 63) * 4;
                const float* src = row < NP ? p.p_prompt + ((size_t)L * NP + row) * 256 + c4 : p.p_sample + ((size_t)L * NS + (row - NP)) * 256 + c4;
                v[q] = __builtin_nontemporal_load((const f32x4*)src); dp[q] = (u16*)(p.ws + W_PB) + ((size_t)L * NR + row) * 256 + c4; } }
#pragma unroll
        for (int q = 0; q < 4; ++q) if (dp[q]) { u32x2 w; w.x = cvt_pk_bf16(v[q].x, v[q].y); w.y = cvt_pk_bf16(v[q].z, v[q].w); *(u32x2*)dp[q] = w; } }
    for (size_t i0 = (size_t)B * 512 + tid; i0 < (size_t)2 * DEPTH * DEC_BATCH * PAST * 128; i0 += (size_t)G * 512 * 4) { f32x4 v[4]; u16* dp[4];
#pragma unroll
        for (int q = 0; q < 4; ++q) { const size_t i = i0 + (size_t)q * G * 512; dp[q] = nullptr;
            if (i < (size_t)2 * DEPTH * DEC_BATCH * PAST * 128) { const int br = (int)(i / ((size_t)DEPTH * DEC_BATCH * PAST * 128)); const size_t r = i % ((size_t)DEPTH * DEC_BATCH * PAST * 128);
                const int ls = (int)(r / (PAST * 128)), pos = (int)((r / 128) % PAST), c4 = (int)(r & 127) * 4;
                v[q] = __builtin_nontemporal_load((const f32x4*)((br ? p.c_fxk : p.c_sbk) + ((size_t)ls * PAST + pos) * 512 + c4)); dp[q] = (u16*)(p.ws + W_KBS) + ((size_t)ls * SL + pos) * 1024 + br * 512 + c4; } }
#pragma unroll
        for (int q = 0; q < 4; ++q) if (dp[q]) { u32x2 w; w.x = cvt_pk_bf16(v[q].x, v[q].y); w.y = cvt_pk_bf16(v[q].z, v[q].w); *(u32x2*)dp[q] = w; } }
    for (int s = B * 8 + wid; s < DEPTH * DEC_BATCH * 4; s += G * 8) { const int ls = s >> 2, hh = s & 3; const float* src = p.c_logf + (size_t)ls * PAST * 4 + hh; float v[16]; float run = 0.f;
#pragma unroll
        for (int i = 0; i < 16; ++i) { run += src[(size_t)(lane * 16 + i) * 4]; v[i] = run; }
        float x = run;
#pragma unroll
        for (int d = 1; d < 64; d <<= 1) { const float y = __shfl_up(x, d); if (lane >= d) x += y; }
        const float pre = x - run; float* dst = (float*)(p.ws + W_CCUM) + (size_t)ls * PAST * 4 + hh;
#pragma unroll
        for (int i = 0; i < 16; ++i) dst[(size_t)(lane * 16 + i) * 4] = pre + v[i];
    }
}

__device__ __forceinline__ void logf_items(int wv, const P& p, int layer, LAS unsigned char* lds, int blk0, int blk_end, int blk_step) {
    LAS f32x4* WfL = (LAS f32x4*)lds;
    LAS float* lf = (LAS float*)(lds + 40960);
    const int tid = opaque_tid(wv);
    const f32x4* Wf = (const f32x4*)(p.ws + W_WF) + (size_t)layer * 2048;
    const float* ssqA = (const float*)(p.ws + W_SSQA);
    for (int blk = blk0; blk < blk_end; blk += blk_step) {
        __syncthreads();
#pragma unroll
        for (int i = 0; i < 4; ++i) { const int k = tid + 512 * i; WfL[k + (k >> 9)] = Wf[k]; }
        __syncthreads();
        const int rl = tid >> 2, kq = tid & 3, row = blk * 128 + rl;
        const u16* xr = (const u16*)(p.ws + W_XBA) + (size_t)row * 2048 + kq * 512;
        f32x4 a = (f32x4){0.f, 0.f, 0.f, 0.f};
        for (int i = 0; i < 64; ++i) { const u32x4 xv = *(const u32x4*)(xr + i * 8); const LAS f32x4* w = WfL + kq * 513 + i * 8;
            a += w[0] * bf_lo(xv.x); a += w[1] * bf_hi(xv.x); a += w[2] * bf_lo(xv.y); a += w[3] * bf_hi(xv.y); a += w[4] * bf_lo(xv.z); a += w[5] * bf_hi(xv.z); a += w[6] * bf_lo(xv.w); a += w[7] * bf_hi(xv.w); }
#pragma unroll
        for (int j = 0; j < 4; ++j) { a[j] += __shfl_xor(a[j], 1); a[j] += __shfl_xor(a[j], 2); }
        if (kq == 0) { float s = 0.f; const f32x4* q = (const f32x4*)(ssqA + (size_t)row * 32);
#pragma unroll
            for (int i = 0; i < 8; ++i) { const f32x4 v = q[i]; s += (v.x + v.y) + (v.z + v.w); }
            const float rs = rsqrtf(s * (1.f / 2048.f) + EPS); f32x4 lg;
#pragma unroll
            for (int j = 0; j < 4; ++j) { const float f = a[j] * rs + p.b_f[layer * 4 + j]; lg[j] = fminf(f, 0.f) - log1pf(expf(-fabsf(f))); }
            float* o = row < NP ? p.out + O_LOGF_P + ((size_t)layer * NP + row) * 4 : p.out + O_LOGF_S + ((size_t)layer * NS + (row - NP)) * 4;
            *(f32x4*)o = lg; lf[rl * 4 + 0] = lg.x; lf[rl * 4 + 1] = lg.y; lf[rl * 4 + 2] = lg.z; lf[rl * 4 + 3] = lg.w; }
        __syncthreads();
        if (tid < 16) { const int seg = tid >> 2, hh = tid & 3; float run = 0.f; float* cin = (float*)(p.ws + W_CIN);
            for (int i = 0; i < 32; ++i) { run += lf[(seg * 32 + i) * 4 + hh]; cin[(size_t)(blk * 128 + seg * 32 + i) * 4 + hh] = run; }
            ((float*)(p.ws + W_SEGTOT))[(size_t)(blk * 4 + seg) * 4 + hh] = run; }
    }
    __syncthreads();
}

constexpr int TEAM = 32;
__device__ __forceinline__ void team_barrier(unsigned* ctr) {
    __threadfence();
    __syncthreads();
    if (threadIdx.x == 0) {
        __hip_atomic_fetch_add(ctr, 1u, __ATOMIC_RELEASE, __HIP_MEMORY_SCOPE_AGENT);
        while (__hip_atomic_load(ctr, __ATOMIC_RELAXED, __HIP_MEMORY_SCOPE_AGENT) < (unsigned)TEAM) __builtin_amdgcn_s_sleep(16);
        __builtin_amdgcn_fence(__ATOMIC_ACQUIRE, "agent");
    }
    __syncthreads();
    __threadfence();
}

constexpr int A_KB = 0, A_VB = 34816, A_CK = 71680, A_SEG = 72192, A_MISC = 74240, A_T = 76800;
constexpr int KROW = 272, VROW = 144;

__device__ __forceinline__ void attn_phase(int wv, const P& p, int layer, LAS unsigned char* lds) {
    LAS float* segpre = (LAS float*)(lds + A_SEG);
    LAS int* misc = (LAS int*)(lds + A_MISC);
    LAS float* wtot = (LAS float*)(lds + A_MISC + 128);
    unsigned* ctr = (unsigned*)(p.ws + W_CTR) + layer;
    const float* Cin = (const float*)(p.ws + W_CIN);
    const int bid = blockIdx.x; const bool team = bid < TEAM;
    unsigned* tbar = (unsigned*)(p.ws + W_CTR) + 16 + layer * 8;
    int sd_left = 0, tstate = team ? 0 : 2;
    if (team) {
        pg8::StaticOrder S1;
        if (layer > 0) {
            if (bid < 8) { pg8::Gemm g{(const u16*)(p.ws + W_OB), (const u16*)(p.ws + W_WTOUT) + (size_t)(layer - 1) * 2048 * 1024, NR, 2048, 1024}; S1.init_one(NP / 256, bid); EpiOut E{p, lds}; pg8::gemm_phase(wv, lds, g, S1, E); }
            else if (bid < 16) { pg8::Gemm g{(const u16*)(p.ws + W_PB) + (size_t)(layer - 1) * NR * 256, (const u16*)(p.ws + W_WTPLE) + (size_t)(layer - 1) * 2048 * 256, NR, 2048, 256}; S1.init_one(NP / 256, bid - 8); EpiPle E{p, lds}; pg8::gemm_phase(wv, lds, g, S1, E); }
            team_barrier(tbar + 0);
            if (bid < 8) { pg8::Gemm g{(const u16*)(p.ws + W_XBB), (const u16*)(p.ws + W_WTGATE) + (size_t)(layer - 1) * 2048 * 2048, NR, 2048, 2048}; S1.init_one(NP / 256, bid); EpiGate E{p, lds}; pg8::gemm_phase(wv, lds, g, S1, E); }
            team_barrier(tbar + 1);
        }
        if (bid < 16) { pg8::Gemm g{(const u16*)(p.ws + W_XBA), (const u16*)(p.ws + W_WTIN) + (size_t)layer * 4096 * 2048, NR, 4096, 2048}; S1.init_one(NP / 256, bid); EpiProj E{p, layer, lds}; pg8::gemm_phase(wv, lds, g, S1, E); }
        else if (bid < 18) logf_items(wv, p, layer, lds, NP / 128 + (bid - 16), NP / 128 + (bid - 16) + 1, 1);
        team_barrier(tbar + 2);
        sd_left = 2;
    }
    {
        const int t8 = opaque_tid(wv);
        __syncthreads();
        if (t8 < 8) { const float* st = (const float*)(p.ws + W_SEGTOT); float est[8];
#pragma unroll
            for (int q = 0; q < 8; ++q) { float e = 0.f; for (int i = 0; i < 16; ++i) e += st[(size_t)((q >> 2) * 512 + 256 + i) * 4 + (q & 3)]; est[q] = e; }
            int rk = 0; float mine = 0.f;
#pragma unroll
            for (int q = 0; q < 8; ++q) if (q == t8) mine = est[q];
#pragma unroll
            for (int q = 0; q < 8; ++q) rk += (est[q] > mine || (est[q] == mine && q < t8)) ? 1 : 0;
            misc[40 + rk] = t8; }
        __syncthreads();
    }
    for (;;) {
        if (tstate == 0 && sd_left == 0) {
            if (layer == DEPTH - 1) {
                pg8::StaticOrder S1;
                team_barrier(tbar + 3);
                if (bid < 8) { pg8::Gemm g{(const u16*)(p.ws + W_OB), (const u16*)(p.ws + W_WTOUT) + (size_t)layer * 2048 * 1024, NR, 2048, 1024}; S1.init_one(NP / 256, bid); EpiOut E{p, lds}; pg8::gemm_phase(wv, lds, g, S1, E); }
                else if (bid < 16) { pg8::Gemm g{(const u16*)(p.ws + W_PB) + (size_t)layer * NR * 256, (const u16*)(p.ws + W_WTPLE) + (size_t)layer * 2048 * 256, NR, 2048, 256}; S1.init_one(NP / 256, bid - 8); EpiPle E{p, lds}; pg8::gemm_phase(wv, lds, g, S1, E); }
                team_barrier(tbar + 4);
                if (bid < 8) { pg8::Gemm g{(const u16*)(p.ws + W_XBB), (const u16*)(p.ws + W_WTGATE) + (size_t)layer * 2048 * 2048, NR, 2048, 2048}; S1.init_one(NP / 256, bid); EpiGate E{p, lds}; pg8::gemm_phase(wv, lds, g, S1, E); }
            }
            tstate = 2;
        }
        const int tid = opaque_tid(wv), wid = __builtin_amdgcn_readfirstlane(tid >> 6), lane = tid & 63, r = lane & 31, h = lane >> 5;
        const int prow = 16 * (r >> 4) + 8 * ((r >> 2) & 1) + 4 * ((r >> 3) & 1) + (r & 3);
        __syncthreads();
        if (tid == 0) misc[0] = sd_left > 0 ? 1024 + (2 - sd_left) * TEAM + bid : (int)atomicAdd(ctr, 1u);
        __syncthreads();
        int item = misc[0];
        if (sd_left > 0) --sd_left; else if (item >= 1024) break;
        int head8, qpos0, nw, row0, ldv, sbi = 0, bi = 0; const u16 *Kb, *Vt; const bool prompt = item < 1024;
        if (prompt) { const int fx = item < 512, it2 = item & 511; int qt, rem; if (fx) { qt = 63 - (it2 & 63); rem = misc[40 + (it2 >> 6)]; } else { qt = 63 - (it2 >> 3); rem = it2 & 7; } bi = rem >> 2; head8 = (fx ? 4 : 0) + (rem & 3);     qpos0 = qt * 256; nw = 8; row0 = bi * SEQ + qpos0;
            Kb = (const u16*)(p.ws + W_KBP) + (size_t)bi * SEQ * 1024 + head8 * 128; Vt = (const u16*)(p.ws + W_VTP) + (size_t)(bi * 8 + head8) * 128 * SEQ; ldv = SEQ;
        } else { const int s = item - 1024; sbi = s >> 3; head8 = s & 7; qpos0 = PAST; nw = 1; row0 = NP + sbi * 32;
            Kb = (const u16*)(p.ws + W_KBS) + (size_t)(layer * 8 + sbi) * SL * 1024 + head8 * 128; Vt = (const u16*)(p.ws + W_VTS) + (size_t)((layer * 8 + sbi) * 8 + head8) * 128 * SL; ldv = SL; }
        const bool fox = head8 >= 4; const int hf = head8 & 3;
        u32x4 kreg[2], vreg[2]; float ckreg = 0.f;
        const int krow_ = tid >> 4, kch = tid & 15, vrow_ = tid >> 3, vch = tid & 7;
        const int jt_top = (qpos0 + 32 * nw - 1) >> 6;
#pragma unroll
        for (int pz = 0; pz < 2; ++pz) { kreg[pz] = *(const u32x4*)(Kb + (size_t)(jt_top * 64 + krow_ + 32 * pz) * 1024 + kch * 8); vreg[pz] = *(const u32x4*)(Vt + (size_t)(vrow_ + 64 * pz) * ldv + jt_top * 64 + vch * 8); }
        const float* ccum = (const float*)(p.ws + W_CCUM) + (size_t)(layer * 8 + sbi) * PAST * 4 + hf;
        if (fox && prompt) {
            const int nseg = (qpos0 + 256) >> 5; const float v = tid < nseg ? ((const float*)(p.ws + W_SEGTOT))[(size_t)(bi * 512 + tid) * 4 + hf] : 0.f; float x = v;
#pragma unroll
            for (int d = 1; d < 64; d <<= 1) { const float y = __shfl_up(x, d); if (lane >= d) x += y; }
            if (lane == 63) wtot[wid] = x;
            __syncthreads();
            float pre = 0.f; for (int w = 0; w < wid; ++w) pre += wtot[w];
            segpre[tid] = pre + x - v;
            __syncthreads();
        }
        auto getC = [&](int pos) -> float {
            if (prompt) return segpre[pos >> 5] + Cin[(size_t)(bi * SEQ + pos) * 4 + hf];
            if (pos < PAST) return ccum[(size_t)pos * 4];
            if (pos < PAST + 32) return ccum[(size_t)(PAST - 1) * 4] + Cin[(size_t)(NP + sbi * 32 + pos - PAST) * 4 + hf];
            return 0.f; };
        const bool wact = wid < nw;
        bf16x8 qf[8];
        float cq2 = 0.f;
        const int qlo = qpos0 + 32 * wid, qhi = qlo + 31, qpos = qlo + r;
        if (wact) { const u16* qg = (const u16*)(p.ws + W_QB) + (size_t)(row0 + 32 * wid) * 1024 + head8 * 128; LAS unsigned char* Tq = lds + A_T + wid * (32 * 272);
            { u32x4 qr[8];
#pragma unroll
              for (int i = 0; i < 8; ++i) qr[i] = *(const u32x4*)(qg + (size_t)(4 * i + (lane >> 4)) * 1024 + (lane & 15) * 8);
#pragma unroll
              for (int i = 0; i < 8; ++i) *(LAS u32x4*)(Tq + (4 * i + (lane >> 4)) * 272 + (lane & 15) * 16) = qr[i]; }
#pragma unroll
            for (int kk = 0; kk < 8; ++kk) qf[kk] = *(const LAS bf16x8*)(Tq + r * 272 + (16 * kk + 8 * h) * 2);
            if (fox) cq2 = getC(qpos) * LOG2E; }
        else {
#pragma unroll
            for (int kk = 0; kk < 8; ++kk) qf[kk] = (bf16x8){0, 0, 0, 0, 0, 0, 0, 0}; }
        float qnK = 3.0e38f;
        if (fox && prompt) { const unsigned* ks = (const unsigned*)(p.ws + W_CTR) + 64 + ((layer * 2 + bi) * 4 + hf) * 4;
            const float kmax = sqrtf(__uint_as_float(ks[0]) + __uint_as_float(ks[1]) + __uint_as_float(ks[2]) + __uint_as_float(ks[3])) * 1.01f; float qn2 = 0.f;
#pragma unroll
            for (int kk = 0; kk < 8; ++kk)
#pragma unroll
                for (int i = 0; i < 8; ++i) { const float f = __uint_as_float(((unsigned)(unsigned short)qf[kk][i]) << 16); qn2 += f * f; }
            qn2 += __shfl_xor(qn2, 32); qnK = sqrtf(qn2) * 1.01f * kmax; }
#define LOAD_TILE(jt_) do { const int k0_ = (jt_) * 64; _Pragma("unroll") for (int pz = 0; pz < 2; ++pz) { \
            kreg[pz] = *(const u32x4*)(Kb + (size_t)(k0_ + krow_ + 32 * pz) * 1024 + kch * 8); \
            vreg[pz] = *(const u32x4*)(Vt + (size_t)(vrow_ + 64 * pz) * ldv + k0_ + vch * 8); } \
            if (fox && tid < 64) ckreg = getC(k0_ + tid) * LOG2E; } while (0)
#define STORE_TILE(buf_) do { _Pragma("unroll") for (int pz = 0; pz < 2; ++pz) { \
            *(LAS u32x4*)(lds + A_KB + (buf_) * 17408 + (krow_ + 32 * pz) * KROW + kch * 16) = kreg[pz]; \
            *(LAS u32x4*)(lds + A_VB + (buf_) * 18432 + (vrow_ + 64 * pz) * VROW + vch * 16) = vreg[pz]; } \
            if (fox && tid < 64) *(LAS float*)(lds + A_CK + (buf_) * 256 + tid * 4) = ckreg; } while (0)
        if (fox && tid < 64) ckreg = getC(jt_top * 64 + tid) * LOG2E;
        STORE_TILE(0);
        __syncthreads();
        f32x16 o[4];
#pragma unroll
        for (int dt = 0; dt < 4; ++dt)
#pragma unroll
            for (int i = 0; i < 16; ++i) o[dt][i] = 0.f;
        float carry = 0.f, mrun = -1e30f, mref = 0.f, lsum = 0.f; bool wave_done = !wact;
        for (int jt = jt_top, it = 0; jt >= 0; --jt, ++it) {
            const int cur = it & 1; const bool more = jt > 0;
            if (more) LOAD_TILE(jt - 1);
            const int key0 = jt * 64;
            if (fox && prompt && !wave_done && key0 <= qhi) {
                const float ck63 = *(const LAS float*)(lds + A_CK + cur * 256 + 252);
                if (__all((qnK + cq2 - ck63) < (mrun - 152.f))) wave_done = true; }
            if (!wave_done && key0 <= qhi) {
                const bool diag = key0 + 63 >= qlo;
                const LAS unsigned char* kb = lds + A_KB + cur * 17408 + prow * KROW + 16 * h;
                const LAS unsigned char* vb = lds + A_VB + cur * 18432 + r * VROW + 16 * h;
                f32x16 sv[2];
                typedef float f32x2 __attribute__((ext_vector_type(2)));
                if (fox) {
                    const LAS float* ckb = (const LAS float*)(lds + A_CK + cur * 256) + 8 * h;
                    const float cqm = cq2 - mref; const f32x2 cqv = {cqm, cqm};
#pragma unroll
                    for (int kt = 0; kt < 2; ++kt)
#pragma unroll
                        for (int q4 = 0; q4 < 4; ++q4) { const f32x4 ck = *(const LAS f32x4*)(ckb + 32 * kt + 16 * (q4 >> 1) + 4 * (q4 & 1));
                            const f32x2 x0 = cqv - (f32x2){ck.x, ck.y}, x1 = cqv - (f32x2){ck.z, ck.w};
                            sv[kt][4 * q4 + 0] = x0.x; sv[kt][4 * q4 + 1] = x0.y; sv[kt][4 * q4 + 2] = x1.x; sv[kt][4 * q4 + 3] = x1.y; }
                } else {
#pragma unroll
                    for (int i = 0; i < 16; ++i) { sv[0][i] = 0.f; sv[1][i] = 0.f; } }
#pragma unroll
                for (int kk = 0; kk < 8; ++kk) { const bf16x8 a0 = *(const LAS bf16x8*)(kb + kk * 32); const bf16x8 a1 = *(const LAS bf16x8*)(kb + 32 * KROW + kk * 32);
                    sv[0] = __builtin_amdgcn_mfma_f32_32x32x16_bf16(a0, qf[kk], sv[0], 0, 0, 0); sv[1] = __builtin_amdgcn_mfma_f32_32x32x16_bf16(a1, qf[kk], sv[1], 0, 0, 0); }
                if (!fox) {
#pragma unroll
                    for (int kt = 1; kt >= 0; --kt) {
                        float sp[16], ex[16], tot[2];
#pragma unroll
                        for (int rg = 0; rg < 16; ++rg) { const int kpos = key0 + 32 * kt + 16 * (rg >> 3) + 8 * h + (rg & 7); const float z = sv[kt][rg];
                            const float spv = fmaxf(z, 0.f) + flog2(1.f + fexp2(-fabsf(z))); sp[rg] = (!diag || kpos < qpos) ? spv : 0.f; }
#pragma unroll
                        for (int c = 0; c < 2; ++c) { float run = 0.f;
#pragma unroll
                            for (int idx = 7; idx >= 0; --idx) { ex[8 * c + idx] = run; run += sp[8 * c + idx]; }
                            tot[c] = run; }
                        const float pt0 = __shfl_xor(tot[0], 32), pt1 = __shfl_xor(tot[1], 32);
                        const float off1 = carry + (h ? 0.f : pt1), off0 = carry + (h ? (pt1 + tot[1]) : (pt0 + tot[1] + pt1));
#pragma unroll
                        for (int rg = 0; rg < 16; ++rg) { const int kpos = key0 + 32 * kt + 16 * (rg >> 3) + 8 * h + (rg & 7);
                            const float e2 = sv[kt][rg] - sp[rg] - ((rg >= 8 ? off1 : off0) + ex[rg]);
                            sv[kt][rg] = (!diag || kpos < qpos) ? fexp2(e2) : 0.f; }
                        carry += (tot[0] + tot[1]) + (pt0 + pt1);
                    }
                    if (__all(carry > 152.f)) wave_done = true;
                } else {
                    if (diag) {
#pragma unroll
                        for (int kt = 0; kt < 2; ++kt)
#pragma unroll
                            for (int rg = 0; rg < 16; ++rg) { const int kpos = key0 + 32 * kt + 16 * (rg >> 3) + 8 * h + (rg & 7); if (kpos > qpos) sv[kt][rg] = -1e30f; } }
                    float mx = -1e30f;
#pragma unroll
                    for (int kt = 0; kt < 2; ++kt)
#pragma unroll
                        for (int i = 0; i < 8; ++i) mx = fmax3(mx, sv[kt][2 * i], sv[kt][2 * i + 1]);
                    mx = fmaxf(mx, __shfl_xor(mx, 32));
                    const bool firstt = mrun < -1e29f;
                    mrun = fmaxf(mrun, mref + mx);
                    if (firstt || __any(mx > 0.f)) {
                        const float dlt = firstt ? mx : fmaxf(mx, 0.f), alpha = fexp2(-dlt); mref += dlt; lsum *= alpha; const f32x2 dv = {dlt, dlt};
#pragma unroll
                        for (int dt = 0; dt < 4; ++dt) o[dt] *= alpha;
#pragma unroll
                        for (int kt = 0; kt < 2; ++kt)
#pragma unroll
                            for (int i = 0; i < 8; ++i) { const f32x2 t = (f32x2){sv[kt][2 * i], sv[kt][2 * i + 1]} - dv; sv[kt][2 * i] = t.x; sv[kt][2 * i + 1] = t.y; } }
                    f32x2 ps2 = {0.f, 0.f};
#pragma unroll
                    for (int kt = 0; kt < 2; ++kt)
#pragma unroll
                        for (int i = 0; i < 8; ++i) { f32x2 e; e.x = fexp2(sv[kt][2 * i]); e.y = fexp2(sv[kt][2 * i + 1]); sv[kt][2 * i] = e.x; sv[kt][2 * i + 1] = e.y; ps2 += e; }
                    lsum += ps2.x + ps2.y;
                }
#pragma unroll
                for (int kt = 0; kt < 2; ++kt)
#pragma unroll
                    for (int c = 0; c < 2; ++c) { union { u32x4 u; bf16x8 v; } pf;
                        pf.u.x = cvt_pk_bf16(sv[kt][8 * c + 0], sv[kt][8 * c + 1]); pf.u.y = cvt_pk_bf16(sv[kt][8 * c + 2], sv[kt][8 * c + 3]);
                        pf.u.z = cvt_pk_bf16(sv[kt][8 * c + 4], sv[kt][8 * c + 5]); pf.u.w = cvt_pk_bf16(sv[kt][8 * c + 6], sv[kt][8 * c + 7]);
#pragma unroll
                        for (int dt = 0; dt < 4; ++dt) { const bf16x8 vf = *(const LAS bf16x8*)(vb + dt * 32 * VROW + (32 * kt + 16 * c) * 2);
                            o[dt] = __builtin_amdgcn_mfma_f32_32x32x16_bf16(vf, pf.v, o[dt], 0, 0, 0); } }
            }
            if (more) STORE_TILE(cur ^ 1);
            if (lane == 0) misc[8 + cur * 8 + wid] = wave_done ? 1 : 0;
            __syncthreads();
            int alld = 1;
#pragma unroll
            for (int w = 0; w < 8; ++w) alld &= misc[8 + cur * 8 + w];
            if (alld) break;
        }
#undef LOAD_TILE
#undef STORE_TILE
        if (wact) {
            if (fox) { lsum += __shfl_xor(lsum, 32); const float inv = 1.f / lsum;
#pragma unroll
                for (int dt = 0; dt < 4; ++dt) o[dt] *= inv; }
            float ss = 0.f;
#pragma unroll
            for (int dt = 0; dt < 4; ++dt)
#pragma unroll
                for (int i = 0; i < 16; ++i) ss += o[dt][i] * o[dt][i];
            ss += __shfl_xor(ss, 32);
            const float rn = rsqrtf(ss * (1.f / 128.f) + EPS);
            const float* gp = (fox ? p.g_ofox : p.g_osb) + layer * 512 + hf * 128 + 4 * h;
            const u16* zg = (const u16*)(p.ws + W_ZB) + (size_t)(row0 + 32 * wid) * 1024 + head8 * 128;
            u16* og = (u16*)(p.ws + W_OB) + (size_t)(row0 + 32 * wid) * 1024 + head8 * 128;
            LAS unsigned char* Tz = lds + A_T + wid * (32 * 272);
            { u32x4 zr[8];
#pragma unroll
              for (int i = 0; i < 8; ++i) zr[i] = *(const u32x4*)(zg + (size_t)(4 * i + (lane >> 4)) * 1024 + (lane & 15) * 8);
#pragma unroll
              for (int i = 0; i < 8; ++i) *(LAS u32x4*)(Tz + (4 * i + (lane >> 4)) * 272 + (lane & 15) * 16) = zr[i]; }
#pragma unroll
            for (int dt = 0; dt < 4; ++dt)
#pragma unroll
                for (int bb = 0; bb < 4; ++bb) { const int d = 32 * dt + 8 * bb; const f32x4 g = *(const f32x4*)(gp + d); LAS u32x2* tp = (LAS u32x2*)(Tz + r * 272 + (d + 4 * h) * 2); const u32x2 z2 = *tp;
                    const float v0 = o[dt][4 * bb + 0] * rn * g.x * bf_lo(z2.x), v1 = o[dt][4 * bb + 1] * rn * g.y * bf_hi(z2.x), v2 = o[dt][4 * bb + 2] * rn * g.z * bf_lo(z2.y), v3 = o[dt][4 * bb + 3] * rn * g.w * bf_hi(z2.y);
                    u32x2 w; w.x = cvt_pk_bf16(v0, v1); w.y = cvt_pk_bf16(v2, v3); *tp = w; }
#pragma unroll
            for (int i = 0; i < 8; ++i) { const u32x4 w = *(const LAS u32x4*)(Tz + (4 * i + (lane >> 4)) * 272 + (lane & 15) * 16); *(u32x4*)(og + (size_t)(4 * i + (lane >> 4)) * 1024 + (lane & 15) * 8) = w; }
        }
    }
}

__device__ __forceinline__ void final_phase(int wv, const P& p) {
    const int tid = opaque_tid(wv), wid = tid >> 6, lane = tid & 63;
    const float* ssqA = (const float*)(p.ws + W_SSQA);
    for (int row = blockIdx.x * 8 + wid; row < NR; row += gridDim.x * 8) {
        float s = lane < 32 ? ssqA[(size_t)row * 32 + lane] : 0.f;
#pragma unroll
        for (int d = 1; d < 64; d <<= 1) s += __shfl_xor(s, d);
        const float rs = rsqrtf(s * (1.f / 2048.f) + EPS);
        float* xo = p.out + (size_t)row * 2048; const u16* xb = (const u16*)(p.ws + W_XBA) + (size_t)row * 2048;
#pragma unroll
        for (int i = 0; i < 8; ++i) { const int c = (i * 64 + lane) * 4; const u32x2 xw = *(const u32x2*)(xb + c); const f32x4 g = *(const f32x4*)(p.g_final + c);
            f32x4 v; v.x = bf_lo(xw.x) * rs * g.x; v.y = bf_hi(xw.x) * rs * g.y; v.z = bf_lo(xw.y) * rs * g.z; v.w = bf_hi(xw.y) * rs * g.w; *(f32x4*)(xo + c) = v; }
    }
}

constexpr int LDS_BYTES = 131072 + 8 * 2304;

__global__ __launch_bounds__(512, 2) void fwd_megakernel(P p) {
    extern __shared__ __attribute__((aligned(16))) unsigned char shm[];
    LAS unsigned char* lds = (LAS unsigned char*)shm;
    cg::grid_group grid = cg::this_grid();
    const int wv = __builtin_amdgcn_readfirstlane(threadIdx.x >> 6);
    prep_phase(wv, p, lds);
    grid.sync();
    pg8::StaticOrder S;
    for (int layer_ = 0; layer_ < DEPTH; ++layer_) {
        int layer = layer_, bid = (int)blockIdx.x, G = (int)gridDim.x; asm volatile("" : "+s"(layer), "+s"(bid), "+s"(G));
        {
            pg8::Gemm g{(const u16*)(p.ws + W_XBA), (const u16*)(p.ws + W_WTIN) + (size_t)layer * 4096 * 2048, NP, 4096, 2048};
            S.init(g.M, g.N, G, bid); EpiProj E{p, layer, lds};
            pg8::gemm_phase(wv, lds, g, S, E);
            logf_items(wv, p, layer, lds, bid, NP / 128, G);
        }
        grid.sync();
        attn_phase(wv, p, layer, lds);
        grid.sync();
        {
            for (int rep = 0; rep < 2; ++rep) {
                if ((rep ^ ((bid >> 2) & 1)) == 0) {
                    pg8::Gemm g{(const u16*)(p.ws + W_OB), (const u16*)(p.ws + W_WTOUT) + (size_t)layer * 2048 * 1024, NP, 2048, 1024};
                    S.init(g.M, g.N, G, bid); EpiOut E{p, lds};
                    pg8::gemm_phase(wv, lds, g, S, E);
                } else {
                    pg8::Gemm g2{(const u16*)(p.ws + W_PB) + (size_t)layer * NR * 256, (const u16*)(p.ws + W_WTPLE) + (size_t)layer * 2048 * 256, NP, 2048, 256};
                    S.init(g2.M, g2.N, G, bid); EpiPle E2{p, lds};
                    pg8::gemm_phase(wv, lds, g2, S, E2);
                }
            }
        }
        grid.sync();
        {
            pg8::Gemm g{(const u16*)(p.ws + W_XBB), (const u16*)(p.ws + W_WTGATE) + (size_t)layer * 2048 * 2048, NP, 2048, 2048};
            S.init(g.M, g.N, G, bid); EpiGate E{p, lds};
            pg8::gemm_phase(wv, lds, g, S, E);
        }
        grid.sync();
    }
    final_phase(wv, p);
}

extern "C" void kernel_launch(void* const* d_in, const int* in_sizes, int n_in, void* d_out, int out_size, void* d_ws, size_t ws_size, hipStream_t stream) {
    static int grid_blocks = 0;
    if (!grid_blocks) {
        if (n_in != 19 || (size_t)out_size != OUT_TOTAL || ws_size < W_END) { fprintf(stderr, "kernel_launch: unexpected shapes: n_in %d out %d (want %zu) ws %zu (want %zu)\n", n_in, out_size, OUT_TOTAL, ws_size, W_END); grid_blocks = -1; return; }
        int dev = 0, cus = 0, per_cu = 0;
        hipGetDevice(&dev);
        hipDeviceGetAttribute(&cus, hipDeviceAttributeMultiprocessorCount, dev);
        if (hipFuncSetAttribute((const void*)fwd_megakernel, hipFuncAttributeMaxDynamicSharedMemorySize, LDS_BYTES) != hipSuccess) fprintf(stderr, "kernel_launch: hipFuncSetAttribute failed\n");
        if (hipOccupancyMaxActiveBlocksPerMultiprocessor(&per_cu, (const void*)fwd_megakernel, 512, LDS_BYTES) != hipSuccess || per_cu < 1) { fprintf(stderr, "kernel_launch: occupancy query gave %d\n", per_cu); per_cu = 1; }
        (void)hipGetLastError();
        grid_blocks = cus * per_cu;
    }
    if (grid_blocks < 0) return;
    P p{};
    const float** f = (const float**)&p;
    for (int i = 0; i < 19; ++i) f[i] = (const float*)d_in[i];
    p.out = (float*)d_out; p.ws = (unsigned char*)d_ws;
    void* args[] = {&p};
    hipError_t e = hipLaunchCooperativeKernel((const void*)fwd_megakernel, dim3(grid_blocks), dim3(512), args, LDS_BYTES, stream);
    if (e != hipSuccess) fprintf(stderr, "cooperative launch failed: %s (grid %d)\n", hipGetErrorString(e), grid_blocks);
}
```

```cpp
#include <hip/hip_runtime.h>
#include <hip/hip_cooperative_groups.h>
#include <cstdio>
namespace cg = cooperative_groups;

#define LAS __attribute__((address_space(3)))
typedef unsigned short u16;
typedef short bf16x8 __attribute__((ext_vector_type(8)));
typedef float f32x4 __attribute__((ext_vector_type(4)));
typedef float f32x16 __attribute__((ext_vector_type(16)));
typedef unsigned u32x2 __attribute__((ext_vector_type(2)));
typedef unsigned u32x4 __attribute__((ext_vector_type(4)));

constexpr int D_MODEL = 2048, SEQ = 16384, DEPTH = 4, DEC_BATCH = 8, DEC_SEQ = 32, PAST = 1024;
constexpr int NP = 2 * SEQ, NS = DEC_BATCH * DEC_SEQ, NR = NP + NS;
constexpr int DMIX = 1024, D_IN = 4100, PLE = 256;
constexpr int SL = 1088;
constexpr float EPS = 1e-6f;
constexpr float LOG2E = 1.4426950408889634f;
constexpr float QSCALE = 0.08838834764831845f * LOG2E;
constexpr int NITEMS = 1024 + 64;

constexpr size_t O_Y = 0;
constexpr size_t O_KV_P = (size_t)NR * D_MODEL;
constexpr size_t KVP = (size_t)DEPTH * NP * 512;
constexpr size_t O_LOGF_P = O_KV_P + 4 * KVP;
constexpr size_t O_KV_S = O_LOGF_P + (size_t)DEPTH * NP * 4;
constexpr size_t KVS = (size_t)DEPTH * NS * 512;
constexpr size_t O_LOGF_S = O_KV_S + 4 * KVS;
constexpr size_t OUT_TOTAL = O_LOGF_S + (size_t)DEPTH * NS * 4;

constexpr size_t al256(size_t x) { return (x + 255) & ~(size_t)255; }
constexpr size_t W_WTIN = 0;
constexpr size_t W_WTOUT = W_WTIN + (size_t)DEPTH * 4096 * 2048 * 2;
constexpr size_t W_WTPLE = W_WTOUT + (size_t)DEPTH * 2048 * 1024 * 2;
constexpr size_t W_WTGATE = W_WTPLE + (size_t)DEPTH * 2048 * 256 * 2;
constexpr size_t W_WF = W_WTGATE + (size_t)DEPTH * 2048 * 2048 * 2;
constexpr size_t W_XBA = W_WF + (size_t)DEPTH * 2048 * 4 * 4;
constexpr size_t W_PB = W_XBA + (size_t)NR * 2048 * 2;
constexpr size_t W_R = W_PB + (size_t)DEPTH * NR * 256 * 2;
constexpr size_t W_QB = W_R;
constexpr size_t W_KBP = W_QB + (size_t)NR * 1024 * 2;
constexpr size_t W_VTP = W_KBP + (size_t)NP * 1024 * 2;
constexpr size_t W_ZB = W_VTP + (size_t)NP * 1024 * 2;
constexpr size_t W_PLEB = W_R;
constexpr size_t W_XBB = W_R + al256((size_t)NR * 2048 * 2);
constexpr size_t R_SIZE = 2 * al256((size_t)NR * 2048 * 2) + 4096;
static_assert(W_ZB + (size_t)NR * 1024 * 2 <= W_R + R_SIZE, "region R too small");
constexpr size_t W_KBS = W_R + R_SIZE;
constexpr size_t W_VTS = W_KBS + (size_t)DEPTH * DEC_BATCH * SL * 1024 * 2;
constexpr size_t W_OB = W_VTS + (size_t)DEPTH * DEC_BATCH * 8 * 128 * SL * 2;
constexpr size_t W_SSQA = W_OB + (size_t)NR * 1024 * 2;
constexpr size_t W_SSQB = W_SSQA + (size_t)NR * 32 * 4;
constexpr size_t W_CIN = W_SSQB + (size_t)NR * 32 * 4;
constexpr size_t W_SEGTOT = W_CIN + (size_t)NR * 4 * 4;
constexpr size_t W_CCUM = W_SEGTOT + al256((size_t)(NR / 32) * 4 * 4);
constexpr size_t W_CTR = W_CCUM + (size_t)DEPTH * DEC_BATCH * PAST * 4 * 4;
constexpr size_t W_PLES = W_CTR + 4096;
constexpr size_t W_END = W_PLES + (size_t)NS * 2048 * 2;

struct P {
    const float *x_prompt, *x_sample, *p_prompt, *p_sample, *c_sbk, *c_sbv, *c_fxk, *c_fxv, *c_logf, *w_in, *b_f, *g_attn, *g_osb, *g_ofox, *w_out, *w_ple, *g_ple, *w_gate, *g_final;
    float* out;
    unsigned char* ws;
};

__device__ __forceinline__ unsigned cvt_pk_bf16(float lo, float hi) { unsigned r; asm volatile("v_cvt_pk_bf16_f32 %0, %1, %2" : "=v"(r) : "v"(lo), "v"(hi)); return r; }
__device__ __forceinline__ float bf_lo(unsigned w) { return __uint_as_float(w << 16); }
__device__ __forceinline__ float bf_hi(unsigned w) { return __uint_as_float(w & 0xffff0000u); }
__device__ __forceinline__ float fexp2(float x) { return __builtin_amdgcn_exp2f(x); }
__device__ __forceinline__ float flog2(float x) { return __builtin_amdgcn_logf(x); }
__device__ __forceinline__ float fmax3(float a, float b, float c) { float r; asm("v_max3_f32 %0, %1, %2, %3" : "=v"(r) : "v"(a), "v"(b), "v"(c)); return r; }
__device__ __forceinline__ int opaque_tid(int wv) { int l; asm volatile("v_mbcnt_lo_u32_b32 %0, -1, 0\n\tv_mbcnt_hi_u32_b32 %0, -1, %0" : "=v"(l)); return wv * 64 + l; }

namespace pg8 {
constexpr int BM = 256, BK = 64, HALF = 128, HTB = HALF * BK * 2, STAGE_BYTES = 8 * HTB, NXCD = 8, WGM = 8;
__host__ __device__ __forceinline__ int lds_byte(int r, int c) { const int st = (r >> 4) * 2 + (c >> 5), rr = r & 15, cc = c & 31, ob = rr * 64 + cc * 2; return st * 1024 + (ob ^ (((ob >> 9) & 1) << 5)); }
__host__ __device__ __forceinline__ void stage_rc(int b, int& R, int& C) { const int st = b / 1024, sb = b % 1024, swz = sb ^ (((sb >> 9) & 1) << 5); R = (st >> 1) * 16 + swz / 64; C = (st & 1) * 32 + (swz % 64) / 2; }
struct Unit { int pm, pn; };
struct Gemm { const u16* A; const u16* Bt; int M, N, K; };
struct StaticOrder {
    int nM, nN, nwg, G, c;
    int one_pm, one_pn;
    __device__ void init(int M, int N, int G_, int c_) { nM = M / BM; nN = N / BM; nwg = nM * nN; G = G_; c = c_; one_pm = -1; one_pn = 0; }
    __device__ void init_one(int pm, int pn) { nM = 1; nN = 1; nwg = 1; G = 1; c = 0; one_pm = pm; one_pn = pn; }
    __device__ bool next(int i, Unit& u) const {
        if (one_pm >= 0) { if (i > 0) return false; u.pm = one_pm; u.pn = one_pn; return true; }
        const long L = (long)i * G + c; if (L >= nwg) return false;
        int wgid = (int)L; { const int q = nwg / NXCD, r = nwg % NXCD, xcd = wgid % NXCD, off = wgid / NXCD; wgid = (xcd < r ? xcd * (q + 1) : r * (q + 1) + (xcd - r) * q) + off; }
        const int nig = WGM * nN, gid = wgid / nig, fm = gid * WGM, gsz = (nM - fm) < WGM ? (nM - fm) : WGM;
        u.pm = fm + ((wgid % nig) % gsz); u.pn = (wgid % nig) / gsz; return true;
    }
};

template <class Epi>
__device__ __forceinline__ void gemm_phase(int wv, LAS unsigned char* lds, const Gemm g, const StaticOrder& S, const Epi& E, const int skew_ticks = 0) {
    const int tid = opaque_tid(wv), wid = __builtin_amdgcn_readfirstlane(tid >> 6), lane = tid & 63, wr = wid >> 2, wc = wid & 3, fr = lane & 15, fq = lane >> 4;
    const int K = g.K, nt = K / BK;
    unsigned voffA[2], voffB0[2];
#pragma unroll
    for (int i = 0; i < 2; ++i) { int R, C; stage_rc(tid * 16 + i * 8192, R, C); voffA[i] = (unsigned)(R * K + C) * 2u;
        const int rho = R & 31, pr = 8 * ((rho & 15) >> 2) + 4 * (rho >> 4) + (rho & 3), Rb = 64 * (R >> 5) + pr;
        voffB0[i] = (unsigned)(Rb * K + C) * 2u; }
    const size_t b1step = (size_t)32 * K * 2;
    const size_t kstep = (size_t)(BK * 2);
    const size_t hstep = (size_t)HALF * K * 2;
    const size_t tstep = 2 * hstep;
    const unsigned ldsw = (unsigned)wid * 1024u;
    const int aoff = lds_byte(wr * 64 + fr, fq * 8), boff = lds_byte(wc * 32 + fr, fq * 8);
#define PG8_SA(b, h) (((b) * 2 + (h)) * HTB)
#define PG8_SB(b, h) ((4 + (b) * 2 + (h)) * HTB)
#define PG8_STAGE(bufoff, gbase, voff) do { _Pragma("unroll") for (int _i = 0; _i < 2; ++_i) \
        __builtin_amdgcn_global_load_lds((const unsigned*)((const char*)(gbase) + (voff)[_i]), (LAS unsigned*)(lds + (bufoff) + ldsw + _i * 8192), 16, 0, 0); } while (0)
#define PG8_LDA(dst, b, h) do { _Pragma("unroll") for (int m = 0; m < 4; ++m) _Pragma("unroll") for (int k = 0; k < 2; ++k) dst[m][k] = *(const LAS bf16x8*)(lds + PG8_SA(b, h) + aoff + m * 2048 + k * 1024); } while (0)
#define PG8_LDB(dst, b, h) do { _Pragma("unroll") for (int n = 0; n < 2; ++n) _Pragma("unroll") for (int k = 0; k < 2; ++k) dst[n][k] = *(const LAS bf16x8*)(lds + PG8_SB(b, h) + boff + n * 2048 + k * 1024); } while (0)
#define PG8_MMA(ai, bj, At, Bt) do { __builtin_amdgcn_s_setprio(1); _Pragma("unroll") for (int m = 0; m < 4; ++m) _Pragma("unroll") for (int n = 0; n < 2; ++n) _Pragma("unroll") for (int k = 0; k < 2; ++k) \
        acc[ai][bj][m][n] = __builtin_amdgcn_mfma_f32_16x16x32_bf16(Bt[n][k], At[m][k], acc[ai][bj][m][n], 0, 0, 0); __builtin_amdgcn_s_setprio(0); } while (0)
#define PG8_WAIT_V(n) asm volatile("s_waitcnt vmcnt(" #n ")" ::: "memory")
#define PG8_WAIT_L(n) asm volatile("s_waitcnt lgkmcnt(" #n ")" ::: "memory")
#define PG8_BAR __builtin_amdgcn_s_barrier()
#define PG8_SCHED __builtin_amdgcn_sched_barrier(0)
    Unit cur, nxt; int ui = 0;
    if (!S.next(0, cur)) return;
    if (skew_ticks > 0) {
        const unsigned long long t0 = __builtin_amdgcn_s_memrealtime();
        while ((long long)(__builtin_amdgcn_s_memrealtime() - t0) < (long long)skew_ticks) __builtin_amdgcn_s_sleep(32);
    }
    f32x4 acc[2][2][4][2];
#pragma unroll
    for (int a = 0; a < 2; ++a)
#pragma unroll
        for (int b = 0; b < 2; ++b)
#pragma unroll
            for (int m = 0; m < 4; ++m)
#pragma unroll
                for (int n = 0; n < 2; ++n) acc[a][b][m][n] = (f32x4){0.f, 0.f, 0.f, 0.f};
    bf16x8 At[4][2], B0[2][2], B1[2][2];
    const char* cA = (const char*)g.A + (size_t)cur.pm * tstep; const char* cB = (const char*)g.Bt + (size_t)cur.pn * tstep;
    PG8_STAGE(PG8_SB(0, 0), cB, voffB0); PG8_STAGE(PG8_SA(0, 0), cA, voffA); PG8_STAGE(PG8_SB(0, 1), cB + b1step, voffB0); PG8_STAGE(PG8_SA(0, 1), cA + hstep, voffA);
    if (wr == 1) PG8_BAR;
    PG8_WAIT_V(4); PG8_BAR;
    PG8_STAGE(PG8_SB(1, 0), cB + kstep, voffB0); PG8_STAGE(PG8_SA(1, 0), cA + kstep, voffA); PG8_STAGE(PG8_SB(1, 1), cB + kstep + b1step, voffB0);
    PG8_WAIT_V(6); PG8_BAR;
    for (;;) {
        const bool has_next = S.next(ui + 1, nxt);
        const char* nA = has_next ? (const char*)g.A + (size_t)nxt.pm * tstep : cA; const char* nB = has_next ? (const char*)g.Bt + (size_t)nxt.pn * tstep : cB;
        for (int t = 0; t < nt; t += 2) {
            const bool last = (t == nt - 2);
            const char* a1 = cA + (size_t)(t + 1) * kstep;
            const char* a2 = last ? nA : cA + (size_t)(t + 2) * kstep; const char* b2 = last ? nB : cB + (size_t)(t + 2) * kstep;
            const char* a3 = a2 + kstep; const char* b3 = b2 + kstep;
            PG8_LDB(B0, 0, 0); PG8_SCHED; PG8_LDA(At, 0, 0); PG8_STAGE(PG8_SA(1, 1), a1 + hstep, voffA);
            PG8_WAIT_L(8); PG8_BAR; PG8_WAIT_L(0); PG8_MMA(0, 0, At, B0); PG8_BAR; PG8_SCHED;
            PG8_LDB(B1, 0, 1); PG8_STAGE(PG8_SB(0, 0), b2, voffB0);
            PG8_BAR; PG8_WAIT_L(0); PG8_MMA(0, 1, At, B1); PG8_BAR;
            PG8_LDA(At, 0, 1); PG8_STAGE(PG8_SA(0, 0), a2, voffA);
            PG8_BAR; PG8_WAIT_L(0); PG8_MMA(1, 0, At, B0); PG8_BAR; PG8_SCHED;
            PG8_STAGE(PG8_SB(0, 1), b2 + b1step, voffB0);
            PG8_WAIT_V(6); PG8_BAR; PG8_MMA(1, 1, At, B1); PG8_BAR;
            PG8_LDB(B0, 1, 0); PG8_SCHED; PG8_LDA(At, 1, 0); PG8_STAGE(PG8_SA(0, 1), a2 + hstep, voffA);
            PG8_WAIT_L(8); PG8_BAR; PG8_WAIT_L(0); PG8_MMA(0, 0, At, B0); PG8_BAR; PG8_SCHED;
            PG8_LDB(B1, 1, 1); PG8_STAGE(PG8_SB(1, 0), b3, voffB0);
            PG8_BAR; PG8_WAIT_L(0); PG8_MMA(0, 1, At, B1); PG8_BAR;
            PG8_LDA(At, 1, 1); PG8_STAGE(PG8_SA(1, 0), a3, voffA);
            PG8_BAR; PG8_WAIT_L(0); PG8_MMA(1, 0, At, B0); PG8_BAR; PG8_SCHED;
            PG8_STAGE(PG8_SB(1, 1), b3 + b1step, voffB0);
            PG8_WAIT_V(6); PG8_BAR; PG8_MMA(1, 1, At, B1); PG8_BAR;
        }
        { int fr2 = fr, fq2 = fq; asm volatile("" : "+v"(fr2), "+v"(fq2)); E(acc, cur, wr, wc, fr2, fq2); }
        if (!has_next) break;
#pragma unroll
        for (int a = 0; a < 2; ++a)
#pragma unroll
            for (int b = 0; b < 2; ++b)
#pragma unroll
                for (int m = 0; m < 4; ++m)
#pragma unroll
                    for (int n = 0; n < 2; ++n) acc[a][b][m][n] = (f32x4){0.f, 0.f, 0.f, 0.f};
        cur = nxt; cA = nA; cB = nB; ++ui;
    }
    PG8_WAIT_V(0);
    if (wr == 0) PG8_BAR;
    PG8_BAR;
#undef PG8_SA
#undef PG8_SB
#undef PG8_STAGE
#undef PG8_LDA
#undef PG8_LDB
#undef PG8_MMA
#undef PG8_WAIT_V
#undef PG8_WAIT_L
#undef PG8_BAR
#undef PG8_SCHED
}
}


__device__ __forceinline__ float row_rstd(const float* ssq, int row, int fq) {
    const f32x4* q = (const f32x4*)(ssq + (size_t)row * 32 + fq * 8);
    const f32x4 a = q[0], b = q[1];
    float s = (a.x + a.y) + (a.z + a.w) + (b.x + b.y) + (b.z + b.w);
    s += __shfl_xor(s, 16); s += __shfl_xor(s, 32);
    return rsqrtf(s * (1.f / 2048.f) + EPS);
}
__device__ __forceinline__ u32x4 pack8(const f32x4 a, const f32x4 b) { u32x4 w; w.x = cvt_pk_bf16(a.x, a.y); w.y = cvt_pk_bf16(a.z, a.w); w.z = cvt_pk_bf16(b.x, b.y); w.w = cvt_pk_bf16(b.z, b.w); return w; }

constexpr int RTAB_OFF = 131072 + 8 * 2304;
__device__ __forceinline__ int rstd_table(int wv, const float* ssq, const pg8::StaticOrder& S, LAS float* tab) {
    pg8::Unit u; int pm0 = -1, pm1 = -1; bool ok = true;
    for (int i = 0; S.next(i, u); ++i) { if (pm0 < 0) pm0 = u.pm; else if (u.pm != pm0) { if (pm1 < 0) pm1 = u.pm; else if (u.pm != pm1) ok = false; } }
    if (!ok || pm0 < 0) return -1;
    const int tid = opaque_tid(wv), slot = tid >> 8, t = tid & 255, pm = slot ? pm1 : pm0;
    if (pm >= 0) { const f32x4* q = (const f32x4*)(ssq + (size_t)(pm * 256 + t) * 32); float sm = 0.f;
#pragma unroll
        for (int i = 0; i < 8; ++i) { const f32x4 v = q[i]; sm += (v.x + v.y) + (v.z + v.w); }
        tab[slot * 256 + t] = rsqrtf(sm * (1.f / 2048.f) + EPS); }
    __syncthreads();
    return pm0;
}

constexpr int TRS = 144, TIO_OFF = 131072, TIO_WAVE = 2304;
__device__ __forceinline__ void tio_store(LAS unsigned char* T, u16* g0, int lane, int fr, int fq, const u32x4 w0, const u32x4 w1) {
    *(LAS u32x4*)(T + fr * TRS + fq * 16) = w0; *(LAS u32x4*)(T + fr * TRS + 64 + fq * 16) = w1;
    const int rr = lane >> 3, ch = lane & 7;
    const u32x4 a = *(const LAS u32x4*)(T + rr * TRS + ch * 16), b = *(const LAS u32x4*)(T + (8 + rr) * TRS + ch * 16);
    *(u32x4*)(g0 + (size_t)rr * 2048 + ch * 8) = a; *(u32x4*)(g0 + (size_t)(8 + rr) * 2048 + ch * 8) = b;
}
__device__ __forceinline__ void tio_load(const u16* g0, int lane, u32x4& a, u32x4& b) { const int rr = lane >> 3, ch = lane & 7; a = *(const u32x4*)(g0 + (size_t)rr * 2048 + ch * 8); b = *(const u32x4*)(g0 + (size_t)(8 + rr) * 2048 + ch * 8); }
__device__ __forceinline__ void tio_unpack(LAS unsigned char* T, int lane, int fr, int fq, const u32x4 a, const u32x4 b, u32x4& w0, u32x4& w1) {
    const int rr = lane >> 3, ch = lane & 7;
    *(LAS u32x4*)(T + rr * TRS + ch * 16) = a; *(LAS u32x4*)(T + (8 + rr) * TRS + ch * 16) = b;
    w0 = *(const LAS u32x4*)(T + fr * TRS + fq * 16); w1 = *(const LAS u32x4*)(T + fr * TRS + 64 + fq * 16);
}

__device__ __forceinline__ void tio_store_f32(LAS unsigned char* T, float* g0, size_t gpitch, int lane, int fr, int fq, const f32x4 v0, const f32x4 v1) {
    *(LAS f32x4*)(T + fr * TRS + fq * 32) = v0; *(LAS f32x4*)(T + fr * TRS + fq * 32 + 16) = v1;
    const int rr = lane >> 3, ch = lane & 7;
    const f32x4 a = *(const LAS f32x4*)(T + rr * TRS + ch * 16), b = *(const LAS f32x4*)(T + (8 + rr) * TRS + ch * 16);
    __builtin_nontemporal_store(a, (f32x4*)(g0 + (size_t)rr * gpitch + ch * 4)); __builtin_nontemporal_store(b, (f32x4*)(g0 + (size_t)(8 + rr) * gpitch + ch * 4));
}
__device__ __forceinline__ void tio_store_p(LAS unsigned char* T, u16* g0, size_t gpitch, int lane, int fr, int fq, const u32x4 w0, const u32x4 w1) {
    *(LAS u32x4*)(T + fr * TRS + fq * 16) = w0; *(LAS u32x4*)(T + fr * TRS + 64 + fq * 16) = w1;
    const int rr = lane >> 3, ch = lane & 7;
    const u32x4 a = *(const LAS u32x4*)(T + rr * TRS + ch * 16), b = *(const LAS u32x4*)(T + (8 + rr) * TRS + ch * 16);
    *(u32x4*)(g0 + (size_t)rr * gpitch + ch * 8) = a; *(u32x4*)(g0 + (size_t)(8 + rr) * gpitch + ch * 8) = b;
}

struct EpiProj {
    const P& p; int layer; LAS unsigned char* lds; const LAS float* rtab; int pm0;
    __device__ __forceinline__ void operator()(const f32x4 (&acc)[2][2][4][2], const pg8::Unit& u, int wr, int wc, int fr, int fq) const {
        const int lane = fq * 16 + fr; LAS unsigned char* T = lds + TIO_OFF + (wr * 4 + wc) * TIO_WAVE; const int cww = (u.pn & 1) * 256 + wc * 64;
        const int group = u.pn >> 1, type = group & 3, br = group >> 2;
        const int cgb = (u.pn & 1) * 256 + wc * 64 + 8 * fq;
        const float* ssqA = (const float*)(p.ws + W_SSQA);
        u16* Qb = (u16*)(p.ws + W_QB); u16* Zb = (u16*)(p.ws + W_ZB);
        float kmx = 0.f;
        float rsv[8];
#pragma unroll
        for (int i = 0; i < 8; ++i) rsv[i] = rtab ? rtab[(u.pm == pm0 ? 0 : 256) + (i >> 2) * 128 + wr * 64 + (i & 3) * 16 + fr] : row_rstd(ssqA, u.pm * 256 + (i >> 2) * 128 + wr * 64 + (i & 3) * 16 + fr, fq);
#pragma unroll
        for (int ai = 0; ai < 2; ++ai)
#pragma unroll
            for (int m = 0; m < 4; ++m) {
                const int row = u.pm * 256 + ai * 128 + wr * 64 + m * 16 + fr;
                const float rs = rsv[ai * 4 + m];
                if (type == 0) {
                    const float sc = rs * QSCALE;
                    tio_store_p(T, Qb + (size_t)(row - fr) * 1024 + br * 512 + cww, 1024, lane, fr, fq, pack8(acc[ai][0][m][0] * sc, acc[ai][0][m][1] * sc), pack8(acc[ai][1][m][0] * sc, acc[ai][1][m][1] * sc));
                } else if (type == 3) {
                    u32x4 zw[2];
#pragma unroll
                    for (int bj = 0; bj < 2; ++bj) { f32x4 v0 = acc[ai][bj][m][0] * rs, v1 = acc[ai][bj][m][1] * rs;
#pragma unroll
                        for (int j = 0; j < 4; ++j) { v0[j] = v0[j] * __builtin_amdgcn_rcpf(1.f + __expf(-v0[j])); v1[j] = v1[j] * __builtin_amdgcn_rcpf(1.f + __expf(-v1[j])); }
                        zw[bj] = pack8(v0, v1); }
                    tio_store_p(T, Zb + (size_t)(row - fr) * 1024 + br * 512 + cww, 1024, lane, fr, fq, zw[0], zw[1]);
                } else {
                    float* o32; u16* kb; u16* vt; size_t vld; float kss = 0.f;
                    if (row < NP) { const int b = row >> 14, t = row & (SEQ - 1);
                        o32 = p.out + O_KV_P + (size_t)(br * 2 + (type - 1)) * KVP + ((size_t)(layer * 2 + b) * SEQ + t) * 512;
                        kb = (u16*)(p.ws + W_KBP) + (size_t)row * 1024 + br * 512;
                        vt = (u16*)(p.ws + W_VTP) + (size_t)(b * 8 + br * 4) * 128 * SEQ + t; vld = SEQ;
                    } else { const int rr = row - NP, sb = rr >> 5, t = rr & 31;
                        o32 = p.out + O_KV_S + (size_t)(br * 2 + (type - 1)) * KVS + ((size_t)(layer * 8 + sb) * 32 + t) * 512;
                        kb = (u16*)(p.ws + W_KBS) + ((size_t)(layer * 8 + sb) * SL + PAST + t) * 1024 + br * 512;
                        vt = (u16*)(p.ws + W_VTS) + (size_t)((layer * 8 + sb) * 8 + br * 4) * 128 * SL + PAST + t; vld = SL;
                    }
                    u32x4 kw[2];
#pragma unroll
                    for (int bj = 0; bj < 2; ++bj) { const f32x4 v0 = acc[ai][bj][m][0] * rs, v1 = acc[ai][bj][m][1] * rs; const int cg = cgb + bj * 32;
                        kss += (v0.x * v0.x + v0.y * v0.y + v0.z * v0.z + v0.w * v0.w) + (v1.x * v1.x + v1.y * v1.y + v1.z * v1.z + v1.w * v1.w);
                        tio_store_f32(T, o32 - (size_t)fr * 512 + cww + bj * 32, 512, lane, fr, fq, v0, v1);
                        const u32x4 w = pack8(v0, v1); kw[bj] = w;
                        if (type == 1) { if (bj == 1) tio_store_p(T, kb - (size_t)fr * 1024 + cww, 1024, lane, fr, fq, kw[0], kw[1]); }
                        else { vt[(size_t)(cg + 0) * vld] = (u16)(w.x & 0xffffu); vt[(size_t)(cg + 1) * vld] = (u16)(w.x >> 16); vt[(size_t)(cg + 2) * vld] = (u16)(w.y & 0xffffu); vt[(size_t)(cg + 3) * vld] = (u16)(w.y >> 16);
                               vt[(size_t)(cg + 4) * vld] = (u16)(w.z & 0xffffu); vt[(size_t)(cg + 5) * vld] = (u16)(w.z >> 16); vt[(size_t)(cg + 6) * vld] = (u16)(w.w & 0xffffu); vt[(size_t)(cg + 7) * vld] = (u16)(w.w >> 16); } }
                    if (type == 1 && br == 1) { kss += __shfl_xor(kss, 16); kss += __shfl_xor(kss, 32); kmx = fmaxf(kmx, kss); }
                }
            }
        if (type == 1 && br == 1 && u.pm < NP / 256) {
            float t = kmx; t = fmaxf(t, __shfl_xor(t, 1)); t = fmaxf(t, __shfl_xor(t, 2)); t = fmaxf(t, __shfl_xor(t, 4)); t = fmaxf(t, __shfl_xor(t, 8));
            if (fr == 0 && fq == 0) atomicMax((unsigned*)(p.ws + W_CTR) + 64 + ((layer * 2 + (u.pm >> 6)) * 4 + (u.pn & 1) * 2 + (wc >> 1)) * 4 + (wc & 1), __float_as_uint(t));
        }
    }
};

struct EpiOut {
    const P& p; LAS unsigned char* lds;
    __device__ __forceinline__ void operator()(const f32x4 (&acc)[2][2][4][2], const pg8::Unit& u, int wr, int wc, int fr, int fq) const {
        float* ssqB = (float*)(p.ws + W_SSQB); u16* XbB = (u16*)(p.ws + W_XBB); const u16* XbA = (const u16*)(p.ws + W_XBA);
        const int lane = fq * 16 + fr, cw = u.pn * 256 + wc * 64; LAS unsigned char* T = lds + TIO_OFF + (wr * 4 + wc) * TIO_WAVE;
#pragma unroll
        for (int ai = 0; ai < 2; ++ai) {
            u32x4 xa[4], xb_[4];
#pragma unroll
            for (int m = 0; m < 4; ++m) tio_load(XbA + (size_t)(u.pm * 256 + ai * 128 + wr * 64 + m * 16) * 2048 + cw, lane, xa[m], xb_[m]);
#pragma unroll
            for (int m = 0; m < 4; ++m) {
                const int row0 = u.pm * 256 + ai * 128 + wr * 64 + m * 16; float ss = 0.f; u32x4 x0, x1;
                tio_unpack(T, lane, fr, fq, xa[m], xb_[m], x0, x1);
                f32x4 v00 = acc[ai][0][m][0], v01 = acc[ai][0][m][1], v10 = acc[ai][1][m][0], v11 = acc[ai][1][m][1];
                v00.x += bf_lo(x0.x); v00.y += bf_hi(x0.x); v00.z += bf_lo(x0.y); v00.w += bf_hi(x0.y); v01.x += bf_lo(x0.z); v01.y += bf_hi(x0.z); v01.z += bf_lo(x0.w); v01.w += bf_hi(x0.w);
                v10.x += bf_lo(x1.x); v10.y += bf_hi(x1.x); v10.z += bf_lo(x1.y); v10.w += bf_hi(x1.y); v11.x += bf_lo(x1.z); v11.y += bf_hi(x1.z); v11.z += bf_lo(x1.w); v11.w += bf_hi(x1.w);
                ss += (v00.x * v00.x + v00.y * v00.y + v00.z * v00.z + v00.w * v00.w) + (v01.x * v01.x + v01.y * v01.y + v01.z * v01.z + v01.w * v01.w);
                ss += (v10.x * v10.x + v10.y * v10.y + v10.z * v10.z + v10.w * v10.w) + (v11.x * v11.x + v11.y * v11.y + v11.z * v11.z + v11.w * v11.w);
                tio_store(T, XbB + (size_t)row0 * 2048 + cw, lane, fr, fq, pack8(v00, v01), pack8(v10, v11));
                ss += __shfl_xor(ss, 16); ss += __shfl_xor(ss, 32);
                if (fq == 0) ssqB[(size_t)(row0 + fr) * 32 + u.pn * 4 + wc] = ss;
            }
        }
    }
};

struct EpiPle {
    const P& p; LAS unsigned char* lds;
    __device__ __forceinline__ void operator()(const f32x4 (&acc)[2][2][4][2], const pg8::Unit& u, int wr, int wc, int fr, int fq) const {
        u16* O = u.pm == NP / 256 ? (u16*)(p.ws + W_PLES) - (size_t)NP * 2048 : (u16*)(p.ws + W_PLEB);
        const int lane = fq * 16 + fr, cw = u.pn * 256 + wc * 64; LAS unsigned char* T = lds + TIO_OFF + (wr * 4 + wc) * TIO_WAVE;
#pragma unroll
        for (int ai = 0; ai < 2; ++ai)
#pragma unroll
            for (int m = 0; m < 4; ++m)
                tio_store(T, O + (size_t)(u.pm * 256 + ai * 128 + wr * 64 + m * 16) * 2048 + cw, lane, fr, fq, pack8(acc[ai][0][m][0], acc[ai][0][m][1]), pack8(acc[ai][1][m][0], acc[ai][1][m][1]));
    }
};

struct EpiGate {
    const P& p; LAS unsigned char* lds; const LAS float* rtab; int pm0;
    __device__ __forceinline__ void operator()(const f32x4 (&acc)[2][2][4][2], const pg8::Unit& u, int wr, int wc, int fr, int fq) const {
        const float* ssqB = (const float*)(p.ws + W_SSQB); float* ssqA = (float*)(p.ws + W_SSQA); u16* XbA = (u16*)(p.ws + W_XBA); const u16* XbB = (const u16*)(p.ws + W_XBB); const u16* PL = u.pm == NP / 256 ? (const u16*)(p.ws + W_PLES) - (size_t)NP * 2048 : (const u16*)(p.ws + W_PLEB);
        const int lane = fq * 16 + fr, cw = u.pn * 256 + wc * 64; LAS unsigned char* T = lds + TIO_OFF + (wr * 4 + wc) * TIO_WAVE;
        float rsv[8];
#pragma unroll
        for (int i = 0; i < 8; ++i) rsv[i] = rtab ? rtab[(u.pm == pm0 ? 0 : 256) + (i >> 2) * 128 + wr * 64 + (i & 3) * 16 + fr] : row_rstd(ssqB, u.pm * 256 + (i >> 2) * 128 + wr * 64 + (i & 3) * 16 + fr, fq);
#pragma unroll
        for (int g4 = 0; g4 < 4; ++g4) { const int ai = g4 >> 1, m0 = (g4 & 1) * 2;
            u32x4 xa[2], xb_[2], pa[2], pb[2];
#pragma unroll
            for (int mm = 0; mm < 2; ++mm) { const size_t ro = (size_t)(u.pm * 256 + ai * 128 + wr * 64 + (m0 + mm) * 16) * 2048 + cw;
                tio_load(XbB + ro, lane, xa[mm], xb_[mm]); tio_load(PL + ro, lane, pa[mm], pb[mm]); }
#pragma unroll
            for (int mm = 0; mm < 2; ++mm) { const int m = m0 + mm;
                const int row0 = u.pm * 256 + ai * 128 + wr * 64 + m * 16;
                const float rs = rsv[ai * 4 + m]; float ss = 0.f;
                u32x4 x0, x1, p0, p1;
                tio_unpack(T, lane, fr, fq, xa[mm], xb_[mm], x0, x1);
                tio_unpack(T, lane, fr, fq, pa[mm], pb[mm], p0, p1);
                f32x4 v[2][2];
#pragma unroll
                for (int bj = 0; bj < 2; ++bj) { const f32x4 a0 = acc[ai][bj][m][0] * rs, a1 = acc[ai][bj][m][1] * rs; const u32x4 pq = bj ? p1 : p0, xq = bj ? x1 : x0;
                    f32x4 v0, v1;
                    v0.x = bf_lo(xq.x) + bf_lo(pq.x) * __builtin_amdgcn_rcpf(1.f + __expf(-a0.x)); v0.y = bf_hi(xq.x) + bf_hi(pq.x) * __builtin_amdgcn_rcpf(1.f + __expf(-a0.y));
                    v0.z = bf_lo(xq.y) + bf_lo(pq.y) * __builtin_amdgcn_rcpf(1.f + __expf(-a0.z)); v0.w = bf_hi(xq.y) + bf_hi(pq.y) * __builtin_amdgcn_rcpf(1.f + __expf(-a0.w));
                    v1.x = bf_lo(xq.z) + bf_lo(pq.z) * __builtin_amdgcn_rcpf(1.f + __expf(-a1.x)); v1.y = bf_hi(xq.z) + bf_hi(pq.z) * __builtin_amdgcn_rcpf(1.f + __expf(-a1.y));
                    v1.z = bf_lo(xq.w) + bf_lo(pq.w) * __builtin_amdgcn_rcpf(1.f + __expf(-a1.z)); v1.w = bf_hi(xq.w) + bf_hi(pq.w) * __builtin_amdgcn_rcpf(1.f + __expf(-a1.w));
                    ss += (v0.x * v0.x + v0.y * v0.y + v0.z * v0.z + v0.w * v0.w) + (v1.x * v1.x + v1.y * v1.y + v1.z * v1.z + v1.w * v1.w);
                    v[bj][0] = v0; v[bj][1] = v1; }
                tio_store(T, XbA + (size_t)row0 * 2048 + cw, lane, fr, fq, pack8(v[0][0], v[0][1]), pack8(v[1][0], v[1][1]));
                ss += __shfl_xor(ss, 16); ss += __shfl_xor(ss, 32);
                if (fq == 0) ssqA[(size_t)(row0 + fr) * 32 + u.pn * 4 + wc] = ss;
            }
        }
    }
};

struct TDesc { const float* src; size_t sld; u16* dst; size_t dld; const float* gk; };
constexpr int NT_WIN = DEPTH * 2048, NT_WOUT = DEPTH * 512, NT_WPLE = DEPTH * 128, NT_WGATE = DEPTH * 1024, NT_VC = DEPTH * DEC_BATCH * 8 * 32;
constexpr int NT_ALL = NT_WIN + NT_WOUT + NT_WPLE + NT_WGATE + NT_VC;
__device__ __forceinline__ TDesc tile_desc(const P& p, int t) {
    TDesc d;
    if (t < NT_WIN) { const int L = t >> 11, r = t & 2047, kt = r >> 6, nt = r & 63;
        d.src = p.w_in + (size_t)L * 2048 * D_IN + (size_t)kt * 64 * D_IN + nt * 64; d.sld = D_IN; d.dst = (u16*)(p.ws + W_WTIN) + (size_t)L * 4096 * 2048 + (size_t)nt * 64 * 2048 + kt * 64; d.dld = 2048; d.gk = p.g_attn + L * 2048 + kt * 64; return d; }
    t -= NT_WIN;
    if (t < NT_WOUT) { const int L = t >> 9, r = t & 511, kt = r >> 5, nt = r & 31;
        d.src = p.w_out + (size_t)L * 1024 * 2048 + (size_t)kt * 64 * 2048 + nt * 64; d.sld = 2048; d.dst = (u16*)(p.ws + W_WTOUT) + (size_t)L * 2048 * 1024 + (size_t)nt * 64 * 1024 + kt * 64; d.dld = 1024; d.gk = nullptr; return d; }
    t -= NT_WOUT;
    if (t < NT_WPLE) { const int L = t >> 7, r = t & 127, kt = r >> 5, nt = r & 31;
        d.src = p.w_ple + (size_t)L * 256 * 2048 + (size_t)kt * 64 * 2048 + nt * 64; d.sld = 2048; d.dst = (u16*)(p.ws + W_WTPLE) + (size_t)L * 2048 * 256 + (size_t)nt * 64 * 256 + kt * 64; d.dld = 256; d.gk = nullptr; return d; }
    t -= NT_WPLE;
    if (t < NT_WGATE) { const int L = t >> 10, r = t & 1023, kt = r >> 5, nt = r & 31;
        d.src = p.w_gate + (size_t)L * 2048 * 2048 + (size_t)kt * 64 * 2048 + nt * 64; d.sld = 2048; d.dst = (u16*)(p.ws + W_WTGATE) + (size_t)L * 2048 * 2048 + (size_t)nt * 64 * 2048 + kt * 64; d.dld = 2048; d.gk = p.g_ple + L * 2048 + kt * 64; return d; }
    t -= NT_WGATE;
    { const int mi = t >> 5, r = t & 31, kt = r >> 1, nt = r & 1; const int ls = mi >> 3, h8 = mi & 7, br = h8 >> 2, hh = h8 & 3;
        d.src = (br ? p.c_fxv : p.c_sbv) + ((size_t)ls * PAST + kt * 64) * 512 + hh * 128 + nt * 64; d.sld = 512; d.dst = (u16*)(p.ws + W_VTS) + ((size_t)mi * 128 + nt * 64) * SL + kt * 64; d.dld = SL; d.gk = nullptr; return d; }
}

__device__ __forceinline__ void prep_phase(int wv, const P& p, LAS unsigned char* lds) {
    LAS float* T = (LAS float*)lds;
    const int tid = opaque_tid(wv), G = gridDim.x, B = blockIdx.x;
    const int wid = tid >> 6, lane = tid & 63;
    if (B == 0) { ((unsigned*)(p.ws + W_CTR))[tid] = 0u; ((unsigned*)(p.ws + W_CTR))[tid + 512] = 0u; }
    {
        const int k0 = tid >> 4, n4 = (tid & 15) * 4, no = tid >> 3, kc = tid & 7;
        f32x4 v[2][2]; float g[2][2]; TDesc d[2]; bool ok[2];
#define PREP_FETCH(t_) do { _Pragma("unroll") for (int q = 0; q < 2; ++q) { const int tt = (t_) + q * G; ok[q] = tt < NT_ALL; g[q][0] = 1.f; g[q][1] = 1.f; \
            if (ok[q]) { d[q] = tile_desc(p, tt); v[q][0] = __builtin_nontemporal_load((const f32x4*)(d[q].src + (size_t)k0 * d[q].sld + n4)); v[q][1] = __builtin_nontemporal_load((const f32x4*)(d[q].src + (size_t)(k0 + 32) * d[q].sld + n4)); \
                if (d[q].gk) { g[q][0] = d[q].gk[k0]; g[q][1] = d[q].gk[k0 + 32]; } } } } while (0)
        int t = B;
        PREP_FETCH(t);
        while (t < NT_ALL) {
            TDesc dc[2]; bool okc[2];
#pragma unroll
            for (int q = 0; q < 2; ++q) { okc[q] = ok[q]; dc[q] = d[q]; LAS float* Tq = T + q * (64 * 65);
                if (ok[q]) {
#pragma unroll
                    for (int hh = 0; hh < 2; ++hh) { const f32x4 x = v[q][hh]; const float gg = g[q][hh]; LAS float* tp = Tq + (k0 + 32 * hh) * 65 + n4; tp[0] = x.x * gg; tp[1] = x.y * gg; tp[2] = x.z * gg; tp[3] = x.w * gg; } } }
            __syncthreads();
            const int tn = t + 2 * G;
            PREP_FETCH(tn);
#pragma unroll
            for (int q = 0; q < 2; ++q) if (okc[q]) { const LAS float* Tq = T + q * (64 * 65); float f[8];
#pragma unroll
                for (int j = 0; j < 8; ++j) f[j] = Tq[(kc * 8 + j) * 65 + no];
                u32x4 w; w.x = cvt_pk_bf16(f[0], f[1]); w.y = cvt_pk_bf16(f[2], f[3]); w.z = cvt_pk_bf16(f[4], f[5]); w.w = cvt_pk_bf16(f[6], f[7]);
                *(u32x4*)(dc[q].dst + (size_t)no * dc[q].dld + kc * 8) = w; }
            __syncthreads();
            t = tn;
        }
#undef PREP_FETCH
    }
    for (int i = B * 512 + tid; i < DEPTH * 2048 * 4; i += G * 512) { const int L = i >> 13, k = (i >> 2) & 2047, j = i & 3;
        ((float*)(p.ws + W_WF))[i] = p.g_attn[L * 2048 + k] * p.w_in[(size_t)L * 2048 * D_IN + (size_t)k * D_IN + 4096 + j]; }
    for (int row = B * 8 + wid; row < NR; row += G * 8) {
        const float* src = row < NP ? p.x_prompt + (size_t)row * 2048 : p.x_sample + (size_t)(row - NP) * 2048;
        u16* xb = (u16*)(p.ws + W_XBA) + (size_t)row * 2048; float ss = 0.f;
#pragma unroll
        for (int i = 0; i < 8; ++i) { const int c = (i * 64 + lane) * 4; const f32x4 v = __builtin_nontemporal_load((const f32x4*)(src + c)); ss += v.x * v.x + v.y * v.y + v.z * v.z + v.w * v.w;
            u32x2 w; w.x = cvt_pk_bf16(v.x, v.y); w.y = cvt_pk_bf16(v.z, v.w); *(u32x2*)(xb + c) = w; }
#pragma unroll
        for (int d = 1; d < 64; d <<= 1) ss += __shfl_xor(ss, d);
        if (lane < 32) ((float*)(p.ws + W_SSQA))[(size_t)row * 32 + lane] = lane == 0 ? ss : 0.f;
    }
    for (size_t i0 = (size_t)B * 512 + tid; i0 < (size_t)DEPTH * NR * 64; i0 += (size_t)G * 512 * 4) { f32x4 v[4]; u16* dp[4];
#pragma unroll
        for (int q = 0; q < 4; ++q) { const size_t i = i0 + (size_t)q * G * 512; dp[q] = nullptr;
            if (i < (size_t)DEPTH * NR * 64) { const int L = (int)(i / ((size_t)NR * 64)); const size_t r = i % ((size_t)NR * 64); const int row = (int)(r >> 6), c4 = (int)(r & 63) * 4;
                const float* src = row < NP ? p.p_prompt + ((size_t)L * NP + row) * 256 + c4 : p.p_sample + ((size_t)L * NS + (row - NP)) * 256 + c4;
                v[q] = __builtin_nontemporal_load((const f32x4*)src); dp[q] = (u16*)(p.ws + W_PB) + ((size_t)L * NR + row) * 256 + c4; } }
#pragma unroll
        for (int q = 0; q < 4; ++q) if (dp[q]) { u32x2 w; w.x = cvt_pk_bf16(v[q].x, v[q].y); w.y = cvt_pk_bf16(v[q].z, v[q].w); *(u32x2*)dp[q] = w; } }
    for (size_t i0 = (size_t)B * 512 + tid; i0 < (size_t)2 * DEPTH * DEC_BATCH * PAST * 128; i0 += (size_t)G * 512 * 4) { f32x4 v[4]; u16* dp[4];
#pragma unroll
        for (int q = 0; q < 4; ++q) { const size_t i = i0 + (size_t)q * G * 512; dp[q] = nullptr;
            if (i < (size_t)2 * DEPTH * DEC_BATCH * PAST * 128) { const int br = (int)(i / ((size_t)DEPTH * DEC_BATCH * PAST * 128)); const size_t r = i % ((size_t)DEPTH * DEC_BATCH * PAST * 128);
                const int ls = (int)(r / (PAST * 128)), pos = (int)((r / 128) % PAST), c4 = (int)(r & 127) * 4;
                v[q] = __builtin_nontemporal_load((const f32x4*)((br ? p.c_fxk : p.c_sbk) + ((size_t)ls * PAST + pos) * 512 + c4)); dp[q] = (u16*)(p.ws + W_KBS) + ((size_t)ls * SL + pos) * 1024 + br * 512 + c4; } }
#pragma unroll
        for (int q = 0; q < 4; ++q) if (dp[q]) { u32x2 w; w.x = cvt_pk_bf16(v[q].x, v[q].y); w.y = cvt_pk_bf16(v[q].z, v[q].w); *(u32x2*)dp[q] = w; } }
    for (int s = B * 8 + wid; s < DEPTH * DEC_BATCH * 4; s += G * 8) { const int ls = s >> 2, hh = s & 3; const float* src = p.c_logf + (size_t)ls * PAST * 4 + hh; float v[16]; float run = 0.f;
#pragma unroll
        for (int i = 0; i < 16; ++i) { run += src[(size_t)(lane * 16 + i) * 4]; v[i] = run; }
        float x = run;
#pragma unroll
        for (int d = 1; d < 64; d <<= 1) { const float y = __shfl_up(x, d); if (lane >= d) x += y; }
        const float pre = x - run; float* dst = (float*)(p.ws + W_CCUM) + (size_t)ls * PAST * 4 + hh;
#pragma unroll
        for (int i = 0; i < 16; ++i) dst[(size_t)(lane * 16 + i) * 4] = pre + v[i];
    }
}

__device__ __forceinline__ void logf_items(int wv, const P& p, int layer, LAS unsigned char* lds, int blk0, int blk_end, int blk_step) {
    LAS f32x4* WfL = (LAS f32x4*)lds;
    LAS float* lf = (LAS float*)(lds + 40960);
    const int tid = opaque_tid(wv);
    const f32x4* Wf = (const f32x4*)(p.ws + W_WF) + (size_t)layer * 2048;
    const float* ssqA = (const float*)(p.ws + W_SSQA);
    for (int blk = blk0; blk < blk_end; blk += blk_step) {
        __syncthreads();
#pragma unroll
        for (int i = 0; i < 4; ++i) { const int k = tid + 512 * i; WfL[k + (k >> 9)] = Wf[k]; }
        __syncthreads();
        const int rl = tid >> 2, kq = tid & 3, row = blk * 128 + rl;
        const u16* xr = (const u16*)(p.ws + W_XBA) + (size_t)row * 2048 + kq * 512;
        f32x4 a = (f32x4){0.f, 0.f, 0.f, 0.f};
        for (int i = 0; i < 64; ++i) { const u32x4 xv = *(const u32x4*)(xr + i * 8); const LAS f32x4* w = WfL + kq * 513 + i * 8;
            a += w[0] * bf_lo(xv.x); a += w[1] * bf_hi(xv.x); a += w[2] * bf_lo(xv.y); a += w[3] * bf_hi(xv.y); a += w[4] * bf_lo(xv.z); a += w[5] * bf_hi(xv.z); a += w[6] * bf_lo(xv.w); a += w[7] * bf_hi(xv.w); }
#pragma unroll
        for (int j = 0; j < 4; ++j) { a[j] += __shfl_xor(a[j], 1); a[j] += __shfl_xor(a[j], 2); }
        if (kq == 0) { float s = 0.f; const f32x4* q = (const f32x4*)(ssqA + (size_t)row * 32);
#pragma unroll
            for (int i = 0; i < 8; ++i) { const f32x4 v = q[i]; s += (v.x + v.y) + (v.z + v.w); }
            const float rs = rsqrtf(s * (1.f / 2048.f) + EPS); f32x4 lg;
#pragma unroll
            for (int j = 0; j < 4; ++j) { const float f = a[j] * rs + p.b_f[layer * 4 + j]; lg[j] = fminf(f, 0.f) - log1pf(expf(-fabsf(f))); }
            float* o = row < NP ? p.out + O_LOGF_P + ((size_t)layer * NP + row) * 4 : p.out + O_LOGF_S + ((size_t)layer * NS + (row - NP)) * 4;
            *(f32x4*)o = lg; lf[rl * 4 + 0] = lg.x; lf[rl * 4 + 1] = lg.y; lf[rl * 4 + 2] = lg.z; lf[rl * 4 + 3] = lg.w; }
        __syncthreads();
        if (tid < 16) { const int seg = tid >> 2, hh = tid & 3; float run = 0.f; float* cin = (float*)(p.ws + W_CIN);
            for (int i = 0; i < 32; ++i) { run += lf[(seg * 32 + i) * 4 + hh]; cin[(size_t)(blk * 128 + seg * 32 + i) * 4 + hh] = run; }
            ((float*)(p.ws + W_SEGTOT))[(size_t)(blk * 4 + seg) * 4 + hh] = run; }
    }
    __syncthreads();
}

constexpr int TEAM = 32;
__device__ __forceinline__ void team_barrier(unsigned* ctr) {
    __threadfence();
    __syncthreads();
    if (threadIdx.x == 0) {
        __hip_atomic_fetch_add(ctr, 1u, __ATOMIC_RELEASE, __HIP_MEMORY_SCOPE_AGENT);
        while (__hip_atomic_load(ctr, __ATOMIC_RELAXED, __HIP_MEMORY_SCOPE_AGENT) < (unsigned)TEAM) __builtin_amdgcn_s_sleep(16);
        __builtin_amdgcn_fence(__ATOMIC_ACQUIRE, "agent");
    }
    __syncthreads();
    __threadfence();
}

constexpr int A_KB = 0, A_VB = 34816, A_CK = 71680, A_SEG = 72192, A_MISC = 74240, A_T = 76800;
constexpr int KROW = 272, VROW = 144;

__device__ __forceinline__ void attn_phase(int wv, const P& p, int layer, LAS unsigned char* lds) {
    LAS float* segpre = (LAS float*)(lds + A_SEG);
    LAS int* misc = (LAS int*)(lds + A_MISC);
    LAS float* wtot = (LAS float*)(lds + A_MISC + 128);
    unsigned* ctr = (unsigned*)(p.ws + W_CTR) + layer;
    const float* Cin = (const float*)(p.ws + W_CIN);
    const int bid = blockIdx.x; const bool team = bid < TEAM;
    unsigned* tbar = (unsigned*)(p.ws + W_CTR) + 16 + layer * 8;
    int sd_left = 0, tstate = team ? 0 : 2;
    if (team) {
        pg8::StaticOrder S1;
        if (layer > 0) {
            if (bid < 8) { pg8::Gemm g{(const u16*)(p.ws + W_OB), (const u16*)(p.ws + W_WTOUT) + (size_t)(layer - 1) * 2048 * 1024, NR, 2048, 1024}; S1.init_one(NP / 256, bid); EpiOut E{p, lds}; pg8::gemm_phase(wv, lds, g, S1, E); }
            else if (bid < 16) { pg8::Gemm g{(const u16*)(p.ws + W_PB) + (size_t)(layer - 1) * NR * 256, (const u16*)(p.ws + W_WTPLE) + (size_t)(layer - 1) * 2048 * 256, NR, 2048, 256}; S1.init_one(NP / 256, bid - 8); EpiPle E{p, lds}; pg8::gemm_phase(wv, lds, g, S1, E); }
            team_barrier(tbar + 0);
            if (bid < 8) { pg8::Gemm g{(const u16*)(p.ws + W_XBB), (const u16*)(p.ws + W_WTGATE) + (size_t)(layer - 1) * 2048 * 2048, NR, 2048, 2048}; S1.init_one(NP / 256, bid); EpiGate E{p, lds, nullptr, 0}; pg8::gemm_phase(wv, lds, g, S1, E); }
            team_barrier(tbar + 1);
        }
        if (bid < 16) { pg8::Gemm g{(const u16*)(p.ws + W_XBA), (const u16*)(p.ws + W_WTIN) + (size_t)layer * 4096 * 2048, NR, 4096, 2048}; S1.init_one(NP / 256, bid); EpiProj E{p, layer, lds, nullptr, 0}; pg8::gemm_phase(wv, lds, g, S1, E); }
        else if (bid < 18) logf_items(wv, p, layer, lds, NP / 128 + (bid - 16), NP / 128 + (bid - 16) + 1, 1);
        team_barrier(tbar + 2);
        sd_left = 2;
    }
    {
        const int t8 = opaque_tid(wv);
        __syncthreads();
        if (t8 < 8) { const float* st = (const float*)(p.ws + W_SEGTOT); float est[8];
#pragma unroll
            for (int q = 0; q < 8; ++q) { float e = 0.f; for (int i = 0; i < 16; ++i) e += st[(size_t)((q >> 2) * 512 + 256 + i) * 4 + (q & 3)]; est[q] = e; }
            int rk = 0; float mine = 0.f;
#pragma unroll
            for (int q = 0; q < 8; ++q) if (q == t8) mine = est[q];
#pragma unroll
            for (int q = 0; q < 8; ++q) rk += (est[q] > mine || (est[q] == mine && q < t8)) ? 1 : 0;
            misc[40 + rk] = t8; }
        __syncthreads();
    }
    for (;;) {
        if (tstate == 0 && sd_left == 0) {
            if (layer == DEPTH - 1) {
                pg8::StaticOrder S1;
                team_barrier(tbar + 3);
                if (bid < 8) { pg8::Gemm g{(const u16*)(p.ws + W_OB), (const u16*)(p.ws + W_WTOUT) + (size_t)layer * 2048 * 1024, NR, 2048, 1024}; S1.init_one(NP / 256, bid); EpiOut E{p, lds}; pg8::gemm_phase(wv, lds, g, S1, E); }
                else if (bid < 16) { pg8::Gemm g{(const u16*)(p.ws + W_PB) + (size_t)layer * NR * 256, (const u16*)(p.ws + W_WTPLE) + (size_t)layer * 2048 * 256, NR, 2048, 256}; S1.init_one(NP / 256, bid - 8); EpiPle E{p, lds}; pg8::gemm_phase(wv, lds, g, S1, E); }
                team_barrier(tbar + 4);
                if (bid < 8) { pg8::Gemm g{(const u16*)(p.ws + W_XBB), (const u16*)(p.ws + W_WTGATE) + (size_t)layer * 2048 * 2048, NR, 2048, 2048}; S1.init_one(NP / 256, bid); EpiGate E{p, lds, nullptr, 0}; pg8::gemm_phase(wv, lds, g, S1, E); }
            }
            tstate = 2;
        }
        const int tid = opaque_tid(wv), wid = __builtin_amdgcn_readfirstlane(tid >> 6), lane = tid & 63, r = lane & 31, h = lane >> 5;
        const int prow = 16 * (r >> 4) + 8 * ((r >> 2) & 1) + 4 * ((r >> 3) & 1) + (r & 3);
        __syncthreads();
        if (tid == 0) misc[0] = sd_left > 0 ? 1024 + (2 - sd_left) * TEAM + bid : (int)atomicAdd(ctr, 1u);
        __syncthreads();
        int item = misc[0];
        if (sd_left > 0) --sd_left; else if (item >= 1024) break;
        int head8, qpos0, nw, row0, ldv, sbi = 0, bi = 0; const u16 *Kb, *Vt; const bool prompt = item < 1024;
        if (prompt) { const int fx = item < 512, it2 = item & 511; int qt, rem; if (fx) { qt = 63 - (it2 & 63); rem = misc[40 + (it2 >> 6)]; } else { qt = 63 - (it2 >> 3); rem = it2 & 7; } bi = rem >> 2; head8 = (fx ? 4 : 0) + (rem & 3);     qpos0 = qt * 256; nw = 8; row0 = bi * SEQ + qpos0;
            Kb = (const u16*)(p.ws + W_KBP) + (size_t)bi * SEQ * 1024 + head8 * 128; Vt = (const u16*)(p.ws + W_VTP) + (size_t)(bi * 8 + head8) * 128 * SEQ; ldv = SEQ;
        } else { const int s = item - 1024; sbi = s >> 3; head8 = s & 7; qpos0 = PAST; nw = 1; row0 = NP + sbi * 32;
            Kb = (const u16*)(p.ws + W_KBS) + (size_t)(layer * 8 + sbi) * SL * 1024 + head8 * 128; Vt = (const u16*)(p.ws + W_VTS) + (size_t)((layer * 8 + sbi) * 8 + head8) * 128 * SL; ldv = SL; }
        const bool fox = head8 >= 4; const int hf = head8 & 3;
        u32x4 kreg[2], vreg[2]; float ckreg = 0.f;
        const int krow_ = tid >> 4, kch = tid & 15, vrow_ = tid >> 3, vch = tid & 7;
        const int jt_top = (qpos0 + 32 * nw - 1) >> 6;
#pragma unroll
        for (int pz = 0; pz < 2; ++pz) { kreg[pz] = *(const u32x4*)(Kb + (size_t)(jt_top * 64 + krow_ + 32 * pz) * 1024 + kch * 8); vreg[pz] = *(const u32x4*)(Vt + (size_t)(vrow_ + 64 * pz) * ldv + jt_top * 64 + vch * 8); }
        const float* ccum = (const float*)(p.ws + W_CCUM) + (size_t)(layer * 8 + sbi) * PAST * 4 + hf;
        if (fox && prompt) {
            const int nseg = (qpos0 + 256) >> 5; const float v = tid < nseg ? ((const float*)(p.ws + W_SEGTOT))[(size_t)(bi * 512 + tid) * 4 + hf] : 0.f; float x = v;
#pragma unroll
            for (int d = 1; d < 64; d <<= 1) { const float y = __shfl_up(x, d); if (lane >= d) x += y; }
            if (lane == 63) wtot[wid] = x;
            __syncthreads();
            float pre = 0.f; for (int w = 0; w < wid; ++w) pre += wtot[w];
            segpre[tid] = pre + x - v;
            __syncthreads();
        }
        auto getC = [&](int pos) -> float {
            if (prompt) return segpre[pos >> 5] + Cin[(size_t)(bi * SEQ + pos) * 4 + hf];
            if (pos < PAST) return ccum[(size_t)pos * 4];
            if (pos < PAST + 32) return ccum[(size_t)(PAST - 1) * 4] + Cin[(size_t)(NP + sbi * 32 + pos - PAST) * 4 + hf];
            return 0.f; };
        const bool wact = wid < nw;
        bf16x8 qf[8];
        float cq2 = 0.f;
        const int qlo = qpos0 + 32 * wid, qhi = qlo + 31, qpos = qlo + r;
        if (wact) { const u16* qg = (const u16*)(p.ws + W_QB) + (size_t)(row0 + 32 * wid) * 1024 + head8 * 128; LAS unsigned char* Tq = lds + A_T + wid * (32 * 272);
            { u32x4 qr[8];
#pragma unroll
              for (int i = 0; i < 8; ++i) qr[i] = *(const u32x4*)(qg + (size_t)(4 * i + (lane >> 4)) * 1024 + (lane & 15) * 8);
#pragma unroll
              for (int i = 0; i < 8; ++i) *(LAS u32x4*)(Tq + (4 * i + (lane >> 4)) * 272 + (lane & 15) * 16) = qr[i]; }
#pragma unroll
            for (int kk = 0; kk < 8; ++kk) qf[kk] = *(const LAS bf16x8*)(Tq + r * 272 + (16 * kk + 8 * h) * 2);
            if (fox) cq2 = getC(qpos) * LOG2E; }
        else {
#pragma unroll
            for (int kk = 0; kk < 8; ++kk) qf[kk] = (bf16x8){0, 0, 0, 0, 0, 0, 0, 0}; }
        float qnK = 3.0e38f;
        if (fox && prompt) { const unsigned* ks = (const unsigned*)(p.ws + W_CTR) + 64 + ((layer * 2 + bi) * 4 + hf) * 4;
            const float kmax = sqrtf(__uint_as_float(ks[0]) + __uint_as_float(ks[1]) + __uint_as_float(ks[2]) + __uint_as_float(ks[3])) * 1.01f; float qn2 = 0.f;
#pragma unroll
            for (int kk = 0; kk < 8; ++kk)
#pragma unroll
                for (int i = 0; i < 8; ++i) { const float f = __uint_as_float(((unsigned)(unsigned short)qf[kk][i]) << 16); qn2 += f * f; }
            qn2 += __shfl_xor(qn2, 32); qnK = sqrtf(qn2) * 1.01f * kmax; }
#define LOAD_TILE(jt_) do { const int k0_ = (jt_) * 64; _Pragma("unroll") for (int pz = 0; pz < 2; ++pz) { \
            kreg[pz] = *(const u32x4*)(Kb + (size_t)(k0_ + krow_ + 32 * pz) * 1024 + kch * 8); \
            vreg[pz] = *(const u32x4*)(Vt + (size_t)(vrow_ + 64 * pz) * ldv + k0_ + vch * 8); } \
            if (fox && tid < 64) ckreg = getC(k0_ + tid) * LOG2E; } while (0)
#define STORE_TILE(buf_) do { _Pragma("unroll") for (int pz = 0; pz < 2; ++pz) { \
            *(LAS u32x4*)(lds + A_KB + (buf_) * 17408 + (krow_ + 32 * pz) * KROW + kch * 16) = kreg[pz]; \
            *(LAS u32x4*)(lds + A_VB + (buf_) * 18432 + (vrow_ + 64 * pz) * VROW + vch * 16) = vreg[pz]; } \
            if (fox && tid < 64) *(LAS float*)(lds + A_CK + (buf_) * 256 + tid * 4) = ckreg; } while (0)
        if (fox && tid < 64) ckreg = getC(jt_top * 64 + tid) * LOG2E;
        STORE_TILE(0);
        __syncthreads();
        f32x16 o[4];
#pragma unroll
        for (int dt = 0; dt < 4; ++dt)
#pragma unroll
            for (int i = 0; i < 16; ++i) o[dt][i] = 0.f;
        float carry = 0.f, mrun = -1e30f, mref = 0.f, lsum = 0.f; bool wave_done = !wact;
        for (int jt = jt_top, it = 0; jt >= 0; --jt, ++it) {
            const int cur = it & 1; const bool more = jt > 0;
            if (more) LOAD_TILE(jt - 1);
            const int key0 = jt * 64;
            if (fox && prompt && !wave_done && key0 <= qhi) {
                const float ck63 = *(const LAS float*)(lds + A_CK + cur * 256 + 252);
                if (__all((qnK + cq2 - ck63) < (mrun - 152.f))) wave_done = true; }
            if (!wave_done && key0 <= qhi) {
                const bool diag = key0 + 63 >= qlo;
                const LAS unsigned char* kb = lds + A_KB + cur * 17408 + prow * KROW + 16 * h;
                const LAS unsigned char* vb = lds + A_VB + cur * 18432 + r * VROW + 16 * h;
                f32x16 sv[2];
                typedef float f32x2 __attribute__((ext_vector_type(2)));
                if (fox) {
                    const LAS float* ckb = (const LAS float*)(lds + A_CK + cur * 256) + 8 * h;
                    const float cqm = cq2 - mref; const f32x2 cqv = {cqm, cqm};
#pragma unroll
                    for (int kt = 0; kt < 2; ++kt)
#pragma unroll
                        for (int q4 = 0; q4 < 4; ++q4) { const f32x4 ck = *(const LAS f32x4*)(ckb + 32 * kt + 16 * (q4 >> 1) + 4 * (q4 & 1));
                            const f32x2 x0 = cqv - (f32x2){ck.x, ck.y}, x1 = cqv - (f32x2){ck.z, ck.w};
                            sv[kt][4 * q4 + 0] = x0.x; sv[kt][4 * q4 + 1] = x0.y; sv[kt][4 * q4 + 2] = x1.x; sv[kt][4 * q4 + 3] = x1.y; }
                } else {
#pragma unroll
                    for (int i = 0; i < 16; ++i) { sv[0][i] = 0.f; sv[1][i] = 0.f; } }
#pragma unroll
                for (int kk = 0; kk < 8; ++kk) { const bf16x8 a0 = *(const LAS bf16x8*)(kb + kk * 32); const bf16x8 a1 = *(const LAS bf16x8*)(kb + 32 * KROW + kk * 32);
                    sv[0] = __builtin_amdgcn_mfma_f32_32x32x16_bf16(a0, qf[kk], sv[0], 0, 0, 0); sv[1] = __builtin_amdgcn_mfma_f32_32x32x16_bf16(a1, qf[kk], sv[1], 0, 0, 0); }
                if (!fox) {
#pragma unroll
                    for (int kt = 1; kt >= 0; --kt) {
                        float sp[16], ex[16], tot[2];
#pragma unroll
                        for (int rg = 0; rg < 16; ++rg) { const int kpos = key0 + 32 * kt + 16 * (rg >> 3) + 8 * h + (rg & 7); const float z = sv[kt][rg];
                            const float spv = fmaxf(z, 0.f) + flog2(1.f + fexp2(-fabsf(z))); sp[rg] = (!diag || kpos < qpos) ? spv : 0.f; }
#pragma unroll
                        for (int c = 0; c < 2; ++c) { float run = 0.f;
#pragma unroll
                            for (int idx = 7; idx >= 0; --idx) { ex[8 * c + idx] = run; run += sp[8 * c + idx]; }
                            tot[c] = run; }
                        const float pt0 = __shfl_xor(tot[0], 32), pt1 = __shfl_xor(tot[1], 32);
                        const float off1 = carry + (h ? 0.f : pt1), off0 = carry + (h ? (pt1 + tot[1]) : (pt0 + tot[1] + pt1));
#pragma unroll
                        for (int rg = 0; rg < 16; ++rg) { const int kpos = key0 + 32 * kt + 16 * (rg >> 3) + 8 * h + (rg & 7);
                            const float e2 = sv[kt][rg] - sp[rg] - ((rg >= 8 ? off1 : off0) + ex[rg]);
                            sv[kt][rg] = (!diag || kpos < qpos) ? fexp2(e2) : 0.f; }
                        carry += (tot[0] + tot[1]) + (pt0 + pt1);
                    }
                    if (__all(carry > 152.f)) wave_done = true;
                } else {
                    if (diag) {
#pragma unroll
                        for (int kt = 0; kt < 2; ++kt)
#pragma unroll
                            for (int rg = 0; rg < 16; ++rg) { const int kpos = key0 + 32 * kt + 16 * (rg >> 3) + 8 * h + (rg & 7); if (kpos > qpos) sv[kt][rg] = -1e30f; } }
                    float mx = -1e30f;
#pragma unroll
                    for (int kt = 0; kt < 2; ++kt)
#pragma unroll
                        for (int i = 0; i < 8; ++i) mx = fmax3(mx, sv[kt][2 * i], sv[kt][2 * i + 1]);
                    mx = fmaxf(mx, __shfl_xor(mx, 32));
                    const bool firstt = mrun < -1e29f;
                    mrun = fmaxf(mrun, mref + mx);
                    if (firstt || __any(mx > 0.f)) {
                        const float dlt = firstt ? mx : fmaxf(mx, 0.f), alpha = fexp2(-dlt); mref += dlt; lsum *= alpha; const f32x2 dv = {dlt, dlt};
#pragma unroll
                        for (int dt = 0; dt < 4; ++dt) o[dt] *= alpha;
#pragma unroll
                        for (int kt = 0; kt < 2; ++kt)
#pragma unroll
                            for (int i = 0; i < 8; ++i) { const f32x2 t = (f32x2){sv[kt][2 * i], sv[kt][2 * i + 1]} - dv; sv[kt][2 * i] = t.x; sv[kt][2 * i + 1] = t.y; } }
                    f32x2 ps2 = {0.f, 0.f};
#pragma unroll
                    for (int kt = 0; kt < 2; ++kt)
#pragma unroll
                        for (int i = 0; i < 8; ++i) { f32x2 e; e.x = fexp2(sv[kt][2 * i]); e.y = fexp2(sv[kt][2 * i + 1]); sv[kt][2 * i] = e.x; sv[kt][2 * i + 1] = e.y; ps2 += e; }
                    lsum += ps2.x + ps2.y;
                }
#pragma unroll
                for (int kt = 0; kt < 2; ++kt)
#pragma unroll
                    for (int c = 0; c < 2; ++c) { union { u32x4 u; bf16x8 v; } pf;
                        pf.u.x = cvt_pk_bf16(sv[kt][8 * c + 0], sv[kt][8 * c + 1]); pf.u.y = cvt_pk_bf16(sv[kt][8 * c + 2], sv[kt][8 * c + 3]);
                        pf.u.z = cvt_pk_bf16(sv[kt][8 * c + 4], sv[kt][8 * c + 5]); pf.u.w = cvt_pk_bf16(sv[kt][8 * c + 6], sv[kt][8 * c + 7]);
#pragma unroll
                        for (int dt = 0; dt < 4; ++dt) { const bf16x8 vf = *(const LAS bf16x8*)(vb + dt * 32 * VROW + (32 * kt + 16 * c) * 2);
                            o[dt] = __builtin_amdgcn_mfma_f32_32x32x16_bf16(vf, pf.v, o[dt], 0, 0, 0); } }
            }
            if (more) STORE_TILE(cur ^ 1);
            if (lane == 0) misc[8 + cur * 8 + wid] = wave_done ? 1 : 0;
            __syncthreads();
            int alld = 1;
#pragma unroll
            for (int w = 0; w < 8; ++w) alld &= misc[8 + cur * 8 + w];
            if (alld) break;
        }
#undef LOAD_TILE
#undef STORE_TILE
        if (wact) {
            if (fox) { lsum += __shfl_xor(lsum, 32); const float inv = 1.f / lsum;
#pragma unroll
                for (int dt = 0; dt < 4; ++dt) o[dt] *= inv; }
            float ss = 0.f;
#pragma unroll
            for (int dt = 0; dt < 4; ++dt)
#pragma unroll
                for (int i = 0; i < 16; ++i) ss += o[dt][i] * o[dt][i];
            ss += __shfl_xor(ss, 32);
            const float rn = rsqrtf(ss * (1.f / 128.f) + EPS);
            const float* gp = (fox ? p.g_ofox : p.g_osb) + layer * 512 + hf * 128 + 4 * h;
            const u16* zg = (const u16*)(p.ws + W_ZB) + (size_t)(row0 + 32 * wid) * 1024 + head8 * 128;
            u16* og = (u16*)(p.ws + W_OB) + (size_t)(row0 + 32 * wid) * 1024 + head8 * 128;
            LAS unsigned char* Tz = lds + A_T + wid * (32 * 272);
            { u32x4 zr[8];
#pragma unroll
              for (int i = 0; i < 8; ++i) zr[i] = *(const u32x4*)(zg + (size_t)(4 * i + (lane >> 4)) * 1024 + (lane & 15) * 8);
#pragma unroll
              for (int i = 0; i < 8; ++i) *(LAS u32x4*)(Tz + (4 * i + (lane >> 4)) * 272 + (lane & 15) * 16) = zr[i]; }
#pragma unroll
            for (int dt = 0; dt < 4; ++dt)
#pragma unroll
                for (int bb = 0; bb < 4; ++bb) { const int d = 32 * dt + 8 * bb; const f32x4 g = *(const f32x4*)(gp + d); LAS u32x2* tp = (LAS u32x2*)(Tz + r * 272 + (d + 4 * h) * 2); const u32x2 z2 = *tp;
                    const float v0 = o[dt][4 * bb + 0] * rn * g.x * bf_lo(z2.x), v1 = o[dt][4 * bb + 1] * rn * g.y * bf_hi(z2.x), v2 = o[dt][4 * bb + 2] * rn * g.z * bf_lo(z2.y), v3 = o[dt][4 * bb + 3] * rn * g.w * bf_hi(z2.y);
                    u32x2 w; w.x = cvt_pk_bf16(v0, v1); w.y = cvt_pk_bf16(v2, v3); *tp = w; }
#pragma unroll
            for (int i = 0; i < 8; ++i) { const u32x4 w = *(const LAS u32x4*)(Tz + (4 * i + (lane >> 4)) * 272 + (lane & 15) * 16); *(u32x4*)(og + (size_t)(4 * i + (lane >> 4)) * 1024 + (lane & 15) * 8) = w; }
        }
    }
}

__device__ __forceinline__ void final_phase(int wv, const P& p) {
    const int tid = opaque_tid(wv), wid = tid >> 6, lane = tid & 63;
    const float* ssqA = (const float*)(p.ws + W_SSQA);
    for (int row = blockIdx.x * 8 + wid; row < NR; row += gridDim.x * 8) {
        float s = lane < 32 ? ssqA[(size_t)row * 32 + lane] : 0.f;
#pragma unroll
        for (int d = 1; d < 64; d <<= 1) s += __shfl_xor(s, d);
        const float rs = rsqrtf(s * (1.f / 2048.f) + EPS);
        float* xo = p.out + (size_t)row * 2048; const u16* xb = (const u16*)(p.ws + W_XBA) + (size_t)row * 2048;
#pragma unroll
        for (int i = 0; i < 8; ++i) { const int c = (i * 64 + lane) * 4; const u32x2 xw = *(const u32x2*)(xb + c); const f32x4 g = *(const f32x4*)(p.g_final + c);
            f32x4 v; v.x = bf_lo(xw.x) * rs * g.x; v.y = bf_hi(xw.x) * rs * g.y; v.z = bf_lo(xw.y) * rs * g.z; v.w = bf_hi(xw.y) * rs * g.w; *(f32x4*)(xo + c) = v; }
    }
}

constexpr int LDS_BYTES = 131072 + 8 * 2304 + 2048;

__global__ __launch_bounds__(512, 2) void fwd_megakernel(P p) {
    extern __shared__ __attribute__((aligned(16))) unsigned char shm[];
    LAS unsigned char* lds = (LAS unsigned char*)shm;
    cg::grid_group grid = cg::this_grid();
    const int wv = __builtin_amdgcn_readfirstlane(threadIdx.x >> 6);
    prep_phase(wv, p, lds);
    grid.sync();
    pg8::StaticOrder S;
    for (int layer_ = 0; layer_ < DEPTH; ++layer_) {
        int layer = layer_, bid = (int)blockIdx.x, G = (int)gridDim.x; asm volatile("" : "+s"(layer), "+s"(bid), "+s"(G));
        {
            pg8::Gemm g{(const u16*)(p.ws + W_XBA), (const u16*)(p.ws + W_WTIN) + (size_t)layer * 4096 * 2048, NP, 4096, 2048};
            S.init(g.M, g.N, G, bid); LAS float* rt = (LAS float*)(lds + RTAB_OFF); const int rp = rstd_table(wv, (const float*)(p.ws + W_SSQA), S, rt);
            EpiProj E{p, layer, lds, rp >= 0 ? rt : nullptr, rp};
            pg8::gemm_phase(wv, lds, g, S, E);
            logf_items(wv, p, layer, lds, bid, NP / 128, G);
        }
        grid.sync();
        attn_phase(wv, p, layer, lds);
        grid.sync();
        {
            for (int rep = 0; rep < 2; ++rep) {
                if ((rep ^ ((bid >> 2) & 1)) == 0) {
                    pg8::Gemm g{(const u16*)(p.ws + W_OB), (const u16*)(p.ws + W_WTOUT) + (size_t)layer * 2048 * 1024, NP, 2048, 1024};
                    S.init(g.M, g.N, G, bid); EpiOut E{p, lds};
                    pg8::gemm_phase(wv, lds, g, S, E);
                } else {
                    pg8::Gemm g2{(const u16*)(p.ws + W_PB) + (size_t)layer * NR * 256, (const u16*)(p.ws + W_WTPLE) + (size_t)layer * 2048 * 256, NP, 2048, 256};
                    S.init(g2.M, g2.N, G, bid); EpiPle E2{p, lds};
                    pg8::gemm_phase(wv, lds, g2, S, E2);
                }
            }
        }
        grid.sync();
        {
            pg8::Gemm g{(const u16*)(p.ws + W_XBB), (const u16*)(p.ws + W_WTGATE) + (size_t)layer * 2048 * 2048, NP, 2048, 2048};
            S.init(g.M, g.N, G, bid); LAS float* rt = (LAS float*)(lds + RTAB_OFF); const int rp = rstd_table(wv, (const float*)(p.ws + W_SSQB), S, rt);
            EpiGate E{p, lds, rp >= 0 ? rt : nullptr, rp};
            pg8::gemm_phase(wv, lds, g, S, E);
        }
        grid.sync();
    }
    final_phase(wv, p);
}

extern "C" void kernel_launch(void* const* d_in, const int* in_sizes, int n_in, void* d_out, int out_size, void* d_ws, size_t ws_size, hipStream_t stream) {
    static int grid_blocks = 0;
    if (!grid_blocks) {
        if (n_in != 19 || (size_t)out_size != OUT_TOTAL || ws_size < W_END) { fprintf(stderr, "kernel_launch: unexpected shapes: n_in %d out %d (want %zu) ws %zu (want %zu)\n", n_in, out_size, OUT_TOTAL, ws_size, W_END); grid_blocks = -1; return; }
        int dev = 0, cus = 0, per_cu = 0;
        hipGetDevice(&dev);
        hipDeviceGetAttribute(&cus, hipDeviceAttributeMultiprocessorCount, dev);
        if (hipFuncSetAttribute((const void*)fwd_megakernel, hipFuncAttributeMaxDynamicSharedMemorySize, LDS_BYTES) != hipSuccess) fprintf(stderr, "kernel_launch: hipFuncSetAttribute failed\n");
        if (hipOccupancyMaxActiveBlocksPerMultiprocessor(&per_cu, (const void*)fwd_megakernel, 512, LDS_BYTES) != hipSuccess || per_cu < 1) { fprintf(stderr, "kernel_launch: occupancy query gave %d\n", per_cu); per_cu = 1; }
        (void)hipGetLastError();
        grid_blocks = cus * per_cu;
    }
    if (grid_blocks < 0) return;
    P p{};
    const float** f = (const float**)&p;
    for (int i = 0; i < 19; ++i) f[i] = (const float*)d_in[i];
    p.out = (float*)d_out; p.ws = (unsigned char*)d_ws;
    void* args[] = {&p};
    hipError_t e = hipLaunchCooperativeKernel((const void*)fwd_megakernel, dim3(grid_blocks), dim3(512), args, LDS_BYTES, stream);
    if (e != hipSuccess) fprintf(stderr, "cooperative launch failed: %s (grid %d)\n", hipGetErrorString(e), grid_blocks);
}
```
